# Optimizing an MI355X kernel written in HIP

```python
import jax, jax.numpy as jnp
from jax import lax
import numpy as np

D_MODEL = 2048
BATCH = 4
SEQ = 2048
DEPTH = 2

MEM_LEN = 256
GRID_W = 64
ROPE_THETA = 10000.0
EPS = 1e-6

N_BRANCH = 4
BRANCH_W = D_MODEL // 4

NA_HEADS = 4
NA_HD = BRANCH_W // NA_HEADS
NA_WIN_R = 8
NA_WIN_C = 16

MLA_HEADS = 4
MLA_NOPE = 128
MLA_ROPE = 64
MLA_V = BRANCH_W // MLA_HEADS
MLA_Q_RANK = (3 * D_MODEL) // 8
MLA_KV_RANK = D_MODEL // 8

SWA_HEADS = 8
SWA_KV_HEADS = 2
SWA_HD = BRANCH_W // SWA_HEADS
SWA_WINDOW = 128
SWA_BLOCK = 128

MEM_HEADS = 4
MEM_HD = BRANCH_W // MEM_HEADS

Q_BLOCK = 128

D_FF = 5632
N_EXPERTS = 8
TOP_K = 2
D_FF_EXPERT = 7168
N_DENSE = (DEPTH + 1) // 2
N_MOE = DEPTH // 2

SPLIT_SIZES = [NA_HEADS * NA_HD, NA_HEADS * NA_HD, NA_HEADS * NA_HD,
               MLA_Q_RANK, MLA_KV_RANK, MLA_ROPE,
               SWA_HEADS * SWA_HD, SWA_KV_HEADS * SWA_HD, SWA_KV_HEADS * SWA_HD,
               MEM_HEADS * MEM_HD]
IN_COLS = int(sum(SPLIT_SIZES))
SPLIT_POINTS = [int(c) for c in np.cumsum(SPLIT_SIZES)[:-1]]

kernel_name = "hybrid_gated_parallel_mixer_encoder"


def rmsnorm(x, g):
    xf = x.astype(jnp.float32)
    y = xf * lax.rsqrt(jnp.mean(xf * xf, axis=-1, keepdims=True) + EPS)
    return (y * g.astype(jnp.float32)).astype(x.dtype)


def rope(x, pos):
    d = x.shape[-1]
    half = d // 2
    freqs = ROPE_THETA ** (-2.0 * jnp.arange(half, dtype=jnp.float32) / d)
    ang = pos.astype(jnp.float32)[:, None] * freqs[None, :]
    cos = jnp.cos(ang)[:, None, :]
    sin = jnp.sin(ang)[:, None, :]
    xf = x.astype(jnp.float32)
    x1, x2 = xf[..., :half], xf[..., half:]
    return jnp.concatenate([x1 * cos - x2 * sin, x2 * cos + x1 * sin], axis=-1).astype(x.dtype)


def neighbourhood_attention(q, k, v, rpb):
    B, S, H, D = q.shape
    rows = S // GRID_W
    wr = min(NA_WIN_R, rows)
    qg = q.reshape(B, rows, GRID_W, H, D)
    kg = k.reshape(B, rows, GRID_W, H, D)
    vg = v.reshape(B, rows, GRID_W, H, D)
    col = jnp.arange(GRID_W)
    col_start = jnp.clip(col - NA_WIN_C // 2, 0, GRID_W - NA_WIN_C)
    col_idx = col_start[:, None] + jnp.arange(NA_WIN_C)[None, :]
    dc = col_idx - col[:, None] + (NA_WIN_C - 1)
    scale = D ** -0.5

    def row_block(args):
        r, q_r = args
        rs = jnp.clip(r - wr // 2, 0, rows - wr)
        k_rows = lax.dynamic_slice_in_dim(kg, rs, wr, axis=1)
        v_rows = lax.dynamic_slice_in_dim(vg, rs, wr, axis=1)
        k_nb = k_rows[:, :, col_idx]
        v_nb = v_rows[:, :, col_idx]
        s = jnp.einsum('bqhd,biqjhd->bhqij', q_r, k_nb).astype(jnp.float32) * scale
        dr = rs + jnp.arange(wr) - r + (NA_WIN_R - 1)
        bias = rpb[:, dr][:, :, dc].astype(jnp.float32)
        s = s + jnp.transpose(bias, (0, 2, 1, 3))[None]
        p = jax.nn.softmax(s.reshape(B, H, GRID_W, wr * NA_WIN_C), axis=-1)
        p = p.reshape(B, H, GRID_W, wr, NA_WIN_C).astype(v.dtype)
        return jnp.einsum('bhqij,biqjhd->bqhd', p, v_nb)

    o = lax.map(row_block, (jnp.arange(rows), jnp.transpose(qg, (1, 0, 2, 3, 4))))
    return jnp.transpose(o, (1, 0, 2, 3, 4)).reshape(B, S, H * D)


def dense_block_attention(q, k, v, scale):
    B, S, H, Dq = q.shape
    Dv = v.shape[-1]
    nb = S // Q_BLOCK
    qb = jnp.transpose(q.reshape(B, nb, Q_BLOCK, H, Dq), (1, 0, 2, 3, 4))

    def one(q_blk):
        s = jnp.einsum('bqhd,bkhd->bhqk', q_blk, k).astype(jnp.float32) * scale
        p = jax.nn.softmax(s, axis=-1).astype(v.dtype)
        return jnp.einsum('bhqk,bkhd->bqhd', p, v)

    o = lax.map(one, qb)
    return jnp.transpose(o, (1, 0, 2, 3, 4)).reshape(B, S, H * Dv)


def mla_branch(c_q, c_kv, k_pe, pos, g_cq, w_uq, g_ckv, w_ukv, g_qn, g_kn):
    B, S, _ = c_q.shape
    q = (rmsnorm(c_q, g_cq) @ w_uq).reshape(B, S, MLA_HEADS, MLA_NOPE + MLA_ROPE)
    kv = (rmsnorm(c_kv, g_ckv) @ w_ukv).reshape(B, S, MLA_HEADS, MLA_NOPE + MLA_V)
    k_nope, v = kv[..., :MLA_NOPE], kv[..., MLA_NOPE:]
    k_rope = jnp.broadcast_to(k_pe[:, :, None, :], (B, S, MLA_HEADS, MLA_ROPE))
    k = jnp.concatenate([k_nope, k_rope], axis=-1)
    q = rmsnorm(q, g_qn)
    k = rmsnorm(k, g_kn)
    q = jnp.concatenate([q[..., :MLA_NOPE], rope(q[..., MLA_NOPE:], pos)], axis=-1)
    k = jnp.concatenate([k[..., :MLA_NOPE], rope(k[..., MLA_NOPE:], pos)], axis=-1)
    return dense_block_attention(q, k, v, (MLA_NOPE + MLA_ROPE) ** -0.5)


def sliding_window_gqa(q, k, v, sink):
    B, S, Hq, D = q.shape
    Hkv = k.shape[2]
    G = Hq // Hkv
    nb = S // SWA_BLOCK
    padw = ((0, 0), (SWA_BLOCK, SWA_BLOCK), (0, 0), (0, 0))
    kb = jnp.pad(k, padw).reshape(B, nb + 2, SWA_BLOCK, Hkv, D)
    vb = jnp.pad(v, padw).reshape(B, nb + 2, SWA_BLOCK, Hkv, D)
    k_band = jnp.concatenate([kb[:, :-2], kb[:, 1:-1], kb[:, 2:]], axis=2)
    v_band = jnp.concatenate([vb[:, :-2], vb[:, 1:-1], vb[:, 2:]], axis=2)
    qb = q.reshape(B, nb, SWA_BLOCK, Hkv, G, D)
    s = jnp.einsum('bnqhgd,bnkhd->bnhgqk', qb, k_band).astype(jnp.float32) * (D ** -0.5)
    qpos = jnp.arange(nb)[:, None] * SWA_BLOCK + jnp.arange(SWA_BLOCK)[None, :]
    kpos = jnp.arange(nb)[:, None] * SWA_BLOCK - SWA_BLOCK + jnp.arange(3 * SWA_BLOCK)[None, :]
    valid = ((jnp.abs(qpos[:, :, None] - kpos[:, None, :]) <= SWA_WINDOW)
             & (kpos >= 0)[:, None, :] & (kpos < S)[:, None, :])
    s = jnp.where(valid[None, :, None, None], s, -1e30)
    sink_b = jnp.broadcast_to(sink.astype(jnp.float32).reshape(1, 1, Hkv, G, 1, 1),
                              s.shape[:-1] + (1,))
    p = jax.nn.softmax(jnp.concatenate([s, sink_b], axis=-1), axis=-1)[..., :-1]
    o = jnp.einsum('bnhgqk,bnkhd->bnqhgd', p.astype(v.dtype), v_band)
    return o.reshape(B, S, Hq * D)


def memory_attention(q, k, v):
    B, S, H, D = q.shape
    s = jnp.einsum('bshd,bmhd->bhsm', q, k).astype(jnp.float32) * (D ** -0.5)
    p = jax.nn.softmax(s, axis=-1).astype(v.dtype)
    return jnp.einsum('bhsm,bmhd->bshd', p, v).reshape(B, S, H * D)


def swiglu(x, w_up, w_down):
    g, u = jnp.split(x @ w_up, 2, axis=-1)
    return (jax.nn.silu(g) * u) @ w_down


def moe_swiglu(x, w_router, w_up, w_down):
    logits = (x @ w_router).astype(jnp.float32)
    top_v, top_i = lax.top_k(logits, TOP_K)
    top_w = jax.nn.softmax(top_v, axis=-1)
    combine = jnp.sum(jax.nn.one_hot(top_i, N_EXPERTS, dtype=jnp.float32) * top_w[..., None], axis=-2)
    combine = combine.astype(x.dtype)
    out = jnp.zeros_like(x)
    for e in range(N_EXPERTS):
        out = out + combine[..., e:e + 1] * swiglu(x, w_up[e], w_down[e])
    return out


def setup_inputs(seed: int = 0) -> dict:
    key = jax.random.key(seed)
    ks = iter(jax.random.split(key, 40))
    f32 = jnp.float32

    def normal(shape, scale):
        return jax.random.normal(next(ks), shape, f32) * scale

    def gain(shape):
        return 1.0 + normal(shape, 0.02)

    D = D_MODEL
    return {
        "x": normal((BATCH, SEQ, D), 1.0),
        "mem": normal((BATCH, MEM_LEN, D), 1.0),
        "norm_mix": gain((DEPTH, D)),
        "w_in": normal((DEPTH, D, IN_COLS), D ** -0.5),
        "na_q_norm": gain((DEPTH, NA_HD)),
        "na_k_norm": gain((DEPTH, NA_HD)),
        "na_rpb": normal((DEPTH, NA_HEADS, 2 * NA_WIN_R - 1, 2 * NA_WIN_C - 1), 0.1),
        "mla_cq_norm": gain((DEPTH, MLA_Q_RANK)),
        "mla_w_uq": normal((DEPTH, MLA_Q_RANK, MLA_HEADS * (MLA_NOPE + MLA_ROPE)), MLA_Q_RANK ** -0.5),
        "mla_ckv_norm": gain((DEPTH, MLA_KV_RANK)),
        "mla_w_ukv": normal((DEPTH, MLA_KV_RANK, MLA_HEADS * (MLA_NOPE + MLA_V)), MLA_KV_RANK ** -0.5),
        "mla_q_norm": gain((DEPTH, MLA_NOPE + MLA_ROPE)),
        "mla_k_norm": gain((DEPTH, MLA_NOPE + MLA_ROPE)),
        "swa_q_norm": gain((DEPTH, SWA_HD)),
        "swa_k_norm": gain((DEPTH, SWA_HD)),
        "swa_sink": normal((DEPTH, SWA_HEADS), 0.5),
        "mem_norm": gain((DEPTH, D)),
        "mem_w_kv": normal((DEPTH, D, 2 * MEM_HEADS * MEM_HD), D ** -0.5),
        "mem_q_norm": gain((DEPTH, MEM_HD)),
        "mem_k_norm": gain((DEPTH, MEM_HD)),
        "w_branch": normal((DEPTH, N_BRANCH, BRANCH_W, D), BRANCH_W ** -0.5),
        "w_gate": normal((DEPTH, D, N_BRANCH, D), D ** -0.5),
        "b_gate": normal((DEPTH, N_BRANCH, D), 0.1),
        "w_o": normal((DEPTH, D, D), (N_BRANCH * D) ** -0.5),
        "norm_ffn": gain((DEPTH, D)),
        "ffn_w_up": normal((N_DENSE, D, 2 * D_FF), D ** -0.5),
        "ffn_w_down": normal((N_DENSE, D_FF, D), D_FF ** -0.5),
        "moe_router": normal((N_MOE, D, N_EXPERTS), D ** -0.5),
        "moe_w_up": normal((N_MOE, N_EXPERTS, D, 2 * D_FF_EXPERT), D ** -0.5),
        "moe_w_down": normal((N_MOE, N_EXPERTS, D_FF_EXPERT, D), D_FF_EXPERT ** -0.5),
    }


def reference(x, mem, norm_mix, w_in, na_q_norm, na_k_norm, na_rpb,
              mla_cq_norm, mla_w_uq, mla_ckv_norm, mla_w_ukv, mla_q_norm, mla_k_norm,
              swa_q_norm, swa_k_norm, swa_sink,
              mem_norm, mem_w_kv, mem_q_norm, mem_k_norm,
              w_branch, w_gate, b_gate, w_o, norm_ffn,
              ffn_w_up, ffn_w_down, moe_router, moe_w_up, moe_w_down):
    B, S, _ = x.shape
    M = mem.shape[1]
    pos = jnp.arange(S)
    h = x
    for l in range(DEPTH):
        u = rmsnorm(h, norm_mix[l])
        z = u @ w_in[l]
        (na_q, na_k, na_v, c_q, c_kv, k_pe,
         sw_q, sw_k, sw_v, me_q) = jnp.split(z, SPLIT_POINTS, axis=-1)

        qa = rmsnorm(na_q.reshape(B, S, NA_HEADS, NA_HD), na_q_norm[l])
        ka = rmsnorm(na_k.reshape(B, S, NA_HEADS, NA_HD), na_k_norm[l])
        va = na_v.reshape(B, S, NA_HEADS, NA_HD)
        o_na = neighbourhood_attention(qa, ka, va, na_rpb[l])

        o_mla = mla_branch(c_q, c_kv, k_pe, pos, mla_cq_norm[l], mla_w_uq[l],
                           mla_ckv_norm[l], mla_w_ukv[l], mla_q_norm[l], mla_k_norm[l])

        qc = rope(rmsnorm(sw_q.reshape(B, S, SWA_HEADS, SWA_HD), swa_q_norm[l]), pos)
        kc = rope(rmsnorm(sw_k.reshape(B, S, SWA_KV_HEADS, SWA_HD), swa_k_norm[l]), pos)
        vc = sw_v.reshape(B, S, SWA_KV_HEADS, SWA_HD)
        o_swa = sliding_window_gqa(qc, kc, vc, swa_sink[l])

        mkv = (rmsnorm(mem, mem_norm[l]) @ mem_w_kv[l]).reshape(B, M, 2, MEM_HEADS, MEM_HD)
        mk = rmsnorm(mkv[:, :, 0], mem_k_norm[l])
        mv = mkv[:, :, 1]
        mq = rmsnorm(me_q.reshape(B, S, MEM_HEADS, MEM_HD), mem_q_norm[l])
        o_mem = memory_attention(mq, mk, mv)

        br = jnp.stack([o_na, o_mla, o_swa, o_mem], axis=2)
        proj = jnp.einsum('bsnc,ncd->bsnd', br, w_branch[l])
        gate_logits = jnp.einsum('bsd,dne->bsne', u, w_gate[l]) + b_gate[l]
        gates = jax.nn.sigmoid(gate_logits.astype(jnp.float32)).astype(proj.dtype)
        merged = jnp.einsum('bsnd,bsnd->bsd', gates, proj)
        h = h + merged @ w_o[l]

        hn = rmsnorm(h, norm_ffn[l])
        if l % 2 == 0:
            h = h + swiglu(hn, ffn_w_up[l // 2], ffn_w_down[l // 2])
        else:
            h = h + moe_swiglu(hn, moe_router[l // 2], moe_w_up[l // 2], moe_w_down[l // 2])
    return h
```

```cpp
#include <hip/hip_runtime.h>
#include <cstdio>
#include <cstdint>

#define LAS __attribute__((address_space(3)))
typedef unsigned short bf16_t;
typedef short bf16x8 __attribute__((ext_vector_type(8)));
typedef float f32x4 __attribute__((ext_vector_type(4)));
typedef float f32x2 __attribute__((ext_vector_type(2)));
typedef unsigned u32x4 __attribute__((ext_vector_type(4)));
typedef unsigned u32x2 __attribute__((ext_vector_type(2)));

#ifndef MK_MULTI
#define MK_MULTI 0
#endif

constexpr int DM = 2048, NBATCH = 4, SEQ = 2048, NTOK = NBATCH * SEQ, MEML = 256, NMEM = NBATCH * MEML, DEPTH = 2;
constexpr int ZC = 4096;
constexpr int INC = 3904;
constexpr int Z_NAQ = 0, Z_NAK = 512, Z_NAV = 1024, Z_CQ = 1536, Z_CKV = 2304, Z_KPE = 2560, Z_SWQ = 2624, Z_SWK = 3136, Z_SWV = 3264, Z_MEQ = 3392;
constexpr int DFF = 5632, NEXP = 8, DFFE = 7168, ECAP = 8192;
constexpr float LOG2E = 1.4426950408889634f;
constexpr float EPS = 1e-6f;
constexpr int NTHREADS = 512;

constexpr size_t al256(size_t x) { return (x + 255) & ~(size_t)255; }
constexpr size_t WS_CTL = 0, CTL_BYTES = 65536;
constexpr size_t WS_ROPE = WS_CTL + CTL_BYTES;
constexpr size_t WS_LW = WS_ROPE + (size_t)SEQ * 32 * 8;
constexpr size_t LW_INGATE = 0;
constexpr size_t LW_UQ = LW_INGATE + (size_t)12288 * 2048 * 2;
constexpr size_t LW_UKV = LW_UQ + (size_t)768 * 768 * 2;
constexpr size_t LW_MEMKV = LW_UKV + (size_t)1024 * 256 * 2;
constexpr size_t LW_BR = LW_MEMKV + (size_t)1024 * 2048 * 2;
constexpr size_t LW_O = LW_BR + (size_t)4 * 2048 * 512 * 2;
constexpr size_t LW_BYTES = LW_O + (size_t)2048 * 2048 * 2;
constexpr size_t WS_FFNUP = WS_LW + 2 * LW_BYTES;
constexpr size_t WS_FFNDN = WS_FFNUP + (size_t)2 * DFF * 2048 * 2;
constexpr size_t WS_MOEUP = WS_FFNDN + (size_t)2048 * DFF * 2;
constexpr size_t WS_MOEDN = WS_MOEUP + (size_t)NEXP * 2 * DFFE * 2048 * 2;
constexpr size_t WS_U = WS_MOEDN + (size_t)NEXP * 2048 * DFFE * 2;
constexpr size_t WS_MEMN = WS_U + (size_t)NTOK * DM * 2;
constexpr size_t WS_Z = WS_MEMN + (size_t)2 * NMEM * DM * 2;
constexpr size_t WS_GATES = WS_Z + (size_t)NTOK * ZC * 2;
constexpr size_t WS_NAQ = WS_GATES + (size_t)NTOK * 8192 * 2;
constexpr size_t WS_NAK = WS_NAQ + (size_t)NTOK * 512 * 2;
constexpr size_t WS_NAVT = WS_NAK + (size_t)NTOK * 512 * 2;
constexpr size_t WS_CQN = WS_NAVT + (size_t)NTOK * 512 * 2;
constexpr size_t WS_CKVN = WS_CQN + (size_t)NTOK * 768 * 2;
constexpr size_t WS_SWQ = WS_CKVN + (size_t)NTOK * 256 * 2;
constexpr size_t WS_SWK = WS_SWQ + (size_t)NTOK * 512 * 2;
constexpr size_t WS_SWVT = WS_SWK + (size_t)NTOK * 128 * 2;
constexpr size_t WS_MEQ = WS_SWVT + (size_t)NTOK * 128 * 2;
constexpr size_t WS_QRAW = WS_MEQ + (size_t)NTOK * 512 * 2;
constexpr size_t WS_KVRAW = WS_QRAW + (size_t)NTOK * 768 * 2;
constexpr size_t WS_MEMKV = WS_KVRAW + (size_t)NTOK * 1024 * 2;
constexpr size_t WS_MLQ = WS_MEMKV + (size_t)2 * NMEM * 1024 * 2;
constexpr size_t WS_MLK = WS_MLQ + (size_t)NTOK * 768 * 2;
constexpr size_t WS_MLVT = WS_MLK + (size_t)NTOK * 768 * 2;
constexpr size_t WS_MEK = WS_MLVT + (size_t)NTOK * 512 * 2;
constexpr size_t WS_MEVT = WS_MEK + (size_t)NMEM * 512 * 2;
constexpr size_t WS_BR = WS_MEVT + (size_t)NMEM * 512 * 2;
constexpr size_t WS_MERGED = WS_BR + (size_t)NTOK * DM * 2;
constexpr size_t WS_ACT = WS_MERGED + (size_t)NTOK * DM * 2;
constexpr size_t WS_XG = WS_ACT + (size_t)NTOK * DFF * 2;
constexpr size_t WS_TOK = WS_XG + (size_t)NEXP * ECAP * DM * 2;
constexpr size_t WS_WT = WS_TOK + (size_t)NEXP * ECAP * 4;
constexpr size_t WS_ACTM = WS_WT + (size_t)NEXP * ECAP * 4;
constexpr size_t WS_END = WS_ACTM + (size_t)NEXP * ECAP * DFFE * 2;

constexpr int CW_BAR = 0;
constexpr int CW_MOECNT = 4096;
constexpr int CW_ATTQ = 4096 + 1024;

constexpr int LDS_BYTES = 147456;
constexpr int LDS_MISC = 147456 - 1024;
namespace pg8 {
constexpr int BM = 256, BK = 64, HALF = 128, HTB = HALF * BK * 2, STAGE_BYTES = 8 * HTB, NXCD = 8, WGM = 8;
__host__ __device__ __forceinline__ int lds_byte(int r, int c) { const int st = (r >> 4) * 2 + (c >> 5), rr = r & 15, cc = c & 31, ob = rr * 64 + cc * 2; return st * 1024 + (ob ^ (((ob >> 9) & 1) << 5)); }
__host__ __device__ __forceinline__ void stage_rc(int b, int& R, int& C) { const int st = b / 1024, sb = b % 1024, swz = sb ^ (((sb >> 9) & 1) << 5); R = (st >> 1) * 16 + swz / 64; C = (st & 1) * 32 + (swz % 64) / 2; }
__host__ __device__ __forceinline__ int perm32(int rho) { const int n = rho >> 4, i = rho & 15; return 8 * (i >> 2) + 4 * n + (i & 3); }

struct Unit { const char* A; const char* B; int orow, ocol, x0, x1; };

__device__ __forceinline__ bool static_tile(int i, int G, int c, int nM, int nN, int& pm, int& pn) {
    const int nwg = nM * nN; const long L = (long)i * G + c; if (L >= nwg) return false;
    int wgid = (int)L; { const int q = nwg / NXCD, r = nwg % NXCD, xcd = wgid % NXCD, off = wgid / NXCD; wgid = (xcd < r ? xcd * (q + 1) : r * (q + 1) + (xcd - r) * q) + off; }
    const int nig = WGM * nN, gid = wgid / nig, fm = gid * WGM, gsz = (nM - fm) < WGM ? (nM - fm) : WGM;
    pm = fm + ((wgid % nig) % gsz); pn = (wgid % nig) / gsz; return true;
}
struct SchedGrid {
    const char* A; const char* B; int lda, ldb, nM, nN, G, c;
    __device__ __forceinline__ bool next(int i, Unit& u) const {
        int pm, pn; if (!static_tile(i, G, c, nM, nN, pm, pn)) return false;
        u.A = A + (size_t)pm * 256 * lda * 2; u.B = B + (size_t)pn * 256 * ldb * 2; u.orow = pm * 256; u.ocol = pn; u.x0 = 0; u.x1 = 0; return true;
    }
};

__device__ __forceinline__ unsigned cvt_pk_bf16(float lo, float hi) { unsigned r; asm volatile("v_cvt_pk_bf16_f32 %0, %1, %2" : "=v"(r) : "v"(lo), "v"(hi)); return r; }
__device__ __forceinline__ float sigmoidf_(float x) { return __builtin_amdgcn_rcpf(1.0f + __builtin_amdgcn_exp2f(-x * LOG2E)); }

typedef f32x4 Acc[2][2][4][2];

template <class Epi, class Sched>
__device__ __forceinline__ void gemm_phase(LAS unsigned char* lds, const int lda, const int ldb, const int K, const Sched S, Epi& E, const int tid) {
    const int wid = __builtin_amdgcn_readfirstlane(tid >> 6), lane = tid & 63, wr = wid >> 2, wc = wid & 3, fr = lane & 15, fq = lane >> 4;
    const int nt = K / BK;
    unsigned voffA[2], voffB[2];
#pragma unroll
    for (int i = 0; i < 2; ++i) { int R, C; stage_rc(tid * 16 + i * 8192, R, C); const int Rb = Epi::PERM ? ((R & ~31) + perm32(R & 31)) : R;
        voffA[i] = (unsigned)(R * lda + C) * 2u; voffB[i] = (unsigned)(Rb * ldb + C) * 2u; }
    const size_t kstep = (size_t)(BK * 2);
    const size_t hstepA = (size_t)HALF * lda * 2, hstepB = (size_t)HALF * ldb * 2;
    const unsigned ldsw = (unsigned)wid * 1024u;
    const int aoff = lds_byte(wr * 64 + fr, fq * 8), boff = lds_byte(wc * 32 + fr, fq * 8);
#define PG8_SA(b, h) (((b) * 2 + (h)) * HTB)
#define PG8_SB(b, h) ((4 + (b) * 2 + (h)) * HTB)
#define PG8_STAGE(bufoff, gbase, voff) do { _Pragma("unroll") for (int _i = 0; _i < 2; ++_i) \
        __builtin_amdgcn_global_load_lds((const unsigned*)((const char*)(gbase) + (voff)[_i]), (LAS unsigned*)(lds + (bufoff) + ldsw + _i * 8192), 16, 0, 0); } while (0)
#define PG8_LDA(dst, b, h) do { _Pragma("unroll") for (int m = 0; m < 4; ++m) _Pragma("unroll") for (int k = 0; k < 2; ++k) dst[m][k] = *(const LAS bf16x8*)(lds + PG8_SA(b, h) + aoff + m * 2048 + k * 1024); } while (0)
#define PG8_LDB(dst, b, h) do { _Pragma("unroll") for (int n = 0; n < 2; ++n) _Pragma("unroll") for (int k = 0; k < 2; ++k) dst[n][k] = *(const LAS bf16x8*)(lds + PG8_SB(b, h) + boff + n * 2048 + k * 1024); } while (0)
#define PG8_MMA(ai, bj, At, Bt) do { __builtin_amdgcn_s_setprio(1); _Pragma("unroll") for (int m = 0; m < 4; ++m) _Pragma("unroll") for (int n = 0; n < 2; ++n) _Pragma("unroll") for (int k = 0; k < 2; ++k) \
        acc[ai][bj][m][n] = __builtin_amdgcn_mfma_f32_16x16x32_bf16(Bt[n][k], At[m][k], acc[ai][bj][m][n], 0, 0, 0); __builtin_amdgcn_s_setprio(0); } while (0)
#define PG8_WAIT_V(n) asm volatile("s_waitcnt vmcnt(" #n ")" ::: "memory")
#define PG8_WAIT_L(n) asm volatile("s_waitcnt lgkmcnt(" #n ")" ::: "memory")
#define PG8_BAR __builtin_amdgcn_s_barrier()
#define PG8_SCHED __builtin_amdgcn_sched_barrier(0)
    Unit cur, nxt; int ui = 0;
    if (!S.next(0, cur)) return;
    Acc acc;
#pragma unroll
    for (int a = 0; a < 2; ++a)
#pragma unroll
        for (int b = 0; b < 2; ++b)
#pragma unroll
            for (int m = 0; m < 4; ++m)
#pragma unroll
                for (int n = 0; n < 2; ++n) acc[a][b][m][n] = (f32x4){0.f, 0.f, 0.f, 0.f};
    bf16x8 At[4][2], B0[2][2], B1[2][2];
    const char* cA = cur.A; const char* cB = cur.B;
    PG8_STAGE(PG8_SB(0, 0), cB, voffB); PG8_STAGE(PG8_SB(0, 1), cB + hstepB, voffB); PG8_STAGE(PG8_SA(0, 0), cA, voffA); PG8_STAGE(PG8_SA(0, 1), cA + hstepA, voffA);
    if (wr == 1) PG8_BAR;
    PG8_WAIT_V(2); PG8_BAR;
    PG8_STAGE(PG8_SB(1, 0), cB + kstep, voffB); PG8_STAGE(PG8_SA(1, 0), cA + kstep, voffA); PG8_STAGE(PG8_SB(1, 1), cB + hstepB + kstep, voffB);
    PG8_WAIT_V(6); PG8_BAR;
    for (;;) {
        const bool has_next = S.next(ui + 1, nxt);
        const char* nA = has_next ? nxt.A : cA; const char* nB = has_next ? nxt.B : cB;
        for (int t = 0; t < nt; t += 2) {
            const bool last = (t == nt - 2);
            const char* a1 = cA + (size_t)(t + 1) * kstep;
            const char* a2 = last ? nA : cA + (size_t)(t + 2) * kstep; const char* b2 = last ? nB : cB + (size_t)(t + 2) * kstep;
            const char* a3 = a2 + kstep; const char* b3 = b2 + kstep;
            PG8_LDB(B0, 0, 0); PG8_LDB(B1, 0, 1); PG8_SCHED; PG8_LDA(At, 0, 0); PG8_STAGE(PG8_SA(1, 1), a1 + hstepA, voffA);
            PG8_WAIT_V(8); PG8_WAIT_L(0); PG8_BAR; PG8_MMA(0, 0, At, B0); PG8_MMA(0, 1, At, B1); PG8_BAR; PG8_SCHED;
            PG8_LDA(At, 0, 1); PG8_STAGE(PG8_SB(0, 0), b2, voffB); PG8_STAGE(PG8_SB(0, 1), b2 + hstepB, voffB); PG8_STAGE(PG8_SA(0, 0), a2, voffA);
            PG8_WAIT_V(8); PG8_WAIT_L(0); PG8_BAR; PG8_MMA(1, 0, At, B0); PG8_MMA(1, 1, At, B1); PG8_BAR; PG8_SCHED;
            PG8_LDB(B0, 1, 0); PG8_LDB(B1, 1, 1); PG8_SCHED; PG8_LDA(At, 1, 0); PG8_STAGE(PG8_SA(0, 1), a2 + hstepA, voffA);
            PG8_WAIT_V(8); PG8_WAIT_L(0); PG8_BAR; PG8_MMA(0, 0, At, B0); PG8_MMA(0, 1, At, B1); PG8_BAR; PG8_SCHED;
            PG8_LDA(At, 1, 1); PG8_STAGE(PG8_SB(1, 0), b3, voffB); PG8_STAGE(PG8_SB(1, 1), b3 + hstepB, voffB); PG8_STAGE(PG8_SA(1, 0), a3, voffA);
            PG8_WAIT_V(8); PG8_WAIT_L(0); PG8_BAR; PG8_MMA(1, 0, At, B0); PG8_MMA(1, 1, At, B1); PG8_BAR; PG8_SCHED;
        }
        if (wr == 0) PG8_BAR;
        E(acc, cur, wr, wc, fr, fq);
        if (!has_next) break;
#pragma unroll
        for (int a = 0; a < 2; ++a)
#pragma unroll
            for (int b = 0; b < 2; ++b)
#pragma unroll
                for (int m = 0; m < 4; ++m)
#pragma unroll
                    for (int n = 0; n < 2; ++n) acc[a][b][m][n] = (f32x4){0.f, 0.f, 0.f, 0.f};
        cur = nxt; cA = nA; cB = nB; ++ui;
        if (wr == 1) PG8_BAR;
    }
    PG8_WAIT_V(0);
    PG8_BAR;
#undef PG8_SA
#undef PG8_SB
#undef PG8_STAGE
#undef PG8_LDA
#undef PG8_LDB
#undef PG8_MMA
#undef PG8_WAIT_V
#undef PG8_WAIT_L
#undef PG8_BAR
#undef PG8_SCHED
}

struct EpiInGate {
    static constexpr bool PERM = true;
    bf16_t* z; bf16_t* gates; const float* bgate;
    __device__ __forceinline__ void operator()(const Acc& acc, const Unit& u, int wr, int wc, int fr, int fq) const {
        const int row0 = u.orow + wr * 64 + fr; const bool isg = u.ocol >= 16;
        const int colt = (isg ? u.ocol - 16 : u.ocol) * 256 + wc * 32 + 8 * fq; const int ldc = isg ? 8192 : ZC; bf16_t* base = isg ? gates : z;
        f32x4 bv[2][2];
#pragma unroll
        for (int bj = 0; bj < 2; ++bj)
#pragma unroll
            for (int n = 0; n < 2; ++n) bv[bj][n] = isg ? *(const f32x4*)(bgate + colt + bj * HALF + 4 * n) : (f32x4){0.f, 0.f, 0.f, 0.f};
#pragma unroll
        for (int ai = 0; ai < 2; ++ai)
#pragma unroll
            for (int m = 0; m < 4; ++m) { bf16_t* rowp = base + (size_t)(row0 + ai * HALF + m * 16) * ldc + colt;
#pragma unroll
                for (int bj = 0; bj < 2; ++bj) { f32x4 v0 = acc[ai][bj][m][0] + bv[bj][0], v1 = acc[ai][bj][m][1] + bv[bj][1];
                    if (isg) {
#pragma unroll
                        for (int j = 0; j < 4; ++j) { v0[j] = sigmoidf_(v0[j]); v1[j] = sigmoidf_(v1[j]); } }
                    u32x4 w; w.x = cvt_pk_bf16(v0[0], v0[1]); w.y = cvt_pk_bf16(v0[2], v0[3]); w.z = cvt_pk_bf16(v1[0], v1[1]); w.w = cvt_pk_bf16(v1[2], v1[3]);
                    *(u32x4*)(rowp + bj * HALF) = w; } }
    }
};
struct EpiBf16 {
    static constexpr bool PERM = true;
    bf16_t* O; int ldc;
    __device__ __forceinline__ void operator()(const Acc& acc, const Unit& u, int wr, int wc, int fr, int fq) const {
        const int row0 = u.orow + wr * 64 + fr, col0 = u.ocol * 256 + wc * 32 + 8 * fq;
#pragma unroll
        for (int ai = 0; ai < 2; ++ai)
#pragma unroll
            for (int m = 0; m < 4; ++m) { bf16_t* rowp = O + (size_t)(row0 + ai * HALF + m * 16) * ldc + col0;
#pragma unroll
                for (int bj = 0; bj < 2; ++bj) { const f32x4 v0 = acc[ai][bj][m][0], v1 = acc[ai][bj][m][1];
                    u32x4 w; w.x = cvt_pk_bf16(v0[0], v0[1]); w.y = cvt_pk_bf16(v0[2], v0[3]); w.z = cvt_pk_bf16(v1[0], v1[1]); w.w = cvt_pk_bf16(v1[2], v1[3]);
                    *(u32x4*)(rowp + bj * HALF) = w; } }
    }
};
struct EpiSwiGLU {
    static constexpr bool PERM = true;
    bf16_t* O; int ldc;
    __device__ __forceinline__ void operator()(const Acc& acc, const Unit& u, int wr, int wc, int fr, int fq) const {
        const int row0 = u.orow + wr * 64 + fr, col0 = u.ocol * 128 + wc * 32 + 8 * fq;
#pragma unroll
        for (int ai = 0; ai < 2; ++ai)
#pragma unroll
            for (int m = 0; m < 4; ++m) { bf16_t* rowp = O + (size_t)(row0 + ai * HALF + m * 16) * ldc + col0;
                f32x4 v0, v1;
#pragma unroll
                for (int j = 0; j < 4; ++j) { const float g0 = acc[ai][0][m][0][j], g1 = acc[ai][0][m][1][j];
                    v0[j] = g0 * sigmoidf_(g0) * acc[ai][1][m][0][j]; v1[j] = g1 * sigmoidf_(g1) * acc[ai][1][m][1][j]; }
                u32x4 w; w.x = cvt_pk_bf16(v0[0], v0[1]); w.y = cvt_pk_bf16(v0[2], v0[3]); w.z = cvt_pk_bf16(v1[0], v1[1]); w.w = cvt_pk_bf16(v1[2], v1[3]);
                *(u32x4*)rowp = w; }
    }
};
__device__ __forceinline__ float bflo(unsigned w) { return __uint_as_float(w << 16); }
__device__ __forceinline__ float bfhi(unsigned w) { return __uint_as_float(w & 0xffff0000u); }
struct EpiMerge {
    static constexpr bool PERM = true;
    const bf16_t* gates; bf16_t* merged;
    __device__ __forceinline__ void operator()(const Acc& acc, const Unit& u, int wr, int wc, int fr, int fq) const {
        const int row0 = u.orow + wr * 64 + fr, col0 = u.ocol * 256 + wc * 32 + 8 * fq, n = u.x0;
#pragma unroll
        for (int ai = 0; ai < 2; ++ai)
#pragma unroll
            for (int m = 0; m < 4; ++m) { const size_t r = (size_t)(row0 + ai * HALF + m * 16);
#pragma unroll
                for (int bj = 0; bj < 2; ++bj) {
                    const u32x4 g = *(const u32x4*)(gates + r * 8192 + n * 2048 + col0 + bj * HALF);
                    bf16_t* mp = merged + r * DM + col0 + bj * HALF;
                    u32x4 o = (u32x4){0u, 0u, 0u, 0u}; if (n > 0) o = *(const u32x4*)mp;
                    const f32x4 v0 = acc[ai][bj][m][0], v1 = acc[ai][bj][m][1];
                    u32x4 w;
                    w.x = cvt_pk_bf16(bflo(o.x) + bflo(g.x) * v0[0], bfhi(o.x) + bfhi(g.x) * v0[1]);
                    w.y = cvt_pk_bf16(bflo(o.y) + bflo(g.y) * v0[2], bfhi(o.y) + bfhi(g.y) * v0[3]);
                    w.z = cvt_pk_bf16(bflo(o.z) + bflo(g.z) * v1[0], bfhi(o.z) + bfhi(g.z) * v1[1]);
                    w.w = cvt_pk_bf16(bflo(o.w) + bflo(g.w) * v1[2], bfhi(o.w) + bfhi(g.w) * v1[3]);
                    *(u32x4*)mp = w; } }
    }
};
struct EpiResF32 {
    static constexpr bool PERM = false;
    const float* base; float* out;
    __device__ __forceinline__ void operator()(const Acc& acc, const Unit& u, int wr, int wc, int fr, int fq) const {
        const int row0 = u.orow + wr * 64 + fr, col0 = u.ocol * 256 + wc * 32 + 4 * fq;
#pragma unroll
        for (int ai = 0; ai < 2; ++ai)
#pragma unroll
            for (int m = 0; m < 4; ++m) { const size_t off = (size_t)(row0 + ai * HALF + m * 16) * DM + col0;
#pragma unroll
                for (int bj = 0; bj < 2; ++bj)
#pragma unroll
                    for (int n = 0; n < 2; ++n) { const f32x4 bs = *(const f32x4*)(base + off + bj * HALF + n * 16); *(f32x4*)(out + off + bj * HALF + n * 16) = bs + acc[ai][bj][m][n]; }
                asm volatile("" ::: "memory"); }
    }
};
struct EpiMoeDown {
    static constexpr bool PERM = false;
    float* out; const int* tok; const float* wt; const unsigned* cnt;
    __device__ __forceinline__ void operator()(const Acc& acc, const Unit& u, int wr, int wc, int fr, int fq) const {
        const int e = u.x0, nrow = (int)cnt[e * 64]; const int lrow0 = u.x1 + wr * 64 + fr, col0 = u.ocol * 256 + wc * 32 + 4 * fq;
#pragma unroll
        for (int ai = 0; ai < 2; ++ai)
#pragma unroll
            for (int m = 0; m < 4; ++m) { const int lr = lrow0 + ai * HALF + m * 16;
                if (lr < nrow) { const int slot = e * ECAP + lr; const int t = tok[slot]; const float w = wt[slot]; float* op = out + (size_t)t * DM + col0;
#pragma unroll
                    for (int bj = 0; bj < 2; ++bj)
#pragma unroll
                        for (int n = 0; n < 2; ++n)
#pragma unroll
                            for (int j = 0; j < 4; ++j) unsafeAtomicAdd(op + bj * HALF + n * 16 + j, w * acc[ai][bj][m][n][j]); } }
    }
};
}
#define XB_TMO      128
#define XB_XCNT(j)  (256  + 64 * (j))
#define XB_XSUB(j)  (1280 + 64 * (j))
#define XB_XGEN(j)  (2304 + 64 * (j))
#define XB_TOP      3328
#define XB_TOPGEN   3392
#define XCD_BAR_WORDS 3456
#define XB_SPIN_CAP (1u << 18)

__device__ __forceinline__ unsigned xb_ld(unsigned* p)              { return __hip_atomic_load(p, __ATOMIC_RELAXED, __HIP_MEMORY_SCOPE_AGENT); }
__device__ __forceinline__ unsigned xb_add(unsigned* p, unsigned v) { return __hip_atomic_fetch_add(p, v, __ATOMIC_RELAXED, __HIP_MEMORY_SCOPE_AGENT); }
__device__ __forceinline__ unsigned xb_xcc_id() { return (unsigned)__builtin_amdgcn_s_getreg((3 << 11) | 20) & 0xFu; }
#define XB_SPIN(cond, bar) do { unsigned _sp = 0; while (cond) { __builtin_amdgcn_s_sleep(1); \
    if ((++_sp & 255u) == 0u) { if (xb_ld(&(bar)[XB_TMO])) break; if (_sp > XB_SPIN_CAP) { atomicAdd(&(bar)[XB_TMO], 1u); break; } } } } while (0)

__device__ __forceinline__ unsigned xb_tid() { unsigned t = threadIdx.x; asm volatile("" : "+v"(t)); return t; }
struct XcdBarrier {
    unsigned* bar; unsigned x;
    volatile LAS unsigned* st;
};

__device__ __forceinline__ XcdBarrier xcd_barrier_post(unsigned* bar, volatile LAS unsigned* st) {
    XcdBarrier b; b.bar = bar; b.x = xb_xcc_id(); b.st = st;
    if (xb_tid() == 0u) (void)xb_add(&bar[XB_XCNT(b.x)], 1u);
    return b;
}
__device__ __forceinline__ void xcd_barrier_complete(unsigned* bar, unsigned x, unsigned& nloc, unsigned& nx) {
    const unsigned G = gridDim.x * gridDim.y * gridDim.z;
    unsigned sum, cnt, mine, sp = 0u;
    for (;;) {
        sum = 0u; cnt = 0u; mine = 0u;
#pragma unroll
        for (unsigned j = 0; j < 16; ++j) { const unsigned c = xb_ld(&bar[XB_XCNT(j)]); sum += c; cnt += (c > 0u) ? 1u : 0u; mine = (j == x) ? c : mine; }
        if (sum == G) break;
        __builtin_amdgcn_s_sleep(1);
        if ((++sp & 255u) == 0u) { if (xb_ld(&bar[XB_TMO])) break; if (sp > XB_SPIN_CAP) { atomicAdd(&bar[XB_TMO], 1u); break; } }
    }
    nloc = mine > 0u ? mine : 1u; nx = cnt > 0u ? cnt : 1u;
}

__device__ __forceinline__ void xcd_barrier(const XcdBarrier& b) {
    asm volatile("s_waitcnt vmcnt(0)" ::: "memory");
    __syncthreads();
    if (xb_tid() == 0u) {
        unsigned* bar = b.bar;
        __builtin_amdgcn_s_waitcnt(0);
        unsigned nloc = b.st[0], nx = b.st[1];
        if (nloc == 0u) { xcd_barrier_complete(bar, b.x, nloc, nx); b.st[0] = nloc; b.st[1] = nx; }
        const unsigned old = xb_add(&bar[XB_XSUB(b.x)], 1u);
        const unsigned gen = old / nloc;
        if (old + 1u == (gen + 1u) * nloc) {
            __builtin_amdgcn_fence(__ATOMIC_RELEASE, "agent");
            asm volatile("s_waitcnt vmcnt(0)" ::: "memory");
            const unsigned og = xb_add(&bar[XB_TOP], 1u);
            const unsigned tg = og / nx;
            if (og + 1u == (tg + 1u) * nx) xb_add(&bar[XB_TOPGEN], 1u);
            else XB_SPIN(xb_ld(&bar[XB_TOPGEN]) == tg, bar);
            __builtin_amdgcn_fence(__ATOMIC_ACQUIRE, "agent");
            xb_add(&bar[XB_XGEN(b.x)], 1u);
            asm volatile("s_waitcnt vmcnt(0)" ::: "memory");
        } else {
            XB_SPIN(xb_ld(&bar[XB_XGEN(b.x)]) == gen, bar);
            __builtin_amdgcn_fence(__ATOMIC_ACQUIRE, "agent");
            asm volatile("s_waitcnt vmcnt(0)" ::: "memory");
        }
    }
    __syncthreads();
}

struct Params { const float* in[30]; float* out; unsigned char* ws; int ph_lo, ph_hi; };
enum { I_X = 0, I_MEM, I_NORM_MIX, I_W_IN, I_NA_QN, I_NA_KN, I_NA_RPB, I_CQ_N, I_W_UQ, I_CKV_N, I_W_UKV, I_MLA_QN, I_MLA_KN, I_SWA_QN, I_SWA_KN, I_SWA_SINK,
       I_MEM_N, I_MEM_WKV, I_MEM_QN, I_MEM_KN, I_W_BRANCH, I_W_GATE, I_B_GATE, I_W_O, I_NORM_FFN, I_FFN_UP, I_FFN_DN, I_ROUTER, I_MOE_UP, I_MOE_DN };

__device__ __forceinline__ float wave_sum(float v) {
#pragma unroll
    for (int o = 32; o >= 1; o >>= 1) v += __shfl_xor(v, o);
    return v;
}
__device__ __forceinline__ float bf2f(bf16_t b) { return __uint_as_float(((unsigned)b) << 16); }
__device__ __forceinline__ bf16_t f2bf(float f) { return (bf16_t)(pg8::cvt_pk_bf16(f, 0.f) & 0xffffu); }
using pg8::cvt_pk_bf16; using pg8::bflo; using pg8::bfhi;

struct CvtJob { const float* src; bf16_t* dst; int src_ld, K, ntn, tile0, mode, dff; };
constexpr int NJOBS = 40;
__device__ __forceinline__ void make_job(int j, const Params& p, CvtJob& jb) {
    unsigned char* ws = p.ws; jb.mode = 0; jb.dff = 1; jb.tile0 = 0;
    if (j < 22) { const int l = j / 11, k = j % 11; unsigned char* lw = ws + WS_LW + (size_t)l * LW_BYTES;
        if (k == 0) { jb.src = p.in[I_W_IN] + (size_t)l * DM * INC; jb.dst = (bf16_t*)(lw + LW_INGATE); jb.src_ld = INC; jb.K = DM; jb.ntn = INC / 64; }
        else if (k == 1) { jb.src = p.in[I_W_IN]; jb.dst = (bf16_t*)(lw + LW_INGATE) + (size_t)INC * DM; jb.src_ld = INC; jb.K = DM; jb.ntn = (ZC - INC) / 64; jb.mode = 2; }
        else if (k == 2) { jb.src = p.in[I_W_GATE] + (size_t)l * DM * 8192; jb.dst = (bf16_t*)(lw + LW_INGATE) + (size_t)ZC * DM; jb.src_ld = 8192; jb.K = DM; jb.ntn = 8192 / 64; }
        else if (k == 3) { jb.src = p.in[I_W_UQ] + (size_t)l * 768 * 768; jb.dst = (bf16_t*)(lw + LW_UQ); jb.src_ld = 768; jb.K = 768; jb.ntn = 768 / 64; }
        else if (k == 4) { jb.src = p.in[I_W_UKV] + (size_t)l * 256 * 1024; jb.dst = (bf16_t*)(lw + LW_UKV); jb.src_ld = 1024; jb.K = 256; jb.ntn = 1024 / 64; }
        else if (k == 5) { jb.src = p.in[I_MEM_WKV] + (size_t)l * DM * 1024; jb.dst = (bf16_t*)(lw + LW_MEMKV); jb.src_ld = 1024; jb.K = DM; jb.ntn = 1024 / 64; }
        else if (k < 10) { const int n = k - 6; jb.src = p.in[I_W_BRANCH] + ((size_t)l * 4 + n) * 512 * DM; jb.dst = (bf16_t*)(lw + LW_BR) + (size_t)n * DM * 512; jb.src_ld = DM; jb.K = 512; jb.ntn = DM / 64; }
        else { jb.src = p.in[I_W_O] + (size_t)l * DM * DM; jb.dst = (bf16_t*)(lw + LW_O); jb.src_ld = DM; jb.K = DM; jb.ntn = DM / 64; }
    } else if (j == 22) { jb.src = p.in[I_FFN_UP]; jb.dst = (bf16_t*)(ws + WS_FFNUP); jb.src_ld = 2 * DFF; jb.K = DM; jb.ntn = 2 * DFF / 64; jb.mode = 1; jb.dff = DFF; }
    else if (j == 23) { jb.src = p.in[I_FFN_DN]; jb.dst = (bf16_t*)(ws + WS_FFNDN); jb.src_ld = DM; jb.K = DFF; jb.ntn = DM / 64; }
    else if (j < 32) { const int e = j - 24; jb.src = p.in[I_MOE_UP] + (size_t)e * DM * 2 * DFFE; jb.dst = (bf16_t*)(ws + WS_MOEUP) + (size_t)e * 2 * DFFE * DM; jb.src_ld = 2 * DFFE; jb.K = DM; jb.ntn = 2 * DFFE / 64; jb.mode = 1; jb.dff = DFFE; }
    else { const int e = j - 32; jb.src = p.in[I_MOE_DN] + (size_t)e * DFFE * DM; jb.dst = (bf16_t*)(ws + WS_MOEDN) + (size_t)e * DM * DFFE; jb.src_ld = DM; jb.K = DFFE; jb.ntn = DM / 64; }
}

__device__ __forceinline__ void norm_rows(const float* src, const float* g, bf16_t* dst, int nrows, int wid, int lane) {
    for (int row = blockIdx.x * 8 + wid; row < nrows; row += gridDim.x * 8) {
        const f32x4* sp = (const f32x4*)(src + (size_t)row * DM); f32x4 v[8]; float ss = 0.f;
#pragma unroll
        for (int j = 0; j < 8; ++j) { v[j] = sp[lane + 64 * j]; ss += v[j][0] * v[j][0] + v[j][1] * v[j][1] + v[j][2] * v[j][2] + v[j][3] * v[j][3]; }
        ss = wave_sum(ss); const float rstd = 1.0f / sqrtf(ss * (1.0f / DM) + EPS);
#pragma unroll
        for (int j = 0; j < 8; ++j) { const f32x4 gv = ((const f32x4*)g)[lane + 64 * j]; u32x2 w; w.x = cvt_pk_bf16(v[j][0] * rstd * gv[0], v[j][1] * rstd * gv[1]); w.y = cvt_pk_bf16(v[j][2] * rstd * gv[2], v[j][3] * rstd * gv[3]);
            *(u32x2*)(dst + (size_t)row * DM + 4 * (lane + 64 * j)) = w; }
    }
}

__device__ __forceinline__ void p0_prologue(const Params& p, LAS unsigned char* lds, int tid, int wid, int lane) {
    LAS CvtJob* jt = (LAS CvtJob*)(lds + 65536);
    LAS int* jtot = (LAS int*)(lds + 65536 + 4096);
    if (tid < NJOBS) { CvtJob jb; make_job(tid, p, jb); jt[tid].src = jb.src; jt[tid].dst = jb.dst; jt[tid].src_ld = jb.src_ld; jt[tid].K = jb.K; jt[tid].ntn = jb.ntn; jt[tid].tile0 = 0; jt[tid].mode = jb.mode; jt[tid].dff = jb.dff; }
    __syncthreads();
    if (tid == 0) { int acc = 0; for (int j = 0; j < NJOBS; ++j) { jt[j].tile0 = acc; acc += (jt[j].K / 128) * jt[j].ntn; } jtot[0] = acc; }
    __syncthreads();
    const int total = jtot[0];
    LAS unsigned* T = (LAS unsigned*)lds;
    int j = 0;
    for (int g = blockIdx.x; g < total; g += gridDim.x) {
        while (j + 1 < NJOBS && jt[j + 1].tile0 <= g) ++j;
        const float* src = jt[j].src; bf16_t* dst = jt[j].dst; const int src_ld = jt[j].src_ld, K = jt[j].K, ntn = jt[j].ntn, mode = jt[j].mode, dff = jt[j].dff;
        const int local = g - jt[j].tile0, tn = local % ntn, tk = local / ntn;
        if (mode == 2) {
#pragma unroll
            for (int it = 0; it < 2; ++it) { const int piece = tid + it * 512, n = piece >> 4, seg = piece & 15;
                *(u32x4*)(dst + (size_t)(tn * 64 + n) * K + tk * 128 + seg * 8) = (u32x4){0u, 0u, 0u, 0u}; }
            continue;
        }
#pragma unroll
        for (int it = 0; it < 2; ++it) { const int item = tid + it * 512, kp = item >> 4, nq = item & 15;
            const float* sp = src + (size_t)(tk * 128 + 2 * kp) * src_ld + tn * 64 + 4 * nq;
            const f32x4 a = *(const f32x4*)sp, b = *(const f32x4*)(sp + src_ld);
#pragma unroll
            for (int q = 0; q < 4; ++q) T[(4 * nq + q) * 65 + kp] = cvt_pk_bf16(a[q], b[q]); }
        __syncthreads();
#pragma unroll
        for (int it = 0; it < 2; ++it) { const int piece = tid + it * 512, n = piece >> 4, seg = piece & 15;
            u32x4 w; w.x = T[n * 65 + seg * 4 + 0]; w.y = T[n * 65 + seg * 4 + 1]; w.z = T[n * 65 + seg * 4 + 2]; w.w = T[n * 65 + seg * 4 + 3];
            int drow = tn * 64 + n;
            if (mode == 1) { const int bj = drow / dff, cc = drow - bj * dff; drow = 256 * (cc >> 7) + 128 * bj + (cc & 127); }
            *(u32x4*)(dst + (size_t)drow * K + tk * 128 + seg * 8) = w; }
        __syncthreads();
    }
    { f32x2* rt = (f32x2*)(p.ws + WS_ROPE);
      for (int e = blockIdx.x * NTHREADS + tid; e < SEQ * 32; e += gridDim.x * NTHREADS) { const int pos = e >> 5, i = e & 31;
          const float freq = __builtin_amdgcn_exp2f(-(float)i * (13.287712379549449f / 32.0f));
          const float ang = (float)pos * freq;
          const double rev = (double)ang * 0.15915494309189535; const float fr_ = (float)(rev - __builtin_rint(rev));
          rt[e] = (f32x2){__builtin_amdgcn_cosf(fr_), __builtin_amdgcn_sinf(fr_)}; } }
    norm_rows(p.in[I_MEM], p.in[I_MEM_N], (bf16_t*)(p.ws + WS_MEMN), NMEM, wid, lane);
    norm_rows(p.in[I_MEM], p.in[I_MEM_N] + DM, (bf16_t*)(p.ws + WS_MEMN) + (size_t)NMEM * DM, NMEM, wid, lane);
    norm_rows(p.in[I_X], p.in[I_NORM_MIX], (bf16_t*)(p.ws + WS_U), NTOK, wid, lane);
}

__device__ __forceinline__ void rope_pair(float& y, const f32x2 cs, int lane) { const float pr = __shfl_xor(y, 32); y = (lane < 32) ? (y * cs.x - pr * cs.y) : (y * cs.x + pr * cs.y); }

__device__ __forceinline__ void prep1(const Params& p, int l, LAS unsigned char* lds, int tid, int wid, int lane) {
    const bf16_t* z = (const bf16_t*)(p.ws + WS_Z);
    bf16_t* naq = (bf16_t*)(p.ws + WS_NAQ); bf16_t* nak = (bf16_t*)(p.ws + WS_NAK); bf16_t* navT = (bf16_t*)(p.ws + WS_NAVT);
    bf16_t* cqn = (bf16_t*)(p.ws + WS_CQN); bf16_t* ckvn = (bf16_t*)(p.ws + WS_CKVN);
    bf16_t* swq = (bf16_t*)(p.ws + WS_SWQ); bf16_t* swk = (bf16_t*)(p.ws + WS_SWK); bf16_t* swvT = (bf16_t*)(p.ws + WS_SWVT); bf16_t* meq = (bf16_t*)(p.ws + WS_MEQ);
    const f32x2* rt = (const f32x2*)(p.ws + WS_ROPE);
    const float* g_naq = p.in[I_NA_QN] + l * 128; const float* g_nak = p.in[I_NA_KN] + l * 128; const float* g_meq = p.in[I_MEM_QN] + l * 128;
    const float* g_cq = p.in[I_CQ_N] + l * 768; const float* g_ckv = p.in[I_CKV_N] + l * 256; const float* g_swq = p.in[I_SWA_QN] + l * 64; const float* g_swk = p.in[I_SWA_KN] + l * 64;
    const float qs128 = 0.08838834764831845f * LOG2E, qs64 = 0.125f * LOG2E;
    constexpr int VW = 640;
    LAS bf16_t* vt = (LAS bf16_t*)lds;
    for (int grp = blockIdx.x; grp < NTOK / 32; grp += gridDim.x) {
        const int b = grp >> 6, chunk = grp & 63;
#pragma unroll 1
        for (int ti = 0; ti < 4; ++ti) {
            const int tl = wid * 4 + ti, s = chunk * 32 + tl, token = grp * 32 + tl;
            const bf16_t* zr = z + (size_t)token * ZC;
            { const u32x4 w = *(const u32x4*)(zr + Z_NAV + 8 * lane); *(LAS u32x4*)(vt + tl * VW + 8 * lane) = w;
              if (lane < 16) { const u32x4 w2 = *(const u32x4*)(zr + Z_SWV + 8 * lane); *(LAS u32x4*)(vt + tl * VW + 512 + 8 * lane) = w2; } }
#pragma unroll
            for (int h = 0; h < 4; ++h) {
                { const unsigned w = *(const unsigned*)(zr + Z_NAQ + h * 128 + 2 * lane); const float x0 = bflo(w), x1 = bfhi(w);
                  const float ss = wave_sum(x0 * x0 + x1 * x1), rs = 1.0f / sqrtf(ss * (1.0f / 128) + EPS) * qs128;
                  *(unsigned*)(naq + ((size_t)(b * 4 + h) * SEQ + s) * 128 + 2 * lane) = cvt_pk_bf16(x0 * rs * g_naq[2 * lane], x1 * rs * g_naq[2 * lane + 1]); }
                { const unsigned w = *(const unsigned*)(zr + Z_NAK + h * 128 + 2 * lane); const float x0 = bflo(w), x1 = bfhi(w);
                  const float ss = wave_sum(x0 * x0 + x1 * x1), rs = 1.0f / sqrtf(ss * (1.0f / 128) + EPS);
                  *(unsigned*)(nak + ((size_t)(b * 4 + h) * SEQ + s) * 128 + 2 * lane) = cvt_pk_bf16(x0 * rs * g_nak[2 * lane], x1 * rs * g_nak[2 * lane + 1]); }
                { const unsigned w = *(const unsigned*)(zr + Z_MEQ + h * 128 + 2 * lane); const float x0 = bflo(w), x1 = bfhi(w);
                  const float ss = wave_sum(x0 * x0 + x1 * x1), rs = 1.0f / sqrtf(ss * (1.0f / 128) + EPS) * qs128;
                  *(unsigned*)(meq + ((size_t)(b * 4 + h) * SEQ + s) * 128 + 2 * lane) = cvt_pk_bf16(x0 * rs * g_meq[2 * lane], x1 * rs * g_meq[2 * lane + 1]); }
            }
            { unsigned w[6]; float ss = 0.f;
#pragma unroll
              for (int j = 0; j < 6; ++j) { w[j] = *(const unsigned*)(zr + Z_CQ + 128 * j + 2 * lane); ss += bflo(w[j]) * bflo(w[j]) + bfhi(w[j]) * bfhi(w[j]); }
              ss = wave_sum(ss); const float rs = 1.0f / sqrtf(ss * (1.0f / 768) + EPS);
#pragma unroll
              for (int j = 0; j < 6; ++j) *(unsigned*)(cqn + (size_t)token * 768 + 128 * j + 2 * lane) = cvt_pk_bf16(bflo(w[j]) * rs * g_cq[128 * j + 2 * lane], bfhi(w[j]) * rs * g_cq[128 * j + 2 * lane + 1]); }
            { unsigned w[2]; float ss = 0.f;
#pragma unroll
              for (int j = 0; j < 2; ++j) { w[j] = *(const unsigned*)(zr + Z_CKV + 128 * j + 2 * lane); ss += bflo(w[j]) * bflo(w[j]) + bfhi(w[j]) * bfhi(w[j]); }
              ss = wave_sum(ss); const float rs = 1.0f / sqrtf(ss * (1.0f / 256) + EPS);
#pragma unroll
              for (int j = 0; j < 2; ++j) *(unsigned*)(ckvn + (size_t)token * 256 + 128 * j + 2 * lane) = cvt_pk_bf16(bflo(w[j]) * rs * g_ckv[128 * j + 2 * lane], bfhi(w[j]) * rs * g_ckv[128 * j + 2 * lane + 1]); }
            const f32x2 cs = rt[s * 32 + (lane & 31)];
#pragma unroll
            for (int h = 0; h < 8; ++h) { const float x = bf2f(zr[Z_SWQ + h * 64 + lane]); const float ss = wave_sum(x * x); float y = x * (1.0f / sqrtf(ss * (1.0f / 64) + EPS)) * g_swq[lane];
                rope_pair(y, cs, lane); swq[((size_t)(b * 8 + h) * SEQ + s) * 64 + lane] = f2bf(y * qs64); }
#pragma unroll
            for (int h = 0; h < 2; ++h) { const float x = bf2f(zr[Z_SWK + h * 64 + lane]); const float ss = wave_sum(x * x); float y = x * (1.0f / sqrtf(ss * (1.0f / 64) + EPS)) * g_swk[lane];
                rope_pair(y, cs, lane); swk[((size_t)(b * 2 + h) * SEQ + s) * 64 + lane] = f2bf(y); }
        }
        __syncthreads();
#pragma unroll 1
        for (int it = 0; it < 5; ++it) { const int item = tid + it * 512, part = item / VW, c = item - part * VW;
            unsigned short e[8];
#pragma unroll
            for (int q = 0; q < 8; ++q) e[q] = vt[(part * 8 + q) * VW + c];
            u32x4 w; w.x = e[0] | ((unsigned)e[1] << 16); w.y = e[2] | ((unsigned)e[3] << 16); w.z = e[4] | ((unsigned)e[5] << 16); w.w = e[6] | ((unsigned)e[7] << 16);
            bf16_t* dp = (c < 512) ? navT + ((((size_t)(b * 4 + (c >> 7)) * 64 + chunk) * 128 + (c & 127)) * 32 + part * 8)
                                   : swvT + ((((size_t)(b * 2 + ((c - 512) >> 6)) * 64 + chunk) * 64 + ((c - 512) & 63)) * 32 + part * 8);
            *(u32x4*)dp = w; }
        __syncthreads();
    }
}

__device__ __forceinline__ void prep2(const Params& p, int l, LAS unsigned char* lds, int tid, int wid, int lane) {
    const bf16_t* z = (const bf16_t*)(p.ws + WS_Z); const bf16_t* qraw = (const bf16_t*)(p.ws + WS_QRAW); const bf16_t* kvraw = (const bf16_t*)(p.ws + WS_KVRAW);
    const bf16_t* memkv = (const bf16_t*)(p.ws + WS_MEMKV) + (size_t)l * NMEM * 1024;
    bf16_t* mlq = (bf16_t*)(p.ws + WS_MLQ); bf16_t* mlk = (bf16_t*)(p.ws + WS_MLK); bf16_t* mlvT = (bf16_t*)(p.ws + WS_MLVT);
    bf16_t* mek = (bf16_t*)(p.ws + WS_MEK); bf16_t* mevT = (bf16_t*)(p.ws + WS_MEVT);
    const f32x2* rt = (const f32x2*)(p.ws + WS_ROPE);
    const float* g_q = p.in[I_MLA_QN] + l * 192; const float* g_k = p.in[I_MLA_KN] + l * 192; const float* g_mk = p.in[I_MEM_KN] + l * 128;
    const float qs192 = 0.07216878364870322f * LOG2E;
    constexpr int VW = 512;
    LAS bf16_t* vt = (LAS bf16_t*)lds;
    for (int grp = blockIdx.x; grp < NTOK / 32 + NMEM / 32; grp += gridDim.x) {
        const bool ismem = grp >= NTOK / 32;
        if (!ismem) {
            const int b = grp >> 6, chunk = grp & 63;
#pragma unroll 1
            for (int ti = 0; ti < 4; ++ti) {
                const int tl = wid * 4 + ti, s = chunk * 32 + tl, token = grp * 32 + tl;
                const f32x2 cs = rt[s * 32 + (lane & 31)];
                const float kpe = bf2f(z[(size_t)token * ZC + Z_KPE + lane]);
#pragma unroll
                for (int h = 0; h < 4; ++h) {
                    { const bf16_t* qr = qraw + (size_t)token * 768 + h * 192; const float x0 = bf2f(qr[lane]), x1 = bf2f(qr[64 + lane]), x2 = bf2f(qr[128 + lane]);
                      const float ss = wave_sum(x0 * x0 + x1 * x1 + x2 * x2), rs = 1.0f / sqrtf(ss * (1.0f / 192) + EPS);
                      float y2 = x2 * rs * g_q[128 + lane]; rope_pair(y2, cs, lane);
                      bf16_t* qo = mlq + ((size_t)(b * 4 + h) * SEQ + s) * 192; qo[lane] = f2bf(x0 * rs * g_q[lane] * qs192); qo[64 + lane] = f2bf(x1 * rs * g_q[64 + lane] * qs192); qo[128 + lane] = f2bf(y2 * qs192); }
                    { const bf16_t* kr = kvraw + (size_t)token * 1024 + h * 256; const float x0 = bf2f(kr[lane]), x1 = bf2f(kr[64 + lane]), x2 = kpe;
                      const float ss = wave_sum(x0 * x0 + x1 * x1 + x2 * x2), rs = 1.0f / sqrtf(ss * (1.0f / 192) + EPS);
                      float y2 = x2 * rs * g_k[128 + lane]; rope_pair(y2, cs, lane);
                      bf16_t* ko = mlk + ((size_t)(b * 4 + h) * SEQ + s) * 192; ko[lane] = f2bf(x0 * rs * g_k[lane]); ko[64 + lane] = f2bf(x1 * rs * g_k[64 + lane]); ko[128 + lane] = f2bf(y2); }
                }
                { const int h = lane >> 4, pc = lane & 15; const u32x4 w = *(const u32x4*)(kvraw + (size_t)token * 1024 + h * 256 + 128 + 8 * pc); *(LAS u32x4*)(vt + tl * VW + h * 128 + 8 * pc) = w; }
            }
            __syncthreads();
#pragma unroll 1
            for (int it = 0; it < 4; ++it) { const int item = tid + it * 512, part = item >> 9, c = item & 511;
                unsigned short e[8];
#pragma unroll
                for (int q = 0; q < 8; ++q) e[q] = vt[(part * 8 + q) * VW + c];
                u32x4 w; w.x = e[0] | ((unsigned)e[1] << 16); w.y = e[2] | ((unsigned)e[3] << 16); w.z = e[4] | ((unsigned)e[5] << 16); w.w = e[6] | ((unsigned)e[7] << 16);
                *(u32x4*)(mlvT + ((((size_t)(b * 4 + (c >> 7)) * 64 + chunk) * 128 + (c & 127)) * 32 + part * 8)) = w; }
            __syncthreads();
        } else {
            const int mg = grp - NTOK / 32, b = mg >> 3, chunk = mg & 7;
#pragma unroll 1
            for (int ti = 0; ti < 4; ++ti) {
                const int tl = wid * 4 + ti, m = chunk * 32 + tl, mt = mg * 32 + tl;
                const bf16_t* mr = memkv + (size_t)mt * 1024;
#pragma unroll
                for (int h = 0; h < 4; ++h) { const unsigned w = *(const unsigned*)(mr + h * 128 + 2 * lane); const float x0 = bflo(w), x1 = bfhi(w);
                    const float ss = wave_sum(x0 * x0 + x1 * x1), rs = 1.0f / sqrtf(ss * (1.0f / 128) + EPS);
                    *(unsigned*)(mek + ((size_t)(b * 4 + h) * MEML + m) * 128 + 2 * lane) = cvt_pk_bf16(x0 * rs * g_mk[2 * lane], x1 * rs * g_mk[2 * lane + 1]); }
                { const u32x4 w = *(const u32x4*)(mr + 512 + 8 * lane); *(LAS u32x4*)(vt + tl * VW + 8 * lane) = w; }
            }
            __syncthreads();
#pragma unroll 1
            for (int it = 0; it < 4; ++it) { const int item = tid + it * 512, part = item >> 9, c = item & 511;
                unsigned short e[8];
#pragma unroll
                for (int q = 0; q < 8; ++q) e[q] = vt[(part * 8 + q) * VW + c];
                u32x4 w; w.x = e[0] | ((unsigned)e[1] << 16); w.y = e[2] | ((unsigned)e[3] << 16); w.z = e[4] | ((unsigned)e[5] << 16); w.w = e[6] | ((unsigned)e[7] << 16);
                *(u32x4*)(mevT + ((((size_t)(b * 4 + (c >> 7)) * 8 + chunk) * 128 + (c & 127)) * 32 + part * 8)) = w; }
            __syncthreads();
        }
    }
}
constexpr int ATT_RPB_OFF = 98304;
template <int DQ, int DV, int MODE>
__device__ __forceinline__ void attn_unit(LAS unsigned char* lds, const bf16_t* qp, const bf16_t* kp, const bf16_t* vp, bf16_t* op,
                                          int nchunks, int c_lo, int c_hi, int mq0, int mk0, int mr, float sink2, int tid, int lane) {
    constexpr int KROW = DQ * 2 + 16, KBUF = 32 * KROW, VROW = 80, VBUF = DV * VROW, NDC = DQ / 32, NDV = DV / 16;
    constexpr int KPIECES = 32 * DQ / 8, VPIECES = DV * 4, DQ8 = DQ / 8;
    const int fr = lane & 15, fq = lane >> 4;
    bf16x8 qf[2][NDC];
#pragma unroll
    for (int qt = 0; qt < 2; ++qt)
#pragma unroll
        for (int dc = 0; dc < NDC; ++dc) qf[qt][dc] = *(const bf16x8*)(qp + (size_t)(qt * 16 + fr) * DQ + dc * 32 + fq * 8);
    f32x4 o[2][NDV];
#pragma unroll
    for (int qt = 0; qt < 2; ++qt)
#pragma unroll
        for (int d = 0; d < NDV; ++d) o[qt][d] = (f32x4){0.f, 0.f, 0.f, 0.f};
    float mrun[2] = {-1e30f, -1e30f}, lrun[2] = {0.f, 0.f};
    const int pk0 = tid, pk1 = tid + 512;
    const bool hk0 = pk0 < KPIECES, hk1 = pk1 < KPIECES, hv = tid < VPIECES;
    int kd0, kd1;
    { const int key = pk0 / DQ8, dp = pk0 - key * DQ8; kd0 = (16 * ((key >> 2) & 1) + 4 * (key >> 3) + (key & 3)) * KROW + dp * 16; }
    { const int key = pk1 / DQ8, dp = pk1 - key * DQ8; kd1 = (16 * ((key >> 2) & 1) + 4 * (key >> 3) + (key & 3)) * KROW + dp * 16; }
    const int vd = (tid >> 2) * VROW + (tid & 3) * 16;
    u32x4 rk0 = (u32x4){0u, 0u, 0u, 0u}, rk1 = rk0, rv = rk0;
    if (hk0) rk0 = *(const u32x4*)(kp + pk0 * 8);
    if (hk1) rk1 = *(const u32x4*)(kp + pk1 * 8);
    if (hv) rv = *(const u32x4*)(vp + tid * 8);
    if (hk0) *(LAS u32x4*)(lds + kd0) = rk0;
    if (hk1) *(LAS u32x4*)(lds + kd1) = rk1;
    if (hv) *(LAS u32x4*)(lds + 2 * KBUF + vd) = rv;
    __syncthreads();
#pragma unroll 1
    for (int c = 0; c < nchunks; ++c) {
        const int cur = c & 1; const bool more = (c + 1 < nchunks);
        if (more) { const bf16_t* kn = kp + (size_t)(c + 1) * 32 * DQ; const bf16_t* vn = vp + (size_t)(c + 1) * DV * 32;
            if (hk0) rk0 = *(const u32x4*)(kn + pk0 * 8);
            if (hk1) rk1 = *(const u32x4*)(kn + pk1 * 8);
            if (hv) rv = *(const u32x4*)(vn + tid * 8); }
        if (c >= c_lo && c < c_hi) {
            const LAS unsigned char* kb = lds + cur * KBUF; const LAS unsigned char* vb = lds + 2 * KBUF + cur * VBUF;
            f32x4 s[2][2];
#pragma unroll
            for (int qt = 0; qt < 2; ++qt) { s[qt][0] = (f32x4){0.f, 0.f, 0.f, 0.f}; s[qt][1] = (f32x4){0.f, 0.f, 0.f, 0.f}; }
#pragma unroll
            for (int dc = 0; dc < NDC; ++dc) {
                const bf16x8 k0 = *(const LAS bf16x8*)(kb + fr * KROW + (dc * 32 + fq * 8) * 2);
                const bf16x8 k1 = *(const LAS bf16x8*)(kb + (16 + fr) * KROW + (dc * 32 + fq * 8) * 2);
#pragma unroll
                for (int qt = 0; qt < 2; ++qt) { s[qt][0] = __builtin_amdgcn_mfma_f32_16x16x32_bf16(k0, qf[qt][dc], s[qt][0], 0, 0, 0);
                                                 s[qt][1] = __builtin_amdgcn_mfma_f32_16x16x32_bf16(k1, qf[qt][dc], s[qt][1], 0, 0, 0); }
            }
            bf16x8 pf[2];
#pragma unroll
            for (int qt = 0; qt < 2; ++qt) {
                if (MODE == 1) {
                    const int qpos = mq0 + qt * 16 + fr, kbase = mk0 + c * 32 + 8 * fq;
#pragma unroll
                    for (int b = 0; b < 2; ++b)
#pragma unroll
                        for (int i = 0; i < 4; ++i) { const int dd = qpos - (kbase + 4 * b + i); if (dd > 128 || dd < -128) s[qt][b][i] = -1e30f; }
                } else if (MODE == 2) {
                    const LAS float* rpb = (const LAS float*)(lds + ATT_RPB_OFF);
                    const int qc = mq0 + qt * 16 + fr, kr = mk0 + (c >> 1), kcb = (c & 1) * 32 + 8 * fq;
                    int cs = qc - 8; cs = cs < 0 ? 0 : (cs > 48 ? 48 : cs);
                    const int rowoff = (kr - mr + 7) * 31;
#pragma unroll
                    for (int b = 0; b < 2; ++b)
#pragma unroll
                        for (int i = 0; i < 4; ++i) { const int kc = kcb + 4 * b + i; const bool ok = (kc >= cs) && (kc <= cs + 15);
                            int bi = kc - qc + 15; bi = bi < 0 ? 0 : (bi > 30 ? 30 : bi);
                            const float bias = rpb[rowoff + bi];
                            s[qt][b][i] = ok ? s[qt][b][i] + bias : -1e30f; }
                }
                float mx = fmaxf(fmaxf(fmaxf(s[qt][0][0], s[qt][0][1]), fmaxf(s[qt][0][2], s[qt][0][3])), fmaxf(fmaxf(s[qt][1][0], s[qt][1][1]), fmaxf(s[qt][1][2], s[qt][1][3])));
                mx = fmaxf(mx, __shfl_xor(mx, 16)); mx = fmaxf(mx, __shfl_xor(mx, 32));
                const float mnew = fmaxf(mrun[qt], mx), alpha = __builtin_amdgcn_exp2f(mrun[qt] - mnew); mrun[qt] = mnew;
                float ps = 0.f;
#pragma unroll
                for (int b = 0; b < 2; ++b)
#pragma unroll
                    for (int i = 0; i < 4; ++i) { const float e = __builtin_amdgcn_exp2f(s[qt][b][i] - mnew); s[qt][b][i] = e; ps += e; }
                lrun[qt] = lrun[qt] * alpha + ps;
#pragma unroll
                for (int d = 0; d < NDV; ++d) o[qt][d] *= alpha;
                u32x4 w; w.x = cvt_pk_bf16(s[qt][0][0], s[qt][0][1]); w.y = cvt_pk_bf16(s[qt][0][2], s[qt][0][3]); w.z = cvt_pk_bf16(s[qt][1][0], s[qt][1][1]); w.w = cvt_pk_bf16(s[qt][1][2], s[qt][1][3]);
                pf[qt] = __builtin_bit_cast(bf16x8, w);
            }
#pragma unroll
            for (int d = 0; d < NDV; ++d) {
                const bf16x8 vf = *(const LAS bf16x8*)(vb + (d * 16 + fr) * VROW + fq * 16);
                o[0][d] = __builtin_amdgcn_mfma_f32_16x16x32_bf16(vf, pf[0], o[0][d], 0, 0, 0);
                o[1][d] = __builtin_amdgcn_mfma_f32_16x16x32_bf16(vf, pf[1], o[1][d], 0, 0, 0);
            }
        }
        if (more) { const int nb = cur ^ 1;
            if (hk0) *(LAS u32x4*)(lds + nb * KBUF + kd0) = rk0;
            if (hk1) *(LAS u32x4*)(lds + nb * KBUF + kd1) = rk1;
            if (hv) *(LAS u32x4*)(lds + 2 * KBUF + nb * VBUF + vd) = rv; }
        __syncthreads();
    }
#pragma unroll
    for (int qt = 0; qt < 2; ++qt) {
        float l = lrun[qt]; l += __shfl_xor(l, 16); l += __shfl_xor(l, 32);
        if (MODE == 1) l += __builtin_amdgcn_exp2f(sink2 - mrun[qt]);
        const float inv = 1.0f / l;
        bf16_t* orow = op + (size_t)(qt * 16 + fr) * DM + 4 * fq;
#pragma unroll
        for (int d = 0; d < NDV; ++d) { u32x2 w; w.x = cvt_pk_bf16(o[qt][d][0] * inv, o[qt][d][1] * inv); w.y = cvt_pk_bf16(o[qt][d][2] * inv, o[qt][d][3] * inv); *(u32x2*)(orow + d * 16) = w; }
    }
}

__device__ __forceinline__ void attn_phase(const Params& p, int l, LAS unsigned char* lds, int tid, int wid, int lane) {
    unsigned* head = (unsigned*)(p.ws + WS_CTL) + CW_ATTQ + l * 64;
    volatile LAS int* qw = (volatile LAS int*)(lds + LDS_MISC + 64);
    bf16_t* br = (bf16_t*)(p.ws + WS_BR);
    for (;;) {
        if (tid == 0) qw[0] = (int)__hip_atomic_fetch_add(head, 1u, __ATOMIC_RELAXED, __HIP_MEMORY_SCOPE_AGENT);
        __syncthreads();
        const int id = __builtin_amdgcn_readfirstlane(qw[0]);
        __syncthreads();
        if (id >= 640) break;
        if (id < 128) {
            const int b = id >> 5, h = (id >> 3) & 3, qt8 = id & 7; const size_t bh = (size_t)(b * 4 + h);
            const bf16_t* q = (const bf16_t*)(p.ws + WS_MLQ) + (bh * SEQ + qt8 * 256 + wid * 32) * 192;
            const bf16_t* k = (const bf16_t*)(p.ws + WS_MLK) + bh * SEQ * 192; const bf16_t* v = (const bf16_t*)(p.ws + WS_MLVT) + bh * SEQ * 128;
            bf16_t* o = br + (size_t)(b * SEQ + qt8 * 256 + wid * 32) * DM + 512 + h * 128;
            attn_unit<192, 128, 0>(lds, q, k, v, o, 64, 0, 64, 0, 0, 0, 0.f, tid, lane);
        } else if (id < 256) {
            const int u = id - 128, b = u >> 5, h = (u >> 3) & 3, r4 = u & 7; const size_t bh = (size_t)(b * 4 + h);
            const int r = r4 * 4 + (wid >> 1), half = wid & 1;
            int kr_lo = r4 * 4 - 4; kr_lo = kr_lo < 0 ? 0 : (kr_lo > 24 ? 24 : kr_lo);
            int kr_hi = r4 * 4 + 3 - 4; kr_hi = (kr_hi < 0 ? 0 : (kr_hi > 24 ? 24 : kr_hi)) + 7;
            int rs = r - 4; rs = rs < 0 ? 0 : (rs > 24 ? 24 : rs);
            { const float* rp = p.in[I_NA_RPB] + ((size_t)l * 4 + h) * 15 * 31; LAS float* rl = (LAS float*)(lds + ATT_RPB_OFF); if (tid < 465) rl[tid] = rp[tid] * LOG2E; }
            const bf16_t* q = (const bf16_t*)(p.ws + WS_NAQ) + (bh * SEQ + r * 64 + half * 32) * 128;
            const bf16_t* k = (const bf16_t*)(p.ws + WS_NAK) + (bh * SEQ + kr_lo * 64) * 128; const bf16_t* v = (const bf16_t*)(p.ws + WS_NAVT) + (bh * 64 + kr_lo * 2) * 128 * 32;
            bf16_t* o = br + (size_t)(b * SEQ + r * 64 + half * 32) * DM + 0 + h * 128;
            attn_unit<128, 128, 2>(lds, q, k, v, o, 2 * (kr_hi - kr_lo + 1), 2 * (rs - kr_lo), 2 * (rs - kr_lo) + 16, half * 32, kr_lo, r, 0.f, tid, lane);
        } else if (id < 512) {
            const int u = id - 256, b = u >> 6, kvh = (u >> 5) & 1, qb = u & 31, q0 = qb * 64; const int hq = kvh * 4 + (wid >> 1), qpos0 = q0 + (wid & 1) * 32;
            const int kstart = q0 - 128 < 0 ? 0 : q0 - 128, kend = q0 + 192 > SEQ ? SEQ : q0 + 192, nch = (kend - kstart) >> 5;
            int c_lo = (qpos0 - 128 - kstart) >> 5; c_lo = c_lo < 0 ? 0 : c_lo; int c_hi = ((qpos0 + 159 - kstart) >> 5) + 1; c_hi = c_hi > nch ? nch : c_hi;
            const bf16_t* q = (const bf16_t*)(p.ws + WS_SWQ) + ((size_t)(b * 8 + hq) * SEQ + qpos0) * 64;
            const bf16_t* k = (const bf16_t*)(p.ws + WS_SWK) + ((size_t)(b * 2 + kvh) * SEQ + kstart) * 64; const bf16_t* v = (const bf16_t*)(p.ws + WS_SWVT) + ((size_t)(b * 2 + kvh) * 64 + (kstart >> 5)) * 64 * 32;
            bf16_t* o = br + (size_t)(b * SEQ + qpos0) * DM + 1024 + hq * 64;
            attn_unit<64, 64, 1>(lds, q, k, v, o, nch, c_lo, c_hi, qpos0, kstart, 0, p.in[I_SWA_SINK][l * 8 + hq] * LOG2E, tid, lane);
        } else {
            const int u = id - 512, b = u >> 5, h = (u >> 3) & 3, qt8 = u & 7; const size_t bh = (size_t)(b * 4 + h);
            const bf16_t* q = (const bf16_t*)(p.ws + WS_MEQ) + (bh * SEQ + qt8 * 256 + wid * 32) * 128;
            const bf16_t* k = (const bf16_t*)(p.ws + WS_MEK) + bh * MEML * 128; const bf16_t* v = (const bf16_t*)(p.ws + WS_MEVT) + bh * MEML * 128;
            bf16_t* o = br + (size_t)(b * SEQ + qt8 * 256 + wid * 32) * DM + 1536 + h * 128;
            attn_unit<128, 128, 0>(lds, q, k, v, o, 8, 0, 8, 0, 0, 0, 0.f, tid, lane);
        }
    }
}

__device__ __forceinline__ void router_phase(const Params& p, LAS unsigned char* lds, int tid, int wid, int lane) {
    const float* hres = p.out; const float* g = p.in[I_NORM_FFN] + DM; const float* wr = p.in[I_ROUTER];
    unsigned* cnt = (unsigned*)(p.ws + WS_CTL) + CW_MOECNT;
    bf16_t* xg = (bf16_t*)(p.ws + WS_XG); int* tokv = (int*)(p.ws + WS_TOK); float* wtv = (float*)(p.ws + WS_WT);
    LAS float* wl = (LAS float*)lds;
    LAS float* sel = (LAS float*)(lds + 65536);
    for (int i = tid; i < DM * NEXP; i += NTHREADS) { const int d = i >> 3, e = i & 7; wl[e * DM + d] = wr[i]; }
    __syncthreads();
    for (int grp = blockIdx.x; grp < NTOK / 32; grp += gridDim.x) {
#pragma unroll 1
        for (int ti = 0; ti < 4; ++ti) {
            const int tl = wid * 4 + ti, token = grp * 32 + tl;
            const f32x4* sp = (const f32x4*)(hres + (size_t)token * DM); f32x4 v[8]; float ss = 0.f;
#pragma unroll
            for (int j = 0; j < 8; ++j) { v[j] = sp[lane + 64 * j]; ss += v[j][0] * v[j][0] + v[j][1] * v[j][1] + v[j][2] * v[j][2] + v[j][3] * v[j][3]; }
            ss = wave_sum(ss); const float rstd = 1.0f / sqrtf(ss * (1.0f / DM) + EPS);
            float lg[8];
#pragma unroll
            for (int e = 0; e < 8; ++e) lg[e] = 0.f;
#pragma unroll
            for (int j = 0; j < 8; ++j) { const f32x4 gv = ((const f32x4*)g)[lane + 64 * j]; const f32x4 hn = v[j] * rstd * gv;
#pragma unroll
                for (int e = 0; e < 8; ++e) { const f32x4 w4 = *(const LAS f32x4*)(wl + e * DM + 4 * (lane + 64 * j)); lg[e] += hn[0] * w4[0] + hn[1] * w4[1] + hn[2] * w4[2] + hn[3] * w4[3]; } }
#pragma unroll
            for (int e = 0; e < 8; ++e) lg[e] = wave_sum(lg[e]);
            int i0 = 0; float v0 = lg[0];
#pragma unroll
            for (int e = 1; e < 8; ++e) if (lg[e] > v0) { v0 = lg[e]; i0 = e; }
            int i1 = -1; float v1 = -3.0e38f;
#pragma unroll
            for (int e = 0; e < 8; ++e) if (e != i0 && lg[e] > v1) { v1 = lg[e]; i1 = e; }
            const float e1 = __expf(v1 - v0), w0 = 1.0f / (1.0f + e1), w1 = e1 * w0;
            if (lane == 0) { sel[tl * 8 + 0] = __int_as_float(i0); sel[tl * 8 + 1] = __int_as_float(i1); sel[tl * 8 + 2] = w0; sel[tl * 8 + 3] = w1; sel[tl * 8 + 4] = rstd; }
        }
        __syncthreads();
        if (tid < NEXP) { int n = 0;
            for (int t = 0; t < 32; ++t) { n += (__float_as_int(sel[t * 8 + 0]) == tid) ? 1 : 0; n += (__float_as_int(sel[t * 8 + 1]) == tid) ? 1 : 0; }
            int base = n ? (int)__hip_atomic_fetch_add(cnt + tid * 64, (unsigned)n, __ATOMIC_RELAXED, __HIP_MEMORY_SCOPE_AGENT) : 0;
            for (int t = 0; t < 32; ++t) { if (__float_as_int(sel[t * 8 + 0]) == tid) sel[t * 8 + 5] = __int_as_float(base++); if (__float_as_int(sel[t * 8 + 1]) == tid) sel[t * 8 + 6] = __int_as_float(base++); } }
        __syncthreads();
#pragma unroll 1
        for (int ti = 0; ti < 4; ++ti) {
            const int tl = wid * 4 + ti, token = grp * 32 + tl;
            const int e0 = __float_as_int(sel[tl * 8 + 0]), e1 = __float_as_int(sel[tl * 8 + 1]); const float w0 = sel[tl * 8 + 2], w1 = sel[tl * 8 + 3], rstd = sel[tl * 8 + 4];
            const int s0 = e0 * ECAP + __float_as_int(sel[tl * 8 + 5]), s1 = e1 * ECAP + __float_as_int(sel[tl * 8 + 6]);
            const f32x4* sp = (const f32x4*)(hres + (size_t)token * DM);
#pragma unroll
            for (int j = 0; j < 8; ++j) { const f32x4 x = sp[lane + 64 * j]; const f32x4 gv = ((const f32x4*)g)[lane + 64 * j];
                u32x2 w; w.x = cvt_pk_bf16(x[0] * rstd * gv[0], x[1] * rstd * gv[1]); w.y = cvt_pk_bf16(x[2] * rstd * gv[2], x[3] * rstd * gv[3]);
                *(u32x2*)(xg + (size_t)s0 * DM + 4 * (lane + 64 * j)) = w; *(u32x2*)(xg + (size_t)s1 * DM + 4 * (lane + 64 * j)) = w; }
            if (lane == 0) { tokv[s0] = token; wtv[s0] = w0; tokv[s1] = token; wtv[s1] = w1; }
        }
        __syncthreads();
    }
}

constexpr int MOE_TAB_OFF = LDS_MISC + 128;
__device__ __forceinline__ void moe_table(LAS unsigned char* lds, const unsigned* cnt, int nN, int tid) {
    LAS int* tab = (LAS int*)(lds + MOE_TAB_OFF);
    __syncthreads();
    if (tid == 0) { int acc = 0; for (int e = 0; e < 8; ++e) { const int n = ((int)cnt[e * 64] + 255) >> 8; tab[e] = n; tab[8 + e] = acc; acc += n * nN; } tab[16] = acc; }
    __syncthreads();
}
struct SchedMoe {
    const char* A; const char* B; size_t a_estride, b_estride, a_tstride, b_tstride; const LAS int* tab; int G, c;
    __device__ __forceinline__ bool next(int i, pg8::Unit& u) const {
        const int L = i * G + c; if (L >= tab[16]) return false;
        int e = 0;
#pragma unroll
        for (int k = 1; k < 8; ++k) e = (L >= tab[8 + k]) ? k : e;
        const int ne = tab[e], loc = L - tab[8 + e], pm = loc % ne, pn = loc / ne;
        u.A = A + (size_t)e * a_estride + (size_t)pm * a_tstride; u.B = B + (size_t)e * b_estride + (size_t)pn * b_tstride;
        u.orow = e * ECAP + pm * 256; u.ocol = pn; u.x0 = e; u.x1 = pm * 256; return true;
    }
};
struct SchedMerge {
    const char* br; const char* wb; int G, c;
    __device__ __forceinline__ bool next(int i, pg8::Unit& u) const {
        int pm, pn; if (!pg8::static_tile(i >> 2, G, c, NTOK / 256, DM / 256, pm, pn)) return false;
        const int n = i & 3;
        u.A = br + ((size_t)pm * 256 * DM + n * 512) * 2; u.B = wb + ((size_t)n * DM * 512 + (size_t)pn * 256 * 512) * 2; u.orow = pm * 256; u.ocol = pn; u.x0 = n; u.x1 = 0; return true;
    }
};
constexpr int NPHASE = 23;
constexpr int LDS_PARAMS = LDS_MISC + 256;
template <class T> __device__ __forceinline__ T* uni(T* q) { const unsigned long long v = (unsigned long long)q; const unsigned lo = __builtin_amdgcn_readfirstlane((unsigned)v), hi = __builtin_amdgcn_readfirstlane((unsigned)(v >> 32)); return (T*)(((unsigned long long)hi << 32) | lo); }
__device__ __forceinline__ Params load_params(LAS unsigned char* lds) {
    unsigned poff = LDS_PARAMS; asm volatile("" : "+v"(poff)); poff = __builtin_amdgcn_readfirstlane(poff);
    const LAS Params* P = (const LAS Params*)(lds + poff); Params p;
#pragma unroll
    for (int i = 0; i < 30; ++i) p.in[i] = uni(P->in[i]);
    p.out = uni(P->out); p.ws = uni(P->ws); p.ph_lo = 0; p.ph_hi = 0; return p;
}
#define PH_HEAD int tid = threadIdx.x; asm volatile("" : "+v"(tid)); const Params p = load_params(lds); const int lane = tid & 63, wid = __builtin_amdgcn_readfirstlane(tid >> 6); int G = (int)gridDim.x, cblk = (int)blockIdx.x; asm volatile("" : "+v"(G), "+v"(cblk)); G = __builtin_amdgcn_readfirstlane(G); cblk = __builtin_amdgcn_readfirstlane(cblk); \
    unsigned char* ws = p.ws; unsigned* ctl = (unsigned*)(ws + WS_CTL); unsigned char* lw = ws + WS_LW + (size_t)l * LW_BYTES; bf16_t* U = (bf16_t*)(ws + WS_U); (void)lane; (void)wid; (void)G; (void)cblk; (void)ctl; (void)lw; (void)U
#define PHASE_FN static __device__ __forceinline__ void

PHASE_FN ph_prologue(LAS unsigned char* lds, int l) { PH_HEAD; p0_prologue(p, lds, tid, wid, lane); }
PHASE_FN ph_ingate(LAS unsigned char* lds, int l) { PH_HEAD;
    pg8::SchedGrid S{(const char*)U, (const char*)(lw + LW_INGATE), DM, DM, NTOK / 256, 12288 / 256, G, cblk};
    pg8::EpiInGate E{(bf16_t*)(ws + WS_Z), (bf16_t*)(ws + WS_GATES), p.in[I_B_GATE] + (size_t)l * 8192};
    pg8::gemm_phase(lds, DM, DM, DM, S, E, tid); }
PHASE_FN ph_prep1(LAS unsigned char* lds, int l) { PH_HEAD; prep1(p, l, lds, tid, wid, lane); }
PHASE_FN ph_mlaup_q(LAS unsigned char* lds, int l) { PH_HEAD;
    pg8::SchedGrid S{(const char*)(ws + WS_CQN), (const char*)(lw + LW_UQ), 768, 768, NTOK / 256, 3, G, cblk};
    pg8::EpiBf16 E{(bf16_t*)(ws + WS_QRAW), 768}; pg8::gemm_phase(lds, 768, 768, 768, S, E, tid); }
PHASE_FN ph_mlaup_kv(LAS unsigned char* lds, int l) { PH_HEAD;
    pg8::SchedGrid S{(const char*)(ws + WS_CKVN), (const char*)(lw + LW_UKV), 256, 256, NTOK / 256, 4, G, (cblk + G - 96 % G) % G};
    pg8::EpiBf16 E{(bf16_t*)(ws + WS_KVRAW), 1024}; pg8::gemm_phase(lds, 256, 256, 256, S, E, tid); }
PHASE_FN ph_memkv(LAS unsigned char* lds, int l) { PH_HEAD;
    pg8::SchedGrid S{(const char*)(ws + WS_MEMN + (size_t)l * NMEM * DM * 2), (const char*)(lw + LW_MEMKV), DM, DM, NMEM / 256, 4, G, (cblk + G - (224 + 16 * l) % G) % G};
    pg8::EpiBf16 E{(bf16_t*)(ws + WS_MEMKV) + (size_t)l * NMEM * 1024, 1024}; pg8::gemm_phase(lds, DM, DM, DM, S, E, tid); }
PHASE_FN ph_prep2(LAS unsigned char* lds, int l) { PH_HEAD; prep2(p, l, lds, tid, wid, lane); }
PHASE_FN ph_attn(LAS unsigned char* lds, int l) { PH_HEAD; attn_phase(p, l, lds, tid, wid, lane); }
PHASE_FN ph_merge(LAS unsigned char* lds, int l) { PH_HEAD;
    SchedMerge S{(const char*)(ws + WS_BR), (const char*)(lw + LW_BR), G, cblk};
    pg8::EpiMerge E{(const bf16_t*)(ws + WS_GATES), (bf16_t*)(ws + WS_MERGED)};
    pg8::gemm_phase(lds, DM, 512, 512, S, E, tid); }
PHASE_FN ph_wo(LAS unsigned char* lds, int l) { PH_HEAD;
    pg8::SchedGrid S{(const char*)(ws + WS_MERGED), (const char*)(lw + LW_O), DM, DM, NTOK / 256, DM / 256, G, cblk};
    pg8::EpiResF32 E{l == 0 ? p.in[I_X] : (const float*)p.out, p.out};
    pg8::gemm_phase(lds, DM, DM, DM, S, E, tid); }
PHASE_FN ph_norm(LAS unsigned char* lds, int l) { PH_HEAD;
    norm_rows(p.out, l == 0 ? p.in[I_NORM_FFN] : p.in[I_NORM_MIX] + DM, U, NTOK, wid, lane); }
PHASE_FN ph_ffnup(LAS unsigned char* lds, int l) { PH_HEAD;
    pg8::SchedGrid S{(const char*)U, (const char*)(ws + WS_FFNUP), DM, DM, NTOK / 256, 2 * DFF / 256, G, cblk};
    pg8::EpiSwiGLU E{(bf16_t*)(ws + WS_ACT), DFF};
    pg8::gemm_phase(lds, DM, DM, DM, S, E, tid); }
PHASE_FN ph_ffndown(LAS unsigned char* lds, int l) { PH_HEAD;
    pg8::SchedGrid S{(const char*)(ws + WS_ACT), (const char*)(ws + WS_FFNDN), DFF, DFF, NTOK / 256, DM / 256, G, cblk};
    pg8::EpiResF32 E{(const float*)p.out, p.out};
    pg8::gemm_phase(lds, DFF, DFF, DFF, S, E, tid); }
PHASE_FN ph_router(LAS unsigned char* lds, int l) { PH_HEAD; router_phase(p, lds, tid, wid, lane); }
PHASE_FN ph_moeup(LAS unsigned char* lds, int l) { PH_HEAD;
    moe_table(lds, ctl + CW_MOECNT, 2 * DFFE / 256, tid);
    const SchedMoe S{(const char*)(ws + WS_XG), (const char*)(ws + WS_MOEUP), (size_t)ECAP * DM * 2, (size_t)2 * DFFE * DM * 2, (size_t)256 * DM * 2, (size_t)256 * DM * 2, (const LAS int*)(lds + MOE_TAB_OFF), G, cblk};
    pg8::EpiSwiGLU E{(bf16_t*)(ws + WS_ACTM), DFFE};
    pg8::gemm_phase(lds, DM, DM, DM, S, E, tid); }
PHASE_FN ph_moedown(LAS unsigned char* lds, int l) { PH_HEAD;
    moe_table(lds, ctl + CW_MOECNT, DM / 256, tid);
    const SchedMoe S{(const char*)(ws + WS_ACTM), (const char*)(ws + WS_MOEDN), (size_t)ECAP * DFFE * 2, (size_t)DM * DFFE * 2, (size_t)256 * DFFE * 2, (size_t)256 * DFFE * 2, (const LAS int*)(lds + MOE_TAB_OFF), G, cblk};
    pg8::EpiMoeDown E{p.out, (const int*)(ws + WS_TOK), (const float*)(ws + WS_WT), ctl + CW_MOECNT};
    pg8::gemm_phase(lds, DFFE, DFFE, DFFE, S, E, tid); }

__global__ void __launch_bounds__(NTHREADS, 2) mk_fwd(Params pk) {
    extern __shared__ __attribute__((aligned(16))) unsigned char lds_raw[];
    LAS unsigned char* lds = (LAS unsigned char*)lds_raw;
    const int tid = threadIdx.x;
    if (tid < 64) ((LAS unsigned*)(lds + LDS_MISC))[tid] = 0u;
    if (tid == 64) { LAS Params* P = (LAS Params*)(lds + LDS_PARAMS);
#pragma unroll
        for (int i = 0; i < 30; ++i) P->in[i] = pk.in[i];
        P->out = pk.out; P->ws = pk.ws; P->ph_lo = pk.ph_lo; P->ph_hi = pk.ph_hi; }
    __syncthreads();
    unsigned* ctl = (unsigned*)(pk.ws + WS_CTL);
#if !MK_MULTI
    (void)xcd_barrier_post(ctl + CW_BAR, (volatile LAS unsigned*)(lds + LDS_MISC));
#endif
    const int lo = pk.ph_lo, hi = pk.ph_hi;
#define IN(k) (lo <= (k) && (k) < hi)
#if MK_MULTI
#define SEAM(k) do { } while (0)
#else
#define SEAM(k) do { if (IN((k) + 1)) { const Params q_ = load_params(lds); XcdBarrier b2_; b2_.bar = (unsigned*)(q_.ws + WS_CTL) + CW_BAR; b2_.x = xb_xcc_id(); b2_.st = (volatile LAS unsigned*)(lds + LDS_MISC); xcd_barrier(b2_); } } while (0)
#endif
    if (IN(0)) { ph_prologue(lds, 0); SEAM(0); }
#pragma unroll 1
    for (int l = 0; l < DEPTH; ++l) {
        const int pb = 1 + 11 * l;
        if (IN(pb + 0)) { ph_ingate(lds, l); SEAM(pb + 0); }
        if (IN(pb + 1)) { ph_prep1(lds, l); SEAM(pb + 1); }
        if (IN(pb + 2)) { ph_mlaup_q(lds, l); ph_mlaup_kv(lds, l); if (l == 0) { ph_memkv(lds, 0); ph_memkv(lds, 1); } SEAM(pb + 2); }
        if (IN(pb + 3)) { ph_prep2(lds, l); SEAM(pb + 3); }
        if (IN(pb + 4)) { ph_attn(lds, l); SEAM(pb + 4); }
        if (IN(pb + 5)) { ph_merge(lds, l); SEAM(pb + 5); }
        if (IN(pb + 6)) { ph_wo(lds, l); SEAM(pb + 6); }
        if (l == 0) {
            if (IN(pb + 7)) { ph_norm(lds, 0); SEAM(pb + 7); }
            if (IN(pb + 8)) { ph_ffnup(lds, 0); SEAM(pb + 8); }
            if (IN(pb + 9)) { ph_ffndown(lds, 0); SEAM(pb + 9); }
            if (IN(pb + 10)) { ph_norm(lds, 1); SEAM(pb + 10); }
        } else {
            if (IN(pb + 7)) { ph_router(lds, 1); SEAM(pb + 7); }
            if (IN(pb + 8)) { ph_moeup(lds, 1); SEAM(pb + 8); }
            if (IN(pb + 9)) { ph_moedown(lds, 1); }
        }
    }
#undef IN
#undef SEAM
}

extern "C" void kernel_launch(void* const* d_in, const int* in_sizes, int n_in, void* d_out, int out_size, void* d_ws, size_t ws_size, hipStream_t stream) {
    static int grid = 0;
    if (grid == 0) {
        if (n_in != 30 || out_size != NTOK * DM || ws_size < WS_END) { fprintf(stderr, "kernel_launch: unexpected problem (n_in %d, out %d, ws %zu < %zu)\n", n_in, out_size, ws_size, (size_t)WS_END); grid = -1; return; }
        int dev = 0, cus = 0, per_cu = 0;
        if (hipGetDevice(&dev) != hipSuccess || hipDeviceGetAttribute(&cus, hipDeviceAttributeMultiprocessorCount, dev) != hipSuccess) { grid = -1; return; }
        if (hipFuncSetAttribute((const void*)mk_fwd, hipFuncAttributeMaxDynamicSharedMemorySize, LDS_BYTES) != hipSuccess) { fprintf(stderr, "kernel_launch: hipFuncSetAttribute failed\n"); grid = -1; return; }
        if (hipOccupancyMaxActiveBlocksPerMultiprocessor(&per_cu, (const void*)mk_fwd, NTHREADS, LDS_BYTES) != hipSuccess || per_cu < 1) fprintf(stderr, "kernel_launch: occupancy query reports %d\n", per_cu);
        (void)hipGetLastError();
        grid = cus;
    }
    if (grid < 0) return;
    if (hipMemsetAsync((char*)d_ws + WS_CTL, 0, CTL_BYTES, stream) != hipSuccess) return;
    Params a{};
    for (int i = 0; i < 30; ++i) a.in[i] = (const float*)d_in[i];
    a.out = (float*)d_out; a.ws = (unsigned char*)d_ws;
#if MK_MULTI
    for (int ph = 0; ph < NPHASE - 1; ++ph) { a.ph_lo = ph; a.ph_hi = ph + 1; hipLaunchKernelGGL(mk_fwd, dim3(grid), dim3(NTHREADS), LDS_BYTES, stream, a); }
#else
    a.ph_lo = 0; a.ph_hi = NPHASE;
    hipLaunchKernelGGL(mk_fwd, dim3(grid), dim3(NTHREADS), LDS_BYTES, stream, a);
#endif
    const hipError_t le = hipPeekAtLastError();
    if (le != hipSuccess) fprintf(stderr, "kernel_launch: launch failed: %s\n", hipGetErrorName(le));
}
```

```cpp
#include <hip/hip_runtime.h>
#include <cstdio>
#include <cstdint>

#define LAS __attribute__((address_space(3)))
typedef unsigned short bf16_t;
typedef short bf16x8 __attribute__((ext_vector_type(8)));
typedef float f32x4 __attribute__((ext_vector_type(4)));
typedef float f32x2 __attribute__((ext_vector_type(2)));
typedef unsigned u32x4 __attribute__((ext_vector_type(4)));
typedef unsigned u32x2 __attribute__((ext_vector_type(2)));

#ifndef MK_MULTI
#define MK_MULTI 0
#endif

constexpr int DM = 2048, NBATCH = 4, SEQ = 2048, NTOK = NBATCH * SEQ, MEML = 256, NMEM = NBATCH * MEML, DEPTH = 2;
constexpr int ZC = 4096;
constexpr int INC = 3904;
constexpr int Z_NAQ = 0, Z_NAK = 512, Z_NAV = 1024, Z_CQ = 1536, Z_CKV = 2304, Z_KPE = 2560, Z_SWQ = 2624, Z_SWK = 3136, Z_SWV = 3264, Z_MEQ = 3392;
constexpr int DFF = 5632, NEXP = 8, DFFE = 7168, ECAP = 8192;
constexpr float LOG2E = 1.4426950408889634f;
constexpr float EPS = 1e-6f;
constexpr int NTHREADS = 512;
constexpr float SC_ACT8 = 16.0f, SC_W8 = 64.0f, SC_H8 = 8.0f;

constexpr size_t al256(size_t x) { return (x + 255) & ~(size_t)255; }
constexpr size_t WS_CTL = 0, CTL_BYTES = 65536;
constexpr size_t WS_ROPE = WS_CTL + CTL_BYTES;
constexpr size_t WS_LW = WS_ROPE + (size_t)SEQ * 32 * 8;
constexpr size_t LW_IN = 0;
constexpr size_t LW_GATE8 = LW_IN + (size_t)4096 * 2048 * 2;
#ifndef INGATE_FP8
#define INGATE_FP8 1
#endif
#define GATES_FP8 0
#ifndef MOE_FP8
#define MOE_FP8 1
#endif
constexpr size_t MOE_ES = MOE_FP8 ? 1 : 2;
constexpr size_t LW_UQ = LW_GATE8 + (size_t)8192 * 2048 * 2;
constexpr size_t LW_UKV = LW_UQ + (size_t)768 * 768 * 2;
constexpr size_t LW_MEMKV = LW_UKV + (size_t)1024 * 256 * 2;
constexpr size_t LW_BR = LW_MEMKV + (size_t)1024 * 2048 * 2;
constexpr size_t LW_O = LW_BR + (size_t)4 * 2048 * 512 * 2;
constexpr size_t LW_BYTES = LW_O + (size_t)2048 * 2048 * 2;
constexpr size_t WS_FFNUP = WS_LW + 2 * LW_BYTES;
constexpr size_t WS_FFNDN = WS_FFNUP + (size_t)2 * DFF * 2048 * 2;
constexpr size_t WS_MOEUP = WS_FFNDN + (size_t)2048 * DFF * 2;
constexpr size_t WS_MOEDN = WS_MOEUP + (size_t)NEXP * 2 * DFFE * 2048 * MOE_ES;
constexpr size_t WS_U = WS_MOEDN + (size_t)NEXP * 2048 * DFFE * MOE_ES;
constexpr size_t WS_U8 = WS_U + (size_t)NTOK * DM * 2;
constexpr size_t WS_MEMN = WS_U8 + (size_t)NTOK * DM;
constexpr size_t WS_Z = WS_MEMN + (size_t)2 * NMEM * DM * 2;
constexpr size_t WS_GATES = WS_Z + (size_t)NTOK * ZC * 2;
constexpr size_t WS_NAQ = WS_GATES + (size_t)NTOK * 8192 * 2;
constexpr size_t WS_NAK = WS_NAQ + (size_t)NTOK * 512 * 2;
constexpr size_t WS_NAVT = WS_NAK + (size_t)NTOK * 512 * 2;
constexpr size_t WS_CQN = WS_NAVT + (size_t)NTOK * 512 * 2;
constexpr size_t WS_CKVN = WS_CQN + (size_t)NTOK * 768 * 2;
constexpr size_t WS_SWQ = WS_CKVN + (size_t)NTOK * 256 * 2;
constexpr size_t WS_SWK = WS_SWQ + (size_t)NTOK * 512 * 2;
constexpr size_t WS_SWVT = WS_SWK + (size_t)NTOK * 128 * 2;
constexpr size_t WS_MEQ = WS_SWVT + (size_t)NTOK * 128 * 2;
constexpr size_t WS_QRAW = WS_MEQ + (size_t)NTOK * 512 * 2;
constexpr size_t WS_KVRAW = WS_QRAW + (size_t)NTOK * 768 * 2;
constexpr size_t WS_MEMKV = WS_KVRAW + (size_t)NTOK * 1024 * 2;
constexpr size_t WS_MLQ = WS_MEMKV + (size_t)2 * NMEM * 1024 * 2;
constexpr size_t WS_MLK = WS_MLQ + (size_t)NTOK * 768 * 2;
constexpr size_t WS_MLVT = WS_MLK + (size_t)NTOK * 768 * 2;
constexpr size_t WS_MEK = WS_MLVT + (size_t)NTOK * 512 * 2;
constexpr size_t WS_MEVT = WS_MEK + (size_t)NMEM * 512 * 2;
constexpr size_t WS_BR = WS_MEVT + (size_t)NMEM * 512 * 2;
constexpr size_t WS_MERGED = WS_BR + (size_t)NTOK * DM * 2;
constexpr size_t WS_ACT = WS_MERGED + (size_t)NTOK * DM * 2;
constexpr size_t WS_XG = WS_ACT + (size_t)NTOK * DFF * 2;
constexpr size_t WS_TOK = WS_XG + (size_t)NEXP * ECAP * DM * MOE_ES;
constexpr size_t WS_WT = WS_TOK + (size_t)NEXP * ECAP * 4;
constexpr size_t WS_ACTM = WS_WT + (size_t)NEXP * ECAP * 4;
constexpr size_t WS_END = WS_ACTM + (size_t)NEXP * ECAP * DFFE * MOE_ES;

constexpr int CW_BAR = 0;
constexpr int CW_MOECNT = 4096;
constexpr int CW_ATTQ = 4096 + 1024;

constexpr int LDS_BYTES = 147456;
constexpr int LDS_MISC = 147456 - 1024;
namespace pg8 {
constexpr int BM = 256, BK = 64, HALF = 128, HTB = HALF * BK * 2, STAGE_BYTES = 8 * HTB, NXCD = 8, WGM = 8;
__host__ __device__ __forceinline__ int lds_byte(int r, int c) { const int st = (r >> 4) * 2 + (c >> 5), rr = r & 15, cc = c & 31, ob = rr * 64 + cc * 2; return st * 1024 + (ob ^ (((ob >> 9) & 1) << 5)); }
__host__ __device__ __forceinline__ void stage_rc(int b, int& R, int& C) { const int st = b / 1024, sb = b % 1024, swz = sb ^ (((sb >> 9) & 1) << 5); R = (st >> 1) * 16 + swz / 64; C = (st & 1) * 32 + (swz % 64) / 2; }
__host__ __device__ __forceinline__ int perm32(int rho) { const int n = rho >> 4, i = rho & 15; return 8 * (i >> 2) + 4 * n + (i & 3); }

struct Unit { const char* A; const char* B; int orow, ocol, x0, x1; };

__device__ __forceinline__ bool static_tile(int i, int G, int c, int nM, int nN, int& pm, int& pn) {
    const int nwg = nM * nN; const long L = (long)i * G + c; if (L >= nwg) return false;
    int wgid = (int)L; { const int q = nwg / NXCD, r = nwg % NXCD, xcd = wgid % NXCD, off = wgid / NXCD; wgid = (xcd < r ? xcd * (q + 1) : r * (q + 1) + (xcd - r) * q) + off; }
    const int nig = WGM * nN, gid = wgid / nig, fm = gid * WGM, gsz = (nM - fm) < WGM ? (nM - fm) : WGM;
    pm = fm + ((wgid % nig) % gsz); pn = (wgid % nig) / gsz; return true;
}
struct SchedGrid {
    const char* A; const char* B; int lda, ldb, nM, nN, G, c;
    __device__ __forceinline__ bool next(int i, Unit& u) const {
        int pm, pn; if (!static_tile(i, G, c, nM, nN, pm, pn)) return false;
        u.A = A + (size_t)pm * 256 * lda * 2; u.B = B + (size_t)pn * 256 * ldb * 2; u.orow = pm * 256; u.ocol = pn; u.x0 = 0; u.x1 = 0; return true;
    }
};

__device__ __forceinline__ unsigned cvt_pk_bf16(float lo, float hi) { unsigned r; asm volatile("v_cvt_pk_bf16_f32 %0, %1, %2" : "=v"(r) : "v"(lo), "v"(hi)); return r; }
__device__ __forceinline__ float sigmoidf_(float x) { return __builtin_amdgcn_rcpf(1.0f + __builtin_amdgcn_exp2f(-x * LOG2E)); }

typedef f32x4 Acc[2][2][4][2];

typedef int i32x8 __attribute__((ext_vector_type(8)));
typedef int i32x4 __attribute__((ext_vector_type(4)));
template <class Epi, class Sched, bool FP8 = false>
__device__ __forceinline__ void gemm_phase(LAS unsigned char* lds, const int lda, const int ldb, const int K, const Sched S, Epi& E, const int tid) {
    const int wid = __builtin_amdgcn_readfirstlane(tid >> 6), lane = tid & 63, wr = wid >> 2, wc = wid & 3, fr = lane & 15, fq = lane >> 4;
    const int nt = K / BK;
    unsigned voffA[2], voffB[2];
#pragma unroll
    for (int i = 0; i < 2; ++i) { int R, C; stage_rc(tid * 16 + i * 8192, R, C); const int Rb = Epi::PERM ? ((R & ~31) + perm32(R & 31)) : R;
        voffA[i] = (unsigned)(R * lda + C) * 2u; voffB[i] = (unsigned)(Rb * ldb + C) * 2u; }
    const size_t kstep = (size_t)(BK * 2);
    const size_t hstepA = (size_t)HALF * lda * 2, hstepB = (size_t)HALF * ldb * 2;
    const unsigned ldsw = (unsigned)wid * 1024u;
    const int aoff = lds_byte(wr * 64 + fr, fq * 8), boff = lds_byte(wc * 32 + fr, fq * 8);
#define PG8_SA(b, h) (((b) * 2 + (h)) * HTB)
#define PG8_SB(b, h) ((4 + (b) * 2 + (h)) * HTB)
#define PG8_STAGE(bufoff, gbase, voff) do { _Pragma("unroll") for (int _i = 0; _i < 2; ++_i) \
        __builtin_amdgcn_global_load_lds((const unsigned*)((const char*)(gbase) + (voff)[_i]), (LAS unsigned*)(lds + (bufoff) + ldsw + _i * 8192), 16, 0, 0); } while (0)
#define PG8_LDA(dst, b, h) do { _Pragma("unroll") for (int m = 0; m < 4; ++m) _Pragma("unroll") for (int k = 0; k < 2; ++k) dst[m][k] = *(const LAS bf16x8*)(lds + PG8_SA(b, h) + aoff + m * 2048 + k * 1024); } while (0)
#define PG8_LDB(dst, b, h) do { _Pragma("unroll") for (int n = 0; n < 2; ++n) _Pragma("unroll") for (int k = 0; k < 2; ++k) dst[n][k] = *(const LAS bf16x8*)(lds + PG8_SB(b, h) + boff + n * 2048 + k * 1024); } while (0)
#define PG8_MMA(ai, bj, At, Bt) do { __builtin_amdgcn_s_setprio(1); _Pragma("unroll") for (int m = 0; m < 4; ++m) _Pragma("unroll") for (int n = 0; n < 2; ++n) _Pragma("unroll") for (int k = 0; k < 2; ++k) \
        acc[ai][bj][m][n] = __builtin_amdgcn_mfma_f32_16x16x32_bf16(Bt[n][k], At[m][k], acc[ai][bj][m][n], 0, 0, 0); __builtin_amdgcn_s_setprio(0); } while (0)
#define PG8_CAT(x, y) __builtin_shufflevector(__builtin_bit_cast(i32x4, x), __builtin_bit_cast(i32x4, y), 0, 1, 2, 3, 4, 5, 6, 7)
#define PG8_MMA8(ai, bj, At, Bt) do { __builtin_amdgcn_s_setprio(1); _Pragma("unroll") for (int m = 0; m < 4; ++m) _Pragma("unroll") for (int n = 0; n < 2; ++n) \
        asm volatile("v_mfma_f32_16x16x128_f8f6f4 %0, %1, %2, %0" : "+v"(acc[ai][bj][m][n]) : "v"(PG8_CAT(Bt[n][0], Bt[n][1])), "v"(PG8_CAT(At[m][0], At[m][1]))); __builtin_amdgcn_s_setprio(0); } while (0)
#define PG8_WAIT_V(n) asm volatile("s_waitcnt vmcnt(" #n ")" ::: "memory")
#define PG8_WAIT_L(n) asm volatile("s_waitcnt lgkmcnt(" #n ")" ::: "memory")
#define PG8_BAR __builtin_amdgcn_s_barrier()
#define PG8_SCHED __builtin_amdgcn_sched_barrier(0)
    Unit cur, nxt; int ui = 0;
    if (!S.next(0, cur)) return;
    Acc acc;
#pragma unroll
    for (int a = 0; a < 2; ++a)
#pragma unroll
        for (int b = 0; b < 2; ++b)
#pragma unroll
            for (int m = 0; m < 4; ++m)
#pragma unroll
                for (int n = 0; n < 2; ++n) acc[a][b][m][n] = (f32x4){0.f, 0.f, 0.f, 0.f};
    bf16x8 At[4][2], B0[2][2], B1[2][2];
    const char* cA = cur.A; const char* cB = cur.B;
    PG8_STAGE(PG8_SB(0, 0), cB, voffB); PG8_STAGE(PG8_SB(0, 1), cB + hstepB, voffB); PG8_STAGE(PG8_SA(0, 0), cA, voffA); PG8_STAGE(PG8_SA(0, 1), cA + hstepA, voffA);
    if (wr == 1) PG8_BAR;
    PG8_WAIT_V(2); PG8_BAR;
    PG8_STAGE(PG8_SB(1, 0), cB + kstep, voffB); PG8_STAGE(PG8_SA(1, 0), cA + kstep, voffA); PG8_STAGE(PG8_SB(1, 1), cB + hstepB + kstep, voffB);
    PG8_WAIT_V(6); PG8_BAR;
    for (;;) {
        const bool has_next = S.next(ui + 1, nxt);
        const char* nA = has_next ? nxt.A : cA; const char* nB = has_next ? nxt.B : cB;
        for (int t = 0; t < nt; t += 2) {
            const bool last = (t == nt - 2);
            const char* a1 = cA + (size_t)(t + 1) * kstep;
            const char* a2 = last ? nA : cA + (size_t)(t + 2) * kstep; const char* b2 = last ? nB : cB + (size_t)(t + 2) * kstep;
            const char* a3 = a2 + kstep; const char* b3 = b2 + kstep;
            if constexpr (FP8) {
            PG8_LDB(B0, 0, 0); PG8_LDB(B1, 0, 1); PG8_SCHED; PG8_LDA(At, 0, 0); PG8_STAGE(PG8_SA(1, 1), a1 + hstepA, voffA);
            PG8_WAIT_V(8); PG8_WAIT_L(0); PG8_BAR; PG8_MMA8(0, 0, At, B0); PG8_MMA8(0, 1, At, B1); PG8_BAR; PG8_SCHED;
            PG8_LDA(At, 0, 1); PG8_STAGE(PG8_SB(0, 0), b2, voffB); PG8_STAGE(PG8_SB(0, 1), b2 + hstepB, voffB); PG8_STAGE(PG8_SA(0, 0), a2, voffA);
            PG8_WAIT_V(8); PG8_WAIT_L(0); PG8_BAR; PG8_MMA8(1, 0, At, B0); PG8_MMA8(1, 1, At, B1); PG8_BAR; PG8_SCHED;
            PG8_LDB(B0, 1, 0); PG8_LDB(B1, 1, 1); PG8_SCHED; PG8_LDA(At, 1, 0); PG8_STAGE(PG8_SA(0, 1), a2 + hstepA, voffA);
            PG8_WAIT_V(8); PG8_WAIT_L(0); PG8_BAR; PG8_MMA8(0, 0, At, B0); PG8_MMA8(0, 1, At, B1); PG8_BAR; PG8_SCHED;
            PG8_LDA(At, 1, 1); PG8_STAGE(PG8_SB(1, 0), b3, voffB); PG8_STAGE(PG8_SB(1, 1), b3 + hstepB, voffB); PG8_STAGE(PG8_SA(1, 0), a3, voffA);
            PG8_WAIT_V(8); PG8_WAIT_L(0); PG8_BAR; PG8_MMA8(1, 0, At, B0); PG8_MMA8(1, 1, At, B1); PG8_BAR; PG8_SCHED;
            } else {
            PG8_LDB(B0, 0, 0); PG8_LDB(B1, 0, 1); PG8_SCHED; PG8_LDA(At, 0, 0); PG8_STAGE(PG8_SA(1, 1), a1 + hstepA, voffA);
            PG8_WAIT_V(8); PG8_WAIT_L(0); PG8_BAR; PG8_MMA(0, 0, At, B0); PG8_MMA(0, 1, At, B1); PG8_BAR; PG8_SCHED;
            PG8_LDA(At, 0, 1); PG8_STAGE(PG8_SB(0, 0), b2, voffB); PG8_STAGE(PG8_SB(0, 1), b2 + hstepB, voffB); PG8_STAGE(PG8_SA(0, 0), a2, voffA);
            PG8_WAIT_V(8); PG8_WAIT_L(0); PG8_BAR; PG8_MMA(1, 0, At, B0); PG8_MMA(1, 1, At, B1); PG8_BAR; PG8_SCHED;
            PG8_LDB(B0, 1, 0); PG8_LDB(B1, 1, 1); PG8_SCHED; PG8_LDA(At, 1, 0); PG8_STAGE(PG8_SA(0, 1), a2 + hstepA, voffA);
            PG8_WAIT_V(8); PG8_WAIT_L(0); PG8_BAR; PG8_MMA(0, 0, At, B0); PG8_MMA(0, 1, At, B1); PG8_BAR; PG8_SCHED;
            PG8_LDA(At, 1, 1); PG8_STAGE(PG8_SB(1, 0), b3, voffB); PG8_STAGE(PG8_SB(1, 1), b3 + hstepB, voffB); PG8_STAGE(PG8_SA(1, 0), a3, voffA);
            PG8_WAIT_V(8); PG8_WAIT_L(0); PG8_BAR; PG8_MMA(1, 0, At, B0); PG8_MMA(1, 1, At, B1); PG8_BAR; PG8_SCHED;
            }
        }
        if (wr == 0) PG8_BAR;
        if constexpr (FP8) {
#pragma unroll
            for (int a = 0; a < 2; ++a)
#pragma unroll
                for (int b = 0; b < 2; ++b)
                    asm volatile("s_nop 15\n\ts_nop 15" : "+v"(acc[a][b][0][0]), "+v"(acc[a][b][0][1]), "+v"(acc[a][b][1][0]), "+v"(acc[a][b][1][1]), "+v"(acc[a][b][2][0]), "+v"(acc[a][b][2][1]), "+v"(acc[a][b][3][0]), "+v"(acc[a][b][3][1]));
        }
        E(acc, cur, wr, wc, fr, fq);
        if (!has_next) break;
#pragma unroll
        for (int a = 0; a < 2; ++a)
#pragma unroll
            for (int b = 0; b < 2; ++b)
#pragma unroll
                for (int m = 0; m < 4; ++m)
#pragma unroll
                    for (int n = 0; n < 2; ++n) acc[a][b][m][n] = (f32x4){0.f, 0.f, 0.f, 0.f};
        cur = nxt; cA = nA; cB = nB; ++ui;
        if (wr == 1) PG8_BAR;
    }
    PG8_WAIT_V(0);
    PG8_BAR;
#undef PG8_SA
#undef PG8_SB
#undef PG8_STAGE
#undef PG8_LDA
#undef PG8_MMA8
#undef PG8_CAT
#undef PG8_LDB
#undef PG8_MMA
#undef PG8_WAIT_V
#undef PG8_WAIT_L
#undef PG8_BAR
#undef PG8_SCHED
}

struct EpiInGate {
    static constexpr bool PERM = true;
    bf16_t* z; bf16_t* gates; const float* bgate; float s;
    __device__ __forceinline__ void operator()(const Acc& acc, const Unit& u, int wr, int wc, int fr, int fq) const {
        const int row0 = u.orow + wr * 64 + fr; const bool isg = u.ocol >= 16;
        const int colt = (isg ? u.ocol - 16 : u.ocol) * 256 + wc * 32 + 8 * fq; const int ldc = isg ? 8192 : ZC; bf16_t* base = isg ? gates : z;
        f32x4 bv[2][2];
#pragma unroll
        for (int bj = 0; bj < 2; ++bj)
#pragma unroll
            for (int n = 0; n < 2; ++n) bv[bj][n] = isg ? *(const f32x4*)(bgate + colt + bj * HALF + 4 * n) : (f32x4){0.f, 0.f, 0.f, 0.f};
#pragma unroll
        for (int ai = 0; ai < 2; ++ai)
#pragma unroll
            for (int m = 0; m < 4; ++m) { bf16_t* rowp = base + (size_t)(row0 + ai * HALF + m * 16) * ldc + colt;
#pragma unroll
                for (int bj = 0; bj < 2; ++bj) { f32x4 v0 = acc[ai][bj][m][0] * s + bv[bj][0], v1 = acc[ai][bj][m][1] * s + bv[bj][1];
                    if (isg) {
#pragma unroll
                        for (int j = 0; j < 4; ++j) { v0[j] = sigmoidf_(v0[j]); v1[j] = sigmoidf_(v1[j]); } }
                    u32x4 w; w.x = cvt_pk_bf16(v0[0], v0[1]); w.y = cvt_pk_bf16(v0[2], v0[3]); w.z = cvt_pk_bf16(v1[0], v1[1]); w.w = cvt_pk_bf16(v1[2], v1[3]);
                    *(u32x4*)(rowp + bj * HALF) = w; } }
    }
};
struct EpiBf16 {
    static constexpr bool PERM = true;
    bf16_t* O; int ldc;
    __device__ __forceinline__ void operator()(const Acc& acc, const Unit& u, int wr, int wc, int fr, int fq) const {
        const int row0 = u.orow + wr * 64 + fr, col0 = u.ocol * 256 + wc * 32 + 8 * fq;
#pragma unroll
        for (int ai = 0; ai < 2; ++ai)
#pragma unroll
            for (int m = 0; m < 4; ++m) { bf16_t* rowp = O + (size_t)(row0 + ai * HALF + m * 16) * ldc + col0;
#pragma unroll
                for (int bj = 0; bj < 2; ++bj) { const f32x4 v0 = acc[ai][bj][m][0], v1 = acc[ai][bj][m][1];
                    u32x4 w; w.x = cvt_pk_bf16(v0[0], v0[1]); w.y = cvt_pk_bf16(v0[2], v0[3]); w.z = cvt_pk_bf16(v1[0], v1[1]); w.w = cvt_pk_bf16(v1[2], v1[3]);
                    *(u32x4*)(rowp + bj * HALF) = w; } }
    }
};
struct EpiSwiGLU {
    static constexpr bool PERM = true;
    bf16_t* O; int ldc;
    __device__ __forceinline__ void operator()(const Acc& acc, const Unit& u, int wr, int wc, int fr, int fq) const {
        const int row0 = u.orow + wr * 64 + fr, col0 = u.ocol * 128 + wc * 32 + 8 * fq;
#pragma unroll
        for (int ai = 0; ai < 2; ++ai)
#pragma unroll
            for (int m = 0; m < 4; ++m) { bf16_t* rowp = O + (size_t)(row0 + ai * HALF + m * 16) * ldc + col0;
                f32x4 v0, v1;
#pragma unroll
                for (int j = 0; j < 4; ++j) { const float g0 = acc[ai][0][m][0][j], g1 = acc[ai][0][m][1][j];
                    v0[j] = g0 * sigmoidf_(g0) * acc[ai][1][m][0][j]; v1[j] = g1 * sigmoidf_(g1) * acc[ai][1][m][1][j]; }
                u32x4 w; w.x = cvt_pk_bf16(v0[0], v0[1]); w.y = cvt_pk_bf16(v0[2], v0[3]); w.z = cvt_pk_bf16(v1[0], v1[1]); w.w = cvt_pk_bf16(v1[2], v1[3]);
                *(u32x4*)rowp = w; }
    }
};
__device__ __forceinline__ float bflo(unsigned w) { return __uint_as_float(w << 16); }
__device__ __forceinline__ float bfhi(unsigned w) { return __uint_as_float(w & 0xffff0000u); }
struct EpiMerge {
    static constexpr bool PERM = true;
    const bf16_t* gates; bf16_t* merged;
    __device__ __forceinline__ void operator()(const Acc& acc, const Unit& u, int wr, int wc, int fr, int fq) const {
        const int row0 = u.orow + wr * 64 + fr, col0 = u.ocol * 256 + wc * 32 + 8 * fq, n = u.x0;
#pragma unroll
        for (int ai = 0; ai < 2; ++ai)
#pragma unroll
            for (int m = 0; m < 4; ++m) { const size_t r = (size_t)(row0 + ai * HALF + m * 16);
#pragma unroll
                for (int bj = 0; bj < 2; ++bj) {
                    const u32x4 g = *(const u32x4*)(gates + r * 8192 + n * 2048 + col0 + bj * HALF);
                    bf16_t* mp = merged + r * DM + col0 + bj * HALF;
                    u32x4 o = (u32x4){0u, 0u, 0u, 0u}; if (n > 0) o = *(const u32x4*)mp;
                    const f32x4 v0 = acc[ai][bj][m][0], v1 = acc[ai][bj][m][1];
                    u32x4 w;
                    w.x = cvt_pk_bf16(bflo(o.x) + bflo(g.x) * v0[0], bfhi(o.x) + bfhi(g.x) * v0[1]);
                    w.y = cvt_pk_bf16(bflo(o.y) + bflo(g.y) * v0[2], bfhi(o.y) + bfhi(g.y) * v0[3]);
                    w.z = cvt_pk_bf16(bflo(o.z) + bflo(g.z) * v1[0], bfhi(o.z) + bfhi(g.z) * v1[1]);
                    w.w = cvt_pk_bf16(bflo(o.w) + bflo(g.w) * v1[2], bfhi(o.w) + bfhi(g.w) * v1[3]);
                    *(u32x4*)mp = w; } }
    }
};
__device__ __forceinline__ unsigned pack_fp8x4(float a, float b, float c, float d) { int w = 0; w = __builtin_amdgcn_cvt_pk_fp8_f32(a, b, w, false); w = __builtin_amdgcn_cvt_pk_fp8_f32(c, d, w, true); return (unsigned)w; }
struct EpiGates {
    static constexpr bool PERM = true;
    bf16_t* gates; const float* bgate; float s;
    __device__ __forceinline__ void operator()(const Acc& acc, const Unit& u, int wr, int wc, int fr, int fq) const {
        const int row0 = u.orow + wr * 64 + fr, colt = u.ocol * 256 + wc * 32 + 8 * fq;
        f32x4 bv[2][2];
#pragma unroll
        for (int bj = 0; bj < 2; ++bj)
#pragma unroll
            for (int n = 0; n < 2; ++n) bv[bj][n] = *(const f32x4*)(bgate + colt + bj * HALF + 4 * n);
#pragma unroll
        for (int ai = 0; ai < 2; ++ai)
#pragma unroll
            for (int m = 0; m < 4; ++m) { bf16_t* rowp = gates + (size_t)(row0 + ai * HALF + m * 16) * 8192 + colt;
#pragma unroll
                for (int bj = 0; bj < 2; ++bj) { f32x4 v0 = acc[ai][bj][m][0] * s + bv[bj][0], v1 = acc[ai][bj][m][1] * s + bv[bj][1];
#pragma unroll
                    for (int j = 0; j < 4; ++j) { v0[j] = sigmoidf_(v0[j]); v1[j] = sigmoidf_(v1[j]); }
                    u32x4 w; w.x = cvt_pk_bf16(v0[0], v0[1]); w.y = cvt_pk_bf16(v0[2], v0[3]); w.z = cvt_pk_bf16(v1[0], v1[1]); w.w = cvt_pk_bf16(v1[2], v1[3]);
                    *(u32x4*)(rowp + bj * HALF) = w; } }
    }
};
struct EpiSwiGLU8 {
    static constexpr bool PERM = true;
    unsigned char* O; int ldc; float si, so;
    __device__ __forceinline__ void operator()(const Acc& acc, const Unit& u, int wr, int wc, int fr, int fq) const {
        const int row0 = u.orow + wr * 64 + fr, col0 = u.ocol * 128 + wc * 32 + 8 * fq;
#pragma unroll
        for (int ai = 0; ai < 2; ++ai)
#pragma unroll
            for (int m = 0; m < 4; ++m) { unsigned char* rowp = O + (size_t)(row0 + ai * HALF + m * 16) * ldc + col0;
                f32x4 v0, v1;
#pragma unroll
                for (int j = 0; j < 4; ++j) { const float g0 = acc[ai][0][m][0][j] * si, g1 = acc[ai][0][m][1][j] * si;
                    v0[j] = g0 * sigmoidf_(g0) * (acc[ai][1][m][0][j] * si) * so; v1[j] = g1 * sigmoidf_(g1) * (acc[ai][1][m][1][j] * si) * so; }
                u32x2 w; w.x = pack_fp8x4(v0[0], v0[1], v0[2], v0[3]); w.y = pack_fp8x4(v1[0], v1[1], v1[2], v1[3]);
                *(u32x2*)rowp = w; }
    }
};
struct EpiResF32 {
    static constexpr bool PERM = false;
    const float* base; float* out;
    __device__ __forceinline__ void operator()(const Acc& acc, const Unit& u, int wr, int wc, int fr, int fq) const {
        const int row0 = u.orow + wr * 64 + fr, col0 = u.ocol * 256 + wc * 32 + 4 * fq;
#pragma unroll
        for (int ai = 0; ai < 2; ++ai)
#pragma unroll
            for (int m = 0; m < 4; ++m) { const size_t off = (size_t)(row0 + ai * HALF + m * 16) * DM + col0;
#pragma unroll
                for (int bj = 0; bj < 2; ++bj)
#pragma unroll
                    for (int n = 0; n < 2; ++n) { const f32x4 bs = *(const f32x4*)(base + off + bj * HALF + n * 16); *(f32x4*)(out + off + bj * HALF + n * 16) = bs + acc[ai][bj][m][n]; }
                asm volatile("" ::: "memory"); }
    }
};
struct EpiMoeDown {
    static constexpr bool PERM = false;
    float* out; const int* tok; const float* wt; const unsigned* cnt; float s;
    __device__ __forceinline__ void operator()(const Acc& acc, const Unit& u, int wr, int wc, int fr, int fq) const {
        const int e = u.x0, nrow = (int)cnt[e * 64]; const int lrow0 = u.x1 + wr * 64 + fr, col0 = u.ocol * 256 + wc * 32 + 4 * fq;
#pragma unroll
        for (int ai = 0; ai < 2; ++ai)
#pragma unroll
            for (int m = 0; m < 4; ++m) { const int lr = lrow0 + ai * HALF + m * 16;
                if (lr < nrow) { const int slot = e * ECAP + lr; const int t = tok[slot]; const float w = wt[slot] * s; float* op = out + (size_t)t * DM + col0;
#pragma unroll
                    for (int bj = 0; bj < 2; ++bj)
#pragma unroll
                        for (int n = 0; n < 2; ++n)
#pragma unroll
                            for (int j = 0; j < 4; ++j) unsafeAtomicAdd(op + bj * HALF + n * 16 + j, w * acc[ai][bj][m][n][j]); } }
    }
};
}
#define XB_TMO      128
#define XB_XCNT(j)  (256  + 64 * (j))
#define XB_XSUB(j)  (1280 + 64 * (j))
#define XB_XGEN(j)  (2304 + 64 * (j))
#define XB_TOP      3328
#define XB_TOPGEN   3392
#define XCD_BAR_WORDS 3456
#define XB_SPIN_CAP (1u << 18)

__device__ __forceinline__ unsigned xb_ld(unsigned* p)              { return __hip_atomic_load(p, __ATOMIC_RELAXED, __HIP_MEMORY_SCOPE_AGENT); }
__device__ __forceinline__ unsigned xb_add(unsigned* p, unsigned v) { return __hip_atomic_fetch_add(p, v, __ATOMIC_RELAXED, __HIP_MEMORY_SCOPE_AGENT); }
__device__ __forceinline__ unsigned xb_xcc_id() { return (unsigned)__builtin_amdgcn_s_getreg((3 << 11) | 20) & 0xFu; }
#define XB_SPIN(cond, bar) do { unsigned _sp = 0; while (cond) { __builtin_amdgcn_s_sleep(1); \
    if ((++_sp & 255u) == 0u) { if (xb_ld(&(bar)[XB_TMO])) break; if (_sp > XB_SPIN_CAP) { atomicAdd(&(bar)[XB_TMO], 1u); break; } } } } while (0)

__device__ __forceinline__ unsigned xb_tid() { unsigned t = threadIdx.x; asm volatile("" : "+v"(t)); return t; }
struct XcdBarrier {
    unsigned* bar; unsigned x;
    volatile LAS unsigned* st;
};

__device__ __forceinline__ XcdBarrier xcd_barrier_post(unsigned* bar, volatile LAS unsigned* st) {
    XcdBarrier b; b.bar = bar; b.x = xb_xcc_id(); b.st = st;
    if (xb_tid() == 0u) (void)xb_add(&bar[XB_XCNT(b.x)], 1u);
    return b;
}
__device__ __forceinline__ void xcd_barrier_complete(unsigned* bar, unsigned x, unsigned& nloc, unsigned& nx) {
    const unsigned G = gridDim.x * gridDim.y * gridDim.z;
    unsigned sum, cnt, mine, sp = 0u;
    for (;;) {
        sum = 0u; cnt = 0u; mine = 0u;
#pragma unroll
        for (unsigned j = 0; j < 16; ++j) { const unsigned c = xb_ld(&bar[XB_XCNT(j)]); sum += c; cnt += (c > 0u) ? 1u : 0u; mine = (j == x) ? c : mine; }
        if (sum == G) break;
        __builtin_amdgcn_s_sleep(1);
        if ((++sp & 255u) == 0u) { if (xb_ld(&bar[XB_TMO])) break; if (sp > XB_SPIN_CAP) { atomicAdd(&bar[XB_TMO], 1u); break; } }
    }
    nloc = mine > 0u ? mine : 1u; nx = cnt > 0u ? cnt : 1u;
}

__device__ __forceinline__ void xcd_barrier(const XcdBarrier& b) {
    asm volatile("s_waitcnt vmcnt(0)" ::: "memory");
    __syncthreads();
    if (xb_tid() == 0u) {
        unsigned* bar = b.bar;
        __builtin_amdgcn_s_waitcnt(0);
        unsigned nloc = b.st[0], nx = b.st[1];
        if (nloc == 0u) { xcd_barrier_complete(bar, b.x, nloc, nx); b.st[0] = nloc; b.st[1] = nx; }
        const unsigned old = xb_add(&bar[XB_XSUB(b.x)], 1u);
        const unsigned gen = old / nloc;
        if (old + 1u == (gen + 1u) * nloc) {
            __builtin_amdgcn_fence(__ATOMIC_RELEASE, "agent");
            asm volatile("s_waitcnt vmcnt(0)" ::: "memory");
            const unsigned og = xb_add(&bar[XB_TOP], 1u);
            const unsigned tg = og / nx;
            if (og + 1u == (tg + 1u) * nx) xb_add(&bar[XB_TOPGEN], 1u);
            else XB_SPIN(xb_ld(&bar[XB_TOPGEN]) == tg, bar);
            __builtin_amdgcn_fence(__ATOMIC_ACQUIRE, "agent");
            xb_add(&bar[XB_XGEN(b.x)], 1u);
            asm volatile("s_waitcnt vmcnt(0)" ::: "memory");
        } else {
            XB_SPIN(xb_ld(&bar[XB_XGEN(b.x)]) == gen, bar);
            __builtin_amdgcn_fence(__ATOMIC_ACQUIRE, "agent");
            asm volatile("s_waitcnt vmcnt(0)" ::: "memory");
        }
    }
    __syncthreads();
}

struct Params { const float* in[30]; float* out; unsigned char* ws; int ph_lo, ph_hi; };
enum { I_X = 0, I_MEM, I_NORM_MIX, I_W_IN, I_NA_QN, I_NA_KN, I_NA_RPB, I_CQ_N, I_W_UQ, I_CKV_N, I_W_UKV, I_MLA_QN, I_MLA_KN, I_SWA_QN, I_SWA_KN, I_SWA_SINK,
       I_MEM_N, I_MEM_WKV, I_MEM_QN, I_MEM_KN, I_W_BRANCH, I_W_GATE, I_B_GATE, I_W_O, I_NORM_FFN, I_FFN_UP, I_FFN_DN, I_ROUTER, I_MOE_UP, I_MOE_DN };

__device__ __forceinline__ float wave_sum(float v) {
#pragma unroll
    for (int o = 32; o >= 1; o >>= 1) v += __shfl_xor(v, o);
    return v;
}
__device__ __forceinline__ float bf2f(bf16_t b) { return __uint_as_float(((unsigned)b) << 16); }
__device__ __forceinline__ bf16_t f2bf(float f) { return (bf16_t)(pg8::cvt_pk_bf16(f, 0.f) & 0xffffu); }
using pg8::cvt_pk_bf16; using pg8::bflo; using pg8::bfhi;

struct CvtJob { const float* src; bf16_t* dst; int src_ld, K, ntn, tile0, mode, dff; };
constexpr int NJOBS = 40;
__device__ __forceinline__ void make_job(int j, const Params& p, CvtJob& jb) {
    unsigned char* ws = p.ws; jb.mode = 0; jb.dff = 1; jb.tile0 = 0;
    if (j < 22) { const int l = j / 11, k = j % 11; unsigned char* lw = ws + WS_LW + (size_t)l * LW_BYTES;
        if (k == 0) { jb.src = p.in[I_W_IN] + (size_t)l * DM * INC; jb.dst = (bf16_t*)(lw + LW_IN); jb.src_ld = INC; jb.K = DM; jb.ntn = INC / 64; jb.mode = INGATE_FP8 ? 3 : 0; }
        else if (k == 1) { jb.src = p.in[I_W_IN]; jb.dst = (bf16_t*)(lw + LW_IN + (size_t)INC * DM * (INGATE_FP8 ? 1 : 2)); jb.src_ld = INC; jb.K = DM; jb.ntn = (ZC - INC) / 64; jb.mode = INGATE_FP8 ? 5 : 2; }
        else if (k == 2) { jb.src = p.in[I_W_GATE] + (size_t)l * DM * 8192; jb.dst = (bf16_t*)(lw + LW_IN + (size_t)ZC * DM * (INGATE_FP8 ? 1 : 2)); jb.src_ld = 8192; jb.K = DM; jb.ntn = 8192 / 64; jb.mode = INGATE_FP8 ? 3 : 0; }
        else if (k == 3) { jb.src = p.in[I_W_UQ] + (size_t)l * 768 * 768; jb.dst = (bf16_t*)(lw + LW_UQ); jb.src_ld = 768; jb.K = 768; jb.ntn = 768 / 64; }
        else if (k == 4) { jb.src = p.in[I_W_UKV] + (size_t)l * 256 * 1024; jb.dst = (bf16_t*)(lw + LW_UKV); jb.src_ld = 1024; jb.K = 256; jb.ntn = 1024 / 64; }
        else if (k == 5) { jb.src = p.in[I_MEM_WKV] + (size_t)l * DM * 1024; jb.dst = (bf16_t*)(lw + LW_MEMKV); jb.src_ld = 1024; jb.K = DM; jb.ntn = 1024 / 64; }
        else if (k < 10) { const int n = k - 6; jb.src = p.in[I_W_BRANCH] + ((size_t)l * 4 + n) * 512 * DM; jb.dst = (bf16_t*)(lw + LW_BR) + (size_t)n * DM * 512; jb.src_ld = DM; jb.K = 512; jb.ntn = DM / 64; }
        else { jb.src = p.in[I_W_O] + (size_t)l * DM * DM; jb.dst = (bf16_t*)(lw + LW_O); jb.src_ld = DM; jb.K = DM; jb.ntn = DM / 64; }
    } else if (j == 22) { jb.src = p.in[I_FFN_UP]; jb.dst = (bf16_t*)(ws + WS_FFNUP); jb.src_ld = 2 * DFF; jb.K = DM; jb.ntn = 2 * DFF / 64; jb.mode = 1; jb.dff = DFF; }
    else if (j == 23) { jb.src = p.in[I_FFN_DN]; jb.dst = (bf16_t*)(ws + WS_FFNDN); jb.src_ld = DM; jb.K = DFF; jb.ntn = DM / 64; }
    else if (j < 32) { const int e = j - 24; jb.src = p.in[I_MOE_UP] + (size_t)e * DM * 2 * DFFE; jb.dst = (bf16_t*)(ws + WS_MOEUP + (size_t)e * 2 * DFFE * DM * MOE_ES); jb.src_ld = 2 * DFFE; jb.K = DM; jb.ntn = 2 * DFFE / 64; jb.mode = MOE_FP8 ? 4 : 1; jb.dff = DFFE; }
    else { const int e = j - 32; jb.src = p.in[I_MOE_DN] + (size_t)e * DFFE * DM; jb.dst = (bf16_t*)(ws + WS_MOEDN + (size_t)e * DM * DFFE * MOE_ES); jb.src_ld = DM; jb.K = DFFE; jb.ntn = DM / 64; jb.mode = MOE_FP8 ? 3 : 0; }
}

__device__ __forceinline__ void norm_rows(const float* src, const float* g, bf16_t* dst, unsigned char* dst8, int nrows, int wid, int lane) {
    for (int row = blockIdx.x * 8 + wid; row < nrows; row += gridDim.x * 8) {
        const f32x4* sp = (const f32x4*)(src + (size_t)row * DM); f32x4 v[8]; float ss = 0.f;
#pragma unroll
        for (int j = 0; j < 8; ++j) { v[j] = sp[lane + 64 * j]; ss += v[j][0] * v[j][0] + v[j][1] * v[j][1] + v[j][2] * v[j][2] + v[j][3] * v[j][3]; }
        ss = wave_sum(ss); const float rstd = 1.0f / sqrtf(ss * (1.0f / DM) + EPS);
#pragma unroll
        for (int j = 0; j < 8; ++j) { const f32x4 gv = ((const f32x4*)g)[lane + 64 * j]; u32x2 w; w.x = cvt_pk_bf16(v[j][0] * rstd * gv[0], v[j][1] * rstd * gv[1]); w.y = cvt_pk_bf16(v[j][2] * rstd * gv[2], v[j][3] * rstd * gv[3]);
            *(u32x2*)(dst + (size_t)row * DM + 4 * (lane + 64 * j)) = w;
            if (dst8) *(unsigned*)(dst8 + (size_t)row * DM + 4 * (lane + 64 * j)) = pg8::pack_fp8x4(v[j][0] * rstd * gv[0] * SC_ACT8, v[j][1] * rstd * gv[1] * SC_ACT8, v[j][2] * rstd * gv[2] * SC_ACT8, v[j][3] * rstd * gv[3] * SC_ACT8); }
    }
}

__device__ __forceinline__ void p0_prologue(const Params& p, LAS unsigned char* lds, int tid, int wid, int lane) {
    LAS CvtJob* jt = (LAS CvtJob*)(lds + 65536);
    LAS int* jtot = (LAS int*)(lds + 65536 + 4096);
    if (tid < NJOBS) { CvtJob jb; make_job(tid, p, jb); jt[tid].src = jb.src; jt[tid].dst = jb.dst; jt[tid].src_ld = jb.src_ld; jt[tid].K = jb.K; jt[tid].ntn = jb.ntn; jt[tid].tile0 = 0; jt[tid].mode = jb.mode; jt[tid].dff = jb.dff; }
    __syncthreads();
    if (tid == 0) { int acc = 0; for (int j = 0; j < NJOBS; ++j) { jt[j].tile0 = acc; acc += (jt[j].K / 128) * jt[j].ntn; } jtot[0] = acc; }
    __syncthreads();
    const int total = jtot[0];
    LAS unsigned* T = (LAS unsigned*)lds;
    int j = 0;
    for (int g = blockIdx.x; g < total; g += gridDim.x) {
        while (j + 1 < NJOBS && jt[j + 1].tile0 <= g) ++j;
        const float* src = (const float*)(__attribute__((address_space(1))) const float*)jt[j].src; bf16_t* dst = (bf16_t*)(__attribute__((address_space(1))) bf16_t*)jt[j].dst; const int src_ld = jt[j].src_ld, K = jt[j].K, ntn = jt[j].ntn, mode = jt[j].mode, dff = jt[j].dff;
        const int local = g - jt[j].tile0, tn = local % ntn, tk = local / ntn;
        if (mode == 2) {
#pragma unroll
            for (int it = 0; it < 2; ++it) { const int piece = tid + it * 512, n = piece >> 4, seg = piece & 15;
                *(u32x4*)(dst + (size_t)(tn * 64 + n) * K + tk * 128 + seg * 8) = (u32x4){0u, 0u, 0u, 0u}; }
            continue;
        }
        if (mode == 5) { const int n = tid >> 3, seg = tid & 7; *(u32x4*)((unsigned char*)dst + (size_t)(tn * 64 + n) * K + tk * 128 + seg * 16) = (u32x4){0u, 0u, 0u, 0u}; continue; }
        if (mode >= 3) {
            { const int kq = tid >> 4, nq = tid & 15; const float* sp = src + (size_t)(tk * 128 + 4 * kq) * src_ld + tn * 64 + 4 * nq;
              const f32x4 r0 = *(const f32x4*)sp * SC_W8, r1 = *(const f32x4*)(sp + src_ld) * SC_W8, r2 = *(const f32x4*)(sp + 2 * (size_t)src_ld) * SC_W8, r3 = *(const f32x4*)(sp + 3 * (size_t)src_ld) * SC_W8;
#pragma unroll
              for (int q = 0; q < 4; ++q) T[(4 * nq + q) * 33 + kq] = pg8::pack_fp8x4(r0[q], r1[q], r2[q], r3[q]); }
            __syncthreads();
            { const int n = tid >> 3, seg = tid & 7;
              u32x4 w; w.x = T[n * 33 + seg * 4 + 0]; w.y = T[n * 33 + seg * 4 + 1]; w.z = T[n * 33 + seg * 4 + 2]; w.w = T[n * 33 + seg * 4 + 3];
              int drow = tn * 64 + n;
              if (mode == 4) { const int bj = drow / dff, cc = drow - bj * dff; drow = 256 * (cc >> 7) + 128 * bj + (cc & 127); }
              *(u32x4*)((unsigned char*)dst + (size_t)drow * K + tk * 128 + seg * 16) = w; }
            __syncthreads();
            continue;
        }
#pragma unroll
        for (int it = 0; it < 2; ++it) { const int item = tid + it * 512, kp = item >> 4, nq = item & 15;
            const float* sp = src + (size_t)(tk * 128 + 2 * kp) * src_ld + tn * 64 + 4 * nq;
            const f32x4 a = *(const f32x4*)sp, b = *(const f32x4*)(sp + src_ld);
#pragma unroll
            for (int q = 0; q < 4; ++q) T[(4 * nq + q) * 65 + kp] = cvt_pk_bf16(a[q], b[q]); }
        __syncthreads();
#pragma unroll
        for (int it = 0; it < 2; ++it) { const int piece = tid + it * 512, n = piece >> 4, seg = piece & 15;
            u32x4 w; w.x = T[n * 65 + seg * 4 + 0]; w.y = T[n * 65 + seg * 4 + 1]; w.z = T[n * 65 + seg * 4 + 2]; w.w = T[n * 65 + seg * 4 + 3];
            int drow = tn * 64 + n;
            if (mode == 1) { const int bj = drow / dff, cc = drow - bj * dff; drow = 256 * (cc >> 7) + 128 * bj + (cc & 127); }
            *(u32x4*)(dst + (size_t)drow * K + tk * 128 + seg * 8) = w; }
        __syncthreads();
    }
#ifdef PROBE_POISON
    { u32x4* q = (u32x4*)(p.ws + WS_XG); const size_t n1 = (size_t)NEXP * ECAP * DM / 16; for (size_t i = (size_t)blockIdx.x * NTHREADS + tid; i < n1; i += (size_t)gridDim.x * NTHREADS) q[i] = (u32x4){0u, 0u, 0u, 0u};
      q = (u32x4*)(p.ws + WS_ACTM); const size_t n2 = (size_t)NEXP * ECAP * DFFE / 16; for (size_t i = (size_t)blockIdx.x * NTHREADS + tid; i < n2; i += (size_t)gridDim.x * NTHREADS) q[i] = (u32x4){0u, 0u, 0u, 0u}; }
#endif
    { f32x2* rt = (f32x2*)(p.ws + WS_ROPE);
      for (int e = blockIdx.x * NTHREADS + tid; e < SEQ * 32; e += gridDim.x * NTHREADS) { const int pos = e >> 5, i = e & 31;
          const float freq = __builtin_amdgcn_exp2f(-(float)i * (13.287712379549449f / 32.0f));
          const float ang = (float)pos * freq;
          const double rev = (double)ang * 0.15915494309189535; const float fr_ = (float)(rev - __builtin_rint(rev));
          rt[e] = (f32x2){__builtin_amdgcn_cosf(fr_), __builtin_amdgcn_sinf(fr_)}; } }
    norm_rows(p.in[I_MEM], p.in[I_MEM_N], (bf16_t*)(p.ws + WS_MEMN), nullptr, NMEM, wid, lane);
    norm_rows(p.in[I_MEM], p.in[I_MEM_N] + DM, (bf16_t*)(p.ws + WS_MEMN) + (size_t)NMEM * DM, nullptr, NMEM, wid, lane);
    norm_rows(p.in[I_X], p.in[I_NORM_MIX], (bf16_t*)(p.ws + WS_U), p.ws + WS_U8, NTOK, wid, lane);
}

__device__ __forceinline__ void rope_pair(float& y, const f32x2 cs, int lane) { const float pr = __shfl_xor(y, 32); y = (lane < 32) ? (y * cs.x - pr * cs.y) : (y * cs.x + pr * cs.y); }

__device__ __forceinline__ void prep1(const Params& p, int l, LAS unsigned char* lds, int tid, int wid, int lane) {
    const bf16_t* z = (const bf16_t*)(p.ws + WS_Z);
    bf16_t* naq = (bf16_t*)(p.ws + WS_NAQ); bf16_t* nak = (bf16_t*)(p.ws + WS_NAK); bf16_t* navT = (bf16_t*)(p.ws + WS_NAVT);
    bf16_t* cqn = (bf16_t*)(p.ws + WS_CQN); bf16_t* ckvn = (bf16_t*)(p.ws + WS_CKVN);
    bf16_t* swq = (bf16_t*)(p.ws + WS_SWQ); bf16_t* swk = (bf16_t*)(p.ws + WS_SWK); bf16_t* swvT = (bf16_t*)(p.ws + WS_SWVT); bf16_t* meq = (bf16_t*)(p.ws + WS_MEQ);
    const f32x2* rt = (const f32x2*)(p.ws + WS_ROPE);
    const float* g_naq = p.in[I_NA_QN] + l * 128; const float* g_nak = p.in[I_NA_KN] + l * 128; const float* g_meq = p.in[I_MEM_QN] + l * 128;
    const float* g_cq = p.in[I_CQ_N] + l * 768; const float* g_ckv = p.in[I_CKV_N] + l * 256; const float* g_swq = p.in[I_SWA_QN] + l * 64; const float* g_swk = p.in[I_SWA_KN] + l * 64;
    const float qs128 = 0.08838834764831845f * LOG2E, qs64 = 0.125f * LOG2E;
    constexpr int VW = 640;
    LAS bf16_t* vt = (LAS bf16_t*)lds;
    for (int grp = blockIdx.x; grp < NTOK / 32; grp += gridDim.x) {
        const int b = grp >> 6, chunk = grp & 63;
#pragma unroll 1
        for (int ti = 0; ti < 4; ++ti) {
            const int tl = wid * 4 + ti, s = chunk * 32 + tl, token = grp * 32 + tl;
            const bf16_t* zr = z + (size_t)token * ZC;
            { const u32x4 w = *(const u32x4*)(zr + Z_NAV + 8 * lane); *(LAS u32x4*)(vt + tl * VW + 8 * lane) = w;
              if (lane < 16) { const u32x4 w2 = *(const u32x4*)(zr + Z_SWV + 8 * lane); *(LAS u32x4*)(vt + tl * VW + 512 + 8 * lane) = w2; } }
#pragma unroll
            for (int h = 0; h < 4; ++h) {
                { const unsigned w = *(const unsigned*)(zr + Z_NAQ + h * 128 + 2 * lane); const float x0 = bflo(w), x1 = bfhi(w);
                  const float ss = wave_sum(x0 * x0 + x1 * x1), rs = 1.0f / sqrtf(ss * (1.0f / 128) + EPS) * qs128;
                  *(unsigned*)(naq + ((size_t)(b * 4 + h) * SEQ + s) * 128 + 2 * lane) = cvt_pk_bf16(x0 * rs * g_naq[2 * lane], x1 * rs * g_naq[2 * lane + 1]); }
                { const unsigned w = *(const unsigned*)(zr + Z_NAK + h * 128 + 2 * lane); const float x0 = bflo(w), x1 = bfhi(w);
                  const float ss = wave_sum(x0 * x0 + x1 * x1), rs = 1.0f / sqrtf(ss * (1.0f / 128) + EPS);
                  *(unsigned*)(nak + ((size_t)(b * 4 + h) * SEQ + s) * 128 + 2 * lane) = cvt_pk_bf16(x0 * rs * g_nak[2 * lane], x1 * rs * g_nak[2 * lane + 1]); }
                { const unsigned w = *(const unsigned*)(zr + Z_MEQ + h * 128 + 2 * lane); const float x0 = bflo(w), x1 = bfhi(w);
                  const float ss = wave_sum(x0 * x0 + x1 * x1), rs = 1.0f / sqrtf(ss * (1.0f / 128) + EPS) * qs128;
                  *(unsigned*)(meq + ((size_t)(b * 4 + h) * SEQ + s) * 128 + 2 * lane) = cvt_pk_bf16(x0 * rs * g_meq[2 * lane], x1 * rs * g_meq[2 * lane + 1]); }
            }
            { unsigned w[6]; float ss = 0.f;
#pragma unroll
              for (int j = 0; j < 6; ++j) { w[j] = *(const unsigned*)(zr + Z_CQ + 128 * j + 2 * lane); ss += bflo(w[j]) * bflo(w[j]) + bfhi(w[j]) * bfhi(w[j]); }
              ss = wave_sum(ss); const float rs = 1.0f / sqrtf(ss * (1.0f / 768) + EPS);
#pragma unroll
              for (int j = 0; j < 6; ++j) *(unsigned*)(cqn + (size_t)token * 768 + 128 * j + 2 * lane) = cvt_pk_bf16(bflo(w[j]) * rs * g_cq[128 * j + 2 * lane], bfhi(w[j]) * rs * g_cq[128 * j + 2 * lane + 1]); }
            { unsigned w[2]; float ss = 0.f;
#pragma unroll
              for (int j = 0; j < 2; ++j) { w[j] = *(const unsigned*)(zr + Z_CKV + 128 * j + 2 * lane); ss += bflo(w[j]) * bflo(w[j]) + bfhi(w[j]) * bfhi(w[j]); }
              ss = wave_sum(ss); const float rs = 1.0f / sqrtf(ss * (1.0f / 256) + EPS);
#pragma unroll
              for (int j = 0; j < 2; ++j) *(unsigned*)(ckvn + (size_t)token * 256 + 128 * j + 2 * lane) = cvt_pk_bf16(bflo(w[j]) * rs * g_ckv[128 * j + 2 * lane], bfhi(w[j]) * rs * g_ckv[128 * j + 2 * lane + 1]); }
            const f32x2 cs = rt[s * 32 + (lane & 31)];
#pragma unroll
            for (int h = 0; h < 8; ++h) { const float x = bf2f(zr[Z_SWQ + h * 64 + lane]); const float ss = wave_sum(x * x); float y = x * (1.0f / sqrtf(ss * (1.0f / 64) + EPS)) * g_swq[lane];
                rope_pair(y, cs, lane); swq[((size_t)(b * 8 + h) * SEQ + s) * 64 + lane] = f2bf(y * qs64); }
#pragma unroll
            for (int h = 0; h < 2; ++h) { const float x = bf2f(zr[Z_SWK + h * 64 + lane]); const float ss = wave_sum(x * x); float y = x * (1.0f / sqrtf(ss * (1.0f / 64) + EPS)) * g_swk[lane];
                rope_pair(y, cs, lane); swk[((size_t)(b * 2 + h) * SEQ + s) * 64 + lane] = f2bf(y); }
        }
        __syncthreads();
#pragma unroll 1
        for (int it = 0; it < 5; ++it) { const int item = tid + it * 512, part = item / VW, c = item - part * VW;
            unsigned short e[8];
#pragma unroll
            for (int q = 0; q < 8; ++q) e[q] = vt[(part * 8 + q) * VW + c];
            u32x4 w; w.x = e[0] | ((unsigned)e[1] << 16); w.y = e[2] | ((unsigned)e[3] << 16); w.z = e[4] | ((unsigned)e[5] << 16); w.w = e[6] | ((unsigned)e[7] << 16);
            bf16_t* dp = (c < 512) ? navT + ((((size_t)(b * 4 + (c >> 7)) * 64 + chunk) * 128 + (c & 127)) * 32 + part * 8)
                                   : swvT + ((((size_t)(b * 2 + ((c - 512) >> 6)) * 64 + chunk) * 64 + ((c - 512) & 63)) * 32 + part * 8);
            *(u32x4*)dp = w; }
        __syncthreads();
    }
}

__device__ __forceinline__ void prep2(const Params& p, int l, LAS unsigned char* lds, int tid, int wid, int lane) {
    const bf16_t* z = (const bf16_t*)(p.ws + WS_Z); const bf16_t* qraw = (const bf16_t*)(p.ws + WS_QRAW); const bf16_t* kvraw = (const bf16_t*)(p.ws + WS_KVRAW);
    const bf16_t* memkv = (const bf16_t*)(p.ws + WS_MEMKV) + (size_t)l * NMEM * 1024;
    bf16_t* mlq = (bf16_t*)(p.ws + WS_MLQ); bf16_t* mlk = (bf16_t*)(p.ws + WS_MLK); bf16_t* mlvT = (bf16_t*)(p.ws + WS_MLVT);
    bf16_t* mek = (bf16_t*)(p.ws + WS_MEK); bf16_t* mevT = (bf16_t*)(p.ws + WS_MEVT);
    const f32x2* rt = (const f32x2*)(p.ws + WS_ROPE);
    const float* g_q = p.in[I_MLA_QN] + l * 192; const float* g_k = p.in[I_MLA_KN] + l * 192; const float* g_mk = p.in[I_MEM_KN] + l * 128;
    const float qs192 = 0.07216878364870322f * LOG2E;
    constexpr int VW = 512;
    LAS bf16_t* vt = (LAS bf16_t*)lds;
    for (int grp = blockIdx.x; grp < NTOK / 32 + NMEM / 32; grp += gridDim.x) {
        const bool ismem = grp >= NTOK / 32;
        if (!ismem) {
            const int b = grp >> 6, chunk = grp & 63;
#pragma unroll 1
            for (int ti = 0; ti < 4; ++ti) {
                const int tl = wid * 4 + ti, s = chunk * 32 + tl, token = grp * 32 + tl;
                const f32x2 cs = rt[s * 32 + (lane & 31)];
                const float kpe = bf2f(z[(size_t)token * ZC + Z_KPE + lane]);
#pragma unroll
                for (int h = 0; h < 4; ++h) {
                    { const bf16_t* qr = qraw + (size_t)token * 768 + h * 192; const float x0 = bf2f(qr[lane]), x1 = bf2f(qr[64 + lane]), x2 = bf2f(qr[128 + lane]);
                      const float ss = wave_sum(x0 * x0 + x1 * x1 + x2 * x2), rs = 1.0f / sqrtf(ss * (1.0f / 192) + EPS);
                      float y2 = x2 * rs * g_q[128 + lane]; rope_pair(y2, cs, lane);
                      bf16_t* qo = mlq + ((size_t)(b * 4 + h) * SEQ + s) * 192; qo[lane] = f2bf(x0 * rs * g_q[lane] * qs192); qo[64 + lane] = f2bf(x1 * rs * g_q[64 + lane] * qs192); qo[128 + lane] = f2bf(y2 * qs192); }
                    { const bf16_t* kr = kvraw + (size_t)token * 1024 + h * 256; const float x0 = bf2f(kr[lane]), x1 = bf2f(kr[64 + lane]), x2 = kpe;
                      const float ss = wave_sum(x0 * x0 + x1 * x1 + x2 * x2), rs = 1.0f / sqrtf(ss * (1.0f / 192) + EPS);
                      float y2 = x2 * rs * g_k[128 + lane]; rope_pair(y2, cs, lane);
                      bf16_t* ko = mlk + ((size_t)(b * 4 + h) * SEQ + s) * 192; ko[lane] = f2bf(x0 * rs * g_k[lane]); ko[64 + lane] = f2bf(x1 * rs * g_k[64 + lane]); ko[128 + lane] = f2bf(y2); }
                }
                { const int h = lane >> 4, pc = lane & 15; const u32x4 w = *(const u32x4*)(kvraw + (size_t)token * 1024 + h * 256 + 128 + 8 * pc); *(LAS u32x4*)(vt + tl * VW + h * 128 + 8 * pc) = w; }
            }
            __syncthreads();
#pragma unroll 1
            for (int it = 0; it < 4; ++it) { const int item = tid + it * 512, part = item >> 9, c = item & 511;
                unsigned short e[8];
#pragma unroll
                for (int q = 0; q < 8; ++q) e[q] = vt[(part * 8 + q) * VW + c];
                u32x4 w; w.x = e[0] | ((unsigned)e[1] << 16); w.y = e[2] | ((unsigned)e[3] << 16); w.z = e[4] | ((unsigned)e[5] << 16); w.w = e[6] | ((unsigned)e[7] << 16);
                *(u32x4*)(mlvT + ((((size_t)(b * 4 + (c >> 7)) * 64 + chunk) * 128 + (c & 127)) * 32 + part * 8)) = w; }
            __syncthreads();
        } else {
            const int mg = grp - NTOK / 32, b = mg >> 3, chunk = mg & 7;
#pragma unroll 1
            for (int ti = 0; ti < 4; ++ti) {
                const int tl = wid * 4 + ti, m = chunk * 32 + tl, mt = mg * 32 + tl;
                const bf16_t* mr = memkv + (size_t)mt * 1024;
#pragma unroll
                for (int h = 0; h < 4; ++h) { const unsigned w = *(const unsigned*)(mr + h * 128 + 2 * lane); const float x0 = bflo(w), x1 = bfhi(w);
                    const float ss = wave_sum(x0 * x0 + x1 * x1), rs = 1.0f / sqrtf(ss * (1.0f / 128) + EPS);
                    *(unsigned*)(mek + ((size_t)(b * 4 + h) * MEML + m) * 128 + 2 * lane) = cvt_pk_bf16(x0 * rs * g_mk[2 * lane], x1 * rs * g_mk[2 * lane + 1]); }
                { const u32x4 w = *(const u32x4*)(mr + 512 + 8 * lane); *(LAS u32x4*)(vt + tl * VW + 8 * lane) = w; }
            }
            __syncthreads();
#pragma unroll 1
            for (int it = 0; it < 4; ++it) { const int item = tid + it * 512, part = item >> 9, c = item & 511;
                unsigned short e[8];
#pragma unroll
                for (int q = 0; q < 8; ++q) e[q] = vt[(part * 8 + q) * VW + c];
                u32x4 w; w.x = e[0] | ((unsigned)e[1] << 16); w.y = e[2] | ((unsigned)e[3] << 16); w.z = e[4] | ((unsigned)e[5] << 16); w.w = e[6] | ((unsigned)e[7] << 16);
                *(u32x4*)(mevT + ((((size_t)(b * 4 + (c >> 7)) * 8 + chunk) * 128 + (c & 127)) * 32 + part * 8)) = w; }
            __syncthreads();
        }
    }
}
constexpr int ATT_RPB_OFF = 98304;
template <int DQ, int DV, int MODE>
__device__ __forceinline__ void attn_unit(LAS unsigned char* lds, const bf16_t* qp, const bf16_t* kp, const bf16_t* vp, bf16_t* op,
                                          int nchunks, int c_lo, int c_hi, int mq0, int mk0, int mr, float sink2, int tid, int lane) {
    constexpr int KROW = DQ * 2 + 16, KBUF = 32 * KROW, VROW = 80, VBUF = DV * VROW, NDC = DQ / 32, NDV = DV / 16;
    constexpr int KPIECES = 32 * DQ / 8, VPIECES = DV * 4, DQ8 = DQ / 8;
    const int fr = lane & 15, fq = lane >> 4;
    bf16x8 qf[2][NDC];
#pragma unroll
    for (int qt = 0; qt < 2; ++qt)
#pragma unroll
        for (int dc = 0; dc < NDC; ++dc) qf[qt][dc] = *(const bf16x8*)(qp + (size_t)(qt * 16 + fr) * DQ + dc * 32 + fq * 8);
    f32x4 o[2][NDV];
#pragma unroll
    for (int qt = 0; qt < 2; ++qt)
#pragma unroll
        for (int d = 0; d < NDV; ++d) o[qt][d] = (f32x4){0.f, 0.f, 0.f, 0.f};
    float mrun[2] = {-1e30f, -1e30f}, lrun[2] = {0.f, 0.f};
    const int pk0 = tid, pk1 = tid + 512;
    const bool hk0 = pk0 < KPIECES, hk1 = pk1 < KPIECES, hv = tid < VPIECES;
    int kd0, kd1;
    { const int key = pk0 / DQ8, dp = pk0 - key * DQ8; kd0 = (16 * ((key >> 2) & 1) + 4 * (key >> 3) + (key & 3)) * KROW + dp * 16; }
    { const int key = pk1 / DQ8, dp = pk1 - key * DQ8; kd1 = (16 * ((key >> 2) & 1) + 4 * (key >> 3) + (key & 3)) * KROW + dp * 16; }
    const int vd = (tid >> 2) * VROW + (tid & 3) * 16;
    u32x4 rk0 = (u32x4){0u, 0u, 0u, 0u}, rk1 = rk0, rv = rk0;
    if (hk0) rk0 = *(const u32x4*)(kp + pk0 * 8);
    if (hk1) rk1 = *(const u32x4*)(kp + pk1 * 8);
    if (hv) rv = *(const u32x4*)(vp + tid * 8);
    if (hk0) *(LAS u32x4*)(lds + kd0) = rk0;
    if (hk1) *(LAS u32x4*)(lds + kd1) = rk1;
    if (hv) *(LAS u32x4*)(lds + 2 * KBUF + vd) = rv;
    __syncthreads();
#pragma unroll 1
    for (int c = 0; c < nchunks; ++c) {
        const int cur = c & 1; const bool more = (c + 1 < nchunks);
        if (more) { const bf16_t* kn = kp + (size_t)(c + 1) * 32 * DQ; const bf16_t* vn = vp + (size_t)(c + 1) * DV * 32;
            if (hk0) rk0 = *(const u32x4*)(kn + pk0 * 8);
            if (hk1) rk1 = *(const u32x4*)(kn + pk1 * 8);
            if (hv) rv = *(const u32x4*)(vn + tid * 8); }
        if (c >= c_lo && c < c_hi) {
            const LAS unsigned char* kb = lds + cur * KBUF; const LAS unsigned char* vb = lds + 2 * KBUF + cur * VBUF;
            f32x4 s[2][2];
#pragma unroll
            for (int qt = 0; qt < 2; ++qt) { s[qt][0] = (f32x4){0.f, 0.f, 0.f, 0.f}; s[qt][1] = (f32x4){0.f, 0.f, 0.f, 0.f}; }
#pragma unroll
            for (int dc = 0; dc < NDC; ++dc) {
                const bf16x8 k0 = *(const LAS bf16x8*)(kb + fr * KROW + (dc * 32 + fq * 8) * 2);
                const bf16x8 k1 = *(const LAS bf16x8*)(kb + (16 + fr) * KROW + (dc * 32 + fq * 8) * 2);
#pragma unroll
                for (int qt = 0; qt < 2; ++qt) { s[qt][0] = __builtin_amdgcn_mfma_f32_16x16x32_bf16(k0, qf[qt][dc], s[qt][0], 0, 0, 0);
                                                 s[qt][1] = __builtin_amdgcn_mfma_f32_16x16x32_bf16(k1, qf[qt][dc], s[qt][1], 0, 0, 0); }
            }
            bf16x8 pf[2];
#pragma unroll
            for (int qt = 0; qt < 2; ++qt) {
                if (MODE == 1) {
                    const int qpos = mq0 + qt * 16 + fr, kbase = mk0 + c * 32 + 8 * fq;
#pragma unroll
                    for (int b = 0; b < 2; ++b)
#pragma unroll
                        for (int i = 0; i < 4; ++i) { const int dd = qpos - (kbase + 4 * b + i); if (dd > 128 || dd < -128) s[qt][b][i] = -1e30f; }
                } else if (MODE == 2) {
                    const LAS float* rpb = (const LAS float*)(lds + ATT_RPB_OFF);
                    const int qc = mq0 + qt * 16 + fr, kr = mk0 + (c >> 1), kcb = (c & 1) * 32 + 8 * fq;
                    int cs = qc - 8; cs = cs < 0 ? 0 : (cs > 48 ? 48 : cs);
                    const int rowoff = (kr - mr + 7) * 31;
#pragma unroll
                    for (int b = 0; b < 2; ++b)
#pragma unroll
                        for (int i = 0; i < 4; ++i) { const int kc = kcb + 4 * b + i; const bool ok = (kc >= cs) && (kc <= cs + 15);
                            int bi = kc - qc + 15; bi = bi < 0 ? 0 : (bi > 30 ? 30 : bi);
                            const float bias = rpb[rowoff + bi];
                            s[qt][b][i] = ok ? s[qt][b][i] + bias : -1e30f; }
                }
                float mx = fmaxf(fmaxf(fmaxf(s[qt][0][0], s[qt][0][1]), fmaxf(s[qt][0][2], s[qt][0][3])), fmaxf(fmaxf(s[qt][1][0], s[qt][1][1]), fmaxf(s[qt][1][2], s[qt][1][3])));
                mx = fmaxf(mx, __shfl_xor(mx, 16)); mx = fmaxf(mx, __shfl_xor(mx, 32));
                const float mnew = fmaxf(mrun[qt], mx), alpha = __builtin_amdgcn_exp2f(mrun[qt] - mnew); mrun[qt] = mnew;
                float ps = 0.f;
#pragma unroll
                for (int b = 0; b < 2; ++b)
#pragma unroll
                    for (int i = 0; i < 4; ++i) { const float e = __builtin_amdgcn_exp2f(s[qt][b][i] - mnew); s[qt][b][i] = e; ps += e; }
                lrun[qt] = lrun[qt] * alpha + ps;
#pragma unroll
                for (int d = 0; d < NDV; ++d) o[qt][d] *= alpha;
                u32x4 w; w.x = cvt_pk_bf16(s[qt][0][0], s[qt][0][1]); w.y = cvt_pk_bf16(s[qt][0][2], s[qt][0][3]); w.z = cvt_pk_bf16(s[qt][1][0], s[qt][1][1]); w.w = cvt_pk_bf16(s[qt][1][2], s[qt][1][3]);
                pf[qt] = __builtin_bit_cast(bf16x8, w);
            }
#pragma unroll
            for (int d = 0; d < NDV; ++d) {
                const bf16x8 vf = *(const LAS bf16x8*)(vb + (d * 16 + fr) * VROW + fq * 16);
                o[0][d] = __builtin_amdgcn_mfma_f32_16x16x32_bf16(vf, pf[0], o[0][d], 0, 0, 0);
                o[1][d] = __builtin_amdgcn_mfma_f32_16x16x32_bf16(vf, pf[1], o[1][d], 0, 0, 0);
            }
        }
        if (more) { const int nb = cur ^ 1;
            if (hk0) *(LAS u32x4*)(lds + nb * KBUF + kd0) = rk0;
            if (hk1) *(LAS u32x4*)(lds + nb * KBUF + kd1) = rk1;
            if (hv) *(LAS u32x4*)(lds + 2 * KBUF + nb * VBUF + vd) = rv; }
        __syncthreads();
    }
#pragma unroll
    for (int qt = 0; qt < 2; ++qt) {
        float l = lrun[qt]; l += __shfl_xor(l, 16); l += __shfl_xor(l, 32);
        if (MODE == 1) l += __builtin_amdgcn_exp2f(sink2 - mrun[qt]);
        const float inv = 1.0f / l;
        bf16_t* orow = op + (size_t)(qt * 16 + fr) * DM + 4 * fq;
#pragma unroll
        for (int d = 0; d < NDV; ++d) { u32x2 w; w.x = cvt_pk_bf16(o[qt][d][0] * inv, o[qt][d][1] * inv); w.y = cvt_pk_bf16(o[qt][d][2] * inv, o[qt][d][3] * inv); *(u32x2*)(orow + d * 16) = w; }
    }
}

__device__ __forceinline__ void attn_phase(const Params& p, int lq, LAS unsigned char* lds, int tid, int wid, int lane) {
    const int l = lq & 1;
    unsigned* head = (unsigned*)(p.ws + WS_CTL) + CW_ATTQ + lq * 64;
    volatile LAS int* qw = (volatile LAS int*)(lds + LDS_MISC + 64);
    bf16_t* br = (bf16_t*)(p.ws + (lq >= 2 ? WS_ACT : WS_BR));
    for (;;) {
        if (tid == 0) qw[0] = (int)__hip_atomic_fetch_add(head, 1u, __ATOMIC_RELAXED, __HIP_MEMORY_SCOPE_AGENT);
        __syncthreads();
        const int id = __builtin_amdgcn_readfirstlane(qw[0]);
        __syncthreads();
        if (id >= 640) break;
        if (id < 128) {
            const int b = id >> 5, h = (id >> 3) & 3, qt8 = id & 7; const size_t bh = (size_t)(b * 4 + h);
            const bf16_t* q = (const bf16_t*)(p.ws + WS_MLQ) + (bh * SEQ + qt8 * 256 + wid * 32) * 192;
            const bf16_t* k = (const bf16_t*)(p.ws + WS_MLK) + bh * SEQ * 192; const bf16_t* v = (const bf16_t*)(p.ws + WS_MLVT) + bh * SEQ * 128;
            bf16_t* o = br + (size_t)(b * SEQ + qt8 * 256 + wid * 32) * DM + 512 + h * 128;
            attn_unit<192, 128, 0>(lds, q, k, v, o, 64, 0, 64, 0, 0, 0, 0.f, tid, lane);
        } else if (id < 256) {
            const int u = id - 128, b = u >> 5, h = (u >> 3) & 3, r4 = u & 7; const size_t bh = (size_t)(b * 4 + h);
            const int r = r4 * 4 + (wid >> 1), half = wid & 1;
            int kr_lo = r4 * 4 - 4; kr_lo = kr_lo < 0 ? 0 : (kr_lo > 24 ? 24 : kr_lo);
            int kr_hi = r4 * 4 + 3 - 4; kr_hi = (kr_hi < 0 ? 0 : (kr_hi > 24 ? 24 : kr_hi)) + 7;
            int rs = r - 4; rs = rs < 0 ? 0 : (rs > 24 ? 24 : rs);
            { const float* rp = p.in[I_NA_RPB] + ((size_t)l * 4 + h) * 15 * 31; LAS float* rl = (LAS float*)(lds + ATT_RPB_OFF); if (tid < 465) rl[tid] = rp[tid] * LOG2E; }
            const bf16_t* q = (const bf16_t*)(p.ws + WS_NAQ) + (bh * SEQ + r * 64 + half * 32) * 128;
            const bf16_t* k = (const bf16_t*)(p.ws + WS_NAK) + (bh * SEQ + kr_lo * 64) * 128; const bf16_t* v = (const bf16_t*)(p.ws + WS_NAVT) + (bh * 64 + kr_lo * 2) * 128 * 32;
            bf16_t* o = br + (size_t)(b * SEQ + r * 64 + half * 32) * DM + 0 + h * 128;
            attn_unit<128, 128, 2>(lds, q, k, v, o, 2 * (kr_hi - kr_lo + 1), 2 * (rs - kr_lo), 2 * (rs - kr_lo) + 16, half * 32, kr_lo, r, 0.f, tid, lane);
        } else if (id < 512) {
            const int u = id - 256, b = u >> 6, kvh = (u >> 5) & 1, qb = u & 31, q0 = qb * 64; const int hq = kvh * 4 + (wid >> 1), qpos0 = q0 + (wid & 1) * 32;
            const int kstart = q0 - 128 < 0 ? 0 : q0 - 128, kend = q0 + 192 > SEQ ? SEQ : q0 + 192, nch = (kend - kstart) >> 5;
            int c_lo = (qpos0 - 128 - kstart) >> 5; c_lo = c_lo < 0 ? 0 : c_lo; int c_hi = ((qpos0 + 159 - kstart) >> 5) + 1; c_hi = c_hi > nch ? nch : c_hi;
            const bf16_t* q = (const bf16_t*)(p.ws + WS_SWQ) + ((size_t)(b * 8 + hq) * SEQ + qpos0) * 64;
            const bf16_t* k = (const bf16_t*)(p.ws + WS_SWK) + ((size_t)(b * 2 + kvh) * SEQ + kstart) * 64; const bf16_t* v = (const bf16_t*)(p.ws + WS_SWVT) + ((size_t)(b * 2 + kvh) * 64 + (kstart >> 5)) * 64 * 32;
            bf16_t* o = br + (size_t)(b * SEQ + qpos0) * DM + 1024 + hq * 64;
            attn_unit<64, 64, 1>(lds, q, k, v, o, nch, c_lo, c_hi, qpos0, kstart, 0, p.in[I_SWA_SINK][l * 8 + hq] * LOG2E, tid, lane);
        } else {
            const int u = id - 512, b = u >> 5, h = (u >> 3) & 3, qt8 = u & 7; const size_t bh = (size_t)(b * 4 + h);
            const bf16_t* q = (const bf16_t*)(p.ws + WS_MEQ) + (bh * SEQ + qt8 * 256 + wid * 32) * 128;
            const bf16_t* k = (const bf16_t*)(p.ws + WS_MEK) + bh * MEML * 128; const bf16_t* v = (const bf16_t*)(p.ws + WS_MEVT) + bh * MEML * 128;
            bf16_t* o = br + (size_t)(b * SEQ + qt8 * 256 + wid * 32) * DM + 1536 + h * 128;
            attn_unit<128, 128, 0>(lds, q, k, v, o, 8, 0, 8, 0, 0, 0, 0.f, tid, lane);
        }
    }
}

__device__ __forceinline__ void router_phase(const Params& p, LAS unsigned char* lds, int tid, int wid, int lane) {
    const float* hres = p.out; const float* g = p.in[I_NORM_FFN] + DM; const float* wr = p.in[I_ROUTER];
    unsigned* cnt = (unsigned*)(p.ws + WS_CTL) + CW_MOECNT;
    unsigned char* xg = p.ws + WS_XG; int* tokv = (int*)(p.ws + WS_TOK); float* wtv = (float*)(p.ws + WS_WT);
    LAS float* wl = (LAS float*)lds;
    LAS float* sel = (LAS float*)(lds + 65536);
    for (int i = tid; i < DM * NEXP; i += NTHREADS) { const int d = i >> 3, e = i & 7; wl[e * DM + d] = wr[i]; }
    __syncthreads();
    for (int grp = blockIdx.x; grp < NTOK / 32; grp += gridDim.x) {
#pragma unroll 1
        for (int ti = 0; ti < 4; ++ti) {
            const int tl = wid * 4 + ti, token = grp * 32 + tl;
            const f32x4* sp = (const f32x4*)(hres + (size_t)token * DM); f32x4 v[8]; float ss = 0.f;
#pragma unroll
            for (int j = 0; j < 8; ++j) { v[j] = sp[lane + 64 * j]; ss += v[j][0] * v[j][0] + v[j][1] * v[j][1] + v[j][2] * v[j][2] + v[j][3] * v[j][3]; }
            ss = wave_sum(ss); const float rstd = 1.0f / sqrtf(ss * (1.0f / DM) + EPS);
            float lg[8];
#pragma unroll
            for (int e = 0; e < 8; ++e) lg[e] = 0.f;
#pragma unroll
            for (int j = 0; j < 8; ++j) { const f32x4 gv = ((const f32x4*)g)[lane + 64 * j]; const f32x4 hn = v[j] * rstd * gv;
#pragma unroll
                for (int e = 0; e < 8; ++e) { const f32x4 w4 = *(const LAS f32x4*)(wl + e * DM + 4 * (lane + 64 * j)); lg[e] += hn[0] * w4[0] + hn[1] * w4[1] + hn[2] * w4[2] + hn[3] * w4[3]; } }
#pragma unroll
            for (int e = 0; e < 8; ++e) lg[e] = wave_sum(lg[e]);
            int i0 = 0; float v0 = lg[0];
#pragma unroll
            for (int e = 1; e < 8; ++e) if (lg[e] > v0) { v0 = lg[e]; i0 = e; }
            int i1 = -1; float v1 = -3.0e38f;
#pragma unroll
            for (int e = 0; e < 8; ++e) if (e != i0 && lg[e] > v1) { v1 = lg[e]; i1 = e; }
            const float e1 = __expf(v1 - v0), w0 = 1.0f / (1.0f + e1), w1 = e1 * w0;
            if (lane == 0) { sel[tl * 8 + 0] = __int_as_float(i0); sel[tl * 8 + 1] = __int_as_float(i1); sel[tl * 8 + 2] = w0; sel[tl * 8 + 3] = w1; sel[tl * 8 + 4] = rstd; }
        }
        __syncthreads();
        if (tid < NEXP) { int n = 0;
            for (int t = 0; t < 32; ++t) { n += (__float_as_int(sel[t * 8 + 0]) == tid) ? 1 : 0; n += (__float_as_int(sel[t * 8 + 1]) == tid) ? 1 : 0; }
            int base = n ? (int)__hip_atomic_fetch_add(cnt + tid * 64, (unsigned)n, __ATOMIC_RELAXED, __HIP_MEMORY_SCOPE_AGENT) : 0;
            for (int t = 0; t < 32; ++t) { if (__float_as_int(sel[t * 8 + 0]) == tid) sel[t * 8 + 5] = __int_as_float(base++); if (__float_as_int(sel[t * 8 + 1]) == tid) sel[t * 8 + 6] = __int_as_float(base++); } }
        __syncthreads();
#pragma unroll 1
        for (int ti = 0; ti < 4; ++ti) {
            const int tl = wid * 4 + ti, token = grp * 32 + tl;
            const int e0 = __float_as_int(sel[tl * 8 + 0]), e1 = __float_as_int(sel[tl * 8 + 1]); const float w0 = sel[tl * 8 + 2], w1 = sel[tl * 8 + 3], rstd = sel[tl * 8 + 4];
            const int s0 = e0 * ECAP + __float_as_int(sel[tl * 8 + 5]), s1 = e1 * ECAP + __float_as_int(sel[tl * 8 + 6]);
            const f32x4* sp = (const f32x4*)(hres + (size_t)token * DM);
#pragma unroll
            for (int j = 0; j < 8; ++j) { const f32x4 x = sp[lane + 64 * j]; const f32x4 gv = ((const f32x4*)g)[lane + 64 * j];
#if MOE_FP8
                const float rg = rstd * SC_ACT8; const unsigned w = pg8::pack_fp8x4(x[0] * rg * gv[0], x[1] * rg * gv[1], x[2] * rg * gv[2], x[3] * rg * gv[3]);
                *(unsigned*)(xg + (size_t)s0 * DM + 4 * (lane + 64 * j)) = w; *(unsigned*)(xg + (size_t)s1 * DM + 4 * (lane + 64 * j)) = w; }
#else
                u32x2 w; w.x = cvt_pk_bf16(x[0] * rstd * gv[0], x[1] * rstd * gv[1]); w.y = cvt_pk_bf16(x[2] * rstd * gv[2], x[3] * rstd * gv[3]);
                *(u32x2*)(xg + ((size_t)s0 * DM + 4 * (lane + 64 * j)) * 2) = w; *(u32x2*)(xg + ((size_t)s1 * DM + 4 * (lane + 64 * j)) * 2) = w; }
#endif
            if (lane == 0) { tokv[s0] = token; wtv[s0] = w0; tokv[s1] = token; wtv[s1] = w1; }
        }
        __syncthreads();
    }
}

constexpr int MOE_TAB_OFF = LDS_MISC + 128;
__device__ __forceinline__ void moe_table(LAS unsigned char* lds, const unsigned* cnt, int nN, int tid) {
    LAS int* tab = (LAS int*)(lds + MOE_TAB_OFF);
    __syncthreads();
    if (tid == 0) { int acc = 0; for (int e = 0; e < 8; ++e) { const int n = ((int)cnt[e * 64] + 255) >> 8; tab[e] = n; tab[8 + e] = acc; acc += n * nN; } tab[16] = acc; }
    __syncthreads();
}
struct SchedMoe {
    const char* A; const char* B; size_t a_estride, b_estride, a_tstride, b_tstride; const LAS int* tab; int G, c;
    __device__ __forceinline__ bool next(int i, pg8::Unit& u) const {
        const int L = i * G + c; if (L >= tab[16]) return false;
        int e = 0;
#pragma unroll
        for (int k = 1; k < 8; ++k) e = (L >= tab[8 + k]) ? k : e;
        const int ne = tab[e], loc = L - tab[8 + e], pm = loc % ne, pn = loc / ne;
        u.A = A + (size_t)e * a_estride + (size_t)pm * a_tstride; u.B = B + (size_t)e * b_estride + (size_t)pn * b_tstride;
        u.orow = e * ECAP + pm * 256; u.ocol = pn; u.x0 = e; u.x1 = pm * 256; return true;
    }
};
struct SchedMerge {
    const char* br; const char* wb; int G, c;
    __device__ __forceinline__ bool next(int i, pg8::Unit& u) const {
        int pm, pn; if (!pg8::static_tile(i >> 2, G, c, NTOK / 256, DM / 256, pm, pn)) return false;
        const int n = i & 3;
        u.A = br + ((size_t)pm * 256 * DM + n * 512) * 2; u.B = wb + ((size_t)n * DM * 512 + (size_t)pn * 256 * 512) * 2; u.orow = pm * 256; u.ocol = pn; u.x0 = n; u.x1 = 0; return true;
    }
};
constexpr int NPHASE = 23;
constexpr int LDS_PARAMS = LDS_MISC + 256;
template <class T> __device__ __forceinline__ T* uni(T* q) { const unsigned long long v = (unsigned long long)q; const unsigned lo = __builtin_amdgcn_readfirstlane((unsigned)v), hi = __builtin_amdgcn_readfirstlane((unsigned)(v >> 32)); return (T*)(__attribute__((address_space(1))) T*)(((unsigned long long)hi << 32) | lo); }
__device__ __forceinline__ Params load_params(LAS unsigned char* lds) {
    unsigned poff = LDS_PARAMS; asm volatile("" : "+v"(poff)); poff = __builtin_amdgcn_readfirstlane(poff);
    const LAS Params* P = (const LAS Params*)(lds + poff); Params p;
#pragma unroll
    for (int i = 0; i < 30; ++i) p.in[i] = uni(P->in[i]);
    p.out = uni(P->out); p.ws = uni(P->ws); p.ph_lo = __builtin_amdgcn_readfirstlane(P->ph_lo); p.ph_hi = __builtin_amdgcn_readfirstlane(P->ph_hi); return p;
}
#define PH_HEAD int tid = threadIdx.x; asm volatile("" : "+v"(tid)); const Params p = load_params(lds); const int lane = tid & 63, wid = __builtin_amdgcn_readfirstlane(tid >> 6); const int G = p.ph_lo, cblk = p.ph_hi;     \
    unsigned char* ws = p.ws; unsigned* ctl = (unsigned*)(ws + WS_CTL); unsigned char* lw = ws + WS_LW + (size_t)l * LW_BYTES; bf16_t* U = (bf16_t*)(ws + WS_U); (void)lane; (void)wid; (void)G; (void)cblk; (void)ctl; (void)lw; (void)U
#define PHASE_FN static __device__ __forceinline__ void

PHASE_FN ph_prologue(LAS unsigned char* lds, int l) { PH_HEAD; p0_prologue(p, lds, tid, wid, lane); }
PHASE_FN ph_ingate(LAS unsigned char* lds, int l) { PH_HEAD;
#if INGATE_FP8
    pg8::SchedGrid S{(const char*)(ws + WS_U8), (const char*)(lw + LW_IN), DM / 2, DM / 2, NTOK / 256, 12288 / 256, G, cblk};
    pg8::EpiInGate E{(bf16_t*)(ws + WS_Z), (bf16_t*)(ws + WS_GATES), p.in[I_B_GATE] + (size_t)l * 8192, 1.0f / (SC_ACT8 * SC_W8)};
    pg8::gemm_phase<pg8::EpiInGate, pg8::SchedGrid, true>(lds, DM / 2, DM / 2, DM / 2, S, E, tid);
#else
    pg8::SchedGrid S{(const char*)U, (const char*)(lw + LW_IN), DM, DM, NTOK / 256, 12288 / 256, G, cblk};
    pg8::EpiInGate E{(bf16_t*)(ws + WS_Z), (bf16_t*)(ws + WS_GATES), p.in[I_B_GATE] + (size_t)l * 8192, 1.0f};
    pg8::gemm_phase(lds, DM, DM, DM, S, E, tid);
#endif
}
PHASE_FN ph_inproj(LAS unsigned char* lds, int l) { PH_HEAD;
    const bool sh = l >= 2; l &= 1; lw = ws + WS_LW + (size_t)l * LW_BYTES;
    pg8::SchedGrid S{(const char*)U, (const char*)(lw + LW_IN), DM, DM, NTOK / 256, ZC / 256, G, cblk};
    pg8::EpiBf16 E{(bf16_t*)(ws + (sh ? WS_ACT : WS_Z)), ZC};
    pg8::gemm_phase(lds, DM, DM, DM, S, E, tid); }
PHASE_FN ph_gates(LAS unsigned char* lds, int l) { PH_HEAD;
#if GATES_FP8
    pg8::SchedGrid S{(const char*)(ws + WS_U8), (const char*)(lw + LW_GATE8), DM / 2, DM / 2, NTOK / 256, 8192 / 256, G, cblk};
    pg8::EpiGates E{(bf16_t*)(ws + WS_GATES), p.in[I_B_GATE] + (size_t)l * 8192, 1.0f / (SC_ACT8 * SC_W8)};
    pg8::gemm_phase<pg8::EpiGates, pg8::SchedGrid, true>(lds, DM / 2, DM / 2, DM / 2, S, E, tid);
#else
    pg8::SchedGrid S{(const char*)U, (const char*)(lw + LW_GATE8), DM, DM, NTOK / 256, 8192 / 256, G, cblk};
    pg8::EpiGates E{(bf16_t*)(ws + WS_GATES), p.in[I_B_GATE] + (size_t)l * 8192, 1.0f};
    pg8::gemm_phase<pg8::EpiGates, pg8::SchedGrid, false>(lds, DM, DM, DM, S, E, tid);
#endif
}
PHASE_FN ph_prep1(LAS unsigned char* lds, int l) { PH_HEAD; prep1(p, l, lds, tid, wid, lane); }
PHASE_FN ph_mlaup_q(LAS unsigned char* lds, int l) { PH_HEAD;
    pg8::SchedGrid S{(const char*)(ws + WS_CQN), (const char*)(lw + LW_UQ), 768, 768, NTOK / 256, 3, G, cblk};
    pg8::EpiBf16 E{(bf16_t*)(ws + WS_QRAW), 768}; pg8::gemm_phase(lds, 768, 768, 768, S, E, tid); }
PHASE_FN ph_mlaup_kv(LAS unsigned char* lds, int l) { PH_HEAD;
    pg8::SchedGrid S{(const char*)(ws + WS_CKVN), (const char*)(lw + LW_UKV), 256, 256, NTOK / 256, 4, G, (cblk + G - 96 % G) % G};
    pg8::EpiBf16 E{(bf16_t*)(ws + WS_KVRAW), 1024}; pg8::gemm_phase(lds, 256, 256, 256, S, E, tid); }
PHASE_FN ph_memkv(LAS unsigned char* lds, int l) { PH_HEAD;
    pg8::SchedGrid S{(const char*)(ws + WS_MEMN + (size_t)l * NMEM * DM * 2), (const char*)(lw + LW_MEMKV), DM, DM, NMEM / 256, 4, G, (cblk + G - (224 + 16 * l) % G) % G};
    pg8::EpiBf16 E{(bf16_t*)(ws + WS_MEMKV) + (size_t)l * NMEM * 1024, 1024}; pg8::gemm_phase(lds, DM, DM, DM, S, E, tid); }
PHASE_FN ph_prep2(LAS unsigned char* lds, int l) { PH_HEAD; prep2(p, l, lds, tid, wid, lane); }
PHASE_FN ph_attn(LAS unsigned char* lds, int l) { PH_HEAD; attn_phase(p, l, lds, tid, wid, lane); }
PHASE_FN ph_merge(LAS unsigned char* lds, int l) { PH_HEAD;
    SchedMerge S{(const char*)(ws + WS_BR), (const char*)(lw + LW_BR), G, cblk};
    pg8::EpiMerge E{(const bf16_t*)(ws + WS_GATES), (bf16_t*)(ws + WS_MERGED)};
    pg8::gemm_phase(lds, DM, 512, 512, S, E, tid); }
PHASE_FN ph_wo(LAS unsigned char* lds, int l) { PH_HEAD;
    pg8::SchedGrid S{(const char*)(ws + WS_MERGED), (const char*)(lw + LW_O), DM, DM, NTOK / 256, DM / 256, G, cblk};
    pg8::EpiResF32 E{l == 0 ? p.in[I_X] : (const float*)p.out, p.out};
    pg8::gemm_phase(lds, DM, DM, DM, S, E, tid); }
PHASE_FN ph_norm(LAS unsigned char* lds, int l) { PH_HEAD;
    norm_rows(p.out, l == 0 ? p.in[I_NORM_FFN] : p.in[I_NORM_MIX] + DM, U, l == 0 ? nullptr : ws + WS_U8, NTOK, wid, lane); }
PHASE_FN ph_ffnup(LAS unsigned char* lds, int l) { PH_HEAD;
    pg8::SchedGrid S{(const char*)U, (const char*)(ws + WS_FFNUP), DM, DM, NTOK / 256, 2 * DFF / 256, G, cblk};
    pg8::EpiSwiGLU E{(bf16_t*)(ws + WS_ACT), DFF};
    pg8::gemm_phase(lds, DM, DM, DM, S, E, tid); }
PHASE_FN ph_ffndown(LAS unsigned char* lds, int l) { PH_HEAD;
    pg8::SchedGrid S{(const char*)(ws + WS_ACT), (const char*)(ws + WS_FFNDN), DFF, DFF, NTOK / 256, DM / 256, G, cblk};
    pg8::EpiResF32 E{(const float*)p.out, p.out};
    pg8::gemm_phase(lds, DFF, DFF, DFF, S, E, tid); }
PHASE_FN ph_router(LAS unsigned char* lds, int l) { PH_HEAD; router_phase(p, lds, tid, wid, lane); }
PHASE_FN ph_moeup(LAS unsigned char* lds, int l) { PH_HEAD;
    moe_table(lds, ctl + CW_MOECNT, 2 * DFFE / 256, tid);
    const SchedMoe S{(const char*)(ws + WS_XG), (const char*)(ws + WS_MOEUP), (size_t)ECAP * DM * MOE_ES, (size_t)2 * DFFE * DM * MOE_ES, (size_t)256 * DM * MOE_ES, (size_t)256 * DM * MOE_ES, (const LAS int*)(lds + MOE_TAB_OFF), G, cblk};
#if MOE_FP8
    pg8::EpiSwiGLU8 E{ws + WS_ACTM, DFFE, 1.0f / (SC_ACT8 * SC_W8), SC_H8};
    pg8::gemm_phase<pg8::EpiSwiGLU8, SchedMoe, true>(lds, DM / 2, DM / 2, DM / 2, S, E, tid);
#else
    pg8::EpiSwiGLU E{(bf16_t*)(ws + WS_ACTM), DFFE};
    pg8::gemm_phase(lds, DM, DM, DM, S, E, tid);
#endif
}
PHASE_FN ph_moedown(LAS unsigned char* lds, int l) { PH_HEAD;
    moe_table(lds, ctl + CW_MOECNT, DM / 256, tid);
    const SchedMoe S{(const char*)(ws + WS_ACTM), (const char*)(ws + WS_MOEDN), (size_t)ECAP * DFFE * MOE_ES, (size_t)DM * DFFE * MOE_ES, (size_t)256 * DFFE * MOE_ES, (size_t)256 * DFFE * MOE_ES, (const LAS int*)(lds + MOE_TAB_OFF), G, cblk};
#if MOE_FP8
    pg8::EpiMoeDown E{p.out, (const int*)(ws + WS_TOK), (const float*)(ws + WS_WT), ctl + CW_MOECNT, 1.0f / (SC_H8 * SC_W8)};
    pg8::gemm_phase<pg8::EpiMoeDown, SchedMoe, true>(lds, DFFE / 2, DFFE / 2, DFFE / 2, S, E, tid);
#else
    pg8::EpiMoeDown E{p.out, (const int*)(ws + WS_TOK), (const float*)(ws + WS_WT), ctl + CW_MOECNT, 1.0f};
    pg8::gemm_phase(lds, DFFE, DFFE, DFFE, S, E, tid);
#endif
}


#ifndef PROBE_CHK
#define PROBE_CHK 0
#endif
constexpr int CW_CHKFLAG = 4096 + 2048;
PHASE_FN ph_compare(LAS unsigned char* lds, int l, size_t offa, size_t offb, size_t nbytes) { PH_HEAD;
    const u32x4* a = (const u32x4*)(ws + offa); const u32x4* b = (const u32x4*)(ws + offb); unsigned bad = 0;
    for (size_t i = (size_t)cblk * NTHREADS + tid; i < nbytes / 16; i += (size_t)G * NTHREADS) { const u32x4 x = a[i], y = b[i]; bad |= (x.x ^ y.x) | (x.y ^ y.y) | (x.z ^ y.z) | (x.w ^ y.w); }
    if (bad) atomicOr(ctl + CW_CHKFLAG, 1u); }
PHASE_FN ph_poison(LAS unsigned char* lds, int l) { PH_HEAD;
    if (__hip_atomic_load(ctl + CW_CHKFLAG, __ATOMIC_RELAXED, __HIP_MEMORY_SCOPE_AGENT) != 0u && tid == 0) p.out[cblk] = __builtin_nanf(""); }
__global__ void __launch_bounds__(NTHREADS, 2) mk_fwd(Params pk) {
    extern __shared__ __attribute__((aligned(16))) unsigned char lds_raw[];
    LAS unsigned char* lds = (LAS unsigned char*)lds_raw;
    const int tid = threadIdx.x;
    if (tid < 64) ((LAS unsigned*)(lds + LDS_MISC))[tid] = 0u;
    if (tid == 64) { LAS Params* P = (LAS Params*)(lds + LDS_PARAMS);
#pragma unroll
        for (int i = 0; i < 30; ++i) P->in[i] = pk.in[i];
        P->out = pk.out; P->ws = pk.ws; P->ph_lo = (int)gridDim.x; P->ph_hi = (int)blockIdx.x; }
    __syncthreads();
    unsigned* ctl = (unsigned*)(pk.ws + WS_CTL);
#if !MK_MULTI
    (void)xcd_barrier_post(ctl + CW_BAR, (volatile LAS unsigned*)(lds + LDS_MISC));
#endif
#ifdef ONLY_FN
    ONLY_FN(lds, pk.ph_lo); return;
#endif
    const int lo = pk.ph_lo, hi = pk.ph_hi;
#define IN(k) (lo <= (k) && (k) < hi)
#if MK_MULTI
#define SEAM(k) do { } while (0)
#else
#define SEAM(k) do { if (IN((k) + 1)) { const Params q_ = load_params(lds); XcdBarrier b2_; b2_.bar = (unsigned*)(q_.ws + WS_CTL) + CW_BAR; b2_.x = xb_xcc_id(); b2_.st = (volatile LAS unsigned*)(lds + LDS_MISC); xcd_barrier(b2_); } } while (0)
#endif
#ifndef PROBE_P0
#define PROBE_P0 0
#endif
#ifndef PROBE_ATTN
#define PROBE_ATTN 0
#endif
#ifndef PROBE_THIN
#define PROBE_THIN 0
#endif
    if (IN(0)) { ph_prologue(lds, 0); if (PROBE_P0) { __syncthreads(); ph_prologue(lds, 0); } SEAM(0); }
#pragma unroll 1
    for (int l = 0; l < DEPTH; ++l) {
        const int pb = 1 + 11 * l;
#ifndef SPLIT_INGATE
#define SPLIT_INGATE 0
#endif
        if (IN(pb + 0)) { if (SPLIT_INGATE == 1) { ph_inproj(lds, l); __syncthreads(); ph_gates(lds, l); } else if (SPLIT_INGATE == 2) { ph_ingate(lds, l); SEAM(pb + 0); ph_inproj(lds, l); } else if (SPLIT_INGATE == 3) { ph_ingate(lds, l); SEAM(pb + 0); ph_gates(lds, l); } else ph_ingate(lds, l); if (PROBE_CHK == 2) ph_inproj(lds, l + 2); SEAM(pb + 0);
            if (PROBE_CHK == 2) { ph_compare(lds, l, WS_Z, WS_ACT, (size_t)NTOK * ZC * 2); SEAM(pb + 0); } }
        if (IN(pb + 1)) { ph_prep1(lds, l); if (PROBE_THIN) { __syncthreads(); ph_prep1(lds, l); } SEAM(pb + 1); }
        if (IN(pb + 2)) { ph_mlaup_q(lds, l); ph_mlaup_kv(lds, l); if (l == 0) { ph_memkv(lds, 0); ph_memkv(lds, 1); } SEAM(pb + 2); }
        if (IN(pb + 3)) { ph_prep2(lds, l); if (PROBE_THIN) { __syncthreads(); ph_prep2(lds, l); } SEAM(pb + 3); }
        if (IN(pb + 4)) { ph_attn(lds, l); if (PROBE_ATTN || PROBE_CHK == 1) { __syncthreads(); ph_attn(lds, l + 2); } SEAM(pb + 4);
            if (PROBE_CHK == 1) { ph_compare(lds, l, WS_BR, WS_ACT, (size_t)NTOK * DM * 2); SEAM(pb + 4); } }
        if (IN(pb + 5)) { ph_merge(lds, l); SEAM(pb + 5); }
        if (IN(pb + 6)) { ph_wo(lds, l); SEAM(pb + 6); }
        if (l == 0) {
            if (IN(pb + 7)) { ph_norm(lds, 0); if (PROBE_THIN) { __syncthreads(); ph_norm(lds, 0); } SEAM(pb + 7); }
            if (IN(pb + 8)) { ph_ffnup(lds, 0); SEAM(pb + 8); }
            if (IN(pb + 9)) { ph_ffndown(lds, 0); SEAM(pb + 9); }
            if (IN(pb + 10)) { ph_norm(lds, 1); if (PROBE_THIN) { __syncthreads(); ph_norm(lds, 1); } SEAM(pb + 10); }
        } else {
            if (IN(pb + 7)) { ph_router(lds, 1); SEAM(pb + 7); }
            if (IN(pb + 8)) { ph_moeup(lds, 1); SEAM(pb + 8); }
            if (IN(pb + 9)) { ph_moedown(lds, 1); if (PROBE_CHK) { SEAM(pb + 8); ph_poison(lds, 1); } }
        }
    }
#undef IN
#undef SEAM
}

extern "C" void kernel_launch(void* const* d_in, const int* in_sizes, int n_in, void* d_out, int out_size, void* d_ws, size_t ws_size, hipStream_t stream) {
    static int grid = 0;
    if (grid == 0) {
        if (n_in != 30 || out_size != NTOK * DM || ws_size < WS_END) { fprintf(stderr, "kernel_launch: unexpected problem (n_in %d, out %d, ws %zu < %zu)\n", n_in, out_size, ws_size, (size_t)WS_END); grid = -1; return; }
        int dev = 0, cus = 0, per_cu = 0;
        if (hipGetDevice(&dev) != hipSuccess || hipDeviceGetAttribute(&cus, hipDeviceAttributeMultiprocessorCount, dev) != hipSuccess) { grid = -1; return; }
        if (hipFuncSetAttribute((const void*)mk_fwd, hipFuncAttributeMaxDynamicSharedMemorySize, LDS_BYTES) != hipSuccess) { fprintf(stderr, "kernel_launch: hipFuncSetAttribute failed\n"); grid = -1; return; }
        if (hipOccupancyMaxActiveBlocksPerMultiprocessor(&per_cu, (const void*)mk_fwd, NTHREADS, LDS_BYTES) != hipSuccess || per_cu < 1) fprintf(stderr, "kernel_launch: occupancy query reports %d\n", per_cu);
        (void)hipGetLastError();
        grid = cus;
    }
    if (grid < 0) return;
    if (hipMemsetAsync((char*)d_ws + WS_CTL, 0, CTL_BYTES, stream) != hipSuccess) return;
    Params a{};
    for (int i = 0; i < 30; ++i) a.in[i] = (const float*)d_in[i];
    a.out = (float*)d_out; a.ws = (unsigned char*)d_ws;
#if MK_MULTI
    for (int ph = 0; ph < NPHASE - 1; ++ph) { a.ph_lo = ph; a.ph_hi = ph + 1; hipLaunchKernelGGL(mk_fwd, dim3(grid), dim3(NTHREADS), LDS_BYTES, stream, a); }
#else
    a.ph_lo = 0; a.ph_hi = NPHASE;
    hipLaunchKernelGGL(mk_fwd, dim3(grid), dim3(NTHREADS), LDS_BYTES, stream, a);
#endif
    const hipError_t le = hipPeekAtLastError();
    if (le != hipSuccess) fprintf(stderr, "kernel_launch: launch failed: %s\n", hipGetErrorName(le));
}
```

```cpp
#include <hip/hip_runtime.h>
#include <cstdio>
#include <cstdint>

#define LAS __attribute__((address_space(3)))
typedef unsigned short bf16_t;
typedef short bf16x8 __attribute__((ext_vector_type(8)));
typedef float f32x4 __attribute__((ext_vector_type(4)));
typedef float f32x2 __attribute__((ext_vector_type(2)));
typedef unsigned u32x4 __attribute__((ext_vector_type(4)));
typedef unsigned u32x2 __attribute__((ext_vector_type(2)));

#ifndef MK_MULTI
#define MK_MULTI 0
#endif

constexpr int DM = 2048, NBATCH = 4, SEQ = 2048, NTOK = NBATCH * SEQ, MEML = 256, NMEM = NBATCH * MEML, DEPTH = 2;
constexpr int ZC = 4096;
constexpr int INC = 3904;
constexpr int Z_NAQ = 0, Z_NAK = 512, Z_NAV = 1024, Z_CQ = 1536, Z_CKV = 2304, Z_KPE = 2560, Z_SWQ = 2624, Z_SWK = 3136, Z_SWV = 3264, Z_MEQ = 3392;
constexpr int DFF = 5632, NEXP = 8, DFFE = 7168, ECAP = 8192;
constexpr float LOG2E = 1.4426950408889634f;
constexpr float EPS = 1e-6f;
constexpr int NTHREADS = 512;
constexpr float SC_ACT8 = 16.0f, SC_W8 = 64.0f, SC_H8 = 8.0f;

constexpr size_t al256(size_t x) { return (x + 255) & ~(size_t)255; }
constexpr size_t WS_CTL = 0, CTL_BYTES = 65536;
constexpr size_t WS_ROPE = WS_CTL + CTL_BYTES;
constexpr size_t WS_LW = WS_ROPE + (size_t)SEQ * 32 * 8;
constexpr size_t LW_IN = 0;
constexpr size_t LW_GATE8 = LW_IN + (size_t)4096 * 2048 * 2;
#ifndef INGATE_FP8
#define INGATE_FP8 1
#endif
#define GATES_FP8 0
#ifndef MOE_FP8
#define MOE_FP8 1
#endif
constexpr size_t MOE_ES = MOE_FP8 ? 1 : 2;
constexpr size_t LW_UQ = LW_GATE8 + (size_t)8192 * 2048 * 2;
constexpr size_t LW_UKV = LW_UQ + (size_t)768 * 768 * 2;
constexpr size_t LW_MEMKV = LW_UKV + (size_t)1024 * 256 * 2;
constexpr size_t LW_BR = LW_MEMKV + (size_t)1024 * 2048 * 2;
constexpr size_t LW_O = LW_BR + (size_t)4 * 2048 * 512 * 2;
constexpr size_t LW_BYTES = LW_O + (size_t)2048 * 2048 * 2;
constexpr size_t WS_FFNUP = WS_LW + 2 * LW_BYTES;
constexpr size_t WS_FFNDN = WS_FFNUP + (size_t)2 * DFF * 2048 * 2;
constexpr size_t WS_MOEUP = WS_FFNDN + (size_t)2048 * DFF * 2;
constexpr size_t WS_MOEDN = WS_MOEUP + (size_t)NEXP * 2 * DFFE * 2048 * MOE_ES;
constexpr size_t WS_U = WS_MOEDN + (size_t)NEXP * 2048 * DFFE * MOE_ES;
constexpr size_t WS_U8 = WS_U + (size_t)NTOK * DM * 2;
constexpr size_t WS_MEMN = WS_U8 + (size_t)NTOK * DM;
constexpr size_t WS_Z = WS_MEMN + (size_t)2 * NMEM * DM * 2;
constexpr size_t WS_GATES = WS_Z + (size_t)NTOK * ZC * 2;
constexpr size_t WS_NAQ = WS_GATES + (size_t)NTOK * 8192 * 2;
constexpr size_t WS_NAK = WS_NAQ + (size_t)NTOK * 512 * 2;
constexpr size_t WS_NAVT = WS_NAK + (size_t)NTOK * 512 * 2;
constexpr size_t WS_CQN = WS_NAVT + (size_t)NTOK * 512 * 2;
constexpr size_t WS_CKVN = WS_CQN + (size_t)NTOK * 768 * 2;
constexpr size_t WS_SWQ = WS_CKVN + (size_t)NTOK * 256 * 2;
constexpr size_t WS_SWK = WS_SWQ + (size_t)NTOK * 512 * 2;
constexpr size_t WS_SWVT = WS_SWK + (size_t)NTOK * 128 * 2;
constexpr size_t WS_MEQ = WS_SWVT + (size_t)NTOK * 128 * 2;
constexpr size_t WS_QRAW = WS_MEQ + (size_t)NTOK * 512 * 2;
constexpr size_t WS_KVRAW = WS_QRAW + (size_t)NTOK * 768 * 2;
constexpr size_t WS_MEMKV = WS_KVRAW + (size_t)NTOK * 1024 * 2;
constexpr size_t WS_MLQ = WS_MEMKV + (size_t)2 * NMEM * 1024 * 2;
constexpr size_t WS_MLK = WS_MLQ + (size_t)NTOK * 768 * 2;
constexpr size_t WS_MLVT = WS_MLK + (size_t)NTOK * 768 * 2;
constexpr size_t WS_MEK = WS_MLVT + (size_t)NTOK * 512 * 2;
constexpr size_t WS_MEVT = WS_MEK + (size_t)NMEM * 512 * 2;
constexpr size_t WS_BR = WS_MEVT + (size_t)NMEM * 512 * 2;
constexpr size_t WS_MERGED = WS_BR + (size_t)NTOK * DM * 2;
constexpr size_t WS_ACT = WS_MERGED + (size_t)NTOK * DM * 2;
constexpr size_t WS_XG = WS_ACT + (size_t)NTOK * DFF * 2;
constexpr size_t WS_TOK = WS_XG + (size_t)NEXP * ECAP * DM * MOE_ES;
constexpr size_t WS_WT = WS_TOK + (size_t)NEXP * ECAP * 4;
constexpr size_t WS_ACTM = WS_WT + (size_t)NEXP * ECAP * 4;
constexpr size_t WS_END = WS_ACTM + (size_t)NEXP * ECAP * DFFE * MOE_ES;

constexpr int CW_BAR = 0;
constexpr int CW_MOECNT = 4096;
constexpr int CW_ATTQ = 4096 + 1024;

constexpr int LDS_BYTES = 147456;
constexpr int LDS_MISC = 147456 - 1024;
namespace pg8 {
constexpr int BM = 256, BK = 64, HALF = 128, HTB = HALF * BK * 2, STAGE_BYTES = 8 * HTB, NXCD = 8, WGM = 8;
__host__ __device__ __forceinline__ int lds_byte(int r, int c) { const int st = (r >> 4) * 2 + (c >> 5), rr = r & 15, cc = c & 31, ob = rr * 64 + cc * 2; return st * 1024 + (ob ^ (((ob >> 9) & 1) << 5)); }
__host__ __device__ __forceinline__ void stage_rc(int b, int& R, int& C) { const int st = b / 1024, sb = b % 1024, swz = sb ^ (((sb >> 9) & 1) << 5); R = (st >> 1) * 16 + swz / 64; C = (st & 1) * 32 + (swz % 64) / 2; }
__host__ __device__ __forceinline__ int perm32(int rho) { const int n = rho >> 4, i = rho & 15; return 8 * (i >> 2) + 4 * n + (i & 3); }

struct Unit { const char* A; const char* B; int orow, ocol, x0, x1; };

__device__ __forceinline__ bool static_tile(int i, int G, int c, int nM, int nN, int& pm, int& pn) {
    const int nwg = nM * nN; const long L = (long)i * G + c; if (L >= nwg) return false;
    int wgid = (int)L; { const int q = nwg / NXCD, r = nwg % NXCD, xcd = wgid % NXCD, off = wgid / NXCD; wgid = (xcd < r ? xcd * (q + 1) : r * (q + 1) + (xcd - r) * q) + off; }
    const int nig = WGM * nN, gid = wgid / nig, fm = gid * WGM, gsz = (nM - fm) < WGM ? (nM - fm) : WGM;
    pm = fm + ((wgid % nig) % gsz); pn = (wgid % nig) / gsz; return true;
}
struct SchedGrid {
    const char* A; const char* B; int lda, ldb, nM, nN, G, c;
    __device__ __forceinline__ bool next(int i, Unit& u) const {
        int pm, pn; if (!static_tile(i, G, c, nM, nN, pm, pn)) return false;
        u.A = A + (size_t)pm * 256 * lda * 2; u.B = B + (size_t)pn * 256 * ldb * 2; u.orow = pm * 256; u.ocol = pn; u.x0 = 0; u.x1 = 0; return true;
    }
};

__device__ __forceinline__ unsigned cvt_pk_bf16(float lo, float hi) { unsigned r; asm volatile("v_cvt_pk_bf16_f32 %0, %1, %2" : "=v"(r) : "v"(lo), "v"(hi)); return r; }
__device__ __forceinline__ float sigmoidf_(float x) { return __builtin_amdgcn_rcpf(1.0f + __builtin_amdgcn_exp2f(-x * LOG2E)); }

typedef f32x4 Acc[2][2][4][2];

typedef int i32x8 __attribute__((ext_vector_type(8)));
typedef int i32x4 __attribute__((ext_vector_type(4)));
template <class Epi, class Sched, bool FP8 = false>
__device__ __forceinline__ void gemm_phase(LAS unsigned char* lds, const int lda, const int ldb, const int K, const Sched S, Epi& E, const int tid) {
    const int wid = __builtin_amdgcn_readfirstlane(tid >> 6), lane = tid & 63, wr = wid >> 2, wc = wid & 3, fr = lane & 15, fq = lane >> 4;
    const int nt = K / BK;
    unsigned voffA[2], voffB[2];
#pragma unroll
    for (int i = 0; i < 2; ++i) { int R, C; stage_rc(tid * 16 + i * 8192, R, C); const int Rb = Epi::PERM ? ((R & ~31) + perm32(R & 31)) : R;
        voffA[i] = (unsigned)(R * lda + C) * 2u; voffB[i] = (unsigned)(Rb * ldb + C) * 2u; }
    const size_t kstep = (size_t)(BK * 2);
    const size_t hstepA = (size_t)HALF * lda * 2, hstepB = (size_t)HALF * ldb * 2;
    const unsigned ldsw = (unsigned)wid * 1024u;
    const int aoff = lds_byte(wr * 64 + fr, fq * 8), boff = lds_byte(wc * 32 + fr, fq * 8);
#define PG8_SA(b, h) (((b) * 2 + (h)) * HTB)
#define PG8_SB(b, h) ((4 + (b) * 2 + (h)) * HTB)
#define PG8_STAGE(bufoff, gbase, voff) do { _Pragma("unroll") for (int _i = 0; _i < 2; ++_i) \
        __builtin_amdgcn_global_load_lds((const unsigned*)((const char*)(gbase) + (voff)[_i]), (LAS unsigned*)(lds + (bufoff) + ldsw + _i * 8192), 16, 0, 0); } while (0)
#define PG8_LDA(dst, b, h) do { _Pragma("unroll") for (int m = 0; m < 4; ++m) _Pragma("unroll") for (int k = 0; k < 2; ++k) dst[m][k] = *(const LAS bf16x8*)(lds + PG8_SA(b, h) + aoff + m * 2048 + k * 1024); } while (0)
#define PG8_LDB(dst, b, h) do { _Pragma("unroll") for (int n = 0; n < 2; ++n) _Pragma("unroll") for (int k = 0; k < 2; ++k) dst[n][k] = *(const LAS bf16x8*)(lds + PG8_SB(b, h) + boff + n * 2048 + k * 1024); } while (0)
#define PG8_MMA(ai, bj, At, Bt) do { __builtin_amdgcn_s_setprio(1); _Pragma("unroll") for (int m = 0; m < 4; ++m) _Pragma("unroll") for (int n = 0; n < 2; ++n) _Pragma("unroll") for (int k = 0; k < 2; ++k) \
        acc[ai][bj][m][n] = __builtin_amdgcn_mfma_f32_16x16x32_bf16(Bt[n][k], At[m][k], acc[ai][bj][m][n], 0, 0, 0); __builtin_amdgcn_s_setprio(0); } while (0)
#define PG8_CAT(x, y) __builtin_shufflevector(__builtin_bit_cast(i32x4, x), __builtin_bit_cast(i32x4, y), 0, 1, 2, 3, 4, 5, 6, 7)
#define PG8_MMA8(ai, bj, At, Bt) do { __builtin_amdgcn_s_setprio(1); _Pragma("unroll") for (int m = 0; m < 4; ++m) _Pragma("unroll") for (int n = 0; n < 2; ++n) \
        asm volatile("v_mfma_f32_16x16x128_f8f6f4 %0, %1, %2, %0" : "+v"(acc[ai][bj][m][n]) : "v"(PG8_CAT(Bt[n][0], Bt[n][1])), "v"(PG8_CAT(At[m][0], At[m][1]))); __builtin_amdgcn_s_setprio(0); } while (0)
#define PG8_WAIT_V(n) asm volatile("s_waitcnt vmcnt(" #n ")" ::: "memory")
#define PG8_WAIT_L(n) asm volatile("s_waitcnt lgkmcnt(" #n ")" ::: "memory")
#define PG8_BAR __builtin_amdgcn_s_barrier()
#define PG8_SCHED __builtin_amdgcn_sched_barrier(0)
    Unit cur, nxt; int ui = 0;
    if (!S.next(0, cur)) return;
    Acc acc;
#pragma unroll
    for (int a = 0; a < 2; ++a)
#pragma unroll
        for (int b = 0; b < 2; ++b)
#pragma unroll
            for (int m = 0; m < 4; ++m)
#pragma unroll
                for (int n = 0; n < 2; ++n) acc[a][b][m][n] = (f32x4){0.f, 0.f, 0.f, 0.f};
    bf16x8 At[4][2], B0[2][2], B1[2][2];
    const char* cA = cur.A; const char* cB = cur.B;
    PG8_STAGE(PG8_SB(0, 0), cB, voffB); PG8_STAGE(PG8_SB(0, 1), cB + hstepB, voffB); PG8_STAGE(PG8_SA(0, 0), cA, voffA); PG8_STAGE(PG8_SA(0, 1), cA + hstepA, voffA);
    if (wr == 1) PG8_BAR;
    PG8_WAIT_V(2); PG8_BAR;
    PG8_STAGE(PG8_SB(1, 0), cB + kstep, voffB); PG8_STAGE(PG8_SA(1, 0), cA + kstep, voffA); PG8_STAGE(PG8_SB(1, 1), cB + hstepB + kstep, voffB);
    PG8_WAIT_V(6); PG8_BAR;
    for (;;) {
        const bool has_next = S.next(ui + 1, nxt);
        const char* nA = has_next ? nxt.A : cA; const char* nB = has_next ? nxt.B : cB;
        for (int t = 0; t < nt; t += 2) {
            const bool last = (t == nt - 2);
            const char* a1 = cA + (size_t)(t + 1) * kstep;
            const char* a2 = last ? nA : cA + (size_t)(t + 2) * kstep; const char* b2 = last ? nB : cB + (size_t)(t + 2) * kstep;
            const char* a3 = a2 + kstep; const char* b3 = b2 + kstep;
            if constexpr (FP8) {
            PG8_LDB(B0, 0, 0); PG8_LDB(B1, 0, 1); PG8_SCHED; PG8_LDA(At, 0, 0); PG8_STAGE(PG8_SA(1, 1), a1 + hstepA, voffA);
            PG8_WAIT_V(8); PG8_WAIT_L(0); PG8_BAR; PG8_MMA8(0, 0, At, B0); PG8_MMA8(0, 1, At, B1); PG8_BAR; PG8_SCHED;
            PG8_LDA(At, 0, 1); PG8_STAGE(PG8_SB(0, 0), b2, voffB); PG8_STAGE(PG8_SB(0, 1), b2 + hstepB, voffB); PG8_STAGE(PG8_SA(0, 0), a2, voffA);
            PG8_WAIT_V(8); PG8_WAIT_L(0); PG8_BAR; PG8_MMA8(1, 0, At, B0); PG8_MMA8(1, 1, At, B1); PG8_BAR; PG8_SCHED;
            PG8_LDB(B0, 1, 0); PG8_LDB(B1, 1, 1); PG8_SCHED; PG8_LDA(At, 1, 0); PG8_STAGE(PG8_SA(0, 1), a2 + hstepA, voffA);
            PG8_WAIT_V(8); PG8_WAIT_L(0); PG8_BAR; PG8_MMA8(0, 0, At, B0); PG8_MMA8(0, 1, At, B1); PG8_BAR; PG8_SCHED;
            PG8_LDA(At, 1, 1); PG8_STAGE(PG8_SB(1, 0), b3, voffB); PG8_STAGE(PG8_SB(1, 1), b3 + hstepB, voffB); PG8_STAGE(PG8_SA(1, 0), a3, voffA);
            PG8_WAIT_V(8); PG8_WAIT_L(0); PG8_BAR; PG8_MMA8(1, 0, At, B0); PG8_MMA8(1, 1, At, B1); PG8_BAR; PG8_SCHED;
            } else {
            PG8_LDB(B0, 0, 0); PG8_LDB(B1, 0, 1); PG8_SCHED; PG8_LDA(At, 0, 0); PG8_STAGE(PG8_SA(1, 1), a1 + hstepA, voffA);
            PG8_WAIT_V(8); PG8_WAIT_L(0); PG8_BAR; PG8_MMA(0, 0, At, B0); PG8_MMA(0, 1, At, B1); PG8_BAR; PG8_SCHED;
            PG8_LDA(At, 0, 1); PG8_STAGE(PG8_SB(0, 0), b2, voffB); PG8_STAGE(PG8_SB(0, 1), b2 + hstepB, voffB); PG8_STAGE(PG8_SA(0, 0), a2, voffA);
            PG8_WAIT_V(8); PG8_WAIT_L(0); PG8_BAR; PG8_MMA(1, 0, At, B0); PG8_MMA(1, 1, At, B1); PG8_BAR; PG8_SCHED;
            PG8_LDB(B0, 1, 0); PG8_LDB(B1, 1, 1); PG8_SCHED; PG8_LDA(At, 1, 0); PG8_STAGE(PG8_SA(0, 1), a2 + hstepA, voffA);
            PG8_WAIT_V(8); PG8_WAIT_L(0); PG8_BAR; PG8_MMA(0, 0, At, B0); PG8_MMA(0, 1, At, B1); PG8_BAR; PG8_SCHED;
            PG8_LDA(At, 1, 1); PG8_STAGE(PG8_SB(1, 0), b3, voffB); PG8_STAGE(PG8_SB(1, 1), b3 + hstepB, voffB); PG8_STAGE(PG8_SA(1, 0), a3, voffA);
            PG8_WAIT_V(8); PG8_WAIT_L(0); PG8_BAR; PG8_MMA(1, 0, At, B0); PG8_MMA(1, 1, At, B1); PG8_BAR; PG8_SCHED;
            }
        }
        if (wr == 0) PG8_BAR;
        if constexpr (FP8) {
#pragma unroll
            for (int a = 0; a < 2; ++a)
#pragma unroll
                for (int b = 0; b < 2; ++b)
                    asm volatile("s_nop 15\n\ts_nop 15" : "+v"(acc[a][b][0][0]), "+v"(acc[a][b][0][1]), "+v"(acc[a][b][1][0]), "+v"(acc[a][b][1][1]), "+v"(acc[a][b][2][0]), "+v"(acc[a][b][2][1]), "+v"(acc[a][b][3][0]), "+v"(acc[a][b][3][1]));
        }
        E(acc, cur, wr, wc, fr, fq);
        if (!has_next) break;
#pragma unroll
        for (int a = 0; a < 2; ++a)
#pragma unroll
            for (int b = 0; b < 2; ++b)
#pragma unroll
                for (int m = 0; m < 4; ++m)
#pragma unroll
                    for (int n = 0; n < 2; ++n) acc[a][b][m][n] = (f32x4){0.f, 0.f, 0.f, 0.f};
        cur = nxt; cA = nA; cB = nB; ++ui;
        if (wr == 1) PG8_BAR;
    }
    PG8_WAIT_V(0);
    PG8_BAR;
#undef PG8_SA
#undef PG8_SB
#undef PG8_STAGE
#undef PG8_LDA
#undef PG8_MMA8
#undef PG8_CAT
#undef PG8_LDB
#undef PG8_MMA
#undef PG8_WAIT_V
#undef PG8_WAIT_L
#undef PG8_BAR
#undef PG8_SCHED
}

struct EpiInGate {
    static constexpr bool PERM = true;
    bf16_t* z; bf16_t* gates; const float* bgate; float s;
    __device__ __forceinline__ void operator()(const Acc& acc, const Unit& u, int wr, int wc, int fr, int fq) const {
        const int row0 = u.orow + wr * 64 + fr; const bool isg = u.ocol >= 16;
        const int colt = (isg ? u.ocol - 16 : u.ocol) * 256 + wc * 32 + 8 * fq; const int ldc = isg ? 8192 : ZC; bf16_t* base = isg ? gates : z;
        f32x4 bv[2][2];
#pragma unroll
        for (int bj = 0; bj < 2; ++bj)
#pragma unroll
            for (int n = 0; n < 2; ++n) bv[bj][n] = isg ? *(const f32x4*)(bgate + colt + bj * HALF + 4 * n) : (f32x4){0.f, 0.f, 0.f, 0.f};
#pragma unroll
        for (int ai = 0; ai < 2; ++ai)
#pragma unroll
            for (int m = 0; m < 4; ++m) { bf16_t* rowp = base + (size_t)(row0 + ai * HALF + m * 16) * ldc + colt;
#pragma unroll
                for (int bj = 0; bj < 2; ++bj) { f32x4 v0 = acc[ai][bj][m][0] * s + bv[bj][0], v1 = acc[ai][bj][m][1] * s + bv[bj][1];
                    if (isg) {
#pragma unroll
                        for (int j = 0; j < 4; ++j) { v0[j] = sigmoidf_(v0[j]); v1[j] = sigmoidf_(v1[j]); } }
                    u32x4 w; w.x = cvt_pk_bf16(v0[0], v0[1]); w.y = cvt_pk_bf16(v0[2], v0[3]); w.z = cvt_pk_bf16(v1[0], v1[1]); w.w = cvt_pk_bf16(v1[2], v1[3]);
                    *(u32x4*)(rowp + bj * HALF) = w; } }
    }
};
struct EpiBf16 {
    static constexpr bool PERM = true;
    bf16_t* O; int ldc;
    __device__ __forceinline__ void operator()(const Acc& acc, const Unit& u, int wr, int wc, int fr, int fq) const {
        const int row0 = u.orow + wr * 64 + fr, col0 = u.ocol * 256 + wc * 32 + 8 * fq;
#pragma unroll
        for (int ai = 0; ai < 2; ++ai)
#pragma unroll
            for (int m = 0; m < 4; ++m) { bf16_t* rowp = O + (size_t)(row0 + ai * HALF + m * 16) * ldc + col0;
#pragma unroll
                for (int bj = 0; bj < 2; ++bj) { const f32x4 v0 = acc[ai][bj][m][0], v1 = acc[ai][bj][m][1];
                    u32x4 w; w.x = cvt_pk_bf16(v0[0], v0[1]); w.y = cvt_pk_bf16(v0[2], v0[3]); w.z = cvt_pk_bf16(v1[0], v1[1]); w.w = cvt_pk_bf16(v1[2], v1[3]);
                    *(u32x4*)(rowp + bj * HALF) = w; } }
    }
};
struct EpiSwiGLU {
    static constexpr bool PERM = true;
    bf16_t* O; int ldc;
    __device__ __forceinline__ void operator()(const Acc& acc, const Unit& u, int wr, int wc, int fr, int fq) const {
        const int row0 = u.orow + wr * 64 + fr, col0 = u.ocol * 128 + wc * 32 + 8 * fq;
#pragma unroll
        for (int ai = 0; ai < 2; ++ai)
#pragma unroll
            for (int m = 0; m < 4; ++m) { bf16_t* rowp = O + (size_t)(row0 + ai * HALF + m * 16) * ldc + col0;
                f32x4 v0, v1;
#pragma unroll
                for (int j = 0; j < 4; ++j) { const float g0 = acc[ai][0][m][0][j], g1 = acc[ai][0][m][1][j];
                    v0[j] = g0 * sigmoidf_(g0) * acc[ai][1][m][0][j]; v1[j] = g1 * sigmoidf_(g1) * acc[ai][1][m][1][j]; }
                u32x4 w; w.x = cvt_pk_bf16(v0[0], v0[1]); w.y = cvt_pk_bf16(v0[2], v0[3]); w.z = cvt_pk_bf16(v1[0], v1[1]); w.w = cvt_pk_bf16(v1[2], v1[3]);
                *(u32x4*)rowp = w; }
    }
};
__device__ __forceinline__ float bflo(unsigned w) { return __uint_as_float(w << 16); }
__device__ __forceinline__ float bfhi(unsigned w) { return __uint_as_float(w & 0xffff0000u); }
struct EpiMerge {
    static constexpr bool PERM = true;
    const bf16_t* gates; bf16_t* merged;
    __device__ __forceinline__ void operator()(const Acc& acc, const Unit& u, int wr, int wc, int fr, int fq) const {
        const int row0 = u.orow + wr * 64 + fr, col0 = u.ocol * 256 + wc * 32 + 8 * fq, n = u.x0;
#pragma unroll
        for (int ai = 0; ai < 2; ++ai)
#pragma unroll
            for (int m = 0; m < 4; ++m) { const size_t r = (size_t)(row0 + ai * HALF + m * 16);
#pragma unroll
                for (int bj = 0; bj < 2; ++bj) {
                    const u32x4 g = *(const u32x4*)(gates + r * 8192 + n * 2048 + col0 + bj * HALF);
                    bf16_t* mp = merged + r * DM + col0 + bj * HALF;
                    u32x4 o = (u32x4){0u, 0u, 0u, 0u}; if (n > 0) o = *(const u32x4*)mp;
                    const f32x4 v0 = acc[ai][bj][m][0], v1 = acc[ai][bj][m][1];
                    u32x4 w;
                    w.x = cvt_pk_bf16(bflo(o.x) + bflo(g.x) * v0[0], bfhi(o.x) + bfhi(g.x) * v0[1]);
                    w.y = cvt_pk_bf16(bflo(o.y) + bflo(g.y) * v0[2], bfhi(o.y) + bfhi(g.y) * v0[3]);
                    w.z = cvt_pk_bf16(bflo(o.z) + bflo(g.z) * v1[0], bfhi(o.z) + bfhi(g.z) * v1[1]);
                    w.w = cvt_pk_bf16(bflo(o.w) + bflo(g.w) * v1[2], bfhi(o.w) + bfhi(g.w) * v1[3]);
                    *(u32x4*)mp = w; } }
    }
};
__device__ __forceinline__ unsigned pack_fp8x4(float a, float b, float c, float d) { int w = 0; w = __builtin_amdgcn_cvt_pk_fp8_f32(a, b, w, false); w = __builtin_amdgcn_cvt_pk_fp8_f32(c, d, w, true); return (unsigned)w; }
struct EpiGates {
    static constexpr bool PERM = true;
    bf16_t* gates; const float* bgate; float s;
    __device__ __forceinline__ void operator()(const Acc& acc, const Unit& u, int wr, int wc, int fr, int fq) const {
        const int row0 = u.orow + wr * 64 + fr, colt = u.ocol * 256 + wc * 32 + 8 * fq;
        f32x4 bv[2][2];
#pragma unroll
        for (int bj = 0; bj < 2; ++bj)
#pragma unroll
            for (int n = 0; n < 2; ++n) bv[bj][n] = *(const f32x4*)(bgate + colt + bj * HALF + 4 * n);
#pragma unroll
        for (int ai = 0; ai < 2; ++ai)
#pragma unroll
            for (int m = 0; m < 4; ++m) { bf16_t* rowp = gates + (size_t)(row0 + ai * HALF + m * 16) * 8192 + colt;
#pragma unroll
                for (int bj = 0; bj < 2; ++bj) { f32x4 v0 = acc[ai][bj][m][0] * s + bv[bj][0], v1 = acc[ai][bj][m][1] * s + bv[bj][1];
#pragma unroll
                    for (int j = 0; j < 4; ++j) { v0[j] = sigmoidf_(v0[j]); v1[j] = sigmoidf_(v1[j]); }
                    u32x4 w; w.x = cvt_pk_bf16(v0[0], v0[1]); w.y = cvt_pk_bf16(v0[2], v0[3]); w.z = cvt_pk_bf16(v1[0], v1[1]); w.w = cvt_pk_bf16(v1[2], v1[3]);
                    *(u32x4*)(rowp + bj * HALF) = w; } }
    }
};
struct EpiSwiGLU8 {
    static constexpr bool PERM = true;
    unsigned char* O; int ldc; float si, so;
    __device__ __forceinline__ void operator()(const Acc& acc, const Unit& u, int wr, int wc, int fr, int fq) const {
        const int row0 = u.orow + wr * 64 + fr, col0 = u.ocol * 128 + wc * 32 + 8 * fq;
#pragma unroll
        for (int ai = 0; ai < 2; ++ai)
#pragma unroll
            for (int m = 0; m < 4; ++m) { unsigned char* rowp = O + (size_t)(row0 + ai * HALF + m * 16) * ldc + col0;
                f32x4 v0, v1;
#pragma unroll
                for (int j = 0; j < 4; ++j) { const float g0 = acc[ai][0][m][0][j] * si, g1 = acc[ai][0][m][1][j] * si;
                    v0[j] = g0 * sigmoidf_(g0) * (acc[ai][1][m][0][j] * si) * so; v1[j] = g1 * sigmoidf_(g1) * (acc[ai][1][m][1][j] * si) * so; }
                u32x2 w; w.x = pack_fp8x4(v0[0], v0[1], v0[2], v0[3]); w.y = pack_fp8x4(v1[0], v1[1], v1[2], v1[3]);
                *(u32x2*)rowp = w; }
    }
};
struct EpiResF32 {
    static constexpr bool PERM = false;
    const float* base; float* out;
    __device__ __forceinline__ void operator()(const Acc& acc, const Unit& u, int wr, int wc, int fr, int fq) const {
        const int row0 = u.orow + wr * 64 + fr, col0 = u.ocol * 256 + wc * 32 + 4 * fq;
#pragma unroll
        for (int ai = 0; ai < 2; ++ai)
#pragma unroll
            for (int m = 0; m < 4; ++m) { const size_t off = (size_t)(row0 + ai * HALF + m * 16) * DM + col0;
#pragma unroll
                for (int bj = 0; bj < 2; ++bj)
#pragma unroll
                    for (int n = 0; n < 2; ++n) { const f32x4 bs = *(const f32x4*)(base + off + bj * HALF + n * 16); *(f32x4*)(out + off + bj * HALF + n * 16) = bs + acc[ai][bj][m][n]; }
                asm volatile("" ::: "memory"); }
    }
};
struct EpiMoeDown {
    static constexpr bool PERM = false;
    float* out; const int* tok; const float* wt; const unsigned* cnt; float s;
    __device__ __forceinline__ void operator()(const Acc& acc, const Unit& u, int wr, int wc, int fr, int fq) const {
        const int e = u.x0, nrow = (int)cnt[e * 64]; const int lrow0 = u.x1 + wr * 64 + fr, col0 = u.ocol * 256 + wc * 32 + 4 * fq;
#pragma unroll
        for (int ai = 0; ai < 2; ++ai)
#pragma unroll
            for (int m = 0; m < 4; ++m) { const int lr = lrow0 + ai * HALF + m * 16;
                if (lr < nrow) { const int slot = e * ECAP + lr; const int t = tok[slot]; const float w = wt[slot] * s; float* op = out + (size_t)t * DM + col0;
#pragma unroll
                    for (int bj = 0; bj < 2; ++bj)
#pragma unroll
                        for (int n = 0; n < 2; ++n)
#pragma unroll
                            for (int j = 0; j < 4; ++j) unsafeAtomicAdd(op + bj * HALF + n * 16 + j, w * acc[ai][bj][m][n][j]); } }
    }
};
}
#define XB_TMO      128
#define XB_XCNT(j)  (256  + 64 * (j))
#define XB_XSUB(j)  (1280 + 64 * (j))
#define XB_XGEN(j)  (2304 + 64 * (j))
#define XB_TOP      3328
#define XB_TOPGEN   3392
#define XCD_BAR_WORDS 3456
#define XB_SPIN_CAP (1u << 18)

__device__ __forceinline__ unsigned xb_ld(unsigned* p)              { return __hip_atomic_load(p, __ATOMIC_RELAXED, __HIP_MEMORY_SCOPE_AGENT); }
__device__ __forceinline__ unsigned xb_add(unsigned* p, unsigned v) { return __hip_atomic_fetch_add(p, v, __ATOMIC_RELAXED, __HIP_MEMORY_SCOPE_AGENT); }
__device__ __forceinline__ unsigned xb_xcc_id() { return (unsigned)__builtin_amdgcn_s_getreg((3 << 11) | 20) & 0xFu; }
#define XB_SPIN(cond, bar) do { unsigned _sp = 0; while (cond) { __builtin_amdgcn_s_sleep(1); \
    if ((++_sp & 255u) == 0u) { if (xb_ld(&(bar)[XB_TMO])) break; if (_sp > XB_SPIN_CAP) { atomicAdd(&(bar)[XB_TMO], 1u); break; } } } } while (0)

__device__ __forceinline__ unsigned xb_tid() { unsigned t = threadIdx.x; asm volatile("" : "+v"(t)); return t; }
struct XcdBarrier {
    unsigned* bar; unsigned x;
    volatile LAS unsigned* st;
};

__device__ __forceinline__ XcdBarrier xcd_barrier_post(unsigned* bar, volatile LAS unsigned* st) {
    XcdBarrier b; b.bar = bar; b.x = xb_xcc_id(); b.st = st;
    if (xb_tid() == 0u) (void)xb_add(&bar[XB_XCNT(b.x)], 1u);
    return b;
}
__device__ __forceinline__ void xcd_barrier_complete(unsigned* bar, unsigned x, unsigned& nloc, unsigned& nx) {
    const unsigned G = gridDim.x * gridDim.y * gridDim.z;
    unsigned sum, cnt, mine, sp = 0u;
    for (;;) {
        sum = 0u; cnt = 0u; mine = 0u;
#pragma unroll
        for (unsigned j = 0; j < 16; ++j) { const unsigned c = xb_ld(&bar[XB_XCNT(j)]); sum += c; cnt += (c > 0u) ? 1u : 0u; mine = (j == x) ? c : mine; }
        if (sum == G) break;
        __builtin_amdgcn_s_sleep(1);
        if ((++sp & 255u) == 0u) { if (xb_ld(&bar[XB_TMO])) break; if (sp > XB_SPIN_CAP) { atomicAdd(&bar[XB_TMO], 1u); break; } }
    }
    nloc = mine > 0u ? mine : 1u; nx = cnt > 0u ? cnt : 1u;
}

__device__ __forceinline__ void xcd_barrier(const XcdBarrier& b) {
    asm volatile("s_waitcnt vmcnt(0)" ::: "memory");
    __syncthreads();
    if (xb_tid() == 0u) {
        unsigned* bar = b.bar;
        __builtin_amdgcn_s_waitcnt(0);
        unsigned nloc = b.st[0], nx = b.st[1];
        if (nloc == 0u) { xcd_barrier_complete(bar, b.x, nloc, nx); b.st[0] = nloc; b.st[1] = nx; }
        const unsigned old = xb_add(&bar[XB_XSUB(b.x)], 1u);
        const unsigned gen = old / nloc;
        if (old + 1u == (gen + 1u) * nloc) {
            __builtin_amdgcn_fence(__ATOMIC_RELEASE, "agent");
            asm volatile("s_waitcnt vmcnt(0)" ::: "memory");
            const unsigned og = xb_add(&bar[XB_TOP], 1u);
            const unsigned tg = og / nx;
            if (og + 1u == (tg + 1u) * nx) xb_add(&bar[XB_TOPGEN], 1u);
            else XB_SPIN(xb_ld(&bar[XB_TOPGEN]) == tg, bar);
            __builtin_amdgcn_fence(__ATOMIC_ACQUIRE, "agent");
            xb_add(&bar[XB_XGEN(b.x)], 1u);
            asm volatile("s_waitcnt vmcnt(0)" ::: "memory");
        } else {
            XB_SPIN(xb_ld(&bar[XB_XGEN(b.x)]) == gen, bar);
            __builtin_amdgcn_fence(__ATOMIC_ACQUIRE, "agent");
            asm volatile("s_waitcnt vmcnt(0)" ::: "memory");
        }
    }
    __syncthreads();
}

struct Params { const float* in[30]; float* out; unsigned char* ws; int ph_lo, ph_hi; };
enum { I_X = 0, I_MEM, I_NORM_MIX, I_W_IN, I_NA_QN, I_NA_KN, I_NA_RPB, I_CQ_N, I_W_UQ, I_CKV_N, I_W_UKV, I_MLA_QN, I_MLA_KN, I_SWA_QN, I_SWA_KN, I_SWA_SINK,
       I_MEM_N, I_MEM_WKV, I_MEM_QN, I_MEM_KN, I_W_BRANCH, I_W_GATE, I_B_GATE, I_W_O, I_NORM_FFN, I_FFN_UP, I_FFN_DN, I_ROUTER, I_MOE_UP, I_MOE_DN };

__device__ __forceinline__ float wave_sum(float v) {
#pragma unroll
    for (int o = 32; o >= 1; o >>= 1) v += __shfl_xor(v, o);
    return v;
}
__device__ __forceinline__ float bf2f(bf16_t b) { return __uint_as_float(((unsigned)b) << 16); }
__device__ __forceinline__ bf16_t f2bf(float f) { return (bf16_t)(pg8::cvt_pk_bf16(f, 0.f) & 0xffffu); }
using pg8::cvt_pk_bf16; using pg8::bflo; using pg8::bfhi;

struct CvtJob { const float* src; bf16_t* dst; int src_ld, K, ntn, tile0, mode, dff; };
constexpr int NJOBS = 40;
__device__ __forceinline__ void make_job(int j, const Params& p, CvtJob& jb) {
    unsigned char* ws = p.ws; jb.mode = 0; jb.dff = 1; jb.tile0 = 0;
    if (j < 22) { const int l = j / 11, k = j % 11; unsigned char* lw = ws + WS_LW + (size_t)l * LW_BYTES;
        if (k == 0) { jb.src = p.in[I_W_IN] + (size_t)l * DM * INC; jb.dst = (bf16_t*)(lw + LW_IN); jb.src_ld = INC; jb.K = DM; jb.ntn = INC / 64; jb.mode = INGATE_FP8 ? 3 : 0; }
        else if (k == 1) { jb.src = p.in[I_W_IN]; jb.dst = (bf16_t*)(lw + LW_IN + (size_t)INC * DM * (INGATE_FP8 ? 1 : 2)); jb.src_ld = INC; jb.K = DM; jb.ntn = (ZC - INC) / 64; jb.mode = INGATE_FP8 ? 5 : 2; }
        else if (k == 2) { jb.src = p.in[I_W_GATE] + (size_t)l * DM * 8192; jb.dst = (bf16_t*)(lw + LW_IN + (size_t)ZC * DM * (INGATE_FP8 ? 1 : 2)); jb.src_ld = 8192; jb.K = DM; jb.ntn = 8192 / 64; jb.mode = INGATE_FP8 ? 3 : 0; }
        else if (k == 3) { jb.src = p.in[I_W_UQ] + (size_t)l * 768 * 768; jb.dst = (bf16_t*)(lw + LW_UQ); jb.src_ld = 768; jb.K = 768; jb.ntn = 768 / 64; }
        else if (k == 4) { jb.src = p.in[I_W_UKV] + (size_t)l * 256 * 1024; jb.dst = (bf16_t*)(lw + LW_UKV); jb.src_ld = 1024; jb.K = 256; jb.ntn = 1024 / 64; }
        else if (k == 5) { jb.src = p.in[I_MEM_WKV] + (size_t)l * DM * 1024; jb.dst = (bf16_t*)(lw + LW_MEMKV); jb.src_ld = 1024; jb.K = DM; jb.ntn = 1024 / 64; }
        else if (k < 10) { const int n = k - 6; jb.src = p.in[I_W_BRANCH] + ((size_t)l * 4 + n) * 512 * DM; jb.dst = (bf16_t*)(lw + LW_BR) + (size_t)n * DM * 512; jb.src_ld = DM; jb.K = 512; jb.ntn = DM / 64; }
        else { jb.src = p.in[I_W_O] + (size_t)l * DM * DM; jb.dst = (bf16_t*)(lw + LW_O); jb.src_ld = DM; jb.K = DM; jb.ntn = DM / 64; }
    } else if (j == 22) { jb.src = p.in[I_FFN_UP]; jb.dst = (bf16_t*)(ws + WS_FFNUP); jb.src_ld = 2 * DFF; jb.K = DM; jb.ntn = 2 * DFF / 64; jb.mode = 1; jb.dff = DFF; }
    else if (j == 23) { jb.src = p.in[I_FFN_DN]; jb.dst = (bf16_t*)(ws + WS_FFNDN); jb.src_ld = DM; jb.K = DFF; jb.ntn = DM / 64; }
    else if (j < 32) { const int e = j - 24; jb.src = p.in[I_MOE_UP] + (size_t)e * DM * 2 * DFFE; jb.dst = (bf16_t*)(ws + WS_MOEUP + (size_t)e * 2 * DFFE * DM * MOE_ES); jb.src_ld = 2 * DFFE; jb.K = DM; jb.ntn = 2 * DFFE / 64; jb.mode = MOE_FP8 ? 4 : 1; jb.dff = DFFE; }
    else { const int e = j - 32; jb.src = p.in[I_MOE_DN] + (size_t)e * DFFE * DM; jb.dst = (bf16_t*)(ws + WS_MOEDN + (size_t)e * DM * DFFE * MOE_ES); jb.src_ld = DM; jb.K = DFFE; jb.ntn = DM / 64; jb.mode = MOE_FP8 ? 3 : 0; }
}

__device__ __forceinline__ void norm_rows(const float* src, const float* g, bf16_t* dst, unsigned char* dst8, int nrows, int wid, int lane) {
    const int nw = gridDim.x * 8;
    for (int row = blockIdx.x * 8 + wid; row < nrows; row += 2 * nw) {
        const int rowb = row + nw; const bool hb = rowb < nrows;
        const f32x4* sa = (const f32x4*)(src + (size_t)row * DM); const f32x4* sb = (const f32x4*)(src + (size_t)(hb ? rowb : row) * DM);
        f32x4 va[8], vb[8]; float ssa = 0.f, ssb = 0.f;
#pragma unroll
        for (int j = 0; j < 8; ++j) { va[j] = sa[lane + 64 * j]; vb[j] = sb[lane + 64 * j]; }
#pragma unroll
        for (int j = 0; j < 8; ++j) { ssa += va[j][0] * va[j][0] + va[j][1] * va[j][1] + va[j][2] * va[j][2] + va[j][3] * va[j][3]; ssb += vb[j][0] * vb[j][0] + vb[j][1] * vb[j][1] + vb[j][2] * vb[j][2] + vb[j][3] * vb[j][3]; }
#pragma unroll
        for (int o = 32; o >= 1; o >>= 1) { ssa += __shfl_xor(ssa, o); ssb += __shfl_xor(ssb, o); }
        const float ra = 1.0f / sqrtf(ssa * (1.0f / DM) + EPS), rb = 1.0f / sqrtf(ssb * (1.0f / DM) + EPS);
#pragma unroll
        for (int j = 0; j < 8; ++j) { const f32x4 gv = ((const f32x4*)g)[lane + 64 * j];
            { const f32x4 y = va[j] * ra * gv; u32x2 w; w.x = cvt_pk_bf16(y[0], y[1]); w.y = cvt_pk_bf16(y[2], y[3]); *(u32x2*)(dst + (size_t)row * DM + 4 * (lane + 64 * j)) = w;
              if (dst8) *(unsigned*)(dst8 + (size_t)row * DM + 4 * (lane + 64 * j)) = pg8::pack_fp8x4(y[0] * SC_ACT8, y[1] * SC_ACT8, y[2] * SC_ACT8, y[3] * SC_ACT8); }
            if (hb) { const f32x4 y = vb[j] * rb * gv; u32x2 w; w.x = cvt_pk_bf16(y[0], y[1]); w.y = cvt_pk_bf16(y[2], y[3]); *(u32x2*)(dst + (size_t)rowb * DM + 4 * (lane + 64 * j)) = w;
              if (dst8) *(unsigned*)(dst8 + (size_t)rowb * DM + 4 * (lane + 64 * j)) = pg8::pack_fp8x4(y[0] * SC_ACT8, y[1] * SC_ACT8, y[2] * SC_ACT8, y[3] * SC_ACT8); } }
    }
}

__device__ __forceinline__ void p0_prologue(const Params& p, LAS unsigned char* lds, int tid, int wid, int lane) {
    LAS CvtJob* jt = (LAS CvtJob*)(lds + 65536);
    LAS int* jtot = (LAS int*)(lds + 65536 + 4096);
    if (tid < NJOBS) { CvtJob jb; make_job(tid, p, jb); jt[tid].src = jb.src; jt[tid].dst = jb.dst; jt[tid].src_ld = jb.src_ld; jt[tid].K = jb.K; jt[tid].ntn = jb.ntn; jt[tid].tile0 = 0; jt[tid].mode = jb.mode; jt[tid].dff = jb.dff; }
    __syncthreads();
    if (tid == 0) { int acc = 0; for (int j = 0; j < NJOBS; ++j) { jt[j].tile0 = acc; acc += (jt[j].K / 128) * jt[j].ntn; } jtot[0] = acc; }
    __syncthreads();
    const int total = jtot[0];
    LAS unsigned* T = (LAS unsigned*)lds;
    const int tq = tid >> 4, nq = tid & 15;
    int j = 0, g = blockIdx.x;
    f32x4 r0, r1, r2, r3; r0 = r1 = r2 = r3 = (f32x4){0.f, 0.f, 0.f, 0.f};
    int c_mode = 2, c_K = 0, c_tn = 0, c_tk = 0, c_dff = 1; bf16_t* c_dst = nullptr;
#define P0_FETCH() do { if (g < total) { while (j + 1 < NJOBS && jt[j + 1].tile0 <= g) ++j; \
        const float* src = (const float*)(__attribute__((address_space(1))) const float*)jt[j].src; const int src_ld = jt[j].src_ld, ntn = jt[j].ntn, local = g - jt[j].tile0; \
        c_mode = jt[j].mode; c_K = jt[j].K; c_dff = jt[j].dff; c_dst = (bf16_t*)(__attribute__((address_space(1))) bf16_t*)jt[j].dst; c_tn = local % ntn; c_tk = local / ntn; \
        if (c_mode != 2 && c_mode != 5) { const bool f8 = c_mode >= 3; const int ra = f8 ? 4 * tq : 2 * tq, rb = ra + 1, rc = f8 ? ra + 2 : ra + 64, rd = rc + 1; \
            const float* sp = src + (size_t)(c_tk * 128) * src_ld + c_tn * 64 + 4 * nq; \
            r0 = __builtin_nontemporal_load((const f32x4*)(sp + (size_t)ra * src_ld)); r1 = __builtin_nontemporal_load((const f32x4*)(sp + (size_t)rb * src_ld)); \
            r2 = __builtin_nontemporal_load((const f32x4*)(sp + (size_t)rc * src_ld)); r3 = __builtin_nontemporal_load((const f32x4*)(sp + (size_t)rd * src_ld)); } } } while (0)
    P0_FETCH();
    while (g < total) {
        const int mode = c_mode, K = c_K, tn = c_tn, tk = c_tk, dff = c_dff; bf16_t* dst = c_dst;
        const f32x4 a0 = r0, a1 = r1, a2 = r2, a3 = r3;
        g += gridDim.x;
        P0_FETCH();
        if (mode == 2) {
#pragma unroll
            for (int it = 0; it < 2; ++it) { const int piece = tid + it * 512, n = piece >> 4, seg = piece & 15;
                *(u32x4*)(dst + (size_t)(tn * 64 + n) * K + tk * 128 + seg * 8) = (u32x4){0u, 0u, 0u, 0u}; }
            continue;
        }
        if (mode == 5) { const int n = tid >> 3, seg = tid & 7; *(u32x4*)((unsigned char*)dst + (size_t)(tn * 64 + n) * K + tk * 128 + seg * 16) = (u32x4){0u, 0u, 0u, 0u}; continue; }
        if (mode >= 3) {
#pragma unroll
            for (int q = 0; q < 4; ++q) T[(4 * nq + q) * 33 + tq] = pg8::pack_fp8x4(a0[q] * SC_W8, a1[q] * SC_W8, a2[q] * SC_W8, a3[q] * SC_W8);
            __syncthreads();
            { const int n = tid >> 3, seg = tid & 7;
              u32x4 w; w.x = T[n * 33 + seg * 4 + 0]; w.y = T[n * 33 + seg * 4 + 1]; w.z = T[n * 33 + seg * 4 + 2]; w.w = T[n * 33 + seg * 4 + 3];
              int drow = tn * 64 + n;
              if (mode == 4) { const int bj = drow / dff, cc = drow - bj * dff; drow = 256 * (cc >> 7) + 128 * bj + (cc & 127); }
              *(u32x4*)((unsigned char*)dst + (size_t)drow * K + tk * 128 + seg * 16) = w; }
            __syncthreads();
            continue;
        }
#pragma unroll
        for (int q = 0; q < 4; ++q) { T[(4 * nq + q) * 65 + tq] = cvt_pk_bf16(a0[q], a1[q]); T[(4 * nq + q) * 65 + tq + 32] = cvt_pk_bf16(a2[q], a3[q]); }
        __syncthreads();
#pragma unroll
        for (int it = 0; it < 2; ++it) { const int piece = tid + it * 512, n = piece >> 4, seg = piece & 15;
            u32x4 w; w.x = T[n * 65 + seg * 4 + 0]; w.y = T[n * 65 + seg * 4 + 1]; w.z = T[n * 65 + seg * 4 + 2]; w.w = T[n * 65 + seg * 4 + 3];
            int drow = tn * 64 + n;
            if (mode == 1) { const int bj = drow / dff, cc = drow - bj * dff; drow = 256 * (cc >> 7) + 128 * bj + (cc & 127); }
            *(u32x4*)(dst + (size_t)drow * K + tk * 128 + seg * 8) = w; }
        __syncthreads();
    }
#undef P0_FETCH
#ifdef PROBE_POISON
    { u32x4* q = (u32x4*)(p.ws + WS_XG); const size_t n1 = (size_t)NEXP * ECAP * DM / 16; for (size_t i = (size_t)blockIdx.x * NTHREADS + tid; i < n1; i += (size_t)gridDim.x * NTHREADS) q[i] = (u32x4){0u, 0u, 0u, 0u};
      q = (u32x4*)(p.ws + WS_ACTM); const size_t n2 = (size_t)NEXP * ECAP * DFFE / 16; for (size_t i = (size_t)blockIdx.x * NTHREADS + tid; i < n2; i += (size_t)gridDim.x * NTHREADS) q[i] = (u32x4){0u, 0u, 0u, 0u}; }
#endif
    { f32x2* rt = (f32x2*)(p.ws + WS_ROPE);
      for (int e = blockIdx.x * NTHREADS + tid; e < SEQ * 32; e += gridDim.x * NTHREADS) { const int pos = e >> 5, i = e & 31;
          const float freq = __builtin_amdgcn_exp2f(-(float)i * (13.287712379549449f / 32.0f));
          const float ang = (float)pos * freq;
          const double rev = (double)ang * 0.15915494309189535; const float fr_ = (float)(rev - __builtin_rint(rev));
          rt[e] = (f32x2){__builtin_amdgcn_cosf(fr_), __builtin_amdgcn_sinf(fr_)}; } }
    norm_rows(p.in[I_MEM], p.in[I_MEM_N], (bf16_t*)(p.ws + WS_MEMN), nullptr, NMEM, wid, lane);
    norm_rows(p.in[I_MEM], p.in[I_MEM_N] + DM, (bf16_t*)(p.ws + WS_MEMN) + (size_t)NMEM * DM, nullptr, NMEM, wid, lane);
    norm_rows(p.in[I_X], p.in[I_NORM_MIX], (bf16_t*)(p.ws + WS_U), p.ws + WS_U8, NTOK, wid, lane);
}

__device__ __forceinline__ void unpack8(const u32x4 w, float (&x)[8]) { x[0] = bflo(w.x); x[1] = bfhi(w.x); x[2] = bflo(w.y); x[3] = bfhi(w.y); x[4] = bflo(w.z); x[5] = bfhi(w.z); x[6] = bflo(w.w); x[7] = bfhi(w.w); }
__device__ __forceinline__ u32x4 pack8(const float (&y)[8]) { u32x4 w; w.x = cvt_pk_bf16(y[0], y[1]); w.y = cvt_pk_bf16(y[2], y[3]); w.z = cvt_pk_bf16(y[4], y[5]); w.w = cvt_pk_bf16(y[6], y[7]); return w; }
__device__ __forceinline__ float sumsq8(const float (&x)[8]) { return (x[0] * x[0] + x[1] * x[1]) + (x[2] * x[2] + x[3] * x[3]) + (x[4] * x[4] + x[5] * x[5]) + (x[6] * x[6] + x[7] * x[7]); }
template <int NL> __device__ __forceinline__ float group_sum(float v) {
#pragma unroll
    for (int o = NL / 2; o >= 1; o >>= 1) v += __shfl_xor(v, o);
    return v;
}
struct Gain8 { f32x4 a, b; };
__device__ __forceinline__ Gain8 ldg8(const float* g) { Gain8 r; r.a = *(const f32x4*)g; r.b = *(const f32x4*)(g + 4); return r; }
__device__ __forceinline__ void scale8(float (&x)[8], float rs, const Gain8& g) { x[0] *= rs * g.a[0]; x[1] *= rs * g.a[1]; x[2] *= rs * g.a[2]; x[3] *= rs * g.a[3]; x[4] *= rs * g.b[0]; x[5] *= rs * g.b[1]; x[6] *= rs * g.b[2]; x[7] *= rs * g.b[3]; }
__device__ __forceinline__ void rope8(float (&y)[8], const f32x4 (&cs)[4], bool upper) {
#pragma unroll
    for (int e = 0; e < 8; ++e) { const float pr = __shfl_xor(y[e], 4); const float c = cs[e >> 1][(e & 1) * 2], s = cs[e >> 1][(e & 1) * 2 + 1]; y[e] = upper ? (y[e] * c + pr * s) : (y[e] * c - pr * s); }
}

__device__ __forceinline__ void prep1(const Params& p, int l, LAS unsigned char* lds, int tid, int wid, int lane) {
    const bf16_t* z = (const bf16_t*)(p.ws + WS_Z);
    bf16_t* naq = (bf16_t*)(p.ws + WS_NAQ); bf16_t* nak = (bf16_t*)(p.ws + WS_NAK); bf16_t* navT = (bf16_t*)(p.ws + WS_NAVT);
    bf16_t* cqn = (bf16_t*)(p.ws + WS_CQN); bf16_t* ckvn = (bf16_t*)(p.ws + WS_CKVN);
    bf16_t* swq = (bf16_t*)(p.ws + WS_SWQ); bf16_t* swk = (bf16_t*)(p.ws + WS_SWK); bf16_t* swvT = (bf16_t*)(p.ws + WS_SWVT); bf16_t* meq = (bf16_t*)(p.ws + WS_MEQ);
    const f32x4* rt4 = (const f32x4*)(p.ws + WS_ROPE);
    const float qs128 = 0.08838834764831845f * LOG2E, qs64 = 0.125f * LOG2E;
    const int l16 = lane & 15, l8 = lane & 7;
    const Gain8 g_naq = ldg8(p.in[I_NA_QN] + l * 128 + 8 * l16), g_nak = ldg8(p.in[I_NA_KN] + l * 128 + 8 * l16), g_meq = ldg8(p.in[I_MEM_QN] + l * 128 + 8 * l16);
    const Gain8 g_cq0 = ldg8(p.in[I_CQ_N] + l * 768 + 8 * lane), g_cq1 = ldg8(p.in[I_CQ_N] + l * 768 + 512 + 8 * (lane & 31)), g_ckv = ldg8(p.in[I_CKV_N] + l * 256 + 8 * (lane & 31));
    const Gain8 g_swq = ldg8(p.in[I_SWA_QN] + l * 64 + 8 * l8), g_swk = ldg8(p.in[I_SWA_KN] + l * 64 + 8 * l8);
    constexpr int VW = 640;
    LAS bf16_t* vt = (LAS bf16_t*)lds;
    const u32x4 zero4 = (u32x4){0u, 0u, 0u, 0u};
    for (int grp = blockIdx.x; grp < NTOK / 32; grp += gridDim.x) {
        const int b = grp >> 6, chunk = grp & 63;
#pragma unroll 2
        for (int ti = 0; ti < 4; ++ti) {
            const int tl = wid * 4 + ti, s = chunk * 32 + tl, token = grp * 32 + tl;
            const bf16_t* zr = z + (size_t)token * ZC;
            const u32x4 w_naq = *(const u32x4*)(zr + Z_NAQ + 8 * lane), w_nak = *(const u32x4*)(zr + Z_NAK + 8 * lane), w_nav = *(const u32x4*)(zr + Z_NAV + 8 * lane), w_meq = *(const u32x4*)(zr + Z_MEQ + 8 * lane);
            const u32x4 w_cq0 = *(const u32x4*)(zr + Z_CQ + 8 * lane); const u32x4 w_cq1 = lane < 32 ? *(const u32x4*)(zr + Z_CQ + 512 + 8 * lane) : zero4;
            const u32x4 w_ckv = lane < 32 ? *(const u32x4*)(zr + Z_CKV + 8 * lane) : zero4;
            const u32x4 w_swq = *(const u32x4*)(zr + Z_SWQ + 8 * lane);
            const u32x4 w_swkv = lane < 32 ? *(const u32x4*)(zr + (lane < 16 ? Z_SWK + 8 * lane : Z_SWV + 8 * (lane - 16))) : zero4;
            f32x4 cs[4];
#pragma unroll
            for (int q = 0; q < 4; ++q) cs[q] = rt4[(s * 32 + (lane & 3) * 8) / 2 + q];
            *(LAS u32x4*)(vt + tl * VW + 8 * lane) = w_nav;
            if (lane >= 16 && lane < 32) *(LAS u32x4*)(vt + tl * VW + 512 + 8 * (lane - 16)) = w_swkv;
            float x[8];
            { unpack8(w_naq, x); const float ss = group_sum<16>(sumsq8(x)); scale8(x, 1.0f / sqrtf(ss * (1.0f / 128) + EPS) * qs128, g_naq);
              *(u32x4*)(naq + ((size_t)(b * 4 + (lane >> 4)) * SEQ + s) * 128 + 8 * l16) = pack8(x); }
            { unpack8(w_nak, x); const float ss = group_sum<16>(sumsq8(x)); scale8(x, 1.0f / sqrtf(ss * (1.0f / 128) + EPS), g_nak);
              *(u32x4*)(nak + ((size_t)(b * 4 + (lane >> 4)) * SEQ + s) * 128 + 8 * l16) = pack8(x); }
            { unpack8(w_meq, x); const float ss = group_sum<16>(sumsq8(x)); scale8(x, 1.0f / sqrtf(ss * (1.0f / 128) + EPS) * qs128, g_meq);
              *(u32x4*)(meq + ((size_t)(b * 4 + (lane >> 4)) * SEQ + s) * 128 + 8 * l16) = pack8(x); }
            { float y[8]; unpack8(w_cq0, x); unpack8(w_cq1, y); const float ss = group_sum<64>(sumsq8(x) + sumsq8(y)); const float rs = 1.0f / sqrtf(ss * (1.0f / 768) + EPS);
              scale8(x, rs, g_cq0); scale8(y, rs, g_cq1);
              *(u32x4*)(cqn + (size_t)token * 768 + 8 * lane) = pack8(x); if (lane < 32) *(u32x4*)(cqn + (size_t)token * 768 + 512 + 8 * lane) = pack8(y); }
            { unpack8(w_ckv, x); const float ss = group_sum<64>(sumsq8(x)); scale8(x, 1.0f / sqrtf(ss * (1.0f / 256) + EPS), g_ckv);
              if (lane < 32) *(u32x4*)(ckvn + (size_t)token * 256 + 8 * lane) = pack8(x); }
            { unpack8(w_swq, x); const float ss = group_sum<8>(sumsq8(x)); scale8(x, 1.0f / sqrtf(ss * (1.0f / 64) + EPS), g_swq); rope8(x, cs, (lane & 4) != 0);
#pragma unroll
              for (int e = 0; e < 8; ++e) x[e] *= qs64;
              *(u32x4*)(swq + ((size_t)(b * 8 + (lane >> 3)) * SEQ + s) * 64 + 8 * l8) = pack8(x); }
            { unpack8(w_swkv, x); const float ss = group_sum<8>(sumsq8(x)); scale8(x, 1.0f / sqrtf(ss * (1.0f / 64) + EPS), g_swk); rope8(x, cs, (lane & 4) != 0);
              if (lane < 16) *(u32x4*)(swk + ((size_t)(b * 2 + (lane >> 3)) * SEQ + s) * 64 + 8 * l8) = pack8(x); }
        }
        __syncthreads();
#pragma unroll 1
        for (int it = 0; it < 5; ++it) { const int item = tid + it * 512, part = item / VW, c = item - part * VW;
            unsigned short e[8];
#pragma unroll
            for (int q = 0; q < 8; ++q) e[q] = vt[(part * 8 + q) * VW + c];
            u32x4 w; w.x = e[0] | ((unsigned)e[1] << 16); w.y = e[2] | ((unsigned)e[3] << 16); w.z = e[4] | ((unsigned)e[5] << 16); w.w = e[6] | ((unsigned)e[7] << 16);
            bf16_t* dp = (c < 512) ? navT + ((((size_t)(b * 4 + (c >> 7)) * 64 + chunk) * 128 + (c & 127)) * 32 + part * 8)
                                   : swvT + ((((size_t)(b * 2 + ((c - 512) >> 6)) * 64 + chunk) * 64 + ((c - 512) & 63)) * 32 + part * 8);
            *(u32x4*)dp = w; }
        __syncthreads();
    }
}

__device__ __forceinline__ void prep2(const Params& p, int l, LAS unsigned char* lds, int tid, int wid, int lane) {
    const bf16_t* z = (const bf16_t*)(p.ws + WS_Z); const bf16_t* qraw = (const bf16_t*)(p.ws + WS_QRAW); const bf16_t* kvraw = (const bf16_t*)(p.ws + WS_KVRAW);
    const bf16_t* memkv = (const bf16_t*)(p.ws + WS_MEMKV) + (size_t)l * NMEM * 1024;
    bf16_t* mlq = (bf16_t*)(p.ws + WS_MLQ); bf16_t* mlk = (bf16_t*)(p.ws + WS_MLK); bf16_t* mlvT = (bf16_t*)(p.ws + WS_MLVT);
    bf16_t* mek = (bf16_t*)(p.ws + WS_MEK); bf16_t* mevT = (bf16_t*)(p.ws + WS_MEVT);
    const f32x4* rt4 = (const f32x4*)(p.ws + WS_ROPE);
    const float qs192 = 0.07216878364870322f * LOG2E;
    const int l16 = lane & 15, l24 = lane < 24 ? lane : 0;
    const Gain8 g_q = ldg8(p.in[I_MLA_QN] + l * 192 + 8 * l24), g_k = ldg8(p.in[I_MLA_KN] + l * 192 + 8 * l24), g_mk = ldg8(p.in[I_MEM_KN] + l * 128 + 8 * l16);
    constexpr int VW = 512;
    LAS bf16_t* vt = (LAS bf16_t*)lds;
    const u32x4 zero4 = (u32x4){0u, 0u, 0u, 0u};
    for (int grp = blockIdx.x; grp < NTOK / 32 + NMEM / 32; grp += gridDim.x) {
        const bool ismem = grp >= NTOK / 32;
        if (!ismem) {
            const int b = grp >> 6, chunk = grp & 63;
#pragma unroll 2
            for (int ti = 0; ti < 4; ++ti) {
                const int tl = wid * 4 + ti, s = chunk * 32 + tl, token = grp * 32 + tl;
                u32x4 wq[4], wk[4];
#pragma unroll
                for (int h = 0; h < 4; ++h) { wq[h] = lane < 24 ? *(const u32x4*)(qraw + (size_t)token * 768 + h * 192 + 8 * lane) : zero4;
                    wk[h] = lane < 16 ? *(const u32x4*)(kvraw + (size_t)token * 1024 + h * 256 + 8 * lane) : (lane < 24 ? *(const u32x4*)(z + (size_t)token * ZC + Z_KPE + 8 * (lane - 16)) : zero4); }
                const u32x4 wv = *(const u32x4*)(kvraw + (size_t)token * 1024 + (lane >> 4) * 256 + 128 + 8 * l16);
                f32x4 cs[4];
#pragma unroll
                for (int q = 0; q < 4; ++q) cs[q] = rt4[(s * 32 + (lane & 3) * 8) / 2 + q];
                *(LAS u32x4*)(vt + tl * VW + (lane >> 4) * 128 + 8 * l16) = wv;
                const bool ropel = lane >= 16 && lane < 24;
#pragma unroll
                for (int h = 0; h < 4; ++h) {
                    float x[8];
                    { unpack8(wq[h], x); const float ss = group_sum<64>(sumsq8(x)); scale8(x, 1.0f / sqrtf(ss * (1.0f / 192) + EPS), g_q);
                      float y[8];
#pragma unroll
                      for (int e = 0; e < 8; ++e) y[e] = x[e];
                      rope8(y, cs, (lane & 4) != 0);
#pragma unroll
                      for (int e = 0; e < 8; ++e) x[e] = (ropel ? y[e] : x[e]) * qs192;
                      if (lane < 24) *(u32x4*)(mlq + ((size_t)(b * 4 + h) * SEQ + s) * 192 + 8 * lane) = pack8(x); }
                    { unpack8(wk[h], x); const float ss = group_sum<64>(sumsq8(x)); scale8(x, 1.0f / sqrtf(ss * (1.0f / 192) + EPS), g_k);
                      float y[8];
#pragma unroll
                      for (int e = 0; e < 8; ++e) y[e] = x[e];
                      rope8(y, cs, (lane & 4) != 0);
#pragma unroll
                      for (int e = 0; e < 8; ++e) x[e] = ropel ? y[e] : x[e];
                      if (lane < 24) *(u32x4*)(mlk + ((size_t)(b * 4 + h) * SEQ + s) * 192 + 8 * lane) = pack8(x); }
                }
            }
            __syncthreads();
#pragma unroll 1
            for (int it = 0; it < 4; ++it) { const int item = tid + it * 512, part = item >> 9, c = item & 511;
                unsigned short e[8];
#pragma unroll
                for (int q = 0; q < 8; ++q) e[q] = vt[(part * 8 + q) * VW + c];
                u32x4 w; w.x = e[0] | ((unsigned)e[1] << 16); w.y = e[2] | ((unsigned)e[3] << 16); w.z = e[4] | ((unsigned)e[5] << 16); w.w = e[6] | ((unsigned)e[7] << 16);
                *(u32x4*)(mlvT + ((((size_t)(b * 4 + (c >> 7)) * 64 + chunk) * 128 + (c & 127)) * 32 + part * 8)) = w; }
            __syncthreads();
        } else {
            const int mg = grp - NTOK / 32, b = mg >> 3, chunk = mg & 7;
#pragma unroll 2
            for (int ti = 0; ti < 4; ++ti) {
                const int tl = wid * 4 + ti, m = chunk * 32 + tl, mt = mg * 32 + tl;
                const bf16_t* mr = memkv + (size_t)mt * 1024;
                const u32x4 wkk = *(const u32x4*)(mr + 8 * lane), wv = *(const u32x4*)(mr + 512 + 8 * lane);
                *(LAS u32x4*)(vt + tl * VW + 8 * lane) = wv;
                float x[8]; unpack8(wkk, x); const float ss = group_sum<16>(sumsq8(x)); scale8(x, 1.0f / sqrtf(ss * (1.0f / 128) + EPS), g_mk);
                *(u32x4*)(mek + ((size_t)(b * 4 + (lane >> 4)) * MEML + m) * 128 + 8 * l16) = pack8(x);
            }
            __syncthreads();
#pragma unroll 1
            for (int it = 0; it < 4; ++it) { const int item = tid + it * 512, part = item >> 9, c = item & 511;
                unsigned short e[8];
#pragma unroll
                for (int q = 0; q < 8; ++q) e[q] = vt[(part * 8 + q) * VW + c];
                u32x4 w; w.x = e[0] | ((unsigned)e[1] << 16); w.y = e[2] | ((unsigned)e[3] << 16); w.z = e[4] | ((unsigned)e[5] << 16); w.w = e[6] | ((unsigned)e[7] << 16);
                *(u32x4*)(mevT + ((((size_t)(b * 4 + (c >> 7)) * 8 + chunk) * 128 + (c & 127)) * 32 + part * 8)) = w; }
            __syncthreads();
        }
    }
}
constexpr int ATT_RPB_OFF = 98304;
template <int DQ, int DV, int MODE>
__device__ __forceinline__ void attn_unit(LAS unsigned char* lds, const bf16_t* qp, const bf16_t* kp, const bf16_t* vp, bf16_t* op,
                                          int nchunks, int c_lo, int c_hi, int mq0, int mk0, int mr, float sink2, int tid, int lane) {
    constexpr int KROW = DQ * 2 + 16, KBUF = 32 * KROW, VROW = 80, VBUF = DV * VROW, NDC = DQ / 32, NDV = DV / 16;
    constexpr int KPIECES = 32 * DQ / 8, VPIECES = DV * 4, DQ8 = DQ / 8;
    const int fr = lane & 15, fq = lane >> 4;
    bf16x8 qf[2][NDC];
#pragma unroll
    for (int qt = 0; qt < 2; ++qt)
#pragma unroll
        for (int dc = 0; dc < NDC; ++dc) qf[qt][dc] = *(const bf16x8*)(qp + (size_t)(qt * 16 + fr) * DQ + dc * 32 + fq * 8);
    f32x4 o[2][NDV];
#pragma unroll
    for (int qt = 0; qt < 2; ++qt)
#pragma unroll
        for (int d = 0; d < NDV; ++d) o[qt][d] = (f32x4){0.f, 0.f, 0.f, 0.f};
    float mrun[2] = {-1e30f, -1e30f}, lrun[2] = {0.f, 0.f};
    const int pk0 = tid, pk1 = tid + 512;
    const bool hk0 = pk0 < KPIECES, hk1 = pk1 < KPIECES, hv = tid < VPIECES;
    int kd0, kd1;
    { const int key = pk0 / DQ8, dp = pk0 - key * DQ8; kd0 = (16 * ((key >> 2) & 1) + 4 * (key >> 3) + (key & 3)) * KROW + dp * 16; }
    { const int key = pk1 / DQ8, dp = pk1 - key * DQ8; kd1 = (16 * ((key >> 2) & 1) + 4 * (key >> 3) + (key & 3)) * KROW + dp * 16; }
    const int vd = (tid >> 2) * VROW + (tid & 3) * 16;
    u32x4 rk0 = (u32x4){0u, 0u, 0u, 0u}, rk1 = rk0, rv = rk0;
    if (hk0) rk0 = *(const u32x4*)(kp + pk0 * 8);
    if (hk1) rk1 = *(const u32x4*)(kp + pk1 * 8);
    if (hv) rv = *(const u32x4*)(vp + tid * 8);
    if (hk0) *(LAS u32x4*)(lds + kd0) = rk0;
    if (hk1) *(LAS u32x4*)(lds + kd1) = rk1;
    if (hv) *(LAS u32x4*)(lds + 2 * KBUF + vd) = rv;
    __syncthreads();
#pragma unroll 1
    for (int c = 0; c < nchunks; ++c) {
        const int cur = c & 1; const bool more = (c + 1 < nchunks);
        if (more) { const bf16_t* kn = kp + (size_t)(c + 1) * 32 * DQ; const bf16_t* vn = vp + (size_t)(c + 1) * DV * 32;
            if (hk0) rk0 = *(const u32x4*)(kn + pk0 * 8);
            if (hk1) rk1 = *(const u32x4*)(kn + pk1 * 8);
            if (hv) rv = *(const u32x4*)(vn + tid * 8); }
        if (c >= c_lo && c < c_hi) {
            const LAS unsigned char* kb = lds + cur * KBUF; const LAS unsigned char* vb = lds + 2 * KBUF + cur * VBUF;
            f32x4 s[2][2];
#pragma unroll
            for (int qt = 0; qt < 2; ++qt) { s[qt][0] = (f32x4){0.f, 0.f, 0.f, 0.f}; s[qt][1] = (f32x4){0.f, 0.f, 0.f, 0.f}; }
#pragma unroll
            for (int dc = 0; dc < NDC; ++dc) {
                const bf16x8 k0 = *(const LAS bf16x8*)(kb + fr * KROW + (dc * 32 + fq * 8) * 2);
                const bf16x8 k1 = *(const LAS bf16x8*)(kb + (16 + fr) * KROW + (dc * 32 + fq * 8) * 2);
#pragma unroll
                for (int qt = 0; qt < 2; ++qt) { s[qt][0] = __builtin_amdgcn_mfma_f32_16x16x32_bf16(k0, qf[qt][dc], s[qt][0], 0, 0, 0);
                                                 s[qt][1] = __builtin_amdgcn_mfma_f32_16x16x32_bf16(k1, qf[qt][dc], s[qt][1], 0, 0, 0); }
            }
            bf16x8 pf[2];
#pragma unroll
            for (int qt = 0; qt < 2; ++qt) {
                if (MODE == 1) {
                    const int qpos = mq0 + qt * 16 + fr, kbase = mk0 + c * 32 + 8 * fq;
#pragma unroll
                    for (int b = 0; b < 2; ++b)
#pragma unroll
                        for (int i = 0; i < 4; ++i) { const int dd = qpos - (kbase + 4 * b + i); if (dd > 128 || dd < -128) s[qt][b][i] = -1e30f; }
                } else if (MODE == 2) {
                    const LAS float* rpb = (const LAS float*)(lds + ATT_RPB_OFF);
                    const int qc = mq0 + qt * 16 + fr, kr = mk0 + (c >> 1), kcb = (c & 1) * 32 + 8 * fq;
                    int cs = qc - 8; cs = cs < 0 ? 0 : (cs > 48 ? 48 : cs);
                    const int rowoff = (kr - mr + 7) * 31;
#pragma unroll
                    for (int b = 0; b < 2; ++b)
#pragma unroll
                        for (int i = 0; i < 4; ++i) { const int kc = kcb + 4 * b + i; const bool ok = (kc >= cs) && (kc <= cs + 15);
                            int bi = kc - qc + 15; bi = bi < 0 ? 0 : (bi > 30 ? 30 : bi);
                            const float bias = rpb[rowoff + bi];
                            s[qt][b][i] = ok ? s[qt][b][i] + bias : -1e30f; }
                }
                float mx = fmaxf(fmaxf(fmaxf(s[qt][0][0], s[qt][0][1]), fmaxf(s[qt][0][2], s[qt][0][3])), fmaxf(fmaxf(s[qt][1][0], s[qt][1][1]), fmaxf(s[qt][1][2], s[qt][1][3])));
                mx = fmaxf(mx, __shfl_xor(mx, 16)); mx = fmaxf(mx, __shfl_xor(mx, 32));
                const float mnew = fmaxf(mrun[qt], mx), alpha = __builtin_amdgcn_exp2f(mrun[qt] - mnew); mrun[qt] = mnew;
                float ps = 0.f;
#pragma unroll
                for (int b = 0; b < 2; ++b)
#pragma unroll
                    for (int i = 0; i < 4; ++i) { const float e = __builtin_amdgcn_exp2f(s[qt][b][i] - mnew); s[qt][b][i] = e; ps += e; }
                lrun[qt] = lrun[qt] * alpha + ps;
#pragma unroll
                for (int d = 0; d < NDV; ++d) o[qt][d] *= alpha;
                u32x4 w; w.x = cvt_pk_bf16(s[qt][0][0], s[qt][0][1]); w.y = cvt_pk_bf16(s[qt][0][2], s[qt][0][3]); w.z = cvt_pk_bf16(s[qt][1][0], s[qt][1][1]); w.w = cvt_pk_bf16(s[qt][1][2], s[qt][1][3]);
                pf[qt] = __builtin_bit_cast(bf16x8, w);
            }
#pragma unroll
            for (int d = 0; d < NDV; ++d) {
                const bf16x8 vf = *(const LAS bf16x8*)(vb + (d * 16 + fr) * VROW + fq * 16);
                o[0][d] = __builtin_amdgcn_mfma_f32_16x16x32_bf16(vf, pf[0], o[0][d], 0, 0, 0);
                o[1][d] = __builtin_amdgcn_mfma_f32_16x16x32_bf16(vf, pf[1], o[1][d], 0, 0, 0);
            }
        }
        if (more) { const int nb = cur ^ 1;
            if (hk0) *(LAS u32x4*)(lds + nb * KBUF + kd0) = rk0;
            if (hk1) *(LAS u32x4*)(lds + nb * KBUF + kd1) = rk1;
            if (hv) *(LAS u32x4*)(lds + 2 * KBUF + nb * VBUF + vd) = rv; }
        __syncthreads();
    }
#pragma unroll
    for (int qt = 0; qt < 2; ++qt) {
        float l = lrun[qt]; l += __shfl_xor(l, 16); l += __shfl_xor(l, 32);
        if (MODE == 1) l += __builtin_amdgcn_exp2f(sink2 - mrun[qt]);
        const float inv = 1.0f / l;
        bf16_t* orow = op + (size_t)(qt * 16 + fr) * DM + 4 * fq;
#pragma unroll
        for (int d = 0; d < NDV; ++d) { u32x2 w; w.x = cvt_pk_bf16(o[qt][d][0] * inv, o[qt][d][1] * inv); w.y = cvt_pk_bf16(o[qt][d][2] * inv, o[qt][d][3] * inv); *(u32x2*)(orow + d * 16) = w; }
    }
}

__device__ __forceinline__ void attn_phase(const Params& p, int lq, LAS unsigned char* lds, int tid, int wid, int lane) {
    const int l = lq & 1;
    unsigned* head = (unsigned*)(p.ws + WS_CTL) + CW_ATTQ + lq * 64;
    volatile LAS int* qw = (volatile LAS int*)(lds + LDS_MISC + 64);
    bf16_t* br = (bf16_t*)(p.ws + (lq >= 2 ? WS_ACT : WS_BR));
    for (;;) {
        if (tid == 0) qw[0] = (int)__hip_atomic_fetch_add(head, 1u, __ATOMIC_RELAXED, __HIP_MEMORY_SCOPE_AGENT);
        __syncthreads();
        const int id = __builtin_amdgcn_readfirstlane(qw[0]);
        __syncthreads();
        if (id >= 640) break;
        if (id < 128) {
            const int b = id >> 5, h = (id >> 3) & 3, qt8 = id & 7; const size_t bh = (size_t)(b * 4 + h);
            const bf16_t* q = (const bf16_t*)(p.ws + WS_MLQ) + (bh * SEQ + qt8 * 256 + wid * 32) * 192;
            const bf16_t* k = (const bf16_t*)(p.ws + WS_MLK) + bh * SEQ * 192; const bf16_t* v = (const bf16_t*)(p.ws + WS_MLVT) + bh * SEQ * 128;
            bf16_t* o = br + (size_t)(b * SEQ + qt8 * 256 + wid * 32) * DM + 512 + h * 128;
            attn_unit<192, 128, 0>(lds, q, k, v, o, 64, 0, 64, 0, 0, 0, 0.f, tid, lane);
        } else if (id < 256) {
            const int u = id - 128, b = u >> 5, h = (u >> 3) & 3, r4 = u & 7; const size_t bh = (size_t)(b * 4 + h);
            const int r = r4 * 4 + (wid >> 1), half = wid & 1;
            int kr_lo = r4 * 4 - 4; kr_lo = kr_lo < 0 ? 0 : (kr_lo > 24 ? 24 : kr_lo);
            int kr_hi = r4 * 4 + 3 - 4; kr_hi = (kr_hi < 0 ? 0 : (kr_hi > 24 ? 24 : kr_hi)) + 7;
            int rs = r - 4; rs = rs < 0 ? 0 : (rs > 24 ? 24 : rs);
            { const float* rp = p.in[I_NA_RPB] + ((size_t)l * 4 + h) * 15 * 31; LAS float* rl = (LAS float*)(lds + ATT_RPB_OFF); if (tid < 465) rl[tid] = rp[tid] * LOG2E; }
            const bf16_t* q = (const bf16_t*)(p.ws + WS_NAQ) + (bh * SEQ + r * 64 + half * 32) * 128;
            const bf16_t* k = (const bf16_t*)(p.ws + WS_NAK) + (bh * SEQ + kr_lo * 64) * 128; const bf16_t* v = (const bf16_t*)(p.ws + WS_NAVT) + (bh * 64 + kr_lo * 2) * 128 * 32;
            bf16_t* o = br + (size_t)(b * SEQ + r * 64 + half * 32) * DM + 0 + h * 128;
            attn_unit<128, 128, 2>(lds, q, k, v, o, 2 * (kr_hi - kr_lo + 1), 2 * (rs - kr_lo), 2 * (rs - kr_lo) + 16, half * 32, kr_lo, r, 0.f, tid, lane);
        } else if (id < 512) {
            const int u = id - 256, b = u >> 6, kvh = (u >> 5) & 1, qb = u & 31, q0 = qb * 64; const int hq = kvh * 4 + (wid >> 1), qpos0 = q0 + (wid & 1) * 32;
            const int kstart = q0 - 128 < 0 ? 0 : q0 - 128, kend = q0 + 192 > SEQ ? SEQ : q0 + 192, nch = (kend - kstart) >> 5;
            int c_lo = (qpos0 - 128 - kstart) >> 5; c_lo = c_lo < 0 ? 0 : c_lo; int c_hi = ((qpos0 + 159 - kstart) >> 5) + 1; c_hi = c_hi > nch ? nch : c_hi;
            const bf16_t* q = (const bf16_t*)(p.ws + WS_SWQ) + ((size_t)(b * 8 + hq) * SEQ + qpos0) * 64;
            const bf16_t* k = (const bf16_t*)(p.ws + WS_SWK) + ((size_t)(b * 2 + kvh) * SEQ + kstart) * 64; const bf16_t* v = (const bf16_t*)(p.ws + WS_SWVT) + ((size_t)(b * 2 + kvh) * 64 + (kstart >> 5)) * 64 * 32;
            bf16_t* o = br + (size_t)(b * SEQ + qpos0) * DM + 1024 + hq * 64;
            attn_unit<64, 64, 1>(lds, q, k, v, o, nch, c_lo, c_hi, qpos0, kstart, 0, p.in[I_SWA_SINK][l * 8 + hq] * LOG2E, tid, lane);
        } else {
            const int u = id - 512, b = u >> 5, h = (u >> 3) & 3, qt8 = u & 7; const size_t bh = (size_t)(b * 4 + h);
            const bf16_t* q = (const bf16_t*)(p.ws + WS_MEQ) + (bh * SEQ + qt8 * 256 + wid * 32) * 128;
            const bf16_t* k = (const bf16_t*)(p.ws + WS_MEK) + bh * MEML * 128; const bf16_t* v = (const bf16_t*)(p.ws + WS_MEVT) + bh * MEML * 128;
            bf16_t* o = br + (size_t)(b * SEQ + qt8 * 256 + wid * 32) * DM + 1536 + h * 128;
            attn_unit<128, 128, 0>(lds, q, k, v, o, 8, 0, 8, 0, 0, 0, 0.f, tid, lane);
        }
    }
}

__device__ __forceinline__ void router_phase(const Params& p, LAS unsigned char* lds, int tid, int wid, int lane) {
    const float* hres = p.out; const float* g = p.in[I_NORM_FFN] + DM; const float* wr = p.in[I_ROUTER];
    unsigned* cnt = (unsigned*)(p.ws + WS_CTL) + CW_MOECNT;
    unsigned char* xg = p.ws + WS_XG; int* tokv = (int*)(p.ws + WS_TOK); float* wtv = (float*)(p.ws + WS_WT);
    LAS float* wl = (LAS float*)lds;
    LAS float* sel = (LAS float*)(lds + 65536);
    for (int i = tid; i < DM * NEXP; i += NTHREADS) { const int d = i >> 3, e = i & 7; wl[e * DM + d] = wr[i]; }
    __syncthreads();
    for (int grp = blockIdx.x; grp < NTOK / 32; grp += gridDim.x) {
#pragma unroll 1
        for (int ti = 0; ti < 4; ++ti) {
            const int tl = wid * 4 + ti, token = grp * 32 + tl;
            const f32x4* sp = (const f32x4*)(hres + (size_t)token * DM); f32x4 v[8]; float ss = 0.f;
#pragma unroll
            for (int j = 0; j < 8; ++j) { v[j] = sp[lane + 64 * j]; ss += v[j][0] * v[j][0] + v[j][1] * v[j][1] + v[j][2] * v[j][2] + v[j][3] * v[j][3]; }
            ss = wave_sum(ss); const float rstd = 1.0f / sqrtf(ss * (1.0f / DM) + EPS);
            float lg[8];
#pragma unroll
            for (int e = 0; e < 8; ++e) lg[e] = 0.f;
#pragma unroll
            for (int j = 0; j < 8; ++j) { const f32x4 gv = ((const f32x4*)g)[lane + 64 * j]; const f32x4 hn = v[j] * rstd * gv;
#pragma unroll
                for (int e = 0; e < 8; ++e) { const f32x4 w4 = *(const LAS f32x4*)(wl + e * DM + 4 * (lane + 64 * j)); lg[e] += hn[0] * w4[0] + hn[1] * w4[1] + hn[2] * w4[2] + hn[3] * w4[3]; } }
#pragma unroll
            for (int e = 0; e < 8; ++e) lg[e] = wave_sum(lg[e]);
            int i0 = 0; float v0 = lg[0];
#pragma unroll
            for (int e = 1; e < 8; ++e) if (lg[e] > v0) { v0 = lg[e]; i0 = e; }
            int i1 = -1; float v1 = -3.0e38f;
#pragma unroll
            for (int e = 0; e < 8; ++e) if (e != i0 && lg[e] > v1) { v1 = lg[e]; i1 = e; }
            const float e1 = __expf(v1 - v0), w0 = 1.0f / (1.0f + e1), w1 = e1 * w0;
            if (lane == 0) { sel[tl * 8 + 0] = __int_as_float(i0); sel[tl * 8 + 1] = __int_as_float(i1); sel[tl * 8 + 2] = w0; sel[tl * 8 + 3] = w1; sel[tl * 8 + 4] = rstd; }
        }
        __syncthreads();
        if (tid < NEXP) { int n = 0;
            for (int t = 0; t < 32; ++t) { n += (__float_as_int(sel[t * 8 + 0]) == tid) ? 1 : 0; n += (__float_as_int(sel[t * 8 + 1]) == tid) ? 1 : 0; }
            int base = n ? (int)__hip_atomic_fetch_add(cnt + tid * 64, (unsigned)n, __ATOMIC_RELAXED, __HIP_MEMORY_SCOPE_AGENT) : 0;
            for (int t = 0; t < 32; ++t) { if (__float_as_int(sel[t * 8 + 0]) == tid) sel[t * 8 + 5] = __int_as_float(base++); if (__float_as_int(sel[t * 8 + 1]) == tid) sel[t * 8 + 6] = __int_as_float(base++); } }
        __syncthreads();
#pragma unroll 1
        for (int ti = 0; ti < 4; ++ti) {
            const int tl = wid * 4 + ti, token = grp * 32 + tl;
            const int e0 = __float_as_int(sel[tl * 8 + 0]), e1 = __float_as_int(sel[tl * 8 + 1]); const float w0 = sel[tl * 8 + 2], w1 = sel[tl * 8 + 3], rstd = sel[tl * 8 + 4];
            const int s0 = e0 * ECAP + __float_as_int(sel[tl * 8 + 5]), s1 = e1 * ECAP + __float_as_int(sel[tl * 8 + 6]);
            const f32x4* sp = (const f32x4*)(hres + (size_t)token * DM);
#pragma unroll
            for (int j = 0; j < 8; ++j) { const f32x4 x = sp[lane + 64 * j]; const f32x4 gv = ((const f32x4*)g)[lane + 64 * j];
#if MOE_FP8
                const float rg = rstd * SC_ACT8; const unsigned w = pg8::pack_fp8x4(x[0] * rg * gv[0], x[1] * rg * gv[1], x[2] * rg * gv[2], x[3] * rg * gv[3]);
                *(unsigned*)(xg + (size_t)s0 * DM + 4 * (lane + 64 * j)) = w; *(unsigned*)(xg + (size_t)s1 * DM + 4 * (lane + 64 * j)) = w; }
#else
                u32x2 w; w.x = cvt_pk_bf16(x[0] * rstd * gv[0], x[1] * rstd * gv[1]); w.y = cvt_pk_bf16(x[2] * rstd * gv[2], x[3] * rstd * gv[3]);
                *(u32x2*)(xg + ((size_t)s0 * DM + 4 * (lane + 64 * j)) * 2) = w; *(u32x2*)(xg + ((size_t)s1 * DM + 4 * (lane + 64 * j)) * 2) = w; }
#endif
            if (lane == 0) { tokv[s0] = token; wtv[s0] = w0; tokv[s1] = token; wtv[s1] = w1; }
        }
        __syncthreads();
    }
}

constexpr int MOE_TAB_OFF = LDS_MISC + 128;
__device__ __forceinline__ void moe_table(LAS unsigned char* lds, const unsigned* cnt, int nN, int tid) {
    LAS int* tab = (LAS int*)(lds + MOE_TAB_OFF);
    __syncthreads();
    if (tid == 0) { int acc = 0; for (int e = 0; e < 8; ++e) { const int n = ((int)cnt[e * 64] + 255) >> 8; tab[e] = n; tab[8 + e] = acc; acc += n * nN; } tab[16] = acc; }
    __syncthreads();
}
struct SchedMoe {
    const char* A; const char* B; size_t a_estride, b_estride, a_tstride, b_tstride; const LAS int* tab; int G, c;
    __device__ __forceinline__ bool next(int i, pg8::Unit& u) const {
        const int L = i * G + c; if (L >= tab[16]) return false;
        int e = 0;
#pragma unroll
        for (int k = 1; k < 8; ++k) e = (L >= tab[8 + k]) ? k : e;
        const int ne = tab[e], loc = L - tab[8 + e], pm = loc % ne, pn = loc / ne;
        u.A = A + (size_t)e * a_estride + (size_t)pm * a_tstride; u.B = B + (size_t)e * b_estride + (size_t)pn * b_tstride;
        u.orow = e * ECAP + pm * 256; u.ocol = pn; u.x0 = e; u.x1 = pm * 256; return true;
    }
};
struct SchedMerge {
    const char* br; const char* wb; int G, c;
    __device__ __forceinline__ bool next(int i, pg8::Unit& u) const {
        int pm, pn; if (!pg8::static_tile(i >> 2, G, c, NTOK / 256, DM / 256, pm, pn)) return false;
        const int n = i & 3;
        u.A = br + ((size_t)pm * 256 * DM + n * 512) * 2; u.B = wb + ((size_t)n * DM * 512 + (size_t)pn * 256 * 512) * 2; u.orow = pm * 256; u.ocol = pn; u.x0 = n; u.x1 = 0; return true;
    }
};
constexpr int NPHASE = 23;
constexpr int LDS_PARAMS = LDS_MISC + 256;
template <class T> __device__ __forceinline__ T* uni(T* q) { const unsigned long long v = (unsigned long long)q; const unsigned lo = __builtin_amdgcn_readfirstlane((unsigned)v), hi = __builtin_amdgcn_readfirstlane((unsigned)(v >> 32)); return (T*)(__attribute__((address_space(1))) T*)(((unsigned long long)hi << 32) | lo); }
__device__ __forceinline__ Params load_params(LAS unsigned char* lds) {
    unsigned poff = LDS_PARAMS; asm volatile("" : "+v"(poff)); poff = __builtin_amdgcn_readfirstlane(poff);
    const LAS Params* P = (const LAS Params*)(lds + poff); Params p;
#pragma unroll
    for (int i = 0; i < 30; ++i) p.in[i] = uni(P->in[i]);
    p.out = uni(P->out); p.ws = uni(P->ws); p.ph_lo = __builtin_amdgcn_readfirstlane(P->ph_lo); p.ph_hi = __builtin_amdgcn_readfirstlane(P->ph_hi); return p;
}
#define PH_HEAD int tid = threadIdx.x; asm volatile("" : "+v"(tid)); const Params p = load_params(lds); const int lane = tid & 63, wid = __builtin_amdgcn_readfirstlane(tid >> 6); const int G = p.ph_lo, cblk = p.ph_hi;     \
    unsigned char* ws = p.ws; unsigned* ctl = (unsigned*)(ws + WS_CTL); unsigned char* lw = ws + WS_LW + (size_t)l * LW_BYTES; bf16_t* U = (bf16_t*)(ws + WS_U); (void)lane; (void)wid; (void)G; (void)cblk; (void)ctl; (void)lw; (void)U
#define PHASE_FN static __device__ __forceinline__ void

PHASE_FN ph_prologue(LAS unsigned char* lds, int l) { PH_HEAD; p0_prologue(p, lds, tid, wid, lane); }
PHASE_FN ph_ingate(LAS unsigned char* lds, int l) { PH_HEAD;
#if INGATE_FP8
    pg8::SchedGrid S{(const char*)(ws + WS_U8), (const char*)(lw + LW_IN), DM / 2, DM / 2, NTOK / 256, 12288 / 256, G, cblk};
    pg8::EpiInGate E{(bf16_t*)(ws + WS_Z), (bf16_t*)(ws + WS_GATES), p.in[I_B_GATE] + (size_t)l * 8192, 1.0f / (SC_ACT8 * SC_W8)};
    pg8::gemm_phase<pg8::EpiInGate, pg8::SchedGrid, true>(lds, DM / 2, DM / 2, DM / 2, S, E, tid);
#else
    pg8::SchedGrid S{(const char*)U, (const char*)(lw + LW_IN), DM, DM, NTOK / 256, 12288 / 256, G, cblk};
    pg8::EpiInGate E{(bf16_t*)(ws + WS_Z), (bf16_t*)(ws + WS_GATES), p.in[I_B_GATE] + (size_t)l * 8192, 1.0f};
    pg8::gemm_phase(lds, DM, DM, DM, S, E, tid);
#endif
}
PHASE_FN ph_inproj(LAS unsigned char* lds, int l) { PH_HEAD;
    const bool sh = l >= 2; l &= 1; lw = ws + WS_LW + (size_t)l * LW_BYTES;
    pg8::SchedGrid S{(const char*)U, (const char*)(lw + LW_IN), DM, DM, NTOK / 256, ZC / 256, G, cblk};
    pg8::EpiBf16 E{(bf16_t*)(ws + (sh ? WS_ACT : WS_Z)), ZC};
    pg8::gemm_phase(lds, DM, DM, DM, S, E, tid); }
PHASE_FN ph_gates(LAS unsigned char* lds, int l) { PH_HEAD;
#if GATES_FP8
    pg8::SchedGrid S{(const char*)(ws + WS_U8), (const char*)(lw + LW_GATE8), DM / 2, DM / 2, NTOK / 256, 8192 / 256, G, cblk};
    pg8::EpiGates E{(bf16_t*)(ws + WS_GATES), p.in[I_B_GATE] + (size_t)l * 8192, 1.0f / (SC_ACT8 * SC_W8)};
    pg8::gemm_phase<pg8::EpiGates, pg8::SchedGrid, true>(lds, DM / 2, DM / 2, DM / 2, S, E, tid);
#else
    pg8::SchedGrid S{(const char*)U, (const char*)(lw + LW_GATE8), DM, DM, NTOK / 256, 8192 / 256, G, cblk};
    pg8::EpiGates E{(bf16_t*)(ws + WS_GATES), p.in[I_B_GATE] + (size_t)l * 8192, 1.0f};
    pg8::gemm_phase<pg8::EpiGates, pg8::SchedGrid, false>(lds, DM, DM, DM, S, E, tid);
#endif
}
PHASE_FN ph_prep1(LAS unsigned char* lds, int l) { PH_HEAD; prep1(p, l, lds, tid, wid, lane); }
PHASE_FN ph_mlaup_q(LAS unsigned char* lds, int l) { PH_HEAD;
    pg8::SchedGrid S{(const char*)(ws + WS_CQN), (const char*)(lw + LW_UQ), 768, 768, NTOK / 256, 3, G, cblk};
    pg8::EpiBf16 E{(bf16_t*)(ws + WS_QRAW), 768}; pg8::gemm_phase(lds, 768, 768, 768, S, E, tid); }
PHASE_FN ph_mlaup_kv(LAS unsigned char* lds, int l) { PH_HEAD;
    pg8::SchedGrid S{(const char*)(ws + WS_CKVN), (const char*)(lw + LW_UKV), 256, 256, NTOK / 256, 4, G, (cblk + G - 96 % G) % G};
    pg8::EpiBf16 E{(bf16_t*)(ws + WS_KVRAW), 1024}; pg8::gemm_phase(lds, 256, 256, 256, S, E, tid); }
PHASE_FN ph_memkv(LAS unsigned char* lds, int l) { PH_HEAD;
    pg8::SchedGrid S{(const char*)(ws + WS_MEMN + (size_t)l * NMEM * DM * 2), (const char*)(lw + LW_MEMKV), DM, DM, NMEM / 256, 4, G, (cblk + G - (224 + 16 * l) % G) % G};
    pg8::EpiBf16 E{(bf16_t*)(ws + WS_MEMKV) + (size_t)l * NMEM * 1024, 1024}; pg8::gemm_phase(lds, DM, DM, DM, S, E, tid); }
PHASE_FN ph_prep2(LAS unsigned char* lds, int l) { PH_HEAD; prep2(p, l, lds, tid, wid, lane); }
PHASE_FN ph_attn(LAS unsigned char* lds, int l) { PH_HEAD; attn_phase(p, l, lds, tid, wid, lane); }
PHASE_FN ph_merge(LAS unsigned char* lds, int l) { PH_HEAD;
    SchedMerge S{(const char*)(ws + WS_BR), (const char*)(lw + LW_BR), G, cblk};
    pg8::EpiMerge E{(const bf16_t*)(ws + WS_GATES), (bf16_t*)(ws + WS_MERGED)};
    pg8::gemm_phase(lds, DM, 512, 512, S, E, tid); }
PHASE_FN ph_wo(LAS unsigned char* lds, int l) { PH_HEAD;
    pg8::SchedGrid S{(const char*)(ws + WS_MERGED), (const char*)(lw + LW_O), DM, DM, NTOK / 256, DM / 256, G, cblk};
    pg8::EpiResF32 E{l == 0 ? p.in[I_X] : (const float*)p.out, p.out};
    pg8::gemm_phase(lds, DM, DM, DM, S, E, tid); }
PHASE_FN ph_norm(LAS unsigned char* lds, int l) { PH_HEAD;
    norm_rows(p.out, l == 0 ? p.in[I_NORM_FFN] : p.in[I_NORM_MIX] + DM, U, l == 0 ? nullptr : ws + WS_U8, NTOK, wid, lane); }
PHASE_FN ph_ffnup(LAS unsigned char* lds, int l) { PH_HEAD;
    pg8::SchedGrid S{(const char*)U, (const char*)(ws + WS_FFNUP), DM, DM, NTOK / 256, 2 * DFF / 256, G, cblk};
    pg8::EpiSwiGLU E{(bf16_t*)(ws + WS_ACT), DFF};
    pg8::gemm_phase(lds, DM, DM, DM, S, E, tid); }
PHASE_FN ph_ffndown(LAS unsigned char* lds, int l) { PH_HEAD;
    pg8::SchedGrid S{(const char*)(ws + WS_ACT), (const char*)(ws + WS_FFNDN), DFF, DFF, NTOK / 256, DM / 256, G, cblk};
    pg8::EpiResF32 E{(const float*)p.out, p.out};
    pg8::gemm_phase(lds, DFF, DFF, DFF, S, E, tid); }
PHASE_FN ph_router(LAS unsigned char* lds, int l) { PH_HEAD; router_phase(p, lds, tid, wid, lane); }
PHASE_FN ph_moeup(LAS unsigned char* lds, int l) { PH_HEAD;
    moe_table(lds, ctl + CW_MOECNT, 2 * DFFE / 256, tid);
    const SchedMoe S{(const char*)(ws + WS_XG), (const char*)(ws + WS_MOEUP), (size_t)ECAP * DM * MOE_ES, (size_t)2 * DFFE * DM * MOE_ES, (size_t)256 * DM * MOE_ES, (size_t)256 * DM * MOE_ES, (const LAS int*)(lds + MOE_TAB_OFF), G, cblk};
#if MOE_FP8
    pg8::EpiSwiGLU8 E{ws + WS_ACTM, DFFE, 1.0f / (SC_ACT8 * SC_W8), SC_H8};
    pg8::gemm_phase<pg8::EpiSwiGLU8, SchedMoe, true>(lds, DM / 2, DM / 2, DM / 2, S, E, tid);
#else
    pg8::EpiSwiGLU E{(bf16_t*)(ws + WS_ACTM), DFFE};
    pg8::gemm_phase(lds, DM, DM, DM, S, E, tid);
#endif
}
PHASE_FN ph_moedown(LAS unsigned char* lds, int l) { PH_HEAD;
    moe_table(lds, ctl + CW_MOECNT, DM / 256, tid);
    const SchedMoe S{(const char*)(ws + WS_ACTM), (const char*)(ws + WS_MOEDN), (size_t)ECAP * DFFE * MOE_ES, (size_t)DM * DFFE * MOE_ES, (size_t)256 * DFFE * MOE_ES, (size_t)256 * DFFE * MOE_ES, (const LAS int*)(lds + MOE_TAB_OFF), G, cblk};
#if MOE_FP8
    pg8::EpiMoeDown E{p.out, (const int*)(ws + WS_TOK), (const float*)(ws + WS_WT), ctl + CW_MOECNT, 1.0f / (SC_H8 * SC_W8)};
    pg8::gemm_phase<pg8::EpiMoeDown, SchedMoe, true>(lds, DFFE / 2, DFFE / 2, DFFE / 2, S, E, tid);
#else
    pg8::EpiMoeDown E{p.out, (const int*)(ws + WS_TOK), (const float*)(ws + WS_WT), ctl + CW_MOECNT, 1.0f};
    pg8::gemm_phase(lds, DFFE, DFFE, DFFE, S, E, tid);
#endif
}


#ifndef PROBE_CHK
#define PROBE_CHK 0
#endif
constexpr int CW_CHKFLAG = 4096 + 2048;
PHASE_FN ph_compare(LAS unsigned char* lds, int l, size_t offa, size_t offb, size_t nbytes) { PH_HEAD;
    const u32x4* a = (const u32x4*)(ws + offa); const u32x4* b = (const u32x4*)(ws + offb); unsigned bad = 0;
    for (size_t i = (size_t)cblk * NTHREADS + tid; i < nbytes / 16; i += (size_t)G * NTHREADS) { const u32x4 x = a[i], y = b[i]; bad |= (x.x ^ y.x) | (x.y ^ y.y) | (x.z ^ y.z) | (x.w ^ y.w); }
    if (bad) atomicOr(ctl + CW_CHKFLAG, 1u); }
PHASE_FN ph_poison(LAS unsigned char* lds, int l) { PH_HEAD;
    if (__hip_atomic_load(ctl + CW_CHKFLAG, __ATOMIC_RELAXED, __HIP_MEMORY_SCOPE_AGENT) != 0u && tid == 0) p.out[cblk] = __builtin_nanf(""); }
__global__ void __launch_bounds__(NTHREADS, 2) mk_fwd(Params pk) {
    extern __shared__ __attribute__((aligned(16))) unsigned char lds_raw[];
    LAS unsigned char* lds = (LAS unsigned char*)lds_raw;
    const int tid = threadIdx.x;
    if (tid < 64) ((LAS unsigned*)(lds + LDS_MISC))[tid] = 0u;
    if (tid == 64) { LAS Params* P = (LAS Params*)(lds + LDS_PARAMS);
#pragma unroll
        for (int i = 0; i < 30; ++i) P->in[i] = pk.in[i];
        P->out = pk.out; P->ws = pk.ws; P->ph_lo = (int)gridDim.x; P->ph_hi = (int)blockIdx.x; }
    __syncthreads();
    unsigned* ctl = (unsigned*)(pk.ws + WS_CTL);
#if !MK_MULTI
    (void)xcd_barrier_post(ctl + CW_BAR, (volatile LAS unsigned*)(lds + LDS_MISC));
#endif
#ifdef ONLY_FN
    ONLY_FN(lds, pk.ph_lo); return;
#endif
    const int lo = pk.ph_lo, hi = pk.ph_hi;
#define IN(k) (lo <= (k) && (k) < hi)
#if MK_MULTI
#define SEAM(k) do { } while (0)
#else
#ifndef PROBE_BAR
#define PROBE_BAR 0
#endif
#define SEAM(k) do { for (int rep_ = 0; rep_ < 1 + PROBE_BAR; ++rep_) if (IN((k) + 1)) { const Params q_ = load_params(lds); XcdBarrier b2_; b2_.bar = (unsigned*)(q_.ws + WS_CTL) + CW_BAR; b2_.x = xb_xcc_id(); b2_.st = (volatile LAS unsigned*)(lds + LDS_MISC); xcd_barrier(b2_); } } while (0)
#endif
#ifndef PROBE_P0
#define PROBE_P0 0
#endif
#ifndef PROBE_ATTN
#define PROBE_ATTN 0
#endif
#ifndef PROBE_THIN
#define PROBE_THIN 0
#endif
    if (IN(0)) { ph_prologue(lds, 0); if (PROBE_P0) { __syncthreads(); ph_prologue(lds, 0); } SEAM(0); }
#pragma unroll 1
    for (int l = 0; l < DEPTH; ++l) {
        const int pb = 1 + 11 * l;
#ifndef SPLIT_INGATE
#define SPLIT_INGATE 0
#endif
        if (IN(pb + 0)) { if (SPLIT_INGATE == 1) { ph_inproj(lds, l); __syncthreads(); ph_gates(lds, l); } else if (SPLIT_INGATE == 2) { ph_ingate(lds, l); SEAM(pb + 0); ph_inproj(lds, l); } else if (SPLIT_INGATE == 3) { ph_ingate(lds, l); SEAM(pb + 0); ph_gates(lds, l); } else ph_ingate(lds, l); if (PROBE_CHK == 2) ph_inproj(lds, l + 2); SEAM(pb + 0);
            if (PROBE_CHK == 2) { ph_compare(lds, l, WS_Z, WS_ACT, (size_t)NTOK * ZC * 2); SEAM(pb + 0); } }
        if (IN(pb + 1)) { ph_prep1(lds, l); if (PROBE_THIN) { __syncthreads(); ph_prep1(lds, l); } SEAM(pb + 1); }
        if (IN(pb + 2)) { ph_mlaup_q(lds, l); ph_mlaup_kv(lds, l); if (l == 0) { ph_memkv(lds, 0); ph_memkv(lds, 1); } SEAM(pb + 2); }
        if (IN(pb + 3)) { ph_prep2(lds, l); if (PROBE_THIN) { __syncthreads(); ph_prep2(lds, l); } SEAM(pb + 3); }
        if (IN(pb + 4)) { ph_attn(lds, l); if (PROBE_ATTN || PROBE_CHK == 1) { __syncthreads(); ph_attn(lds, l + 2); } SEAM(pb + 4);
            if (PROBE_CHK == 1) { ph_compare(lds, l, WS_BR, WS_ACT, (size_t)NTOK * DM * 2); SEAM(pb + 4); } }
        if (IN(pb + 5)) { ph_merge(lds, l); SEAM(pb + 5); }
        if (IN(pb + 6)) { ph_wo(lds, l); SEAM(pb + 6); }
        if (l == 0) {
            if (IN(pb + 7)) { ph_norm(lds, 0); if (PROBE_THIN) { __syncthreads(); ph_norm(lds, 0); } SEAM(pb + 7); }
            if (IN(pb + 8)) { ph_ffnup(lds, 0); SEAM(pb + 8); }
            if (IN(pb + 9)) { ph_ffndown(lds, 0); SEAM(pb + 9); }
            if (IN(pb + 10)) { ph_norm(lds, 1); if (PROBE_THIN) { __syncthreads(); ph_norm(lds, 1); } SEAM(pb + 10); }
        } else {
            if (IN(pb + 7)) { ph_router(lds, 1); SEAM(pb + 7); }
            if (IN(pb + 8)) { ph_moeup(lds, 1); SEAM(pb + 8); }
            if (IN(pb + 9)) { ph_moedown(lds, 1); if (PROBE_CHK) { SEAM(pb + 8); ph_poison(lds, 1); } }
        }
    }
#undef IN
#undef SEAM
}

extern "C" void kernel_launch(void* const* d_in, const int* in_sizes, int n_in, void* d_out, int out_size, void* d_ws, size_t ws_size, hipStream_t stream) {
    static int grid = 0;
    if (grid == 0) {
        if (n_in != 30 || out_size != NTOK * DM || ws_size < WS_END) { fprintf(stderr, "kernel_launch: unexpected problem (n_in %d, out %d, ws %zu < %zu)\n", n_in, out_size, ws_size, (size_t)WS_END); grid = -1; return; }
        int dev = 0, cus = 0, per_cu = 0;
        if (hipGetDevice(&dev) != hipSuccess || hipDeviceGetAttribute(&cus, hipDeviceAttributeMultiprocessorCount, dev) != hipSuccess) { grid = -1; return; }
        if (hipFuncSetAttribute((const void*)mk_fwd, hipFuncAttributeMaxDynamicSharedMemorySize, LDS_BYTES) != hipSuccess) { fprintf(stderr, "kernel_launch: hipFuncSetAttribute failed\n"); grid = -1; return; }
        if (hipOccupancyMaxActiveBlocksPerMultiprocessor(&per_cu, (const void*)mk_fwd, NTHREADS, LDS_BYTES) != hipSuccess || per_cu < 1) fprintf(stderr, "kernel_launch: occupancy query reports %d\n", per_cu);
        (void)hipGetLastError();
        grid = cus;
    }
    if (grid < 0) return;
    if (hipMemsetAsync((char*)d_ws + WS_CTL, 0, CTL_BYTES, stream) != hipSuccess) return;
    Params a{};
    for (int i = 0; i < 30; ++i) a.in[i] = (const float*)d_in[i];
    a.out = (float*)d_out; a.ws = (unsigned char*)d_ws;
#if MK_MULTI
    for (int ph = 0; ph < NPHASE - 1; ++ph) { a.ph_lo = ph; a.ph_hi = ph + 1; hipLaunchKernelGGL(mk_fwd, dim3(grid), dim3(NTHREADS), LDS_BYTES, stream, a); }
#else
    a.ph_lo = 0; a.ph_hi = NPHASE;
    hipLaunchKernelGGL(mk_fwd, dim3(grid), dim3(NTHREADS), LDS_BYTES, stream, a);
#endif
    const hipError_t le = hipPeekAtLastError();
    if (le != hipSuccess) fprintf(stderr, "kernel_launch: launch failed: %s\n", hipGetErrorName(le));
}
```

```cpp
#include <hip/hip_runtime.h>
#include <cstdio>
#include <cstdint>

#define LAS __attribute__((address_space(3)))
typedef unsigned short bf16_t;
typedef short bf16x8 __attribute__((ext_vector_type(8)));
typedef float f32x4 __attribute__((ext_vector_type(4)));
typedef float f32x2 __attribute__((ext_vector_type(2)));
typedef unsigned u32x4 __attribute__((ext_vector_type(4)));
typedef unsigned u32x2 __attribute__((ext_vector_type(2)));

#ifndef MK_MULTI
#define MK_MULTI 0
#endif

constexpr int DM = 2048, NBATCH = 4, SEQ = 2048, NTOK = NBATCH * SEQ, MEML = 256, NMEM = NBATCH * MEML, DEPTH = 2;
constexpr int ZC = 4096;
constexpr int INC = 3904;
constexpr int Z_NAQ = 0, Z_NAK = 512, Z_NAV = 1024, Z_CQ = 1536, Z_CKV = 2304, Z_KPE = 2560, Z_SWQ = 2624, Z_SWK = 3136, Z_SWV = 3264, Z_MEQ = 3392;
constexpr int DFF = 5632, NEXP = 8, DFFE = 7168, ECAP = 8192;
constexpr float LOG2E = 1.4426950408889634f;
constexpr float EPS = 1e-6f;
constexpr int NTHREADS = 512;
constexpr float SC_ACT8 = 16.0f, SC_W8 = 64.0f, SC_H8 = 8.0f;

constexpr size_t al256(size_t x) { return (x + 255) & ~(size_t)255; }
constexpr size_t WS_CTL = 0, CTL_BYTES = 65536;
constexpr size_t WS_ROPE = WS_CTL + CTL_BYTES;
constexpr size_t WS_LW = WS_ROPE + (size_t)SEQ * 32 * 8;
constexpr size_t LW_IN = 0;
constexpr size_t LW_GATE8 = LW_IN + (size_t)4096 * 2048 * 2;
#ifndef INGATE_FP8
#define INGATE_FP8 1
#endif
#define GATES_FP8 0
#ifndef MOE_FP8
#define MOE_FP8 1
#endif
constexpr size_t MOE_ES = MOE_FP8 ? 1 : 2;
constexpr size_t LW_UQ = LW_GATE8 + (size_t)8192 * 2048 * 2;
constexpr size_t LW_UKV = LW_UQ + (size_t)768 * 768 * 2;
constexpr size_t LW_MEMKV = LW_UKV + (size_t)1024 * 256 * 2;
constexpr size_t LW_BR = LW_MEMKV + (size_t)1024 * 2048 * 2;
constexpr size_t LW_O = LW_BR + (size_t)4 * 2048 * 512 * 2;
constexpr size_t LW_BYTES = LW_O + (size_t)2048 * 2048 * 2;
constexpr size_t WS_FFNUP = WS_LW + 2 * LW_BYTES;
constexpr size_t WS_FFNDN = WS_FFNUP + (size_t)2 * DFF * 2048 * 2;
constexpr size_t WS_MOEUP = WS_FFNDN + (size_t)2048 * DFF * 2;
constexpr size_t WS_MOEDN = WS_MOEUP + (size_t)NEXP * 2 * DFFE * 2048 * MOE_ES;
constexpr size_t WS_U = WS_MOEDN + (size_t)NEXP * 2048 * DFFE * MOE_ES;
constexpr size_t WS_U8 = WS_U + (size_t)NTOK * DM * 2;
constexpr size_t WS_MEMN = WS_U8 + (size_t)NTOK * DM;
constexpr size_t WS_Z = WS_MEMN + (size_t)2 * NMEM * DM * 2;
constexpr size_t WS_GATES = WS_Z + (size_t)NTOK * ZC * 2;
constexpr size_t WS_NAQ = WS_GATES + (size_t)NTOK * 8192 * 2;
constexpr size_t WS_NAK = WS_NAQ + (size_t)NTOK * 512 * 2;
constexpr size_t WS_NAVT = WS_NAK + (size_t)NTOK * 512 * 2;
constexpr size_t WS_CQN = WS_NAVT + (size_t)NTOK * 512 * 2;
constexpr size_t WS_CKVN = WS_CQN + (size_t)NTOK * 768 * 2;
constexpr size_t WS_SWQ = WS_CKVN + (size_t)NTOK * 256 * 2;
constexpr size_t WS_SWK = WS_SWQ + (size_t)NTOK * 512 * 2;
constexpr size_t WS_SWVT = WS_SWK + (size_t)NTOK * 128 * 2;
constexpr size_t WS_MEQ = WS_SWVT + (size_t)NTOK * 128 * 2;
constexpr size_t WS_QRAW = WS_MEQ + (size_t)NTOK * 512 * 2;
constexpr size_t WS_KVRAW = WS_QRAW + (size_t)NTOK * 768 * 2;
constexpr size_t WS_MEMKV = WS_KVRAW + (size_t)NTOK * 1024 * 2;
constexpr size_t WS_MLQ = WS_MEMKV + (size_t)2 * NMEM * 1024 * 2;
constexpr size_t WS_MLK = WS_MLQ + (size_t)NTOK * 768 * 2;
constexpr size_t WS_MLVT = WS_MLK + (size_t)NTOK * 768 * 2;
constexpr size_t WS_MEK = WS_MLVT + (size_t)NTOK * 512 * 2;
constexpr size_t WS_MEVT = WS_MEK + (size_t)NMEM * 512 * 2;
constexpr size_t WS_BR = WS_MEVT + (size_t)NMEM * 512 * 2;
constexpr size_t WS_MERGED = WS_BR + (size_t)NTOK * DM * 2;
constexpr size_t WS_ACT = WS_MERGED + (size_t)NTOK * DM * 2;
constexpr size_t WS_XG = WS_ACT + (size_t)NTOK * DFF * 2;
constexpr size_t WS_TOK = WS_XG + (size_t)NEXP * ECAP * DM * MOE_ES;
constexpr size_t WS_WT = WS_TOK + (size_t)NEXP * ECAP * 4;
constexpr size_t WS_ACTM = WS_WT + (size_t)NEXP * ECAP * 4;
constexpr size_t WS_Y = WS_ACTM + (size_t)NEXP * ECAP * DFFE * MOE_ES;
constexpr size_t WS_TSLOT = WS_Y + (size_t)NEXP * ECAP * DM * 2;
constexpr size_t WS_END = WS_TSLOT + (size_t)NTOK * 2 * 4;

constexpr int CW_BAR = 0;
constexpr int CW_MOECNT = 4096;
constexpr int CW_ATTQ = 4096 + 1024;

constexpr int LDS_BYTES = 147456;
constexpr int LDS_MISC = 147456 - 1024;
namespace pg8 {
constexpr int BM = 256, BK = 64, HALF = 128, HTB = HALF * BK * 2, STAGE_BYTES = 8 * HTB, NXCD = 8, WGM = 8;
__host__ __device__ __forceinline__ int lds_byte(int r, int c) { const int st = (r >> 4) * 2 + (c >> 5), rr = r & 15, cc = c & 31, ob = rr * 64 + cc * 2; return st * 1024 + (ob ^ (((ob >> 9) & 1) << 5)); }
__host__ __device__ __forceinline__ void stage_rc(int b, int& R, int& C) { const int st = b / 1024, sb = b % 1024, swz = sb ^ (((sb >> 9) & 1) << 5); R = (st >> 1) * 16 + swz / 64; C = (st & 1) * 32 + (swz % 64) / 2; }
__host__ __device__ __forceinline__ int perm32(int rho) { const int n = rho >> 4, i = rho & 15; return 8 * (i >> 2) + 4 * n + (i & 3); }

struct Unit { const char* A; const char* B; int orow, ocol, x0, x1; };

__device__ __forceinline__ bool static_tile(int i, int G, int c, int nM, int nN, int& pm, int& pn) {
    const int nwg = nM * nN; const long L = (long)i * G + c; if (L >= nwg) return false;
    int wgid = (int)L; { const int q = nwg / NXCD, r = nwg % NXCD, xcd = wgid % NXCD, off = wgid / NXCD; wgid = (xcd < r ? xcd * (q + 1) : r * (q + 1) + (xcd - r) * q) + off; }
    const int nig = WGM * nN, gid = wgid / nig, fm = gid * WGM, gsz = (nM - fm) < WGM ? (nM - fm) : WGM;
    pm = fm + ((wgid % nig) % gsz); pn = (wgid % nig) / gsz; return true;
}
struct SchedGrid {
    const char* A; const char* B; int lda, ldb, nM, nN, G, c;
    __device__ __forceinline__ bool next(int i, Unit& u) const {
        int pm, pn; if (!static_tile(i, G, c, nM, nN, pm, pn)) return false;
        u.A = A + (size_t)pm * 256 * lda * 2; u.B = B + (size_t)pn * 256 * ldb * 2; u.orow = pm * 256; u.ocol = pn; u.x0 = 0; u.x1 = 0; return true;
    }
};

__device__ __forceinline__ unsigned cvt_pk_bf16(float lo, float hi) { unsigned r; asm volatile("v_cvt_pk_bf16_f32 %0, %1, %2" : "=v"(r) : "v"(lo), "v"(hi)); return r; }
__device__ __forceinline__ float sigmoidf_(float x) { return __builtin_amdgcn_rcpf(1.0f + __builtin_amdgcn_exp2f(-x * LOG2E)); }

typedef f32x4 Acc[2][2][4][2];

typedef int i32x8 __attribute__((ext_vector_type(8)));
typedef int i32x4 __attribute__((ext_vector_type(4)));
template <class Epi, class Sched, bool FP8 = false>
__device__ __forceinline__ void gemm_phase(LAS unsigned char* lds, const int lda, const int ldb, const int K, const Sched S, Epi& E, const int tid) {
    const int wid = __builtin_amdgcn_readfirstlane(tid >> 6), lane = tid & 63, wr = wid >> 2, wc = wid & 3, fr = lane & 15, fq = lane >> 4;
    const int nt = K / BK;
    unsigned voffA[2], voffB[2];
#pragma unroll
    for (int i = 0; i < 2; ++i) { int R, C; stage_rc(tid * 16 + i * 8192, R, C); const int Rb = Epi::PERM ? ((R & ~31) + perm32(R & 31)) : R;
        voffA[i] = (unsigned)(R * lda + C) * 2u; voffB[i] = (unsigned)(Rb * ldb + C) * 2u; }
    const size_t kstep = (size_t)(BK * 2);
    const size_t hstepA = (size_t)HALF * lda * 2, hstepB = (size_t)HALF * ldb * 2;
    const unsigned ldsw = (unsigned)wid * 1024u;
    const int aoff = lds_byte(wr * 64 + fr, fq * 8), boff = lds_byte(wc * 32 + fr, fq * 8);
#define PG8_SA(b, h) (((b) * 2 + (h)) * HTB)
#define PG8_SB(b, h) ((4 + (b) * 2 + (h)) * HTB)
#define PG8_STAGE(bufoff, gbase, voff) do { _Pragma("unroll") for (int _i = 0; _i < 2; ++_i) \
        __builtin_amdgcn_global_load_lds((const unsigned*)((const char*)(gbase) + (voff)[_i]), (LAS unsigned*)(lds + (bufoff) + ldsw + _i * 8192), 16, 0, 0); } while (0)
#define PG8_LDA(dst, b, h) do { _Pragma("unroll") for (int m = 0; m < 4; ++m) _Pragma("unroll") for (int k = 0; k < 2; ++k) dst[m][k] = *(const LAS bf16x8*)(lds + PG8_SA(b, h) + aoff + m * 2048 + k * 1024); } while (0)
#define PG8_LDB(dst, b, h) do { _Pragma("unroll") for (int n = 0; n < 2; ++n) _Pragma("unroll") for (int k = 0; k < 2; ++k) dst[n][k] = *(const LAS bf16x8*)(lds + PG8_SB(b, h) + boff + n * 2048 + k * 1024); } while (0)
#define PG8_MMA(ai, bj, At, Bt) do { __builtin_amdgcn_s_setprio(1); _Pragma("unroll") for (int m = 0; m < 4; ++m) _Pragma("unroll") for (int n = 0; n < 2; ++n) _Pragma("unroll") for (int k = 0; k < 2; ++k) \
        acc[ai][bj][m][n] = __builtin_amdgcn_mfma_f32_16x16x32_bf16(Bt[n][k], At[m][k], acc[ai][bj][m][n], 0, 0, 0); __builtin_amdgcn_s_setprio(0); } while (0)
#define PG8_CAT(x, y) __builtin_shufflevector(__builtin_bit_cast(i32x4, x), __builtin_bit_cast(i32x4, y), 0, 1, 2, 3, 4, 5, 6, 7)
#define PG8_MMA8(ai, bj, At, Bt) do { __builtin_amdgcn_s_setprio(1); _Pragma("unroll") for (int m = 0; m < 4; ++m) _Pragma("unroll") for (int n = 0; n < 2; ++n) \
        asm volatile("v_mfma_f32_16x16x128_f8f6f4 %0, %1, %2, %0" : "+v"(acc[ai][bj][m][n]) : "v"(PG8_CAT(Bt[n][0], Bt[n][1])), "v"(PG8_CAT(At[m][0], At[m][1]))); __builtin_amdgcn_s_setprio(0); } while (0)
#define PG8_WAIT_V(n) asm volatile("s_waitcnt vmcnt(" #n ")" ::: "memory")
#define PG8_WAIT_L(n) asm volatile("s_waitcnt lgkmcnt(" #n ")" ::: "memory")
#define PG8_BAR __builtin_amdgcn_s_barrier()
#define PG8_SCHED __builtin_amdgcn_sched_barrier(0)
    Unit cur, nxt; int ui = 0;
    if (!S.next(0, cur)) return;
    Acc acc;
#pragma unroll
    for (int a = 0; a < 2; ++a)
#pragma unroll
        for (int b = 0; b < 2; ++b)
#pragma unroll
            for (int m = 0; m < 4; ++m)
#pragma unroll
                for (int n = 0; n < 2; ++n) acc[a][b][m][n] = (f32x4){0.f, 0.f, 0.f, 0.f};
    bf16x8 At[4][2], B0[2][2], B1[2][2];
    const char* cA = cur.A; const char* cB = cur.B;
    PG8_STAGE(PG8_SB(0, 0), cB, voffB); PG8_STAGE(PG8_SB(0, 1), cB + hstepB, voffB); PG8_STAGE(PG8_SA(0, 0), cA, voffA); PG8_STAGE(PG8_SA(0, 1), cA + hstepA, voffA);
    if (wr == 1) PG8_BAR;
    PG8_WAIT_V(2); PG8_BAR;
    PG8_STAGE(PG8_SB(1, 0), cB + kstep, voffB); PG8_STAGE(PG8_SA(1, 0), cA + kstep, voffA); PG8_STAGE(PG8_SB(1, 1), cB + hstepB + kstep, voffB);
    PG8_WAIT_V(6); PG8_BAR;
    for (;;) {
        const bool has_next = S.next(ui + 1, nxt);
        const char* nA = has_next ? nxt.A : cA; const char* nB = has_next ? nxt.B : cB;
        for (int t = 0; t < nt; t += 2) {
            const bool last = (t == nt - 2);
            const char* a1 = cA + (size_t)(t + 1) * kstep;
            const char* a2 = last ? nA : cA + (size_t)(t + 2) * kstep; const char* b2 = last ? nB : cB + (size_t)(t + 2) * kstep;
            const char* a3 = a2 + kstep; const char* b3 = b2 + kstep;
            if constexpr (FP8) {
            PG8_LDB(B0, 0, 0); PG8_LDB(B1, 0, 1); PG8_SCHED; PG8_LDA(At, 0, 0); PG8_STAGE(PG8_SA(1, 1), a1 + hstepA, voffA);
            PG8_WAIT_V(8); PG8_WAIT_L(0); PG8_BAR; PG8_MMA8(0, 0, At, B0); PG8_MMA8(0, 1, At, B1); PG8_BAR; PG8_SCHED;
            PG8_LDA(At, 0, 1); PG8_STAGE(PG8_SB(0, 0), b2, voffB); PG8_STAGE(PG8_SB(0, 1), b2 + hstepB, voffB); PG8_STAGE(PG8_SA(0, 0), a2, voffA);
            PG8_WAIT_V(8); PG8_WAIT_L(0); PG8_BAR; PG8_MMA8(1, 0, At, B0); PG8_MMA8(1, 1, At, B1); PG8_BAR; PG8_SCHED;
            PG8_LDB(B0, 1, 0); PG8_LDB(B1, 1, 1); PG8_SCHED; PG8_LDA(At, 1, 0); PG8_STAGE(PG8_SA(0, 1), a2 + hstepA, voffA);
            PG8_WAIT_V(8); PG8_WAIT_L(0); PG8_BAR; PG8_MMA8(0, 0, At, B0); PG8_MMA8(0, 1, At, B1); PG8_BAR; PG8_SCHED;
            PG8_LDA(At, 1, 1); PG8_STAGE(PG8_SB(1, 0), b3, voffB); PG8_STAGE(PG8_SB(1, 1), b3 + hstepB, voffB); PG8_STAGE(PG8_SA(1, 0), a3, voffA);
            PG8_WAIT_V(8); PG8_WAIT_L(0); PG8_BAR; PG8_MMA8(1, 0, At, B0); PG8_MMA8(1, 1, At, B1); PG8_BAR; PG8_SCHED;
            } else {
            PG8_LDB(B0, 0, 0); PG8_LDB(B1, 0, 1); PG8_SCHED; PG8_LDA(At, 0, 0); PG8_STAGE(PG8_SA(1, 1), a1 + hstepA, voffA);
            PG8_WAIT_V(8); PG8_WAIT_L(0); PG8_BAR; PG8_MMA(0, 0, At, B0); PG8_MMA(0, 1, At, B1); PG8_BAR; PG8_SCHED;
            PG8_LDA(At, 0, 1); PG8_STAGE(PG8_SB(0, 0), b2, voffB); PG8_STAGE(PG8_SB(0, 1), b2 + hstepB, voffB); PG8_STAGE(PG8_SA(0, 0), a2, voffA);
            PG8_WAIT_V(8); PG8_WAIT_L(0); PG8_BAR; PG8_MMA(1, 0, At, B0); PG8_MMA(1, 1, At, B1); PG8_BAR; PG8_SCHED;
            PG8_LDB(B0, 1, 0); PG8_LDB(B1, 1, 1); PG8_SCHED; PG8_LDA(At, 1, 0); PG8_STAGE(PG8_SA(0, 1), a2 + hstepA, voffA);
            PG8_WAIT_V(8); PG8_WAIT_L(0); PG8_BAR; PG8_MMA(0, 0, At, B0); PG8_MMA(0, 1, At, B1); PG8_BAR; PG8_SCHED;
            PG8_LDA(At, 1, 1); PG8_STAGE(PG8_SB(1, 0), b3, voffB); PG8_STAGE(PG8_SB(1, 1), b3 + hstepB, voffB); PG8_STAGE(PG8_SA(1, 0), a3, voffA);
            PG8_WAIT_V(8); PG8_WAIT_L(0); PG8_BAR; PG8_MMA(1, 0, At, B0); PG8_MMA(1, 1, At, B1); PG8_BAR; PG8_SCHED;
            }
        }
        if (wr == 0) PG8_BAR;
        if constexpr (FP8) {
#pragma unroll
            for (int a = 0; a < 2; ++a)
#pragma unroll
                for (int b = 0; b < 2; ++b)
                    asm volatile("s_nop 15\n\ts_nop 15" : "+v"(acc[a][b][0][0]), "+v"(acc[a][b][0][1]), "+v"(acc[a][b][1][0]), "+v"(acc[a][b][1][1]), "+v"(acc[a][b][2][0]), "+v"(acc[a][b][2][1]), "+v"(acc[a][b][3][0]), "+v"(acc[a][b][3][1]));
        }
        E(acc, cur, wr, wc, fr, fq);
        if (!has_next) break;
#pragma unroll
        for (int a = 0; a < 2; ++a)
#pragma unroll
            for (int b = 0; b < 2; ++b)
#pragma unroll
                for (int m = 0; m < 4; ++m)
#pragma unroll
                    for (int n = 0; n < 2; ++n) acc[a][b][m][n] = (f32x4){0.f, 0.f, 0.f, 0.f};
        cur = nxt; cA = nA; cB = nB; ++ui;
        if (wr == 1) PG8_BAR;
    }
    PG8_WAIT_V(0);
    PG8_BAR;
#undef PG8_SA
#undef PG8_SB
#undef PG8_STAGE
#undef PG8_LDA
#undef PG8_MMA8
#undef PG8_CAT
#undef PG8_LDB
#undef PG8_MMA
#undef PG8_WAIT_V
#undef PG8_WAIT_L
#undef PG8_BAR
#undef PG8_SCHED
}

struct EpiInGate {
    static constexpr bool PERM = true;
    bf16_t* z; bf16_t* gates; const float* bgate; float s;
    __device__ __forceinline__ void operator()(const Acc& acc, const Unit& u, int wr, int wc, int fr, int fq) const {
        const int row0 = u.orow + wr * 64 + fr; const bool isg = u.ocol >= 16;
        const int colt = (isg ? u.ocol - 16 : u.ocol) * 256 + wc * 32 + 8 * fq; const int ldc = isg ? 8192 : ZC; bf16_t* base = isg ? gates : z;
        f32x4 bv[2][2];
#pragma unroll
        for (int bj = 0; bj < 2; ++bj)
#pragma unroll
            for (int n = 0; n < 2; ++n) bv[bj][n] = isg ? *(const f32x4*)(bgate + colt + bj * HALF + 4 * n) : (f32x4){0.f, 0.f, 0.f, 0.f};
#pragma unroll
        for (int ai = 0; ai < 2; ++ai)
#pragma unroll
            for (int m = 0; m < 4; ++m) { bf16_t* rowp = base + (size_t)(row0 + ai * HALF + m * 16) * ldc + colt;
#pragma unroll
                for (int bj = 0; bj < 2; ++bj) { f32x4 v0 = acc[ai][bj][m][0] * s + bv[bj][0], v1 = acc[ai][bj][m][1] * s + bv[bj][1];
                    if (isg) {
#pragma unroll
                        for (int j = 0; j < 4; ++j) { v0[j] = sigmoidf_(v0[j]); v1[j] = sigmoidf_(v1[j]); } }
                    u32x4 w; w.x = cvt_pk_bf16(v0[0], v0[1]); w.y = cvt_pk_bf16(v0[2], v0[3]); w.z = cvt_pk_bf16(v1[0], v1[1]); w.w = cvt_pk_bf16(v1[2], v1[3]);
                    *(u32x4*)(rowp + bj * HALF) = w; } }
    }
};
struct EpiBf16 {
    static constexpr bool PERM = true;
    bf16_t* O; int ldc;
    __device__ __forceinline__ void operator()(const Acc& acc, const Unit& u, int wr, int wc, int fr, int fq) const {
        const int row0 = u.orow + wr * 64 + fr, col0 = u.ocol * 256 + wc * 32 + 8 * fq;
#pragma unroll
        for (int ai = 0; ai < 2; ++ai)
#pragma unroll
            for (int m = 0; m < 4; ++m) { bf16_t* rowp = O + (size_t)(row0 + ai * HALF + m * 16) * ldc + col0;
#pragma unroll
                for (int bj = 0; bj < 2; ++bj) { const f32x4 v0 = acc[ai][bj][m][0], v1 = acc[ai][bj][m][1];
                    u32x4 w; w.x = cvt_pk_bf16(v0[0], v0[1]); w.y = cvt_pk_bf16(v0[2], v0[3]); w.z = cvt_pk_bf16(v1[0], v1[1]); w.w = cvt_pk_bf16(v1[2], v1[3]);
                    *(u32x4*)(rowp + bj * HALF) = w; } }
    }
};
struct EpiSwiGLU {
    static constexpr bool PERM = true;
    bf16_t* O; int ldc;
    __device__ __forceinline__ void operator()(const Acc& acc, const Unit& u, int wr, int wc, int fr, int fq) const {
        const int row0 = u.orow + wr * 64 + fr, col0 = u.ocol * 128 + wc * 32 + 8 * fq;
#pragma unroll
        for (int ai = 0; ai < 2; ++ai)
#pragma unroll
            for (int m = 0; m < 4; ++m) { bf16_t* rowp = O + (size_t)(row0 + ai * HALF + m * 16) * ldc + col0;
                f32x4 v0, v1;
#pragma unroll
                for (int j = 0; j < 4; ++j) { const float g0 = acc[ai][0][m][0][j], g1 = acc[ai][0][m][1][j];
                    v0[j] = g0 * sigmoidf_(g0) * acc[ai][1][m][0][j]; v1[j] = g1 * sigmoidf_(g1) * acc[ai][1][m][1][j]; }
                u32x4 w; w.x = cvt_pk_bf16(v0[0], v0[1]); w.y = cvt_pk_bf16(v0[2], v0[3]); w.z = cvt_pk_bf16(v1[0], v1[1]); w.w = cvt_pk_bf16(v1[2], v1[3]);
                *(u32x4*)rowp = w; }
    }
};
__device__ __forceinline__ float bflo(unsigned w) { return __uint_as_float(w << 16); }
__device__ __forceinline__ float bfhi(unsigned w) { return __uint_as_float(w & 0xffff0000u); }
struct EpiMerge {
    static constexpr bool PERM = true;
    const bf16_t* gates; bf16_t* merged;
    __device__ __forceinline__ void operator()(const Acc& acc, const Unit& u, int wr, int wc, int fr, int fq) const {
        const int row0 = u.orow + wr * 64 + fr, col0 = u.ocol * 256 + wc * 32 + 8 * fq, n = u.x0;
#pragma unroll
        for (int ai = 0; ai < 2; ++ai)
#pragma unroll
            for (int m = 0; m < 4; ++m) { const size_t r = (size_t)(row0 + ai * HALF + m * 16);
#pragma unroll
                for (int bj = 0; bj < 2; ++bj) {
                    const u32x4 g = *(const u32x4*)(gates + r * 8192 + n * 2048 + col0 + bj * HALF);
                    bf16_t* mp = merged + r * DM + col0 + bj * HALF;
                    u32x4 o = (u32x4){0u, 0u, 0u, 0u}; if (n > 0) o = *(const u32x4*)mp;
                    const f32x4 v0 = acc[ai][bj][m][0], v1 = acc[ai][bj][m][1];
                    u32x4 w;
                    w.x = cvt_pk_bf16(bflo(o.x) + bflo(g.x) * v0[0], bfhi(o.x) + bfhi(g.x) * v0[1]);
                    w.y = cvt_pk_bf16(bflo(o.y) + bflo(g.y) * v0[2], bfhi(o.y) + bfhi(g.y) * v0[3]);
                    w.z = cvt_pk_bf16(bflo(o.z) + bflo(g.z) * v1[0], bfhi(o.z) + bfhi(g.z) * v1[1]);
                    w.w = cvt_pk_bf16(bflo(o.w) + bflo(g.w) * v1[2], bfhi(o.w) + bfhi(g.w) * v1[3]);
                    *(u32x4*)mp = w; } }
    }
};
__device__ __forceinline__ unsigned pack_fp8x4(float a, float b, float c, float d) { int w = 0; w = __builtin_amdgcn_cvt_pk_fp8_f32(a, b, w, false); w = __builtin_amdgcn_cvt_pk_fp8_f32(c, d, w, true); return (unsigned)w; }
struct EpiGates {
    static constexpr bool PERM = true;
    bf16_t* gates; const float* bgate; float s;
    __device__ __forceinline__ void operator()(const Acc& acc, const Unit& u, int wr, int wc, int fr, int fq) const {
        const int row0 = u.orow + wr * 64 + fr, colt = u.ocol * 256 + wc * 32 + 8 * fq;
        f32x4 bv[2][2];
#pragma unroll
        for (int bj = 0; bj < 2; ++bj)
#pragma unroll
            for (int n = 0; n < 2; ++n) bv[bj][n] = *(const f32x4*)(bgate + colt + bj * HALF + 4 * n);
#pragma unroll
        for (int ai = 0; ai < 2; ++ai)
#pragma unroll
            for (int m = 0; m < 4; ++m) { bf16_t* rowp = gates + (size_t)(row0 + ai * HALF + m * 16) * 8192 + colt;
#pragma unroll
                for (int bj = 0; bj < 2; ++bj) { f32x4 v0 = acc[ai][bj][m][0] * s + bv[bj][0], v1 = acc[ai][bj][m][1] * s + bv[bj][1];
#pragma unroll
                    for (int j = 0; j < 4; ++j) { v0[j] = sigmoidf_(v0[j]); v1[j] = sigmoidf_(v1[j]); }
                    u32x4 w; w.x = cvt_pk_bf16(v0[0], v0[1]); w.y = cvt_pk_bf16(v0[2], v0[3]); w.z = cvt_pk_bf16(v1[0], v1[1]); w.w = cvt_pk_bf16(v1[2], v1[3]);
                    *(u32x4*)(rowp + bj * HALF) = w; } }
    }
};
struct EpiSwiGLU8 {
    static constexpr bool PERM = true;
    unsigned char* O; int ldc; float si, so;
    __device__ __forceinline__ void operator()(const Acc& acc, const Unit& u, int wr, int wc, int fr, int fq) const {
        const int row0 = u.orow + wr * 64 + fr, col0 = u.ocol * 128 + wc * 32 + 8 * fq;
#pragma unroll
        for (int ai = 0; ai < 2; ++ai)
#pragma unroll
            for (int m = 0; m < 4; ++m) { unsigned char* rowp = O + (size_t)(row0 + ai * HALF + m * 16) * ldc + col0;
                f32x4 v0, v1;
#pragma unroll
                for (int j = 0; j < 4; ++j) { const float g0 = acc[ai][0][m][0][j] * si, g1 = acc[ai][0][m][1][j] * si;
                    v0[j] = g0 * sigmoidf_(g0) * (acc[ai][1][m][0][j] * si) * so; v1[j] = g1 * sigmoidf_(g1) * (acc[ai][1][m][1][j] * si) * so; }
                u32x2 w; w.x = pack_fp8x4(v0[0], v0[1], v0[2], v0[3]); w.y = pack_fp8x4(v1[0], v1[1], v1[2], v1[3]);
                *(u32x2*)rowp = w; }
    }
};
struct EpiResF32 {
    static constexpr bool PERM = false;
    const float* base; float* out;
    __device__ __forceinline__ void operator()(const Acc& acc, const Unit& u, int wr, int wc, int fr, int fq) const {
        const int row0 = u.orow + wr * 64 + fr, col0 = u.ocol * 256 + wc * 32 + 4 * fq;
#pragma unroll
        for (int ai = 0; ai < 2; ++ai)
#pragma unroll
            for (int m = 0; m < 4; ++m) { const size_t off = (size_t)(row0 + ai * HALF + m * 16) * DM + col0;
#pragma unroll
                for (int bj = 0; bj < 2; ++bj)
#pragma unroll
                    for (int n = 0; n < 2; ++n) { const f32x4 bs = *(const f32x4*)(base + off + bj * HALF + n * 16); *(f32x4*)(out + off + bj * HALF + n * 16) = bs + acc[ai][bj][m][n]; }
                asm volatile("" ::: "memory"); }
    }
};
struct EpiMoeDown {
    static constexpr bool PERM = false;
    float* out; const int* tok; const float* wt; const unsigned* cnt; float s;
    __device__ __forceinline__ void operator()(const Acc& acc, const Unit& u, int wr, int wc, int fr, int fq) const {
        const int e = u.x0, nrow = (int)cnt[e * 64]; const int lrow0 = u.x1 + wr * 64 + fr, col0 = u.ocol * 256 + wc * 32 + 4 * fq;
#pragma unroll
        for (int ai = 0; ai < 2; ++ai)
#pragma unroll
            for (int m = 0; m < 4; ++m) { const int lr = lrow0 + ai * HALF + m * 16;
                if (lr < nrow) { const int slot = e * ECAP + lr; const int t = tok[slot]; const float w = wt[slot] * s; float* op = out + (size_t)t * DM + col0;
#pragma unroll
                    for (int bj = 0; bj < 2; ++bj)
#pragma unroll
                        for (int n = 0; n < 2; ++n)
#pragma unroll
                            for (int j = 0; j < 4; ++j) unsafeAtomicAdd(op + bj * HALF + n * 16 + j, w * acc[ai][bj][m][n][j]); } }
    }
};
struct EpiMoeDownY {
    static constexpr bool PERM = true;
    bf16_t* y; const float* wt; const unsigned* cnt; float s;
    __device__ __forceinline__ void operator()(const Acc& acc, const Unit& u, int wr, int wc, int fr, int fq) const {
        const int e = u.x0, nrow = (int)cnt[e * 64]; const int lrow0 = u.x1 + wr * 64 + fr, col0 = u.ocol * 256 + wc * 32 + 8 * fq;
#pragma unroll
        for (int ai = 0; ai < 2; ++ai)
#pragma unroll
            for (int m = 0; m < 4; ++m) { const int lr = lrow0 + ai * HALF + m * 16;
                if (lr < nrow) { const int slot = e * ECAP + lr; const float w = wt[slot] * s; bf16_t* rowp = y + (size_t)slot * DM + col0;
#pragma unroll
                    for (int bj = 0; bj < 2; ++bj) { const f32x4 v0 = acc[ai][bj][m][0] * w, v1 = acc[ai][bj][m][1] * w;
                        u32x4 q; q.x = cvt_pk_bf16(v0[0], v0[1]); q.y = cvt_pk_bf16(v0[2], v0[3]); q.z = cvt_pk_bf16(v1[0], v1[1]); q.w = cvt_pk_bf16(v1[2], v1[3]);
                        *(u32x4*)(rowp + bj * HALF) = q; } } }
    }
};
}
#define XB_TMO      128
#define XB_XCNT(j)  (256  + 64 * (j))
#define XB_XSUB(j)  (1280 + 64 * (j))
#define XB_XGEN(j)  (2304 + 64 * (j))
#define XB_TOP      3328
#define XB_TOPGEN   3392
#define XCD_BAR_WORDS 3456
#define XB_SPIN_CAP (1u << 18)

__device__ __forceinline__ unsigned xb_ld(unsigned* p)              { return __hip_atomic_load(p, __ATOMIC_RELAXED, __HIP_MEMORY_SCOPE_AGENT); }
__device__ __forceinline__ unsigned xb_add(unsigned* p, unsigned v) { return __hip_atomic_fetch_add(p, v, __ATOMIC_RELAXED, __HIP_MEMORY_SCOPE_AGENT); }
__device__ __forceinline__ unsigned xb_xcc_id() { return (unsigned)__builtin_amdgcn_s_getreg((3 << 11) | 20) & 0xFu; }
#define XB_SPIN(cond, bar) do { unsigned _sp = 0; while (cond) { __builtin_amdgcn_s_sleep(1); \
    if ((++_sp & 255u) == 0u) { if (xb_ld(&(bar)[XB_TMO])) break; if (_sp > XB_SPIN_CAP) { atomicAdd(&(bar)[XB_TMO], 1u); break; } } } } while (0)

__device__ __forceinline__ unsigned xb_tid() { unsigned t = threadIdx.x; asm volatile("" : "+v"(t)); return t; }
struct XcdBarrier {
    unsigned* bar; unsigned x;
    volatile LAS unsigned* st;
};

__device__ __forceinline__ XcdBarrier xcd_barrier_post(unsigned* bar, volatile LAS unsigned* st) {
    XcdBarrier b; b.bar = bar; b.x = xb_xcc_id(); b.st = st;
    if (xb_tid() == 0u) (void)xb_add(&bar[XB_XCNT(b.x)], 1u);
    return b;
}
__device__ __forceinline__ void xcd_barrier_complete(unsigned* bar, unsigned x, unsigned& nloc, unsigned& nx) {
    const unsigned G = gridDim.x * gridDim.y * gridDim.z;
    unsigned sum, cnt, mine, sp = 0u;
    for (;;) {
        sum = 0u; cnt = 0u; mine = 0u;
#pragma unroll
        for (unsigned j = 0; j < 16; ++j) { const unsigned c = xb_ld(&bar[XB_XCNT(j)]); sum += c; cnt += (c > 0u) ? 1u : 0u; mine = (j == x) ? c : mine; }
        if (sum == G) break;
        __builtin_amdgcn_s_sleep(1);
        if ((++sp & 255u) == 0u) { if (xb_ld(&bar[XB_TMO])) break; if (sp > XB_SPIN_CAP) { atomicAdd(&bar[XB_TMO], 1u); break; } }
    }
    nloc = mine > 0u ? mine : 1u; nx = cnt > 0u ? cnt : 1u;
}

__device__ __forceinline__ void xcd_barrier(const XcdBarrier& b) {
    asm volatile("s_waitcnt vmcnt(0)" ::: "memory");
    __syncthreads();
    if (xb_tid() == 0u) {
        unsigned* bar = b.bar;
        __builtin_amdgcn_s_waitcnt(0);
        unsigned nloc = b.st[0], nx = b.st[1];
        if (nloc == 0u) { xcd_barrier_complete(bar, b.x, nloc, nx); b.st[0] = nloc; b.st[1] = nx; }
        const unsigned old = xb_add(&bar[XB_XSUB(b.x)], 1u);
        const unsigned gen = old / nloc;
        if (old + 1u == (gen + 1u) * nloc) {
            __builtin_amdgcn_fence(__ATOMIC_RELEASE, "agent");
            asm volatile("s_waitcnt vmcnt(0)" ::: "memory");
            const unsigned og = xb_add(&bar[XB_TOP], 1u);
            const unsigned tg = og / nx;
            if (og + 1u == (tg + 1u) * nx) xb_add(&bar[XB_TOPGEN], 1u);
            else XB_SPIN(xb_ld(&bar[XB_TOPGEN]) == tg, bar);
            __builtin_amdgcn_fence(__ATOMIC_ACQUIRE, "agent");
            xb_add(&bar[XB_XGEN(b.x)], 1u);
            asm volatile("s_waitcnt vmcnt(0)" ::: "memory");
        } else {
            XB_SPIN(xb_ld(&bar[XB_XGEN(b.x)]) == gen, bar);
            __builtin_amdgcn_fence(__ATOMIC_ACQUIRE, "agent");
            asm volatile("s_waitcnt vmcnt(0)" ::: "memory");
        }
    }
    __syncthreads();
}

struct Params { const float* in[30]; float* out; unsigned char* ws; int ph_lo, ph_hi; };
enum { I_X = 0, I_MEM, I_NORM_MIX, I_W_IN, I_NA_QN, I_NA_KN, I_NA_RPB, I_CQ_N, I_W_UQ, I_CKV_N, I_W_UKV, I_MLA_QN, I_MLA_KN, I_SWA_QN, I_SWA_KN, I_SWA_SINK,
       I_MEM_N, I_MEM_WKV, I_MEM_QN, I_MEM_KN, I_W_BRANCH, I_W_GATE, I_B_GATE, I_W_O, I_NORM_FFN, I_FFN_UP, I_FFN_DN, I_ROUTER, I_MOE_UP, I_MOE_DN };

__device__ __forceinline__ float wave_sum(float v) {
#pragma unroll
    for (int o = 32; o >= 1; o >>= 1) v += __shfl_xor(v, o);
    return v;
}
__device__ __forceinline__ float bf2f(bf16_t b) { return __uint_as_float(((unsigned)b) << 16); }
__device__ __forceinline__ bf16_t f2bf(float f) { return (bf16_t)(pg8::cvt_pk_bf16(f, 0.f) & 0xffffu); }
using pg8::cvt_pk_bf16; using pg8::bflo; using pg8::bfhi;

struct CvtJob { const float* src; bf16_t* dst; int src_ld, K, ntn, tile0, mode, dff; };
constexpr int NJOBS = 40;
__device__ __forceinline__ void make_job(int j, const Params& p, CvtJob& jb) {
    unsigned char* ws = p.ws; jb.mode = 0; jb.dff = 1; jb.tile0 = 0;
    if (j < 22) { const int l = j / 11, k = j % 11; unsigned char* lw = ws + WS_LW + (size_t)l * LW_BYTES;
        if (k == 0) { jb.src = p.in[I_W_IN] + (size_t)l * DM * INC; jb.dst = (bf16_t*)(lw + LW_IN); jb.src_ld = INC; jb.K = DM; jb.ntn = INC / 64; jb.mode = INGATE_FP8 ? 3 : 0; }
        else if (k == 1) { jb.src = p.in[I_W_IN]; jb.dst = (bf16_t*)(lw + LW_IN + (size_t)INC * DM * (INGATE_FP8 ? 1 : 2)); jb.src_ld = INC; jb.K = DM; jb.ntn = (ZC - INC) / 64; jb.mode = INGATE_FP8 ? 5 : 2; }
        else if (k == 2) { jb.src = p.in[I_W_GATE] + (size_t)l * DM * 8192; jb.dst = (bf16_t*)(lw + LW_IN + (size_t)ZC * DM * (INGATE_FP8 ? 1 : 2)); jb.src_ld = 8192; jb.K = DM; jb.ntn = 8192 / 64; jb.mode = INGATE_FP8 ? 3 : 0; }
        else if (k == 3) { jb.src = p.in[I_W_UQ] + (size_t)l * 768 * 768; jb.dst = (bf16_t*)(lw + LW_UQ); jb.src_ld = 768; jb.K = 768; jb.ntn = 768 / 64; }
        else if (k == 4) { jb.src = p.in[I_W_UKV] + (size_t)l * 256 * 1024; jb.dst = (bf16_t*)(lw + LW_UKV); jb.src_ld = 1024; jb.K = 256; jb.ntn = 1024 / 64; }
        else if (k == 5) { jb.src = p.in[I_MEM_WKV] + (size_t)l * DM * 1024; jb.dst = (bf16_t*)(lw + LW_MEMKV); jb.src_ld = 1024; jb.K = DM; jb.ntn = 1024 / 64; }
        else if (k < 10) { const int n = k - 6; jb.src = p.in[I_W_BRANCH] + ((size_t)l * 4 + n) * 512 * DM; jb.dst = (bf16_t*)(lw + LW_BR) + (size_t)n * DM * 512; jb.src_ld = DM; jb.K = 512; jb.ntn = DM / 64; }
        else { jb.src = p.in[I_W_O] + (size_t)l * DM * DM; jb.dst = (bf16_t*)(lw + LW_O); jb.src_ld = DM; jb.K = DM; jb.ntn = DM / 64; }
    } else if (j == 22) { jb.src = p.in[I_FFN_UP]; jb.dst = (bf16_t*)(ws + WS_FFNUP); jb.src_ld = 2 * DFF; jb.K = DM; jb.ntn = 2 * DFF / 64; jb.mode = 1; jb.dff = DFF; }
    else if (j == 23) { jb.src = p.in[I_FFN_DN]; jb.dst = (bf16_t*)(ws + WS_FFNDN); jb.src_ld = DM; jb.K = DFF; jb.ntn = DM / 64; }
    else if (j < 32) { const int e = j - 24; jb.src = p.in[I_MOE_UP] + (size_t)e * DM * 2 * DFFE; jb.dst = (bf16_t*)(ws + WS_MOEUP + (size_t)e * 2 * DFFE * DM * MOE_ES); jb.src_ld = 2 * DFFE; jb.K = DM; jb.ntn = 2 * DFFE / 64; jb.mode = MOE_FP8 ? 4 : 1; jb.dff = DFFE; }
    else { const int e = j - 32; jb.src = p.in[I_MOE_DN] + (size_t)e * DFFE * DM; jb.dst = (bf16_t*)(ws + WS_MOEDN + (size_t)e * DM * DFFE * MOE_ES); jb.src_ld = DM; jb.K = DFFE; jb.ntn = DM / 64; jb.mode = MOE_FP8 ? 3 : 0; }
}

__device__ __forceinline__ void norm_rows(const float* src, const float* g, bf16_t* dst, unsigned char* dst8, int nrows, int wid, int lane) {
    const int nw = gridDim.x * 8;
    for (int row = blockIdx.x * 8 + wid; row < nrows; row += 2 * nw) {
        const int rowb = row + nw; const bool hb = rowb < nrows;
        const f32x4* sa = (const f32x4*)(src + (size_t)row * DM); const f32x4* sb = (const f32x4*)(src + (size_t)(hb ? rowb : row) * DM);
        f32x4 va[8], vb[8]; float ssa = 0.f, ssb = 0.f;
#pragma unroll
        for (int j = 0; j < 8; ++j) { va[j] = sa[lane + 64 * j]; vb[j] = sb[lane + 64 * j]; }
#pragma unroll
        for (int j = 0; j < 8; ++j) { ssa += va[j][0] * va[j][0] + va[j][1] * va[j][1] + va[j][2] * va[j][2] + va[j][3] * va[j][3]; ssb += vb[j][0] * vb[j][0] + vb[j][1] * vb[j][1] + vb[j][2] * vb[j][2] + vb[j][3] * vb[j][3]; }
#pragma unroll
        for (int o = 32; o >= 1; o >>= 1) { ssa += __shfl_xor(ssa, o); ssb += __shfl_xor(ssb, o); }
        const float ra = 1.0f / sqrtf(ssa * (1.0f / DM) + EPS), rb = 1.0f / sqrtf(ssb * (1.0f / DM) + EPS);
#pragma unroll
        for (int j = 0; j < 8; ++j) { const f32x4 gv = ((const f32x4*)g)[lane + 64 * j];
            { const f32x4 y = va[j] * ra * gv; u32x2 w; w.x = cvt_pk_bf16(y[0], y[1]); w.y = cvt_pk_bf16(y[2], y[3]); *(u32x2*)(dst + (size_t)row * DM + 4 * (lane + 64 * j)) = w;
              if (dst8) *(unsigned*)(dst8 + (size_t)row * DM + 4 * (lane + 64 * j)) = pg8::pack_fp8x4(y[0] * SC_ACT8, y[1] * SC_ACT8, y[2] * SC_ACT8, y[3] * SC_ACT8); }
            if (hb) { const f32x4 y = vb[j] * rb * gv; u32x2 w; w.x = cvt_pk_bf16(y[0], y[1]); w.y = cvt_pk_bf16(y[2], y[3]); *(u32x2*)(dst + (size_t)rowb * DM + 4 * (lane + 64 * j)) = w;
              if (dst8) *(unsigned*)(dst8 + (size_t)rowb * DM + 4 * (lane + 64 * j)) = pg8::pack_fp8x4(y[0] * SC_ACT8, y[1] * SC_ACT8, y[2] * SC_ACT8, y[3] * SC_ACT8); } }
    }
}

__device__ __forceinline__ void p0_prologue(const Params& p, LAS unsigned char* lds, int tid, int wid, int lane) {
    LAS CvtJob* jt = (LAS CvtJob*)(lds + 65536);
    LAS int* jtot = (LAS int*)(lds + 65536 + 4096);
    if (tid < NJOBS) { CvtJob jb; make_job(tid, p, jb); jt[tid].src = jb.src; jt[tid].dst = jb.dst; jt[tid].src_ld = jb.src_ld; jt[tid].K = jb.K; jt[tid].ntn = jb.ntn; jt[tid].tile0 = 0; jt[tid].mode = jb.mode; jt[tid].dff = jb.dff; }
    __syncthreads();
    if (tid == 0) { int acc = 0; for (int j = 0; j < NJOBS; ++j) { jt[j].tile0 = acc; acc += (jt[j].K / 128) * jt[j].ntn; } jtot[0] = acc; }
    __syncthreads();
    const int total = jtot[0];
    LAS unsigned* T = (LAS unsigned*)lds;
    const int tq = tid >> 4, nq = tid & 15;
    int j = 0, g = blockIdx.x;
    f32x4 r0, r1, r2, r3; r0 = r1 = r2 = r3 = (f32x4){0.f, 0.f, 0.f, 0.f};
    int c_mode = 2, c_K = 0, c_tn = 0, c_tk = 0, c_dff = 1; bf16_t* c_dst = nullptr;
#define P0_FETCH() do { if (g < total) { while (j + 1 < NJOBS && jt[j + 1].tile0 <= g) ++j; \
        const float* src = (const float*)(__attribute__((address_space(1))) const float*)jt[j].src; const int src_ld = jt[j].src_ld, ntn = jt[j].ntn, local = g - jt[j].tile0; \
        c_mode = jt[j].mode; c_K = jt[j].K; c_dff = jt[j].dff; c_dst = (bf16_t*)(__attribute__((address_space(1))) bf16_t*)jt[j].dst; c_tn = local % ntn; c_tk = local / ntn; \
        if (c_mode != 2 && c_mode != 5) { const bool f8 = c_mode >= 3; const int ra = f8 ? 4 * tq : 2 * tq, rb = ra + 1, rc = f8 ? ra + 2 : ra + 64, rd = rc + 1; \
            const float* sp = src + (size_t)(c_tk * 128) * src_ld + c_tn * 64 + 4 * nq; \
            r0 = __builtin_nontemporal_load((const f32x4*)(sp + (size_t)ra * src_ld)); r1 = __builtin_nontemporal_load((const f32x4*)(sp + (size_t)rb * src_ld)); \
            r2 = __builtin_nontemporal_load((const f32x4*)(sp + (size_t)rc * src_ld)); r3 = __builtin_nontemporal_load((const f32x4*)(sp + (size_t)rd * src_ld)); } } } while (0)
    P0_FETCH();
    while (g < total) {
        const int mode = c_mode, K = c_K, tn = c_tn, tk = c_tk, dff = c_dff; bf16_t* dst = c_dst;
        const f32x4 a0 = r0, a1 = r1, a2 = r2, a3 = r3;
        g += gridDim.x;
        P0_FETCH();
        if (mode == 2) {
#pragma unroll
            for (int it = 0; it < 2; ++it) { const int piece = tid + it * 512, n = piece >> 4, seg = piece & 15;
                *(u32x4*)(dst + (size_t)(tn * 64 + n) * K + tk * 128 + seg * 8) = (u32x4){0u, 0u, 0u, 0u}; }
            continue;
        }
        if (mode == 5) { const int n = tid >> 3, seg = tid & 7; *(u32x4*)((unsigned char*)dst + (size_t)(tn * 64 + n) * K + tk * 128 + seg * 16) = (u32x4){0u, 0u, 0u, 0u}; continue; }
        if (mode >= 3) {
#pragma unroll
            for (int q = 0; q < 4; ++q) T[(4 * nq + q) * 33 + tq] = pg8::pack_fp8x4(a0[q] * SC_W8, a1[q] * SC_W8, a2[q] * SC_W8, a3[q] * SC_W8);
            __syncthreads();
            { const int n = tid >> 3, seg = tid & 7;
              u32x4 w; w.x = T[n * 33 + seg * 4 + 0]; w.y = T[n * 33 + seg * 4 + 1]; w.z = T[n * 33 + seg * 4 + 2]; w.w = T[n * 33 + seg * 4 + 3];
              int drow = tn * 64 + n;
              if (mode == 4) { const int bj = drow / dff, cc = drow - bj * dff; drow = 256 * (cc >> 7) + 128 * bj + (cc & 127); }
              *(u32x4*)((unsigned char*)dst + (size_t)drow * K + tk * 128 + seg * 16) = w; }
            __syncthreads();
            continue;
        }
#pragma unroll
        for (int q = 0; q < 4; ++q) { T[(4 * nq + q) * 65 + tq] = cvt_pk_bf16(a0[q], a1[q]); T[(4 * nq + q) * 65 + tq + 32] = cvt_pk_bf16(a2[q], a3[q]); }
        __syncthreads();
#pragma unroll
        for (int it = 0; it < 2; ++it) { const int piece = tid + it * 512, n = piece >> 4, seg = piece & 15;
            u32x4 w; w.x = T[n * 65 + seg * 4 + 0]; w.y = T[n * 65 + seg * 4 + 1]; w.z = T[n * 65 + seg * 4 + 2]; w.w = T[n * 65 + seg * 4 + 3];
            int drow = tn * 64 + n;
            if (mode == 1) { const int bj = drow / dff, cc = drow - bj * dff; drow = 256 * (cc >> 7) + 128 * bj + (cc & 127); }
            *(u32x4*)(dst + (size_t)drow * K + tk * 128 + seg * 8) = w; }
        __syncthreads();
    }
#undef P0_FETCH
#ifdef PROBE_POISON
    { u32x4* q = (u32x4*)(p.ws + WS_XG); const size_t n1 = (size_t)NEXP * ECAP * DM / 16; for (size_t i = (size_t)blockIdx.x * NTHREADS + tid; i < n1; i += (size_t)gridDim.x * NTHREADS) q[i] = (u32x4){0u, 0u, 0u, 0u};
      q = (u32x4*)(p.ws + WS_ACTM); const size_t n2 = (size_t)NEXP * ECAP * DFFE / 16; for (size_t i = (size_t)blockIdx.x * NTHREADS + tid; i < n2; i += (size_t)gridDim.x * NTHREADS) q[i] = (u32x4){0u, 0u, 0u, 0u}; }
#endif
    { f32x2* rt = (f32x2*)(p.ws + WS_ROPE);
      for (int e = blockIdx.x * NTHREADS + tid; e < SEQ * 32; e += gridDim.x * NTHREADS) { const int pos = e >> 5, i = e & 31;
          const float freq = __builtin_amdgcn_exp2f(-(float)i * (13.287712379549449f / 32.0f));
          const float ang = (float)pos * freq;
          const double rev = (double)ang * 0.15915494309189535; const float fr_ = (float)(rev - __builtin_rint(rev));
          rt[e] = (f32x2){__builtin_amdgcn_cosf(fr_), __builtin_amdgcn_sinf(fr_)}; } }
    norm_rows(p.in[I_MEM], p.in[I_MEM_N], (bf16_t*)(p.ws + WS_MEMN), nullptr, NMEM, wid, lane);
    norm_rows(p.in[I_MEM], p.in[I_MEM_N] + DM, (bf16_t*)(p.ws + WS_MEMN) + (size_t)NMEM * DM, nullptr, NMEM, wid, lane);
    norm_rows(p.in[I_X], p.in[I_NORM_MIX], (bf16_t*)(p.ws + WS_U), p.ws + WS_U8, NTOK, wid, lane);
}

__device__ __forceinline__ void unpack8(const u32x4 w, float (&x)[8]) { x[0] = bflo(w.x); x[1] = bfhi(w.x); x[2] = bflo(w.y); x[3] = bfhi(w.y); x[4] = bflo(w.z); x[5] = bfhi(w.z); x[6] = bflo(w.w); x[7] = bfhi(w.w); }
__device__ __forceinline__ u32x4 pack8(const float (&y)[8]) { u32x4 w; w.x = cvt_pk_bf16(y[0], y[1]); w.y = cvt_pk_bf16(y[2], y[3]); w.z = cvt_pk_bf16(y[4], y[5]); w.w = cvt_pk_bf16(y[6], y[7]); return w; }
__device__ __forceinline__ float sumsq8(const float (&x)[8]) { return (x[0] * x[0] + x[1] * x[1]) + (x[2] * x[2] + x[3] * x[3]) + (x[4] * x[4] + x[5] * x[5]) + (x[6] * x[6] + x[7] * x[7]); }
template <int NL> __device__ __forceinline__ float group_sum(float v) {
#pragma unroll
    for (int o = NL / 2; o >= 1; o >>= 1) v += __shfl_xor(v, o);
    return v;
}
struct Gain8 { f32x4 a, b; };
__device__ __forceinline__ Gain8 ldg8(const float* g) { Gain8 r; r.a = *(const f32x4*)g; r.b = *(const f32x4*)(g + 4); return r; }
__device__ __forceinline__ void scale8(float (&x)[8], float rs, const Gain8& g) { x[0] *= rs * g.a[0]; x[1] *= rs * g.a[1]; x[2] *= rs * g.a[2]; x[3] *= rs * g.a[3]; x[4] *= rs * g.b[0]; x[5] *= rs * g.b[1]; x[6] *= rs * g.b[2]; x[7] *= rs * g.b[3]; }
__device__ __forceinline__ void rope8(float (&y)[8], const f32x4 (&cs)[4], bool upper) {
#pragma unroll
    for (int e = 0; e < 8; ++e) { const float pr = __shfl_xor(y[e], 4); const float c = cs[e >> 1][(e & 1) * 2], s = cs[e >> 1][(e & 1) * 2 + 1]; y[e] = upper ? (y[e] * c + pr * s) : (y[e] * c - pr * s); }
}

__device__ __forceinline__ void prep1(const Params& p, int l, LAS unsigned char* lds, int tid, int wid, int lane) {
    const bf16_t* z = (const bf16_t*)(p.ws + WS_Z);
    bf16_t* naq = (bf16_t*)(p.ws + WS_NAQ); bf16_t* nak = (bf16_t*)(p.ws + WS_NAK); bf16_t* navT = (bf16_t*)(p.ws + WS_NAVT);
    bf16_t* cqn = (bf16_t*)(p.ws + WS_CQN); bf16_t* ckvn = (bf16_t*)(p.ws + WS_CKVN);
    bf16_t* swq = (bf16_t*)(p.ws + WS_SWQ); bf16_t* swk = (bf16_t*)(p.ws + WS_SWK); bf16_t* swvT = (bf16_t*)(p.ws + WS_SWVT); bf16_t* meq = (bf16_t*)(p.ws + WS_MEQ);
    const f32x4* rt4 = (const f32x4*)(p.ws + WS_ROPE);
    const float qs128 = 0.08838834764831845f * LOG2E, qs64 = 0.125f * LOG2E;
    const int l16 = lane & 15, l8 = lane & 7;
    const Gain8 g_naq = ldg8(p.in[I_NA_QN] + l * 128 + 8 * l16), g_nak = ldg8(p.in[I_NA_KN] + l * 128 + 8 * l16), g_meq = ldg8(p.in[I_MEM_QN] + l * 128 + 8 * l16);
    const Gain8 g_cq0 = ldg8(p.in[I_CQ_N] + l * 768 + 8 * lane), g_cq1 = ldg8(p.in[I_CQ_N] + l * 768 + 512 + 8 * (lane & 31)), g_ckv = ldg8(p.in[I_CKV_N] + l * 256 + 8 * (lane & 31));
    const Gain8 g_swq = ldg8(p.in[I_SWA_QN] + l * 64 + 8 * l8), g_swk = ldg8(p.in[I_SWA_KN] + l * 64 + 8 * l8);
    constexpr int VW = 640;
    LAS bf16_t* vt = (LAS bf16_t*)lds;
    const u32x4 zero4 = (u32x4){0u, 0u, 0u, 0u};
    for (int grp = blockIdx.x; grp < NTOK / 32; grp += gridDim.x) {
        const int b = grp >> 6, chunk = grp & 63;
#pragma unroll 2
        for (int ti = 0; ti < 4; ++ti) {
            const int tl = wid * 4 + ti, s = chunk * 32 + tl, token = grp * 32 + tl;
            const bf16_t* zr = z + (size_t)token * ZC;
            const u32x4 w_naq = *(const u32x4*)(zr + Z_NAQ + 8 * lane), w_nak = *(const u32x4*)(zr + Z_NAK + 8 * lane), w_nav = *(const u32x4*)(zr + Z_NAV + 8 * lane), w_meq = *(const u32x4*)(zr + Z_MEQ + 8 * lane);
            const u32x4 w_cq0 = *(const u32x4*)(zr + Z_CQ + 8 * lane); const u32x4 w_cq1 = lane < 32 ? *(const u32x4*)(zr + Z_CQ + 512 + 8 * lane) : zero4;
            const u32x4 w_ckv = lane < 32 ? *(const u32x4*)(zr + Z_CKV + 8 * lane) : zero4;
            const u32x4 w_swq = *(const u32x4*)(zr + Z_SWQ + 8 * lane);
            const u32x4 w_swkv = lane < 32 ? *(const u32x4*)(zr + (lane < 16 ? Z_SWK + 8 * lane : Z_SWV + 8 * (lane - 16))) : zero4;
            f32x4 cs[4];
#pragma unroll
            for (int q = 0; q < 4; ++q) cs[q] = rt4[(s * 32 + (lane & 3) * 8) / 2 + q];
            *(LAS u32x4*)(vt + tl * VW + 8 * lane) = w_nav;
            if (lane >= 16 && lane < 32) *(LAS u32x4*)(vt + tl * VW + 512 + 8 * (lane - 16)) = w_swkv;
            float x[8];
            { unpack8(w_naq, x); const float ss = group_sum<16>(sumsq8(x)); scale8(x, 1.0f / sqrtf(ss * (1.0f / 128) + EPS) * qs128, g_naq);
              *(u32x4*)(naq + ((size_t)(b * 4 + (lane >> 4)) * SEQ + s) * 128 + 8 * l16) = pack8(x); }
            { unpack8(w_nak, x); const float ss = group_sum<16>(sumsq8(x)); scale8(x, 1.0f / sqrtf(ss * (1.0f / 128) + EPS), g_nak);
              *(u32x4*)(nak + ((size_t)(b * 4 + (lane >> 4)) * SEQ + s) * 128 + 8 * l16) = pack8(x); }
            { unpack8(w_meq, x); const float ss = group_sum<16>(sumsq8(x)); scale8(x, 1.0f / sqrtf(ss * (1.0f / 128) + EPS) * qs128, g_meq);
              *(u32x4*)(meq + ((size_t)(b * 4 + (lane >> 4)) * SEQ + s) * 128 + 8 * l16) = pack8(x); }
            { float y[8]; unpack8(w_cq0, x); unpack8(w_cq1, y); const float ss = group_sum<64>(sumsq8(x) + sumsq8(y)); const float rs = 1.0f / sqrtf(ss * (1.0f / 768) + EPS);
              scale8(x, rs, g_cq0); scale8(y, rs, g_cq1);
              *(u32x4*)(cqn + (size_t)token * 768 + 8 * lane) = pack8(x); if (lane < 32) *(u32x4*)(cqn + (size_t)token * 768 + 512 + 8 * lane) = pack8(y); }
            { unpack8(w_ckv, x); const float ss = group_sum<64>(sumsq8(x)); scale8(x, 1.0f / sqrtf(ss * (1.0f / 256) + EPS), g_ckv);
              if (lane < 32) *(u32x4*)(ckvn + (size_t)token * 256 + 8 * lane) = pack8(x); }
            { unpack8(w_swq, x); const float ss = group_sum<8>(sumsq8(x)); scale8(x, 1.0f / sqrtf(ss * (1.0f / 64) + EPS), g_swq); rope8(x, cs, (lane & 4) != 0);
#pragma unroll
              for (int e = 0; e < 8; ++e) x[e] *= qs64;
              *(u32x4*)(swq + ((size_t)(b * 8 + (lane >> 3)) * SEQ + s) * 64 + 8 * l8) = pack8(x); }
            { unpack8(w_swkv, x); const float ss = group_sum<8>(sumsq8(x)); scale8(x, 1.0f / sqrtf(ss * (1.0f / 64) + EPS), g_swk); rope8(x, cs, (lane & 4) != 0);
              if (lane < 16) *(u32x4*)(swk + ((size_t)(b * 2 + (lane >> 3)) * SEQ + s) * 64 + 8 * l8) = pack8(x); }
        }
        __syncthreads();
#pragma unroll 1
        for (int it = 0; it < 5; ++it) { const int item = tid + it * 512, part = item / VW, c = item - part * VW;
            unsigned short e[8];
#pragma unroll
            for (int q = 0; q < 8; ++q) e[q] = vt[(part * 8 + q) * VW + c];
            u32x4 w; w.x = e[0] | ((unsigned)e[1] << 16); w.y = e[2] | ((unsigned)e[3] << 16); w.z = e[4] | ((unsigned)e[5] << 16); w.w = e[6] | ((unsigned)e[7] << 16);
            bf16_t* dp = (c < 512) ? navT + ((((size_t)(b * 4 + (c >> 7)) * 64 + chunk) * 128 + (c & 127)) * 32 + part * 8)
                                   : swvT + ((((size_t)(b * 2 + ((c - 512) >> 6)) * 64 + chunk) * 64 + ((c - 512) & 63)) * 32 + part * 8);
            *(u32x4*)dp = w; }
        __syncthreads();
    }
}

__device__ __forceinline__ void prep2(const Params& p, int l, LAS unsigned char* lds, int tid, int wid, int lane) {
    const bf16_t* z = (const bf16_t*)(p.ws + WS_Z); const bf16_t* qraw = (const bf16_t*)(p.ws + WS_QRAW); const bf16_t* kvraw = (const bf16_t*)(p.ws + WS_KVRAW);
    const bf16_t* memkv = (const bf16_t*)(p.ws + WS_MEMKV) + (size_t)l * NMEM * 1024;
    bf16_t* mlq = (bf16_t*)(p.ws + WS_MLQ); bf16_t* mlk = (bf16_t*)(p.ws + WS_MLK); bf16_t* mlvT = (bf16_t*)(p.ws + WS_MLVT);
    bf16_t* mek = (bf16_t*)(p.ws + WS_MEK); bf16_t* mevT = (bf16_t*)(p.ws + WS_MEVT);
    const f32x4* rt4 = (const f32x4*)(p.ws + WS_ROPE);
    const float qs192 = 0.07216878364870322f * LOG2E;
    const int l16 = lane & 15, l24 = lane < 24 ? lane : 0;
    const Gain8 g_q = ldg8(p.in[I_MLA_QN] + l * 192 + 8 * l24), g_k = ldg8(p.in[I_MLA_KN] + l * 192 + 8 * l24), g_mk = ldg8(p.in[I_MEM_KN] + l * 128 + 8 * l16);
    constexpr int VW = 512;
    LAS bf16_t* vt = (LAS bf16_t*)lds;
    const u32x4 zero4 = (u32x4){0u, 0u, 0u, 0u};
    for (int grp = blockIdx.x; grp < NTOK / 32 + NMEM / 32; grp += gridDim.x) {
        const bool ismem = grp >= NTOK / 32;
        if (!ismem) {
            const int b = grp >> 6, chunk = grp & 63;
#pragma unroll 2
            for (int ti = 0; ti < 4; ++ti) {
                const int tl = wid * 4 + ti, s = chunk * 32 + tl, token = grp * 32 + tl;
                u32x4 wq[4], wk[4];
#pragma unroll
                for (int h = 0; h < 4; ++h) { wq[h] = lane < 24 ? *(const u32x4*)(qraw + (size_t)token * 768 + h * 192 + 8 * lane) : zero4;
                    wk[h] = lane < 16 ? *(const u32x4*)(kvraw + (size_t)token * 1024 + h * 256 + 8 * lane) : (lane < 24 ? *(const u32x4*)(z + (size_t)token * ZC + Z_KPE + 8 * (lane - 16)) : zero4); }
                const u32x4 wv = *(const u32x4*)(kvraw + (size_t)token * 1024 + (lane >> 4) * 256 + 128 + 8 * l16);
                f32x4 cs[4];
#pragma unroll
                for (int q = 0; q < 4; ++q) cs[q] = rt4[(s * 32 + (lane & 3) * 8) / 2 + q];
                *(LAS u32x4*)(vt + tl * VW + (lane >> 4) * 128 + 8 * l16) = wv;
                const bool ropel = lane >= 16 && lane < 24;
#pragma unroll
                for (int h = 0; h < 4; ++h) {
                    float x[8];
                    { unpack8(wq[h], x); const float ss = group_sum<64>(sumsq8(x)); scale8(x, 1.0f / sqrtf(ss * (1.0f / 192) + EPS), g_q);
                      float y[8];
#pragma unroll
                      for (int e = 0; e < 8; ++e) y[e] = x[e];
                      rope8(y, cs, (lane & 4) != 0);
#pragma unroll
                      for (int e = 0; e < 8; ++e) x[e] = (ropel ? y[e] : x[e]) * qs192;
                      if (lane < 24) *(u32x4*)(mlq + ((size_t)(b * 4 + h) * SEQ + s) * 192 + 8 * lane) = pack8(x); }
                    { unpack8(wk[h], x); const float ss = group_sum<64>(sumsq8(x)); scale8(x, 1.0f / sqrtf(ss * (1.0f / 192) + EPS), g_k);
                      float y[8];
#pragma unroll
                      for (int e = 0; e < 8; ++e) y[e] = x[e];
                      rope8(y, cs, (lane & 4) != 0);
#pragma unroll
                      for (int e = 0; e < 8; ++e) x[e] = ropel ? y[e] : x[e];
                      if (lane < 24) *(u32x4*)(mlk + ((size_t)(b * 4 + h) * SEQ + s) * 192 + 8 * lane) = pack8(x); }
                }
            }
            __syncthreads();
#pragma unroll 1
            for (int it = 0; it < 4; ++it) { const int item = tid + it * 512, part = item >> 9, c = item & 511;
                unsigned short e[8];
#pragma unroll
                for (int q = 0; q < 8; ++q) e[q] = vt[(part * 8 + q) * VW + c];
                u32x4 w; w.x = e[0] | ((unsigned)e[1] << 16); w.y = e[2] | ((unsigned)e[3] << 16); w.z = e[4] | ((unsigned)e[5] << 16); w.w = e[6] | ((unsigned)e[7] << 16);
                *(u32x4*)(mlvT + ((((size_t)(b * 4 + (c >> 7)) * 64 + chunk) * 128 + (c & 127)) * 32 + part * 8)) = w; }
            __syncthreads();
        } else {
            const int mg = grp - NTOK / 32, b = mg >> 3, chunk = mg & 7;
#pragma unroll 2
            for (int ti = 0; ti < 4; ++ti) {
                const int tl = wid * 4 + ti, m = chunk * 32 + tl, mt = mg * 32 + tl;
                const bf16_t* mr = memkv + (size_t)mt * 1024;
                const u32x4 wkk = *(const u32x4*)(mr + 8 * lane), wv = *(const u32x4*)(mr + 512 + 8 * lane);
                *(LAS u32x4*)(vt + tl * VW + 8 * lane) = wv;
                float x[8]; unpack8(wkk, x); const float ss = group_sum<16>(sumsq8(x)); scale8(x, 1.0f / sqrtf(ss * (1.0f / 128) + EPS), g_mk);
                *(u32x4*)(mek + ((size_t)(b * 4 + (lane >> 4)) * MEML + m) * 128 + 8 * l16) = pack8(x);
            }
            __syncthreads();
#pragma unroll 1
            for (int it = 0; it < 4; ++it) { const int item = tid + it * 512, part = item >> 9, c = item & 511;
                unsigned short e[8];
#pragma unroll
                for (int q = 0; q < 8; ++q) e[q] = vt[(part * 8 + q) * VW + c];
                u32x4 w; w.x = e[0] | ((unsigned)e[1] << 16); w.y = e[2] | ((unsigned)e[3] << 16); w.z = e[4] | ((unsigned)e[5] << 16); w.w = e[6] | ((unsigned)e[7] << 16);
                *(u32x4*)(mevT + ((((size_t)(b * 4 + (c >> 7)) * 8 + chunk) * 128 + (c & 127)) * 32 + part * 8)) = w; }
            __syncthreads();
        }
    }
}
constexpr int ATT_RPB_OFF = 98304;
template <int DQ, int DV, int MODE, int NQT>
__device__ __forceinline__ void attn_unit(LAS unsigned char* lds, const bf16_t* qp, const bf16_t* kp, const bf16_t* vp, bf16_t* op,
                                          int nsub, int c_lo, int c_hi, int mq0, int mk0, int mr, float sink2, int tid, int lane) {
    constexpr int KROW = DQ * 2 + 16, KBUF = 64 * KROW, VROW = 144, VBUF = DV * VROW, NDC = DQ / 32, NDV = DV / 16, DQ8 = DQ / 8;
    constexpr int KP = 64 * DQ8 / 512, VP = 2 * DV * 4 / 512;
    static_assert(KP * 512 == 64 * DQ8 && VP * 512 == 2 * DV * 4 && 2 * KBUF + 2 * VBUF <= ATT_RPB_OFF, "attention staging geometry");
    const int fr = lane & 15, fq = lane >> 4;
    bf16x8 qf[NQT][NDC];
#pragma unroll
    for (int qt = 0; qt < NQT; ++qt)
#pragma unroll
        for (int dc = 0; dc < NDC; ++dc) qf[qt][dc] = *(const bf16x8*)(qp + (size_t)(qt * 16 + fr) * DQ + dc * 32 + fq * 8);
    f32x4 o[NQT][NDV];
#pragma unroll
    for (int qt = 0; qt < NQT; ++qt)
#pragma unroll
        for (int d = 0; d < NDV; ++d) o[qt][d] = (f32x4){0.f, 0.f, 0.f, 0.f};
    float mrun[NQT], lrun[NQT];
#pragma unroll
    for (int qt = 0; qt < NQT; ++qt) { mrun[qt] = -1e30f; lrun[qt] = 0.f; }
    int kd[KP], vd[VP];
#pragma unroll
    for (int i = 0; i < KP; ++i) { const int pk = tid + i * 512, key = pk / DQ8, dp = pk - key * DQ8, k32 = key & 31;
        kd[i] = (32 * (key >> 5) + 16 * ((k32 >> 2) & 1) + 4 * (k32 >> 3) + (k32 & 3)) * KROW + dp * 16; }
#pragma unroll
    for (int i = 0; i < VP; ++i) { const int pv = tid + i * 512, sub = pv / (DV * 4), r = pv - sub * (DV * 4); vd[i] = (r >> 2) * VROW + sub * 64 + (r & 3) * 16; }
    u32x4 rk[KP], rv[VP];
#pragma unroll
    for (int i = 0; i < KP; ++i) rk[i] = *(const u32x4*)(kp + (size_t)(tid + i * 512) * 8);
#pragma unroll
    for (int i = 0; i < VP; ++i) rv[i] = *(const u32x4*)(vp + (size_t)(tid + i * 512) * 8);
#pragma unroll
    for (int i = 0; i < KP; ++i) *(LAS u32x4*)(lds + kd[i]) = rk[i];
#pragma unroll
    for (int i = 0; i < VP; ++i) *(LAS u32x4*)(lds + 2 * KBUF + vd[i]) = rv[i];
    __syncthreads();
    const int n64 = nsub >> 1;
#pragma unroll 1
    for (int c = 0; c < n64; ++c) {
        const int cur = c & 1; const bool more = (c + 1 < n64);
        if (more) { const bf16_t* kn = kp + (size_t)(c + 1) * 64 * DQ; const bf16_t* vn = vp + (size_t)(c + 1) * 2 * DV * 32;
#pragma unroll
            for (int i = 0; i < KP; ++i) rk[i] = *(const u32x4*)(kn + (size_t)(tid + i * 512) * 8);
#pragma unroll
            for (int i = 0; i < VP; ++i) rv[i] = *(const u32x4*)(vn + (size_t)(tid + i * 512) * 8); }
#pragma unroll 1
        for (int sub = 0; sub < 2; ++sub) {
            const int sc = 2 * c + sub;
            if (sc >= c_lo && sc < c_hi) {
                const LAS unsigned char* kb = lds + cur * KBUF + sub * 32 * KROW; const LAS unsigned char* vb = lds + 2 * KBUF + cur * VBUF + sub * 64;
                f32x4 s[NQT][2];
#pragma unroll
                for (int qt = 0; qt < NQT; ++qt) { s[qt][0] = (f32x4){0.f, 0.f, 0.f, 0.f}; s[qt][1] = (f32x4){0.f, 0.f, 0.f, 0.f}; }
#pragma unroll
                for (int dc = 0; dc < NDC; ++dc) {
                    const bf16x8 k0 = *(const LAS bf16x8*)(kb + fr * KROW + (dc * 32 + fq * 8) * 2);
                    const bf16x8 k1 = *(const LAS bf16x8*)(kb + (16 + fr) * KROW + (dc * 32 + fq * 8) * 2);
#pragma unroll
                    for (int qt = 0; qt < NQT; ++qt) { s[qt][0] = __builtin_amdgcn_mfma_f32_16x16x32_bf16(k0, qf[qt][dc], s[qt][0], 0, 0, 0);
                                                     s[qt][1] = __builtin_amdgcn_mfma_f32_16x16x32_bf16(k1, qf[qt][dc], s[qt][1], 0, 0, 0); }
                }
                bf16x8 pf[NQT];
#pragma unroll
                for (int qt = 0; qt < NQT; ++qt) {
                    if (MODE == 1) {
                        const int qpos = mq0 + qt * 16 + fr, kbase = mk0 + sc * 32 + 8 * fq;
#pragma unroll
                        for (int b = 0; b < 2; ++b)
#pragma unroll
                            for (int i = 0; i < 4; ++i) { const int dd = qpos - (kbase + 4 * b + i); if (dd > 128 || dd < -128) s[qt][b][i] = -1e30f; }
                    } else if (MODE == 2) {
                        const LAS float* rpb = (const LAS float*)(lds + ATT_RPB_OFF);
                        const int qc = mq0 + qt * 16 + fr, kr = mk0 + (sc >> 1), kcb = (sc & 1) * 32 + 8 * fq;
                        int cs = qc - 8; cs = cs < 0 ? 0 : (cs > 48 ? 48 : cs);
                        const int rowoff = (kr - mr + 7) * 31;
#pragma unroll
                        for (int b = 0; b < 2; ++b)
#pragma unroll
                            for (int i = 0; i < 4; ++i) { const int kc = kcb + 4 * b + i; const bool ok = (kc >= cs) && (kc <= cs + 15);
                                int bi = kc - qc + 15; bi = bi < 0 ? 0 : (bi > 30 ? 30 : bi);
                                const float bias = rpb[rowoff + bi];
                                s[qt][b][i] = ok ? s[qt][b][i] + bias : -1e30f; }
                    }
                    float mx = fmaxf(fmaxf(fmaxf(s[qt][0][0], s[qt][0][1]), fmaxf(s[qt][0][2], s[qt][0][3])), fmaxf(fmaxf(s[qt][1][0], s[qt][1][1]), fmaxf(s[qt][1][2], s[qt][1][3])));
                    mx = fmaxf(mx, __shfl_xor(mx, 16)); mx = fmaxf(mx, __shfl_xor(mx, 32));
                    const float mnew = fmaxf(mrun[qt], mx), alpha = __builtin_amdgcn_exp2f(mrun[qt] - mnew); mrun[qt] = mnew;
                    float ps = 0.f;
#pragma unroll
                    for (int b = 0; b < 2; ++b)
#pragma unroll
                        for (int i = 0; i < 4; ++i) { const float e = __builtin_amdgcn_exp2f(s[qt][b][i] - mnew); s[qt][b][i] = e; ps += e; }
                    lrun[qt] = lrun[qt] * alpha + ps;
                    if (__any(alpha != 1.0f)) {
#pragma unroll
                        for (int d = 0; d < NDV; ++d) o[qt][d] *= alpha; }
                    u32x4 w; w.x = cvt_pk_bf16(s[qt][0][0], s[qt][0][1]); w.y = cvt_pk_bf16(s[qt][0][2], s[qt][0][3]); w.z = cvt_pk_bf16(s[qt][1][0], s[qt][1][1]); w.w = cvt_pk_bf16(s[qt][1][2], s[qt][1][3]);
                    pf[qt] = __builtin_bit_cast(bf16x8, w);
                }
#pragma unroll
                for (int d = 0; d < NDV; ++d) {
                    const bf16x8 vf = *(const LAS bf16x8*)(vb + (d * 16 + fr) * VROW + fq * 16);
#pragma unroll
                    for (int qt = 0; qt < NQT; ++qt) o[qt][d] = __builtin_amdgcn_mfma_f32_16x16x32_bf16(vf, pf[qt], o[qt][d], 0, 0, 0);
                }
            }
        }
        if (more) { const int nb = cur ^ 1;
#pragma unroll
            for (int i = 0; i < KP; ++i) *(LAS u32x4*)(lds + nb * KBUF + kd[i]) = rk[i];
#pragma unroll
            for (int i = 0; i < VP; ++i) *(LAS u32x4*)(lds + 2 * KBUF + nb * VBUF + vd[i]) = rv[i]; }
        __syncthreads();
    }
#pragma unroll
    for (int qt = 0; qt < NQT; ++qt) {
        float l = lrun[qt]; l += __shfl_xor(l, 16); l += __shfl_xor(l, 32);
        if (MODE == 1) l += __builtin_amdgcn_exp2f(sink2 - mrun[qt]);
        const float inv = 1.0f / l;
        bf16_t* orow = op + (size_t)(qt * 16 + fr) * DM + 4 * fq;
#pragma unroll
        for (int d = 0; d < NDV; ++d) { u32x2 w; w.x = cvt_pk_bf16(o[qt][d][0] * inv, o[qt][d][1] * inv); w.y = cvt_pk_bf16(o[qt][d][2] * inv, o[qt][d][3] * inv); *(u32x2*)(orow + d * 16) = w; }
    }
}

__device__ __forceinline__ void attn_phase(const Params& p, int lq, LAS unsigned char* lds, int tid, int wid, int lane, int G, int cblk) {
    const int l = lq & 1;
    unsigned* head = (unsigned*)(p.ws + WS_CTL) + CW_ATTQ + lq * 64;
    volatile LAS int* qw = (volatile LAS int*)(lds + LDS_MISC + 64);
    bf16_t* br = (bf16_t*)(p.ws + (lq >= 2 ? WS_ACT : WS_BR));
    for (int id = cblk; id < 256; id += G) {
        const int x = id & 7, j = id >> 3, bhi = x * 2 + (j >> 4), qt16 = j & 15, b = bhi >> 2, h = bhi & 3; const size_t bh = (size_t)bhi;
        const bf16_t* q = (const bf16_t*)(p.ws + WS_MLQ) + (bh * SEQ + qt16 * 128 + wid * 16) * 192;
        const bf16_t* k = (const bf16_t*)(p.ws + WS_MLK) + bh * SEQ * 192; const bf16_t* v = (const bf16_t*)(p.ws + WS_MLVT) + bh * SEQ * 128;
        bf16_t* o = br + (size_t)(b * SEQ + qt16 * 128 + wid * 16) * DM + 512 + h * 128;
        attn_unit<192, 128, 0, 1>(lds, q, k, v, o, 64, 0, 64, 0, 0, 0, 0.f, tid, lane);
    }
    for (;;) {
        if (tid == 0) qw[0] = 256 + (int)__hip_atomic_fetch_add(head, 1u, __ATOMIC_RELAXED, __HIP_MEMORY_SCOPE_AGENT);
        __syncthreads();
        const int id = __builtin_amdgcn_readfirstlane(qw[0]);
        __syncthreads();
        if (id >= 768) break;
        if (id < 256) {
        } else if (id < 384) {
            const int u = id - 256, b = u >> 5, h = (u >> 3) & 3, r4 = u & 7; const size_t bh = (size_t)(b * 4 + h);
            const int r = r4 * 4 + (wid >> 1), half = wid & 1;
            int kr_lo = r4 * 4 - 4; kr_lo = kr_lo < 0 ? 0 : (kr_lo > 24 ? 24 : kr_lo);
            int kr_hi = r4 * 4 + 3 - 4; kr_hi = (kr_hi < 0 ? 0 : (kr_hi > 24 ? 24 : kr_hi)) + 7;
            int rs = r - 4; rs = rs < 0 ? 0 : (rs > 24 ? 24 : rs);
            { const float* rp = p.in[I_NA_RPB] + ((size_t)l * 4 + h) * 15 * 31; LAS float* rl = (LAS float*)(lds + ATT_RPB_OFF); if (tid < 465) rl[tid] = rp[tid] * LOG2E; }
            const bf16_t* q = (const bf16_t*)(p.ws + WS_NAQ) + (bh * SEQ + r * 64 + half * 32) * 128;
            const bf16_t* k = (const bf16_t*)(p.ws + WS_NAK) + (bh * SEQ + kr_lo * 64) * 128; const bf16_t* v = (const bf16_t*)(p.ws + WS_NAVT) + (bh * 64 + kr_lo * 2) * 128 * 32;
            bf16_t* o = br + (size_t)(b * SEQ + r * 64 + half * 32) * DM + 0 + h * 128;
            attn_unit<128, 128, 2, 2>(lds, q, k, v, o, 2 * (kr_hi - kr_lo + 1), 2 * (rs - kr_lo), 2 * (rs - kr_lo) + 16, half * 32, kr_lo, r, 0.f, tid, lane);
        } else if (id < 640) {
            const int u = id - 384, b = u >> 6, kvh = (u >> 5) & 1, qb = u & 31, q0 = qb * 64; const int hq = kvh * 4 + (wid >> 1), qpos0 = q0 + (wid & 1) * 32;
            const int kstart = q0 - 128 < 0 ? 0 : q0 - 128, kend = q0 + 192 > SEQ ? SEQ : q0 + 192, nch = (kend - kstart) >> 5;
            int c_lo = (qpos0 - 128 - kstart) >> 5; c_lo = c_lo < 0 ? 0 : c_lo; int c_hi = ((qpos0 + 159 - kstart) >> 5) + 1; c_hi = c_hi > nch ? nch : c_hi;
            const bf16_t* q = (const bf16_t*)(p.ws + WS_SWQ) + ((size_t)(b * 8 + hq) * SEQ + qpos0) * 64;
            const bf16_t* k = (const bf16_t*)(p.ws + WS_SWK) + ((size_t)(b * 2 + kvh) * SEQ + kstart) * 64; const bf16_t* v = (const bf16_t*)(p.ws + WS_SWVT) + ((size_t)(b * 2 + kvh) * 64 + (kstart >> 5)) * 64 * 32;
            bf16_t* o = br + (size_t)(b * SEQ + qpos0) * DM + 1024 + hq * 64;
            attn_unit<64, 64, 1, 2>(lds, q, k, v, o, nch, c_lo, c_hi, qpos0, kstart, 0, p.in[I_SWA_SINK][l * 8 + hq] * LOG2E, tid, lane);
        } else {
            const int u = id - 640, b = u >> 5, h = (u >> 3) & 3, qt8 = u & 7; const size_t bh = (size_t)(b * 4 + h);
            const bf16_t* q = (const bf16_t*)(p.ws + WS_MEQ) + (bh * SEQ + qt8 * 256 + wid * 32) * 128;
            const bf16_t* k = (const bf16_t*)(p.ws + WS_MEK) + bh * MEML * 128; const bf16_t* v = (const bf16_t*)(p.ws + WS_MEVT) + bh * MEML * 128;
            bf16_t* o = br + (size_t)(b * SEQ + qt8 * 256 + wid * 32) * DM + 1536 + h * 128;
            attn_unit<128, 128, 0, 2>(lds, q, k, v, o, 8, 0, 8, 0, 0, 0, 0.f, tid, lane);
        }
    }
}

__device__ __forceinline__ void router_phase(const Params& p, LAS unsigned char* lds, int tid, int wid, int lane) {
    const float* hres = p.out; const float* g = p.in[I_NORM_FFN] + DM; const float* wr = p.in[I_ROUTER];
    unsigned* cnt = (unsigned*)(p.ws + WS_CTL) + CW_MOECNT;
    unsigned char* xg = p.ws + WS_XG; int* tokv = (int*)(p.ws + WS_TOK); float* wtv = (float*)(p.ws + WS_WT);
    LAS float* wl = (LAS float*)lds;
    LAS float* sel = (LAS float*)(lds + 65536);
    for (int i = tid; i < DM * NEXP; i += NTHREADS) { const int d = i >> 3, e = i & 7; wl[e * DM + d] = wr[i]; }
    __syncthreads();
    for (int grp = blockIdx.x; grp < NTOK / 32; grp += gridDim.x) {
#pragma unroll 1
        for (int ti = 0; ti < 4; ++ti) {
            const int tl = wid * 4 + ti, token = grp * 32 + tl;
            const f32x4* sp = (const f32x4*)(hres + (size_t)token * DM); f32x4 v[8]; float ss = 0.f;
#pragma unroll
            for (int j = 0; j < 8; ++j) { v[j] = sp[lane + 64 * j]; ss += v[j][0] * v[j][0] + v[j][1] * v[j][1] + v[j][2] * v[j][2] + v[j][3] * v[j][3]; }
            ss = wave_sum(ss); const float rstd = 1.0f / sqrtf(ss * (1.0f / DM) + EPS);
            float lg[8];
#pragma unroll
            for (int e = 0; e < 8; ++e) lg[e] = 0.f;
#pragma unroll
            for (int j = 0; j < 8; ++j) { const f32x4 gv = ((const f32x4*)g)[lane + 64 * j]; const f32x4 hn = v[j] * rstd * gv;
#pragma unroll
                for (int e = 0; e < 8; ++e) { const f32x4 w4 = *(const LAS f32x4*)(wl + e * DM + 4 * (lane + 64 * j)); lg[e] += hn[0] * w4[0] + hn[1] * w4[1] + hn[2] * w4[2] + hn[3] * w4[3]; } }
#pragma unroll
            for (int e = 0; e < 8; ++e) lg[e] = wave_sum(lg[e]);
            int i0 = 0; float v0 = lg[0];
#pragma unroll
            for (int e = 1; e < 8; ++e) if (lg[e] > v0) { v0 = lg[e]; i0 = e; }
            int i1 = -1; float v1 = -3.0e38f;
#pragma unroll
            for (int e = 0; e < 8; ++e) if (e != i0 && lg[e] > v1) { v1 = lg[e]; i1 = e; }
            const float e1 = __expf(v1 - v0), w0 = 1.0f / (1.0f + e1), w1 = e1 * w0;
            if (lane == 0) { sel[tl * 8 + 0] = __int_as_float(i0); sel[tl * 8 + 1] = __int_as_float(i1); sel[tl * 8 + 2] = w0; sel[tl * 8 + 3] = w1; sel[tl * 8 + 4] = rstd; }
        }
        __syncthreads();
        if (tid < NEXP) { int n = 0;
            for (int t = 0; t < 32; ++t) { n += (__float_as_int(sel[t * 8 + 0]) == tid) ? 1 : 0; n += (__float_as_int(sel[t * 8 + 1]) == tid) ? 1 : 0; }
            int base = n ? (int)__hip_atomic_fetch_add(cnt + tid * 64, (unsigned)n, __ATOMIC_RELAXED, __HIP_MEMORY_SCOPE_AGENT) : 0;
            for (int t = 0; t < 32; ++t) { if (__float_as_int(sel[t * 8 + 0]) == tid) sel[t * 8 + 5] = __int_as_float(base++); if (__float_as_int(sel[t * 8 + 1]) == tid) sel[t * 8 + 6] = __int_as_float(base++); } }
        __syncthreads();
#pragma unroll 1
        for (int ti = 0; ti < 4; ++ti) {
            const int tl = wid * 4 + ti, token = grp * 32 + tl;
            const int e0 = __float_as_int(sel[tl * 8 + 0]), e1 = __float_as_int(sel[tl * 8 + 1]); const float w0 = sel[tl * 8 + 2], w1 = sel[tl * 8 + 3], rstd = sel[tl * 8 + 4];
            const int s0 = e0 * ECAP + __float_as_int(sel[tl * 8 + 5]), s1 = e1 * ECAP + __float_as_int(sel[tl * 8 + 6]);
            const f32x4* sp = (const f32x4*)(hres + (size_t)token * DM);
#pragma unroll
            for (int j = 0; j < 8; ++j) { const f32x4 x = sp[lane + 64 * j]; const f32x4 gv = ((const f32x4*)g)[lane + 64 * j];
#if MOE_FP8
                const float rg = rstd * SC_ACT8; const unsigned w = pg8::pack_fp8x4(x[0] * rg * gv[0], x[1] * rg * gv[1], x[2] * rg * gv[2], x[3] * rg * gv[3]);
                *(unsigned*)(xg + (size_t)s0 * DM + 4 * (lane + 64 * j)) = w; *(unsigned*)(xg + (size_t)s1 * DM + 4 * (lane + 64 * j)) = w; }
#else
                u32x2 w; w.x = cvt_pk_bf16(x[0] * rstd * gv[0], x[1] * rstd * gv[1]); w.y = cvt_pk_bf16(x[2] * rstd * gv[2], x[3] * rstd * gv[3]);
                *(u32x2*)(xg + ((size_t)s0 * DM + 4 * (lane + 64 * j)) * 2) = w; *(u32x2*)(xg + ((size_t)s1 * DM + 4 * (lane + 64 * j)) * 2) = w; }
#endif
            if (lane == 0) { tokv[s0] = token; wtv[s0] = w0; tokv[s1] = token; wtv[s1] = w1; int* ts = (int*)(p.ws + WS_TSLOT); ts[token * 2] = s0; ts[token * 2 + 1] = s1; }
        }
        __syncthreads();
    }
}

constexpr int MOE_TAB_OFF = LDS_MISC + 128;
__device__ __forceinline__ void moe_table(LAS unsigned char* lds, const unsigned* cnt, int nN, int tid) {
    LAS int* tab = (LAS int*)(lds + MOE_TAB_OFF);
    __syncthreads();
    if (tid == 0) { int acc = 0; for (int e = 0; e < 8; ++e) { const int n = ((int)cnt[e * 64] + 255) >> 8; tab[e] = n; tab[8 + e] = acc; acc += n * nN; } tab[16] = acc; }
    __syncthreads();
}
struct SchedMoe {
    const char* A; const char* B; size_t a_estride, b_estride, a_tstride, b_tstride; const LAS int* tab; int G, c; int ksplit; size_t kbytes;
    __device__ __forceinline__ bool next(int i, pg8::Unit& u) const {
        const int L0 = i * G + c; if (L0 >= tab[16] * ksplit) return false;
        const int ks = L0 % ksplit, L = L0 / ksplit;
        int e = 0;
#pragma unroll
        for (int k = 1; k < 8; ++k) e = (L >= tab[8 + k]) ? k : e;
        const int ne = tab[e], loc = L - tab[8 + e], pm = loc % ne, pn = loc / ne;
        u.A = A + (size_t)e * a_estride + (size_t)pm * a_tstride + (size_t)ks * kbytes; u.B = B + (size_t)e * b_estride + (size_t)pn * b_tstride + (size_t)ks * kbytes;
        u.orow = e * ECAP + pm * 256; u.ocol = pn; u.x0 = e; u.x1 = pm * 256; return true;
    }
};
struct SchedMerge {
    const char* br; const char* wb; int G, c;
    __device__ __forceinline__ bool next(int i, pg8::Unit& u) const {
        int pm, pn; if (!pg8::static_tile(i >> 2, G, c, NTOK / 256, DM / 256, pm, pn)) return false;
        const int n = i & 3;
        u.A = br + ((size_t)pm * 256 * DM + n * 512) * 2; u.B = wb + ((size_t)n * DM * 512 + (size_t)pn * 256 * 512) * 2; u.orow = pm * 256; u.ocol = pn; u.x0 = n; u.x1 = 0; return true;
    }
};

__device__ __forceinline__ void moe_combine(const Params& p, int wid, int lane) {
    const int* ts = (const int*)(p.ws + WS_TSLOT); const bf16_t* y = (const bf16_t*)(p.ws + WS_Y); float* out = p.out;
    for (int row = blockIdx.x * 8 + wid; row < NTOK; row += gridDim.x * 8) {
        const int s0 = ts[row * 2], s1 = ts[row * 2 + 1];
        const u32x4* y0 = (const u32x4*)(y + (size_t)s0 * DM); const u32x4* y1 = (const u32x4*)(y + (size_t)s1 * DM); f32x4* o = (f32x4*)(out + (size_t)row * DM);
        u32x4 a[4], b[4]; f32x4 hv[8];
#pragma unroll
        for (int j = 0; j < 4; ++j) { a[j] = y0[lane + 64 * j]; b[j] = y1[lane + 64 * j]; }
#pragma unroll
        for (int j = 0; j < 4; ++j) { hv[2 * j] = o[2 * (lane + 64 * j)]; hv[2 * j + 1] = o[2 * (lane + 64 * j) + 1]; }
#pragma unroll
        for (int j = 0; j < 4; ++j) {
            f32x4 r0 = hv[2 * j], r1 = hv[2 * j + 1];
            r0[0] += bflo(a[j].x) + bflo(b[j].x); r0[1] += bfhi(a[j].x) + bfhi(b[j].x); r0[2] += bflo(a[j].y) + bflo(b[j].y); r0[3] += bfhi(a[j].y) + bfhi(b[j].y);
            r1[0] += bflo(a[j].z) + bflo(b[j].z); r1[1] += bfhi(a[j].z) + bfhi(b[j].z); r1[2] += bflo(a[j].w) + bflo(b[j].w); r1[3] += bfhi(a[j].w) + bfhi(b[j].w);
            o[2 * (lane + 64 * j)] = r0; o[2 * (lane + 64 * j) + 1] = r1; }
    }
}
constexpr int NPHASE = 23;
constexpr int LDS_PARAMS = LDS_MISC + 256;
template <class T> __device__ __forceinline__ T* uni(T* q) { const unsigned long long v = (unsigned long long)q; const unsigned lo = __builtin_amdgcn_readfirstlane((unsigned)v), hi = __builtin_amdgcn_readfirstlane((unsigned)(v >> 32)); return (T*)(__attribute__((address_space(1))) T*)(((unsigned long long)hi << 32) | lo); }
__device__ __forceinline__ Params load_params(LAS unsigned char* lds) {
    unsigned poff = LDS_PARAMS; asm volatile("" : "+v"(poff)); poff = __builtin_amdgcn_readfirstlane(poff);
    const LAS Params* P = (const LAS Params*)(lds + poff); Params p;
#pragma unroll
    for (int i = 0; i < 30; ++i) p.in[i] = uni(P->in[i]);
    p.out = uni(P->out); p.ws = uni(P->ws); p.ph_lo = __builtin_amdgcn_readfirstlane(P->ph_lo); p.ph_hi = __builtin_amdgcn_readfirstlane(P->ph_hi); return p;
}
#define PH_HEAD int tid = threadIdx.x; asm volatile("" : "+v"(tid)); const Params p = load_params(lds); const int lane = tid & 63, wid = __builtin_amdgcn_readfirstlane(tid >> 6); const int G = p.ph_lo, cblk = p.ph_hi;     \
    unsigned char* ws = p.ws; unsigned* ctl = (unsigned*)(ws + WS_CTL); unsigned char* lw = ws + WS_LW + (size_t)l * LW_BYTES; bf16_t* U = (bf16_t*)(ws + WS_U); (void)lane; (void)wid; (void)G; (void)cblk; (void)ctl; (void)lw; (void)U
#define PHASE_FN static __device__ __forceinline__ void

PHASE_FN ph_prologue(LAS unsigned char* lds, int l) { PH_HEAD; p0_prologue(p, lds, tid, wid, lane); }
PHASE_FN ph_ingate(LAS unsigned char* lds, int l) { PH_HEAD;
#if INGATE_FP8
    pg8::SchedGrid S{(const char*)(ws + WS_U8), (const char*)(lw + LW_IN), DM / 2, DM / 2, NTOK / 256, 12288 / 256, G, cblk};
    pg8::EpiInGate E{(bf16_t*)(ws + WS_Z), (bf16_t*)(ws + WS_GATES), p.in[I_B_GATE] + (size_t)l * 8192, 1.0f / (SC_ACT8 * SC_W8)};
    pg8::gemm_phase<pg8::EpiInGate, pg8::SchedGrid, true>(lds, DM / 2, DM / 2, DM / 2, S, E, tid);
#else
    pg8::SchedGrid S{(const char*)U, (const char*)(lw + LW_IN), DM, DM, NTOK / 256, 12288 / 256, G, cblk};
    pg8::EpiInGate E{(bf16_t*)(ws + WS_Z), (bf16_t*)(ws + WS_GATES), p.in[I_B_GATE] + (size_t)l * 8192, 1.0f};
    pg8::gemm_phase(lds, DM, DM, DM, S, E, tid);
#endif
}
PHASE_FN ph_inproj(LAS unsigned char* lds, int l) { PH_HEAD;
    const bool sh = l >= 2; l &= 1; lw = ws + WS_LW + (size_t)l * LW_BYTES;
    pg8::SchedGrid S{(const char*)U, (const char*)(lw + LW_IN), DM, DM, NTOK / 256, ZC / 256, G, cblk};
    pg8::EpiBf16 E{(bf16_t*)(ws + (sh ? WS_ACT : WS_Z)), ZC};
    pg8::gemm_phase(lds, DM, DM, DM, S, E, tid); }
PHASE_FN ph_gates(LAS unsigned char* lds, int l) { PH_HEAD;
#if GATES_FP8
    pg8::SchedGrid S{(const char*)(ws + WS_U8), (const char*)(lw + LW_GATE8), DM / 2, DM / 2, NTOK / 256, 8192 / 256, G, cblk};
    pg8::EpiGates E{(bf16_t*)(ws + WS_GATES), p.in[I_B_GATE] + (size_t)l * 8192, 1.0f / (SC_ACT8 * SC_W8)};
    pg8::gemm_phase<pg8::EpiGates, pg8::SchedGrid, true>(lds, DM / 2, DM / 2, DM / 2, S, E, tid);
#else
    pg8::SchedGrid S{(const char*)U, (const char*)(lw + LW_GATE8), DM, DM, NTOK / 256, 8192 / 256, G, cblk};
    pg8::EpiGates E{(bf16_t*)(ws + WS_GATES), p.in[I_B_GATE] + (size_t)l * 8192, 1.0f};
    pg8::gemm_phase<pg8::EpiGates, pg8::SchedGrid, false>(lds, DM, DM, DM, S, E, tid);
#endif
}
PHASE_FN ph_prep1(LAS unsigned char* lds, int l) { PH_HEAD; prep1(p, l, lds, tid, wid, lane); }
PHASE_FN ph_mlaup_q(LAS unsigned char* lds, int l) { PH_HEAD;
    pg8::SchedGrid S{(const char*)(ws + WS_CQN), (const char*)(lw + LW_UQ), 768, 768, NTOK / 256, 3, G, cblk};
    pg8::EpiBf16 E{(bf16_t*)(ws + WS_QRAW), 768}; pg8::gemm_phase(lds, 768, 768, 768, S, E, tid); }
PHASE_FN ph_mlaup_kv(LAS unsigned char* lds, int l) { PH_HEAD;
    pg8::SchedGrid S{(const char*)(ws + WS_CKVN), (const char*)(lw + LW_UKV), 256, 256, NTOK / 256, 4, G, (cblk + G - 96 % G) % G};
    pg8::EpiBf16 E{(bf16_t*)(ws + WS_KVRAW), 1024}; pg8::gemm_phase(lds, 256, 256, 256, S, E, tid); }
PHASE_FN ph_memkv(LAS unsigned char* lds, int l) { PH_HEAD;
    pg8::SchedGrid S{(const char*)(ws + WS_MEMN + (size_t)l * NMEM * DM * 2), (const char*)(lw + LW_MEMKV), DM, DM, NMEM / 256, 4, G, (cblk + G - (224 + 16 * l) % G) % G};
    pg8::EpiBf16 E{(bf16_t*)(ws + WS_MEMKV) + (size_t)l * NMEM * 1024, 1024}; pg8::gemm_phase(lds, DM, DM, DM, S, E, tid); }
PHASE_FN ph_prep2(LAS unsigned char* lds, int l) { PH_HEAD; prep2(p, l, lds, tid, wid, lane); }
PHASE_FN ph_attn(LAS unsigned char* lds, int l) { PH_HEAD; attn_phase(p, l, lds, tid, wid, lane, G, cblk); }
PHASE_FN ph_merge(LAS unsigned char* lds, int l) { PH_HEAD;
    SchedMerge S{(const char*)(ws + WS_BR), (const char*)(lw + LW_BR), G, cblk};
    pg8::EpiMerge E{(const bf16_t*)(ws + WS_GATES), (bf16_t*)(ws + WS_MERGED)};
    pg8::gemm_phase(lds, DM, 512, 512, S, E, tid); }
PHASE_FN ph_wo(LAS unsigned char* lds, int l) { PH_HEAD;
    pg8::SchedGrid S{(const char*)(ws + WS_MERGED), (const char*)(lw + LW_O), DM, DM, NTOK / 256, DM / 256, G, cblk};
    pg8::EpiResF32 E{l == 0 ? p.in[I_X] : (const float*)p.out, p.out};
    pg8::gemm_phase(lds, DM, DM, DM, S, E, tid); }
PHASE_FN ph_norm(LAS unsigned char* lds, int l) { PH_HEAD;
    norm_rows(p.out, l == 0 ? p.in[I_NORM_FFN] : p.in[I_NORM_MIX] + DM, U, l == 0 ? nullptr : ws + WS_U8, NTOK, wid, lane); }
PHASE_FN ph_ffnup(LAS unsigned char* lds, int l) { PH_HEAD;
    pg8::SchedGrid S{(const char*)U, (const char*)(ws + WS_FFNUP), DM, DM, NTOK / 256, 2 * DFF / 256, G, cblk};
    pg8::EpiSwiGLU E{(bf16_t*)(ws + WS_ACT), DFF};
    pg8::gemm_phase(lds, DM, DM, DM, S, E, tid); }
PHASE_FN ph_ffndown(LAS unsigned char* lds, int l) { PH_HEAD;
    pg8::SchedGrid S{(const char*)(ws + WS_ACT), (const char*)(ws + WS_FFNDN), DFF, DFF, NTOK / 256, DM / 256, G, cblk};
    pg8::EpiResF32 E{(const float*)p.out, p.out};
    pg8::gemm_phase(lds, DFF, DFF, DFF, S, E, tid); }
PHASE_FN ph_router(LAS unsigned char* lds, int l) { PH_HEAD; router_phase(p, lds, tid, wid, lane); }
PHASE_FN ph_moeup(LAS unsigned char* lds, int l) { PH_HEAD;
    moe_table(lds, ctl + CW_MOECNT, 2 * DFFE / 256, tid);
    const SchedMoe S{(const char*)(ws + WS_XG), (const char*)(ws + WS_MOEUP), (size_t)ECAP * DM * MOE_ES, (size_t)2 * DFFE * DM * MOE_ES, (size_t)256 * DM * MOE_ES, (size_t)256 * DM * MOE_ES, (const LAS int*)(lds + MOE_TAB_OFF), G, cblk, 1, 0};
#if MOE_FP8
    pg8::EpiSwiGLU8 E{ws + WS_ACTM, DFFE, 1.0f / (SC_ACT8 * SC_W8), SC_H8};
    pg8::gemm_phase<pg8::EpiSwiGLU8, SchedMoe, true>(lds, DM / 2, DM / 2, DM / 2, S, E, tid);
#else
    pg8::EpiSwiGLU E{(bf16_t*)(ws + WS_ACTM), DFFE};
    pg8::gemm_phase(lds, DM, DM, DM, S, E, tid);
#endif
}
#ifndef MOE_KSPLIT
#define MOE_KSPLIT 1
#endif
PHASE_FN ph_moedown(LAS unsigned char* lds, int l) { PH_HEAD;
    moe_table(lds, ctl + CW_MOECNT, DM / 256, tid);
    const SchedMoe S{(const char*)(ws + WS_ACTM), (const char*)(ws + WS_MOEDN), (size_t)ECAP * DFFE * MOE_ES, (size_t)DM * DFFE * MOE_ES, (size_t)256 * DFFE * MOE_ES, (size_t)256 * DFFE * MOE_ES, (const LAS int*)(lds + MOE_TAB_OFF), G, cblk, MOE_KSPLIT, (size_t)DFFE * MOE_ES / MOE_KSPLIT};
#if MOE_FP8
    pg8::EpiMoeDownY E{(bf16_t*)(ws + WS_Y), (const float*)(ws + WS_WT), ctl + CW_MOECNT, 1.0f / (SC_H8 * SC_W8)};
    pg8::gemm_phase<pg8::EpiMoeDownY, SchedMoe, true>(lds, DFFE / 2, DFFE / 2, DFFE / 2 / MOE_KSPLIT, S, E, tid);
#else
    pg8::EpiMoeDown E{p.out, (const int*)(ws + WS_TOK), (const float*)(ws + WS_WT), ctl + CW_MOECNT, 1.0f};
    pg8::gemm_phase(lds, DFFE, DFFE, DFFE / MOE_KSPLIT, S, E, tid);
#endif
}


#ifndef PROBE_CHK
#define PROBE_CHK 0
#endif
constexpr int CW_CHKFLAG = 4096 + 2048;
PHASE_FN ph_compare(LAS unsigned char* lds, int l, size_t offa, size_t offb, size_t nbytes) { PH_HEAD;
    const u32x4* a = (const u32x4*)(ws + offa); const u32x4* b = (const u32x4*)(ws + offb); unsigned bad = 0;
    for (size_t i = (size_t)cblk * NTHREADS + tid; i < nbytes / 16; i += (size_t)G * NTHREADS) { const u32x4 x = a[i], y = b[i]; bad |= (x.x ^ y.x) | (x.y ^ y.y) | (x.z ^ y.z) | (x.w ^ y.w); }
    if (bad) atomicOr(ctl + CW_CHKFLAG, 1u); }
PHASE_FN ph_poison(LAS unsigned char* lds, int l) { PH_HEAD;
    if (__hip_atomic_load(ctl + CW_CHKFLAG, __ATOMIC_RELAXED, __HIP_MEMORY_SCOPE_AGENT) != 0u && tid == 0) p.out[cblk] = __builtin_nanf(""); }
PHASE_FN ph_combine(LAS unsigned char* lds, int l) { PH_HEAD; moe_combine(p, wid, lane); }
__global__ void __launch_bounds__(NTHREADS, 2) mk_fwd(Params pk) {
    extern __shared__ __attribute__((aligned(16))) unsigned char lds_raw[];
    LAS unsigned char* lds = (LAS unsigned char*)lds_raw;
    const int tid = threadIdx.x;
    if (tid < 64) ((LAS unsigned*)(lds + LDS_MISC))[tid] = 0u;
    if (tid == 64) { LAS Params* P = (LAS Params*)(lds + LDS_PARAMS);
#pragma unroll
        for (int i = 0; i < 30; ++i) P->in[i] = pk.in[i];
        P->out = pk.out; P->ws = pk.ws; P->ph_lo = (int)gridDim.x; P->ph_hi = (int)blockIdx.x; }
    __syncthreads();
    unsigned* ctl = (unsigned*)(pk.ws + WS_CTL);
#if !MK_MULTI
    (void)xcd_barrier_post(ctl + CW_BAR, (volatile LAS unsigned*)(lds + LDS_MISC));
#endif
#ifdef ONLY_FN
    ONLY_FN(lds, pk.ph_lo); return;
#endif
    const int lo = pk.ph_lo, hi = pk.ph_hi;
#define IN(k) (lo <= (k) && (k) < hi)
#if MK_MULTI
#define SEAM(k) do { } while (0)
#else
#ifndef PROBE_BAR
#define PROBE_BAR 0
#endif
#define SEAM(k) do { for (int rep_ = 0; rep_ < 1 + PROBE_BAR; ++rep_) if (IN((k) + 1)) { const Params q_ = load_params(lds); XcdBarrier b2_; b2_.bar = (unsigned*)(q_.ws + WS_CTL) + CW_BAR; b2_.x = xb_xcc_id(); b2_.st = (volatile LAS unsigned*)(lds + LDS_MISC); xcd_barrier(b2_); } } while (0)
#endif
#ifndef PROBE_P0
#define PROBE_P0 0
#endif
#ifndef PROBE_ATTN
#define PROBE_ATTN 0
#endif
#ifndef PROBE_THIN
#define PROBE_THIN 0
#endif
    if (IN(0)) { ph_prologue(lds, 0); if (PROBE_P0) { __syncthreads(); ph_prologue(lds, 0); } SEAM(0); }
#pragma unroll 1
    for (int l = 0; l < DEPTH; ++l) {
        const int pb = 1 + 11 * l;
#ifndef SPLIT_INGATE
#define SPLIT_INGATE 0
#endif
        if (IN(pb + 0)) { if (SPLIT_INGATE == 1) { ph_inproj(lds, l); __syncthreads(); ph_gates(lds, l); } else if (SPLIT_INGATE == 2) { ph_ingate(lds, l); SEAM(pb + 0); ph_inproj(lds, l); } else if (SPLIT_INGATE == 3) { ph_ingate(lds, l); SEAM(pb + 0); ph_gates(lds, l); } else ph_ingate(lds, l); if (PROBE_CHK == 2) ph_inproj(lds, l + 2); SEAM(pb + 0);
            if (PROBE_CHK == 2) { ph_compare(lds, l, WS_Z, WS_ACT, (size_t)NTOK * ZC * 2); SEAM(pb + 0); } }
        if (IN(pb + 1)) { ph_prep1(lds, l); if (PROBE_THIN) { __syncthreads(); ph_prep1(lds, l); } SEAM(pb + 1); }
        if (IN(pb + 2)) { ph_mlaup_q(lds, l); ph_mlaup_kv(lds, l); if (l == 0) { ph_memkv(lds, 0); ph_memkv(lds, 1); } SEAM(pb + 2); }
        if (IN(pb + 3)) { ph_prep2(lds, l); if (PROBE_THIN) { __syncthreads(); ph_prep2(lds, l); } SEAM(pb + 3); }
        if (IN(pb + 4)) { ph_attn(lds, l); if (PROBE_ATTN || PROBE_CHK == 1) { __syncthreads(); ph_attn(lds, l + 2); } SEAM(pb + 4);
            if (PROBE_CHK == 1) { ph_compare(lds, l, WS_BR, WS_ACT, (size_t)NTOK * DM * 2); SEAM(pb + 4); } }
        if (IN(pb + 5)) { ph_merge(lds, l); SEAM(pb + 5); }
        if (IN(pb + 6)) { ph_wo(lds, l); SEAM(pb + 6); }
        if (l == 0) {
            if (IN(pb + 7)) { ph_norm(lds, 0); if (PROBE_THIN) { __syncthreads(); ph_norm(lds, 0); } SEAM(pb + 7); }
            if (IN(pb + 8)) { ph_ffnup(lds, 0); SEAM(pb + 8); }
            if (IN(pb + 9)) { ph_ffndown(lds, 0); SEAM(pb + 9); }
            if (IN(pb + 10)) { ph_norm(lds, 1); if (PROBE_THIN) { __syncthreads(); ph_norm(lds, 1); } SEAM(pb + 10); }
        } else {
            if (IN(pb + 7)) { ph_router(lds, 1); SEAM(pb + 7); }
            if (IN(pb + 8)) { ph_moeup(lds, 1); SEAM(pb + 8); }
            if (IN(pb + 9)) { ph_moedown(lds, 1); SEAM(pb + 8); ph_combine(lds, 1); if (PROBE_CHK) { SEAM(pb + 8); ph_poison(lds, 1); } }
        }
    }
#undef IN
#undef SEAM
}

extern "C" void kernel_launch(void* const* d_in, const int* in_sizes, int n_in, void* d_out, int out_size, void* d_ws, size_t ws_size, hipStream_t stream) {
    static int grid = 0;
    if (grid == 0) {
        if (n_in != 30 || out_size != NTOK * DM || ws_size < WS_END) { fprintf(stderr, "kernel_launch: unexpected problem (n_in %d, out %d, ws %zu < %zu)\n", n_in, out_size, ws_size, (size_t)WS_END); grid = -1; return; }
        int dev = 0, cus = 0, per_cu = 0;
        if (hipGetDevice(&dev) != hipSuccess || hipDeviceGetAttribute(&cus, hipDeviceAttributeMultiprocessorCount, dev) != hipSuccess) { grid = -1; return; }
        if (hipFuncSetAttribute((const void*)mk_fwd, hipFuncAttributeMaxDynamicSharedMemorySize, LDS_BYTES) != hipSuccess) { fprintf(stderr, "kernel_launch: hipFuncSetAttribute failed\n"); grid = -1; return; }
        if (hipOccupancyMaxActiveBlocksPerMultiprocessor(&per_cu, (const void*)mk_fwd, NTHREADS, LDS_BYTES) != hipSuccess || per_cu < 1) fprintf(stderr, "kernel_launch: occupancy query reports %d\n", per_cu);
        (void)hipGetLastError();
        grid = cus;
    }
    if (grid < 0) return;
    if (hipMemsetAsync((char*)d_ws + WS_CTL, 0, CTL_BYTES, stream) != hipSuccess) return;
    Params a{};
    for (int i = 0; i < 30; ++i) a.in[i] = (const float*)d_in[i];
    a.out = (float*)d_out; a.ws = (unsigned char*)d_ws;
#if MK_MULTI
    for (int ph = 0; ph < NPHASE - 1; ++ph) { a.ph_lo = ph; a.ph_hi = ph + 1; hipLaunchKernelGGL(mk_fwd, dim3(grid), dim3(NTHREADS), LDS_BYTES, stream, a); }
#else
    a.ph_lo = 0; a.ph_hi = NPHASE;
    hipLaunchKernelGGL(mk_fwd, dim3(grid), dim3(NTHREADS), LDS_BYTES, stream, a);
#endif
    const hipError_t le = hipPeekAtLastError();
    if (le != hipSuccess) fprintf(stderr, "kernel_launch: launch failed: %s\n", hipGetErrorName(le));
}
```

```cpp
#include <hip/hip_runtime.h>
#include <cstdio>
#include <cstdint>

#define LAS __attribute__((address_space(3)))
typedef unsigned short bf16_t;
typedef short bf16x8 __attribute__((ext_vector_type(8)));
typedef float f32x4 __attribute__((ext_vector_type(4)));
typedef float f32x2 __attribute__((ext_vector_type(2)));
typedef unsigned u32x4 __attribute__((ext_vector_type(4)));
typedef unsigned u32x2 __attribute__((ext_vector_type(2)));

#ifndef MK_MULTI
#define MK_MULTI 0
#endif

constexpr int DM = 2048, NBATCH = 4, SEQ = 2048, NTOK = NBATCH * SEQ, MEML = 256, NMEM = NBATCH * MEML, DEPTH = 2;
constexpr int ZC = 4096;
constexpr int INC = 3904;
constexpr int Z_NAQ = 0, Z_NAK = 512, Z_NAV = 1024, Z_CQ = 1536, Z_CKV = 2304, Z_KPE = 2560, Z_SWQ = 2624, Z_SWK = 3136, Z_SWV = 3264, Z_MEQ = 3392;
constexpr int DFF = 5632, NEXP = 8, DFFE = 7168, ECAP = 8192;
constexpr float LOG2E = 1.4426950408889634f;
constexpr float EPS = 1e-6f;
constexpr int NTHREADS = 512;
constexpr float SC_ACT8 = 16.0f, SC_W8 = 64.0f, SC_H8 = 8.0f;

constexpr size_t al256(size_t x) { return (x + 255) & ~(size_t)255; }
constexpr size_t WS_CTL = 0, CTL_BYTES = 65536;
constexpr size_t WS_ROPE = WS_CTL + CTL_BYTES;
constexpr size_t WS_LW = WS_ROPE + (size_t)SEQ * 32 * 8;
constexpr size_t LW_IN = 0;
constexpr size_t LW_GATE8 = LW_IN + (size_t)4096 * 2048 * 2;
#ifndef INGATE_FP8
#define INGATE_FP8 1
#endif
#define GATES_FP8 0
#ifndef MOE_FP8
#define MOE_FP8 1
#endif
constexpr size_t MOE_ES = MOE_FP8 ? 1 : 2;
constexpr size_t LW_UQ = LW_GATE8 + (size_t)8192 * 2048 * 2;
constexpr size_t LW_UKV = LW_UQ + (size_t)768 * 768 * 2;
constexpr size_t LW_MEMKV = LW_UKV + (size_t)1024 * 256 * 2;
constexpr size_t LW_BR = LW_MEMKV + (size_t)1024 * 2048 * 2;
constexpr size_t LW_O = LW_BR + (size_t)4 * 2048 * 512 * 2;
constexpr size_t LW_BYTES = LW_O + (size_t)2048 * 2048 * 2;
constexpr size_t WS_FFNUP = WS_LW + 2 * LW_BYTES;
constexpr size_t WS_FFNDN = WS_FFNUP + (size_t)2 * DFF * 2048 * 2;
constexpr size_t WS_MOEUP = WS_FFNDN + (size_t)2048 * DFF * 2;
constexpr size_t WS_MOEDN = WS_MOEUP + (size_t)NEXP * 2 * DFFE * 2048 * MOE_ES;
constexpr size_t WS_U = WS_MOEDN + (size_t)NEXP * 2048 * DFFE * MOE_ES;
constexpr size_t WS_U8 = WS_U + (size_t)NTOK * DM * 2;
constexpr size_t WS_MEMN = WS_U8 + (size_t)NTOK * DM;
constexpr size_t WS_Z = WS_MEMN + (size_t)2 * NMEM * DM * 2;
constexpr size_t WS_GATES = WS_Z + (size_t)NTOK * ZC * 2;
constexpr size_t WS_NAQ = WS_GATES + (size_t)NTOK * 8192 * 2;
constexpr size_t WS_NAK = WS_NAQ + (size_t)NTOK * 512 * 2;
constexpr size_t WS_NAVT = WS_NAK + (size_t)NTOK * 512 * 2;
constexpr size_t WS_CQN = WS_NAVT + (size_t)NTOK * 512 * 2;
constexpr size_t WS_CKVN = WS_CQN + (size_t)NTOK * 768 * 2;
constexpr size_t WS_SWQ = WS_CKVN + (size_t)NTOK * 256 * 2;
constexpr size_t WS_SWK = WS_SWQ + (size_t)NTOK * 512 * 2;
constexpr size_t WS_SWVT = WS_SWK + (size_t)NTOK * 128 * 2;
constexpr size_t WS_MEQ = WS_SWVT + (size_t)NTOK * 128 * 2;
constexpr size_t WS_QRAW = WS_MEQ + (size_t)NTOK * 512 * 2;
constexpr size_t WS_KVRAW = WS_QRAW + (size_t)NTOK * 768 * 2;
constexpr size_t WS_MEMKV = WS_KVRAW + (size_t)NTOK * 1024 * 2;
constexpr size_t WS_MLQ = WS_MEMKV + (size_t)2 * NMEM * 1024 * 2;
constexpr size_t WS_MLK = WS_MLQ + (size_t)NTOK * 768 * 2;
constexpr size_t WS_MLVT = WS_MLK + (size_t)NTOK * 768 * 2;
constexpr size_t WS_MEK = WS_MLVT + (size_t)NTOK * 512 * 2;
constexpr size_t WS_MEVT = WS_MEK + (size_t)NMEM * 512 * 2;
constexpr size_t WS_BR = WS_MEVT + (size_t)NMEM * 512 * 2;
constexpr size_t WS_MERGED = WS_BR + (size_t)NTOK * DM * 2;
constexpr size_t WS_ACT = WS_MERGED + (size_t)NTOK * DM * 2;
constexpr size_t WS_XG = WS_ACT + (size_t)NTOK * DFF * 2;
constexpr size_t WS_TOK = WS_XG + (size_t)NEXP * ECAP * DM * MOE_ES;
constexpr size_t WS_WT = WS_TOK + (size_t)NEXP * ECAP * 4;
constexpr size_t WS_ACTM = WS_WT + (size_t)NEXP * ECAP * 4;
constexpr size_t WS_Y = WS_ACTM + (size_t)NEXP * ECAP * DFFE * MOE_ES;
constexpr int MOE_KS = 2;
constexpr size_t WS_TSLOT = WS_Y + (size_t)MOE_KS * NEXP * ECAP * DM * 2;
constexpr size_t WS_END = WS_TSLOT + (size_t)NTOK * 2 * 4;

constexpr int CW_BAR = 0;
constexpr int CW_MOECNT = 4096;
constexpr int CW_ATTQ = 4096 + 1024;

constexpr int LDS_BYTES = 147456;
constexpr int LDS_MISC = 147456 - 1024;
namespace pg8 {
constexpr int BM = 256, BK = 64, HALF = 128, HTB = HALF * BK * 2, STAGE_BYTES = 8 * HTB, NXCD = 8, WGM = 8;
__host__ __device__ __forceinline__ int lds_byte(int r, int c) { const int st = (r >> 4) * 2 + (c >> 5), rr = r & 15, cc = c & 31, ob = rr * 64 + cc * 2; return st * 1024 + (ob ^ (((ob >> 9) & 1) << 5)); }
__host__ __device__ __forceinline__ void stage_rc(int b, int& R, int& C) { const int st = b / 1024, sb = b % 1024, swz = sb ^ (((sb >> 9) & 1) << 5); R = (st >> 1) * 16 + swz / 64; C = (st & 1) * 32 + (swz % 64) / 2; }
__host__ __device__ __forceinline__ int perm32(int rho) { const int n = rho >> 4, i = rho & 15; return 8 * (i >> 2) + 4 * n + (i & 3); }

struct Unit { const char* A; const char* B; int orow, ocol, x0, x1, ks, pad_; };

__device__ __forceinline__ bool static_tile(int i, int G, int c, int nM, int nN, int& pm, int& pn) {
    const int nwg = nM * nN; const long L = (long)i * G + c; if (L >= nwg) return false;
    int wgid = (int)L; { const int q = nwg / NXCD, r = nwg % NXCD, xcd = wgid % NXCD, off = wgid / NXCD; wgid = (xcd < r ? xcd * (q + 1) : r * (q + 1) + (xcd - r) * q) + off; }
    const int nig = WGM * nN, gid = wgid / nig, fm = gid * WGM, gsz = (nM - fm) < WGM ? (nM - fm) : WGM;
    pm = fm + ((wgid % nig) % gsz); pn = (wgid % nig) / gsz; return true;
}
struct SchedGrid {
    const char* A; const char* B; int lda, ldb, nM, nN, G, c;
    __device__ __forceinline__ bool next(int i, Unit& u) const {
        int pm, pn; if (!static_tile(i, G, c, nM, nN, pm, pn)) return false;
        u.A = A + (size_t)pm * 256 * lda * 2; u.B = B + (size_t)pn * 256 * ldb * 2; u.orow = pm * 256; u.ocol = pn; u.x0 = 0; u.x1 = 0; u.ks = 0; u.pad_ = 0; return true;
    }
};

__device__ __forceinline__ unsigned cvt_pk_bf16(float lo, float hi) { unsigned r; asm volatile("v_cvt_pk_bf16_f32 %0, %1, %2" : "=v"(r) : "v"(lo), "v"(hi)); return r; }
__device__ __forceinline__ float sigmoidf_(float x) { return __builtin_amdgcn_rcpf(1.0f + __builtin_amdgcn_exp2f(-x * LOG2E)); }

typedef f32x4 Acc[2][2][4][2];

typedef int i32x8 __attribute__((ext_vector_type(8)));
typedef int i32x4 __attribute__((ext_vector_type(4)));
template <class Epi, class Sched, bool FP8 = false, bool ALIGN_EPI = true>
__device__ __forceinline__ void gemm_phase(LAS unsigned char* lds, const int lda, const int ldb, const int K, const Sched S, Epi& E, const int tid) {
    const int wid = __builtin_amdgcn_readfirstlane(tid >> 6), lane = tid & 63, wr = wid >> 2, wc = wid & 3, fr = lane & 15, fq = lane >> 4;
    const int nt = K / BK;
    unsigned voffA[2], voffB[2];
#pragma unroll
    for (int i = 0; i < 2; ++i) { int R, C; stage_rc(tid * 16 + i * 8192, R, C); const int Rb = Epi::PERM ? ((R & ~31) + perm32(R & 31)) : R;
        voffA[i] = (unsigned)(R * lda + C) * 2u; voffB[i] = (unsigned)(Rb * ldb + C) * 2u; }
    const size_t kstep = (size_t)(BK * 2);
    const size_t hstepA = (size_t)HALF * lda * 2, hstepB = (size_t)HALF * ldb * 2;
    const unsigned ldsw = (unsigned)wid * 1024u;
    const int aoff = lds_byte(wr * 64 + fr, fq * 8), boff = lds_byte(wc * 32 + fr, fq * 8);
#define PG8_SA(b, h) (((b) * 2 + (h)) * HTB)
#define PG8_SB(b, h) ((4 + (b) * 2 + (h)) * HTB)
#define PG8_STAGE(bufoff, gbase, voff) do { _Pragma("unroll") for (int _i = 0; _i < 2; ++_i) \
        __builtin_amdgcn_global_load_lds((const unsigned*)((const char*)(gbase) + (voff)[_i]), (LAS unsigned*)(lds + (bufoff) + ldsw + _i * 8192), 16, 0, 0); } while (0)
#define PG8_LDA(dst, b, h) do { _Pragma("unroll") for (int m = 0; m < 4; ++m) _Pragma("unroll") for (int k = 0; k < 2; ++k) dst[m][k] = *(const LAS bf16x8*)(lds + PG8_SA(b, h) + aoff + m * 2048 + k * 1024); } while (0)
#define PG8_LDB(dst, b, h) do { _Pragma("unroll") for (int n = 0; n < 2; ++n) _Pragma("unroll") for (int k = 0; k < 2; ++k) dst[n][k] = *(const LAS bf16x8*)(lds + PG8_SB(b, h) + boff + n * 2048 + k * 1024); } while (0)
#define PG8_MMA(ai, bj, At, Bt) do { __builtin_amdgcn_s_setprio(1); _Pragma("unroll") for (int m = 0; m < 4; ++m) _Pragma("unroll") for (int n = 0; n < 2; ++n) _Pragma("unroll") for (int k = 0; k < 2; ++k) \
        acc[ai][bj][m][n] = __builtin_amdgcn_mfma_f32_16x16x32_bf16(Bt[n][k], At[m][k], acc[ai][bj][m][n], 0, 0, 0); __builtin_amdgcn_s_setprio(0); } while (0)
#define PG8_CAT(x, y) __builtin_shufflevector(__builtin_bit_cast(i32x4, x), __builtin_bit_cast(i32x4, y), 0, 1, 2, 3, 4, 5, 6, 7)
#define PG8_MMA8(ai, bj, At, Bt) do { __builtin_amdgcn_s_setprio(1); _Pragma("unroll") for (int m = 0; m < 4; ++m) _Pragma("unroll") for (int n = 0; n < 2; ++n) \
        asm volatile("v_mfma_f32_16x16x128_f8f6f4 %0, %1, %2, %0" : "+v"(acc[ai][bj][m][n]) : "v"(PG8_CAT(Bt[n][0], Bt[n][1])), "v"(PG8_CAT(At[m][0], At[m][1]))); __builtin_amdgcn_s_setprio(0); } while (0)
#define PG8_WAIT_V(n) asm volatile("s_waitcnt vmcnt(" #n ")" ::: "memory")
#define PG8_WAIT_L(n) asm volatile("s_waitcnt lgkmcnt(" #n ")" ::: "memory")
#define PG8_BAR __builtin_amdgcn_s_barrier()
#define PG8_SCHED __builtin_amdgcn_sched_barrier(0)
    Unit cur, nxt; int ui = 0;
    if (!S.next(0, cur)) return;
    Acc acc;
#pragma unroll
    for (int a = 0; a < 2; ++a)
#pragma unroll
        for (int b = 0; b < 2; ++b)
#pragma unroll
            for (int m = 0; m < 4; ++m)
#pragma unroll
                for (int n = 0; n < 2; ++n) acc[a][b][m][n] = (f32x4){0.f, 0.f, 0.f, 0.f};
    bf16x8 At[4][2], B0[2][2], B1[2][2];
    const char* cA = cur.A; const char* cB = cur.B;
    PG8_STAGE(PG8_SB(0, 0), cB, voffB); PG8_STAGE(PG8_SB(0, 1), cB + hstepB, voffB); PG8_STAGE(PG8_SA(0, 0), cA, voffA); PG8_STAGE(PG8_SA(0, 1), cA + hstepA, voffA);
    if (wr == 1) PG8_BAR;
    PG8_WAIT_V(2); PG8_BAR;
    PG8_STAGE(PG8_SB(1, 0), cB + kstep, voffB); PG8_STAGE(PG8_SA(1, 0), cA + kstep, voffA); PG8_STAGE(PG8_SB(1, 1), cB + hstepB + kstep, voffB);
    PG8_WAIT_V(6); PG8_BAR;
    for (;;) {
        const bool has_next = S.next(ui + 1, nxt);
        const char* nA = has_next ? nxt.A : cA; const char* nB = has_next ? nxt.B : cB;
        for (int t = 0; t < nt; t += 2) {
            const bool last = (t == nt - 2);
            const char* a1 = cA + (size_t)(t + 1) * kstep;
            const char* a2 = last ? nA : cA + (size_t)(t + 2) * kstep; const char* b2 = last ? nB : cB + (size_t)(t + 2) * kstep;
            const char* a3 = a2 + kstep; const char* b3 = b2 + kstep;
            if constexpr (FP8) {
            PG8_LDB(B0, 0, 0); PG8_LDB(B1, 0, 1); PG8_SCHED; PG8_LDA(At, 0, 0); PG8_STAGE(PG8_SA(1, 1), a1 + hstepA, voffA);
            PG8_WAIT_V(8); PG8_WAIT_L(0); PG8_BAR; PG8_MMA8(0, 0, At, B0); PG8_MMA8(0, 1, At, B1); PG8_BAR; PG8_SCHED;
            PG8_LDA(At, 0, 1); PG8_STAGE(PG8_SB(0, 0), b2, voffB); PG8_STAGE(PG8_SB(0, 1), b2 + hstepB, voffB); PG8_STAGE(PG8_SA(0, 0), a2, voffA);
            PG8_WAIT_V(8); PG8_WAIT_L(0); PG8_BAR; PG8_MMA8(1, 0, At, B0); PG8_MMA8(1, 1, At, B1); PG8_BAR; PG8_SCHED;
            PG8_LDB(B0, 1, 0); PG8_LDB(B1, 1, 1); PG8_SCHED; PG8_LDA(At, 1, 0); PG8_STAGE(PG8_SA(0, 1), a2 + hstepA, voffA);
            PG8_WAIT_V(8); PG8_WAIT_L(0); PG8_BAR; PG8_MMA8(0, 0, At, B0); PG8_MMA8(0, 1, At, B1); PG8_BAR; PG8_SCHED;
            PG8_LDA(At, 1, 1); PG8_STAGE(PG8_SB(1, 0), b3, voffB); PG8_STAGE(PG8_SB(1, 1), b3 + hstepB, voffB); PG8_STAGE(PG8_SA(1, 0), a3, voffA);
            PG8_WAIT_V(8); PG8_WAIT_L(0); PG8_BAR; PG8_MMA8(1, 0, At, B0); PG8_MMA8(1, 1, At, B1); PG8_BAR; PG8_SCHED;
            } else {
            PG8_LDB(B0, 0, 0); PG8_LDB(B1, 0, 1); PG8_SCHED; PG8_LDA(At, 0, 0); PG8_STAGE(PG8_SA(1, 1), a1 + hstepA, voffA);
            PG8_WAIT_V(8); PG8_WAIT_L(0); PG8_BAR; PG8_MMA(0, 0, At, B0); PG8_MMA(0, 1, At, B1); PG8_BAR; PG8_SCHED;
            PG8_LDA(At, 0, 1); PG8_STAGE(PG8_SB(0, 0), b2, voffB); PG8_STAGE(PG8_SB(0, 1), b2 + hstepB, voffB); PG8_STAGE(PG8_SA(0, 0), a2, voffA);
            PG8_WAIT_V(8); PG8_WAIT_L(0); PG8_BAR; PG8_MMA(1, 0, At, B0); PG8_MMA(1, 1, At, B1); PG8_BAR; PG8_SCHED;
            PG8_LDB(B0, 1, 0); PG8_LDB(B1, 1, 1); PG8_SCHED; PG8_LDA(At, 1, 0); PG8_STAGE(PG8_SA(0, 1), a2 + hstepA, voffA);
            PG8_WAIT_V(8); PG8_WAIT_L(0); PG8_BAR; PG8_MMA(0, 0, At, B0); PG8_MMA(0, 1, At, B1); PG8_BAR; PG8_SCHED;
            PG8_LDA(At, 1, 1); PG8_STAGE(PG8_SB(1, 0), b3, voffB); PG8_STAGE(PG8_SB(1, 1), b3 + hstepB, voffB); PG8_STAGE(PG8_SA(1, 0), a3, voffA);
            PG8_WAIT_V(8); PG8_WAIT_L(0); PG8_BAR; PG8_MMA(1, 0, At, B0); PG8_MMA(1, 1, At, B1); PG8_BAR; PG8_SCHED;
            }
        }
        if constexpr (ALIGN_EPI) { if (wr == 0) PG8_BAR; }
        if constexpr (FP8) {
#pragma unroll
            for (int a = 0; a < 2; ++a)
#pragma unroll
                for (int b = 0; b < 2; ++b)
                    asm volatile("s_nop 15\n\ts_nop 15" : "+v"(acc[a][b][0][0]), "+v"(acc[a][b][0][1]), "+v"(acc[a][b][1][0]), "+v"(acc[a][b][1][1]), "+v"(acc[a][b][2][0]), "+v"(acc[a][b][2][1]), "+v"(acc[a][b][3][0]), "+v"(acc[a][b][3][1]));
        }
        E(acc, cur, wr, wc, fr, fq);
        if (!has_next) break;
#pragma unroll
        for (int a = 0; a < 2; ++a)
#pragma unroll
            for (int b = 0; b < 2; ++b)
#pragma unroll
                for (int m = 0; m < 4; ++m)
#pragma unroll
                    for (int n = 0; n < 2; ++n) acc[a][b][m][n] = (f32x4){0.f, 0.f, 0.f, 0.f};
        cur = nxt; cA = nA; cB = nB; ++ui;
        if constexpr (ALIGN_EPI) { if (wr == 1) PG8_BAR; }
    }
    PG8_WAIT_V(0);
    if constexpr (!ALIGN_EPI) { if (wr == 0) PG8_BAR; }
    PG8_BAR;
#undef PG8_SA
#undef PG8_SB
#undef PG8_STAGE
#undef PG8_LDA
#undef PG8_MMA8
#undef PG8_CAT
#undef PG8_LDB
#undef PG8_MMA
#undef PG8_WAIT_V
#undef PG8_WAIT_L
#undef PG8_BAR
#undef PG8_SCHED
}

struct EpiInGate {
    static constexpr bool PERM = true;
    bf16_t* z; bf16_t* gates; const float* bgate; float s;
    __device__ __forceinline__ void operator()(const Acc& acc, const Unit& u, int wr, int wc, int fr, int fq) const {
        const int row0 = u.orow + wr * 64 + fr; const bool isg = u.ocol >= 16;
        const int colt = (isg ? u.ocol - 16 : u.ocol) * 256 + wc * 32 + 8 * fq; const int ldc = isg ? 8192 : ZC; bf16_t* base = isg ? gates : z;
        f32x4 bv[2][2];
#pragma unroll
        for (int bj = 0; bj < 2; ++bj)
#pragma unroll
            for (int n = 0; n < 2; ++n) bv[bj][n] = isg ? *(const f32x4*)(bgate + colt + bj * HALF + 4 * n) : (f32x4){0.f, 0.f, 0.f, 0.f};
#pragma unroll
        for (int ai = 0; ai < 2; ++ai)
#pragma unroll
            for (int m = 0; m < 4; ++m) { bf16_t* rowp = base + (size_t)(row0 + ai * HALF + m * 16) * ldc + colt;
#pragma unroll
                for (int bj = 0; bj < 2; ++bj) { f32x4 v0 = acc[ai][bj][m][0] * s + bv[bj][0], v1 = acc[ai][bj][m][1] * s + bv[bj][1];
                    if (isg) {
#pragma unroll
                        for (int j = 0; j < 4; ++j) { v0[j] = sigmoidf_(v0[j]); v1[j] = sigmoidf_(v1[j]); } }
                    u32x4 w; w.x = cvt_pk_bf16(v0[0], v0[1]); w.y = cvt_pk_bf16(v0[2], v0[3]); w.z = cvt_pk_bf16(v1[0], v1[1]); w.w = cvt_pk_bf16(v1[2], v1[3]);
                    *(u32x4*)(rowp + bj * HALF) = w; } }
    }
};
struct EpiBf16 {
    static constexpr bool PERM = true;
    bf16_t* O; int ldc;
    __device__ __forceinline__ void operator()(const Acc& acc, const Unit& u, int wr, int wc, int fr, int fq) const {
        const int row0 = u.orow + wr * 64 + fr, col0 = u.ocol * 256 + wc * 32 + 8 * fq;
#pragma unroll
        for (int ai = 0; ai < 2; ++ai)
#pragma unroll
            for (int m = 0; m < 4; ++m) { bf16_t* rowp = O + (size_t)(row0 + ai * HALF + m * 16) * ldc + col0;
#pragma unroll
                for (int bj = 0; bj < 2; ++bj) { const f32x4 v0 = acc[ai][bj][m][0], v1 = acc[ai][bj][m][1];
                    u32x4 w; w.x = cvt_pk_bf16(v0[0], v0[1]); w.y = cvt_pk_bf16(v0[2], v0[3]); w.z = cvt_pk_bf16(v1[0], v1[1]); w.w = cvt_pk_bf16(v1[2], v1[3]);
                    *(u32x4*)(rowp + bj * HALF) = w; } }
    }
};
struct EpiSwiGLU {
    static constexpr bool PERM = true;
    bf16_t* O; int ldc;
    __device__ __forceinline__ void operator()(const Acc& acc, const Unit& u, int wr, int wc, int fr, int fq) const {
        const int row0 = u.orow + wr * 64 + fr, col0 = u.ocol * 128 + wc * 32 + 8 * fq;
#pragma unroll
        for (int ai = 0; ai < 2; ++ai)
#pragma unroll
            for (int m = 0; m < 4; ++m) { bf16_t* rowp = O + (size_t)(row0 + ai * HALF + m * 16) * ldc + col0;
                f32x4 v0, v1;
#pragma unroll
                for (int j = 0; j < 4; ++j) { const float g0 = acc[ai][0][m][0][j], g1 = acc[ai][0][m][1][j];
                    v0[j] = g0 * sigmoidf_(g0) * acc[ai][1][m][0][j]; v1[j] = g1 * sigmoidf_(g1) * acc[ai][1][m][1][j]; }
                u32x4 w; w.x = cvt_pk_bf16(v0[0], v0[1]); w.y = cvt_pk_bf16(v0[2], v0[3]); w.z = cvt_pk_bf16(v1[0], v1[1]); w.w = cvt_pk_bf16(v1[2], v1[3]);
                *(u32x4*)rowp = w; }
    }
};
__device__ __forceinline__ float bflo(unsigned w) { return __uint_as_float(w << 16); }
__device__ __forceinline__ float bfhi(unsigned w) { return __uint_as_float(w & 0xffff0000u); }
struct EpiMerge {
    static constexpr bool PERM = true;
    const bf16_t* gates; bf16_t* merged;
    __device__ __forceinline__ void operator()(const Acc& acc, const Unit& u, int wr, int wc, int fr, int fq) const {
        const int row0 = u.orow + wr * 64 + fr, col0 = u.ocol * 256 + wc * 32 + 8 * fq, n = u.x0;
#pragma unroll
        for (int ai = 0; ai < 2; ++ai) {
            u32x4 gv[4][2], ov[4][2];
#pragma unroll
            for (int m = 0; m < 4; ++m)
#pragma unroll
                for (int bj = 0; bj < 2; ++bj) { const size_t r = (size_t)(row0 + ai * HALF + m * 16);
                    gv[m][bj] = *(const u32x4*)(gates + r * 8192 + n * 2048 + col0 + bj * HALF);
                    ov[m][bj] = (u32x4){0u, 0u, 0u, 0u}; if (n > 0) ov[m][bj] = *(const u32x4*)(merged + r * DM + col0 + bj * HALF); }
#pragma unroll
            for (int m = 0; m < 4; ++m)
#pragma unroll
                for (int bj = 0; bj < 2; ++bj) { const size_t r = (size_t)(row0 + ai * HALF + m * 16);
                    const u32x4 g = gv[m][bj], o = ov[m][bj]; const f32x4 v0 = acc[ai][bj][m][0], v1 = acc[ai][bj][m][1];
                    u32x4 w;
                    w.x = cvt_pk_bf16(bflo(o.x) + bflo(g.x) * v0[0], bfhi(o.x) + bfhi(g.x) * v0[1]);
                    w.y = cvt_pk_bf16(bflo(o.y) + bflo(g.y) * v0[2], bfhi(o.y) + bfhi(g.y) * v0[3]);
                    w.z = cvt_pk_bf16(bflo(o.z) + bflo(g.z) * v1[0], bfhi(o.z) + bfhi(g.z) * v1[1]);
                    w.w = cvt_pk_bf16(bflo(o.w) + bflo(g.w) * v1[2], bfhi(o.w) + bfhi(g.w) * v1[3]);
                    *(u32x4*)(merged + r * DM + col0 + bj * HALF) = w; }
        }
    }
};
__device__ __forceinline__ unsigned pack_fp8x4(float a, float b, float c, float d) { int w = 0; w = __builtin_amdgcn_cvt_pk_fp8_f32(a, b, w, false); w = __builtin_amdgcn_cvt_pk_fp8_f32(c, d, w, true); return (unsigned)w; }
struct EpiGates {
    static constexpr bool PERM = true;
    bf16_t* gates; const float* bgate; float s;
    __device__ __forceinline__ void operator()(const Acc& acc, const Unit& u, int wr, int wc, int fr, int fq) const {
        const int row0 = u.orow + wr * 64 + fr, colt = u.ocol * 256 + wc * 32 + 8 * fq;
        f32x4 bv[2][2];
#pragma unroll
        for (int bj = 0; bj < 2; ++bj)
#pragma unroll
            for (int n = 0; n < 2; ++n) bv[bj][n] = *(const f32x4*)(bgate + colt + bj * HALF + 4 * n);
#pragma unroll
        for (int ai = 0; ai < 2; ++ai)
#pragma unroll
            for (int m = 0; m < 4; ++m) { bf16_t* rowp = gates + (size_t)(row0 + ai * HALF + m * 16) * 8192 + colt;
#pragma unroll
                for (int bj = 0; bj < 2; ++bj) { f32x4 v0 = acc[ai][bj][m][0] * s + bv[bj][0], v1 = acc[ai][bj][m][1] * s + bv[bj][1];
#pragma unroll
                    for (int j = 0; j < 4; ++j) { v0[j] = sigmoidf_(v0[j]); v1[j] = sigmoidf_(v1[j]); }
                    u32x4 w; w.x = cvt_pk_bf16(v0[0], v0[1]); w.y = cvt_pk_bf16(v0[2], v0[3]); w.z = cvt_pk_bf16(v1[0], v1[1]); w.w = cvt_pk_bf16(v1[2], v1[3]);
                    *(u32x4*)(rowp + bj * HALF) = w; } }
    }
};
struct EpiSwiGLU8 {
    static constexpr bool PERM = true;
    unsigned char* O; int ldc; float si, so;
    __device__ __forceinline__ void operator()(const Acc& acc, const Unit& u, int wr, int wc, int fr, int fq) const {
        const int row0 = u.orow + wr * 64 + fr, col0 = u.ocol * 128 + wc * 32 + 8 * fq;
#pragma unroll
        for (int ai = 0; ai < 2; ++ai)
#pragma unroll
            for (int m = 0; m < 4; ++m) { unsigned char* rowp = O + (size_t)(row0 + ai * HALF + m * 16) * ldc + col0;
                f32x4 v0, v1;
#pragma unroll
                for (int j = 0; j < 4; ++j) { const float g0 = acc[ai][0][m][0][j] * si, g1 = acc[ai][0][m][1][j] * si;
                    v0[j] = g0 * sigmoidf_(g0) * (acc[ai][1][m][0][j] * si) * so; v1[j] = g1 * sigmoidf_(g1) * (acc[ai][1][m][1][j] * si) * so; }
                u32x2 w; w.x = pack_fp8x4(v0[0], v0[1], v0[2], v0[3]); w.y = pack_fp8x4(v1[0], v1[1], v1[2], v1[3]);
                *(u32x2*)rowp = w; }
    }
};
struct EpiResF32 {
    static constexpr bool PERM = false;
    const float* base; float* out; float s;
    __device__ __forceinline__ void operator()(const Acc& acc, const Unit& u, int wr, int wc, int fr, int fq) const {
        const int row0 = u.orow + wr * 64 + fr, col0 = u.ocol * 256 + wc * 32 + 4 * fq;
#pragma unroll
        for (int ai = 0; ai < 2; ++ai)
#pragma unroll
            for (int mp = 0; mp < 2; ++mp) {
                f32x4 bs[2][2][2];
#pragma unroll
                for (int mm = 0; mm < 2; ++mm) { const size_t off = (size_t)(row0 + ai * HALF + (mp * 2 + mm) * 16) * DM + col0;
#pragma unroll
                    for (int bj = 0; bj < 2; ++bj)
#pragma unroll
                        for (int n = 0; n < 2; ++n) bs[mm][bj][n] = *(const f32x4*)(base + off + bj * HALF + n * 16); }
#pragma unroll
                for (int mm = 0; mm < 2; ++mm) { const int m = mp * 2 + mm; const size_t off = (size_t)(row0 + ai * HALF + m * 16) * DM + col0;
#pragma unroll
                    for (int bj = 0; bj < 2; ++bj)
#pragma unroll
                        for (int n = 0; n < 2; ++n) *(f32x4*)(out + off + bj * HALF + n * 16) = bs[mm][bj][n] + acc[ai][bj][m][n] * s; }
                asm volatile("" ::: "memory"); }
    }
};
struct EpiMoeDown {
    static constexpr bool PERM = false;
    float* out; const int* tok; const float* wt; const unsigned* cnt; float s;
    __device__ __forceinline__ void operator()(const Acc& acc, const Unit& u, int wr, int wc, int fr, int fq) const {
        const int e = u.x0, nrow = (int)cnt[e * 64]; const int lrow0 = u.x1 + wr * 64 + fr, col0 = u.ocol * 256 + wc * 32 + 4 * fq;
#pragma unroll
        for (int ai = 0; ai < 2; ++ai)
#pragma unroll
            for (int m = 0; m < 4; ++m) { const int lr = lrow0 + ai * HALF + m * 16;
                if (lr < nrow) { const int slot = e * ECAP + lr; const int t = tok[slot]; const float w = wt[slot] * s; float* op = out + (size_t)t * DM + col0;
#pragma unroll
                    for (int bj = 0; bj < 2; ++bj)
#pragma unroll
                        for (int n = 0; n < 2; ++n)
#pragma unroll
                            for (int j = 0; j < 4; ++j) unsafeAtomicAdd(op + bj * HALF + n * 16 + j, w * acc[ai][bj][m][n][j]); } }
    }
};
struct EpiMoeDownY {
    static constexpr bool PERM = true;
    bf16_t* y; const float* wt; const unsigned* cnt; float s;
    __device__ __forceinline__ void operator()(const Acc& acc, const Unit& u, int wr, int wc, int fr, int fq) const {
        const int e = u.x0, nrow = (int)cnt[e * 64]; const int lrow0 = u.x1 + wr * 64 + fr, col0 = u.ocol * 256 + wc * 32 + 8 * fq;
#pragma unroll
        for (int ai = 0; ai < 2; ++ai)
#pragma unroll
            for (int m = 0; m < 4; ++m) { const int lr = lrow0 + ai * HALF + m * 16;
                if (lr < nrow) { const int slot = e * ECAP + lr; const float w = wt[slot] * s; bf16_t* rowp = y + ((size_t)u.ks * NEXP * ECAP + slot) * DM + col0;
#pragma unroll
                    for (int bj = 0; bj < 2; ++bj) { const f32x4 v0 = acc[ai][bj][m][0] * w, v1 = acc[ai][bj][m][1] * w;
                        u32x4 q; q.x = cvt_pk_bf16(v0[0], v0[1]); q.y = cvt_pk_bf16(v0[2], v0[3]); q.z = cvt_pk_bf16(v1[0], v1[1]); q.w = cvt_pk_bf16(v1[2], v1[3]);
                        *(u32x4*)(rowp + bj * HALF) = q; } } }
    }
};
}
#define XB_TMO      128
#define XB_XCNT(j)  (256  + 64 * (j))
#define XB_XSUB(j)  (1280 + 64 * (j))
#define XB_XGEN(j)  (2304 + 64 * (j))
#define XB_TOP      3328
#define XB_TOPGEN   3392
#define XCD_BAR_WORDS 3456
#define XB_SPIN_CAP (1u << 18)

__device__ __forceinline__ unsigned xb_ld(unsigned* p)              { return __hip_atomic_load(p, __ATOMIC_RELAXED, __HIP_MEMORY_SCOPE_AGENT); }
__device__ __forceinline__ unsigned xb_add(unsigned* p, unsigned v) { return __hip_atomic_fetch_add(p, v, __ATOMIC_RELAXED, __HIP_MEMORY_SCOPE_AGENT); }
__device__ __forceinline__ unsigned xb_xcc_id() { return (unsigned)__builtin_amdgcn_s_getreg((3 << 11) | 20) & 0xFu; }
#define XB_SPIN(cond, bar) do { unsigned _sp = 0; while (cond) { __builtin_amdgcn_s_sleep(1); \
    if ((++_sp & 255u) == 0u) { if (xb_ld(&(bar)[XB_TMO])) break; if (_sp > XB_SPIN_CAP) { atomicAdd(&(bar)[XB_TMO], 1u); break; } } } } while (0)

__device__ __forceinline__ unsigned xb_tid() { unsigned t = threadIdx.x; asm volatile("" : "+v"(t)); return t; }
struct XcdBarrier {
    unsigned* bar; unsigned x;
    volatile LAS unsigned* st;
};

__device__ __forceinline__ XcdBarrier xcd_barrier_post(unsigned* bar, volatile LAS unsigned* st) {
    XcdBarrier b; b.bar = bar; b.x = xb_xcc_id(); b.st = st;
    if (xb_tid() == 0u) (void)xb_add(&bar[XB_XCNT(b.x)], 1u);
    return b;
}
__device__ __forceinline__ void xcd_barrier_complete(unsigned* bar, unsigned x, unsigned& nloc, unsigned& nx) {
    const unsigned G = gridDim.x * gridDim.y * gridDim.z;
    unsigned sum, cnt, mine, sp = 0u;
    for (;;) {
        sum = 0u; cnt = 0u; mine = 0u;
#pragma unroll
        for (unsigned j = 0; j < 16; ++j) { const unsigned c = xb_ld(&bar[XB_XCNT(j)]); sum += c; cnt += (c > 0u) ? 1u : 0u; mine = (j == x) ? c : mine; }
        if (sum == G) break;
        __builtin_amdgcn_s_sleep(1);
        if ((++sp & 255u) == 0u) { if (xb_ld(&bar[XB_TMO])) break; if (sp > XB_SPIN_CAP) { atomicAdd(&bar[XB_TMO], 1u); break; } }
    }
    nloc = mine > 0u ? mine : 1u; nx = cnt > 0u ? cnt : 1u;
}

__device__ __forceinline__ void xcd_barrier(const XcdBarrier& b) {
    asm volatile("s_waitcnt vmcnt(0)" ::: "memory");
    __syncthreads();
    if (xb_tid() == 0u) {
        unsigned* bar = b.bar;
        __builtin_amdgcn_s_waitcnt(0);
        unsigned nloc = b.st[0], nx = b.st[1];
        if (nloc == 0u) { xcd_barrier_complete(bar, b.x, nloc, nx); b.st[0] = nloc; b.st[1] = nx; }
        const unsigned old = xb_add(&bar[XB_XSUB(b.x)], 1u);
        const unsigned gen = old / nloc;
        if (old + 1u == (gen + 1u) * nloc) {
            __builtin_amdgcn_fence(__ATOMIC_RELEASE, "agent");
            asm volatile("s_waitcnt vmcnt(0)" ::: "memory");
            const unsigned og = xb_add(&bar[XB_TOP], 1u);
            const unsigned tg = og / nx;
            if (og + 1u == (tg + 1u) * nx) xb_add(&bar[XB_TOPGEN], 1u);
            else XB_SPIN(xb_ld(&bar[XB_TOPGEN]) == tg, bar);
            __builtin_amdgcn_fence(__ATOMIC_ACQUIRE, "agent");
            xb_add(&bar[XB_XGEN(b.x)], 1u);
            asm volatile("s_waitcnt vmcnt(0)" ::: "memory");
        } else {
            XB_SPIN(xb_ld(&bar[XB_XGEN(b.x)]) == gen, bar);
            __builtin_amdgcn_fence(__ATOMIC_ACQUIRE, "agent");
            asm volatile("s_waitcnt vmcnt(0)" ::: "memory");
        }
    }
    __syncthreads();
}

struct Params { const float* in[30]; float* out; unsigned char* ws; int ph_lo, ph_hi; };
enum { I_X = 0, I_MEM, I_NORM_MIX, I_W_IN, I_NA_QN, I_NA_KN, I_NA_RPB, I_CQ_N, I_W_UQ, I_CKV_N, I_W_UKV, I_MLA_QN, I_MLA_KN, I_SWA_QN, I_SWA_KN, I_SWA_SINK,
       I_MEM_N, I_MEM_WKV, I_MEM_QN, I_MEM_KN, I_W_BRANCH, I_W_GATE, I_B_GATE, I_W_O, I_NORM_FFN, I_FFN_UP, I_FFN_DN, I_ROUTER, I_MOE_UP, I_MOE_DN };

__device__ __forceinline__ float wave_sum(float v) {
#pragma unroll
    for (int o = 32; o >= 1; o >>= 1) v += __shfl_xor(v, o);
    return v;
}
__device__ __forceinline__ float bf2f(bf16_t b) { return __uint_as_float(((unsigned)b) << 16); }
__device__ __forceinline__ bf16_t f2bf(float f) { return (bf16_t)(pg8::cvt_pk_bf16(f, 0.f) & 0xffffu); }
using pg8::cvt_pk_bf16; using pg8::bflo; using pg8::bfhi;

struct CvtJob { const float* src; bf16_t* dst; int src_ld, K, ntn, tile0, mode, dff; };
constexpr int NJOBS = 40;
__device__ __forceinline__ void make_job(int j, const Params& p, CvtJob& jb) {
    unsigned char* ws = p.ws; jb.mode = 0; jb.dff = 1; jb.tile0 = 0;
    if (j < 22) { const int l = j / 11, k = j % 11; unsigned char* lw = ws + WS_LW + (size_t)l * LW_BYTES;
        if (k == 0) { jb.src = p.in[I_W_IN] + (size_t)l * DM * INC; jb.dst = (bf16_t*)(lw + LW_IN); jb.src_ld = INC; jb.K = DM; jb.ntn = INC / 64; jb.mode = INGATE_FP8 ? 3 : 0; }
        else if (k == 1) { jb.src = p.in[I_W_IN]; jb.dst = (bf16_t*)(lw + LW_IN + (size_t)INC * DM * (INGATE_FP8 ? 1 : 2)); jb.src_ld = INC; jb.K = DM; jb.ntn = (ZC - INC) / 64; jb.mode = INGATE_FP8 ? 5 : 2; }
        else if (k == 2) { jb.src = p.in[I_W_GATE] + (size_t)l * DM * 8192; jb.dst = (bf16_t*)(lw + LW_IN + (size_t)ZC * DM * (INGATE_FP8 ? 1 : 2)); jb.src_ld = 8192; jb.K = DM; jb.ntn = 8192 / 64; jb.mode = INGATE_FP8 ? 3 : 0; }
        else if (k == 3) { jb.src = p.in[I_W_UQ] + (size_t)l * 768 * 768; jb.dst = (bf16_t*)(lw + LW_UQ); jb.src_ld = 768; jb.K = 768; jb.ntn = 768 / 64; }
        else if (k == 4) { jb.src = p.in[I_W_UKV] + (size_t)l * 256 * 1024; jb.dst = (bf16_t*)(lw + LW_UKV); jb.src_ld = 1024; jb.K = 256; jb.ntn = 1024 / 64; }
        else if (k == 5) { jb.src = p.in[I_MEM_WKV] + (size_t)l * DM * 1024; jb.dst = (bf16_t*)(lw + LW_MEMKV); jb.src_ld = 1024; jb.K = DM; jb.ntn = 1024 / 64; }
        else if (k < 10) { const int n = k - 6; jb.src = p.in[I_W_BRANCH] + ((size_t)l * 4 + n) * 512 * DM; jb.dst = (bf16_t*)(lw + LW_BR) + (size_t)n * DM * 512; jb.src_ld = DM; jb.K = 512; jb.ntn = DM / 64; }
        else { jb.src = p.in[I_W_O] + (size_t)l * DM * DM; jb.dst = (bf16_t*)(lw + LW_O); jb.src_ld = DM; jb.K = DM; jb.ntn = DM / 64; }
    } else if (j == 22) { jb.src = p.in[I_FFN_UP]; jb.dst = (bf16_t*)(ws + WS_FFNUP); jb.src_ld = 2 * DFF; jb.K = DM; jb.ntn = 2 * DFF / 64; jb.mode = 1; jb.dff = DFF; }
    else if (j == 23) { jb.src = p.in[I_FFN_DN]; jb.dst = (bf16_t*)(ws + WS_FFNDN); jb.src_ld = DM; jb.K = DFF; jb.ntn = DM / 64; }
    else if (j < 32) { const int e = j - 24; jb.src = p.in[I_MOE_UP] + (size_t)e * DM * 2 * DFFE; jb.dst = (bf16_t*)(ws + WS_MOEUP + (size_t)e * 2 * DFFE * DM * MOE_ES); jb.src_ld = 2 * DFFE; jb.K = DM; jb.ntn = 2 * DFFE / 64; jb.mode = MOE_FP8 ? 4 : 1; jb.dff = DFFE; }
    else { const int e = j - 32; jb.src = p.in[I_MOE_DN] + (size_t)e * DFFE * DM; jb.dst = (bf16_t*)(ws + WS_MOEDN + (size_t)e * DM * DFFE * MOE_ES); jb.src_ld = DM; jb.K = DFFE; jb.ntn = DM / 64; jb.mode = MOE_FP8 ? 3 : 0; }
}

__device__ __forceinline__ void norm_rows(const float* src, const float* g, bf16_t* dst, unsigned char* dst8, int nrows, int wid, int lane) {
    const int nw = gridDim.x * 8;
    for (int row = blockIdx.x * 8 + wid; row < nrows; row += 2 * nw) {
        const int rowb = row + nw; const bool hb = rowb < nrows;
        const f32x4* sa = (const f32x4*)(src + (size_t)row * DM); const f32x4* sb = (const f32x4*)(src + (size_t)(hb ? rowb : row) * DM);
        f32x4 va[8], vb[8]; float ssa = 0.f, ssb = 0.f;
#pragma unroll
        for (int j = 0; j < 8; ++j) { va[j] = sa[lane + 64 * j]; vb[j] = sb[lane + 64 * j]; }
#pragma unroll
        for (int j = 0; j < 8; ++j) { ssa += va[j][0] * va[j][0] + va[j][1] * va[j][1] + va[j][2] * va[j][2] + va[j][3] * va[j][3]; ssb += vb[j][0] * vb[j][0] + vb[j][1] * vb[j][1] + vb[j][2] * vb[j][2] + vb[j][3] * vb[j][3]; }
#pragma unroll
        for (int o = 32; o >= 1; o >>= 1) { ssa += __shfl_xor(ssa, o); ssb += __shfl_xor(ssb, o); }
        const float ra = 1.0f / sqrtf(ssa * (1.0f / DM) + EPS), rb = 1.0f / sqrtf(ssb * (1.0f / DM) + EPS);
#pragma unroll
        for (int j = 0; j < 8; ++j) { const f32x4 gv = ((const f32x4*)g)[lane + 64 * j];
            { const f32x4 y = va[j] * ra * gv; u32x2 w; w.x = cvt_pk_bf16(y[0], y[1]); w.y = cvt_pk_bf16(y[2], y[3]); *(u32x2*)(dst + (size_t)row * DM + 4 * (lane + 64 * j)) = w;
              if (dst8) *(unsigned*)(dst8 + (size_t)row * DM + 4 * (lane + 64 * j)) = pg8::pack_fp8x4(y[0] * SC_ACT8, y[1] * SC_ACT8, y[2] * SC_ACT8, y[3] * SC_ACT8); }
            if (hb) { const f32x4 y = vb[j] * rb * gv; u32x2 w; w.x = cvt_pk_bf16(y[0], y[1]); w.y = cvt_pk_bf16(y[2], y[3]); *(u32x2*)(dst + (size_t)rowb * DM + 4 * (lane + 64 * j)) = w;
              if (dst8) *(unsigned*)(dst8 + (size_t)rowb * DM + 4 * (lane + 64 * j)) = pg8::pack_fp8x4(y[0] * SC_ACT8, y[1] * SC_ACT8, y[2] * SC_ACT8, y[3] * SC_ACT8); } }
    }
}

__device__ __forceinline__ void p0_prologue(const Params& p, LAS unsigned char* lds, int tid, int wid, int lane) {
    LAS CvtJob* jt = (LAS CvtJob*)(lds + 65536);
    LAS int* jtot = (LAS int*)(lds + 65536 + 4096);
    if (tid < NJOBS) { CvtJob jb; make_job(tid, p, jb); jt[tid].src = jb.src; jt[tid].dst = jb.dst; jt[tid].src_ld = jb.src_ld; jt[tid].K = jb.K; jt[tid].ntn = jb.ntn; jt[tid].tile0 = 0; jt[tid].mode = jb.mode; jt[tid].dff = jb.dff; }
    __syncthreads();
    if (tid == 0) { int acc = 0; for (int j = 0; j < NJOBS; ++j) { jt[j].tile0 = acc; acc += (jt[j].K / 128) * jt[j].ntn; } jtot[0] = acc; }
    __syncthreads();
    const int total = jtot[0];
    LAS unsigned* T = (LAS unsigned*)lds;
    const int tq = tid >> 4, nq = tid & 15;
    int j = 0, g = blockIdx.x;
    f32x4 r0, r1, r2, r3; r0 = r1 = r2 = r3 = (f32x4){0.f, 0.f, 0.f, 0.f};
    int c_mode = 2, c_K = 0, c_tn = 0, c_tk = 0, c_dff = 1; bf16_t* c_dst = nullptr;
#define P0_FETCH() do { if (g < total) { while (j + 1 < NJOBS && jt[j + 1].tile0 <= g) ++j; \
        const float* src = (const float*)(__attribute__((address_space(1))) const float*)jt[j].src; const int src_ld = jt[j].src_ld, ntn = jt[j].ntn, local = g - jt[j].tile0; \
        c_mode = jt[j].mode; c_K = jt[j].K; c_dff = jt[j].dff; c_dst = (bf16_t*)(__attribute__((address_space(1))) bf16_t*)jt[j].dst; c_tn = local % ntn; c_tk = local / ntn; \
        if (c_mode != 2 && c_mode != 5) { const bool f8 = c_mode >= 3; const int ra = f8 ? 4 * tq : 2 * tq, rb = ra + 1, rc = f8 ? ra + 2 : ra + 64, rd = rc + 1; \
            const float* sp = src + (size_t)(c_tk * 128) * src_ld + c_tn * 64 + 4 * nq; \
            r0 = __builtin_nontemporal_load((const f32x4*)(sp + (size_t)ra * src_ld)); r1 = __builtin_nontemporal_load((const f32x4*)(sp + (size_t)rb * src_ld)); \
            r2 = __builtin_nontemporal_load((const f32x4*)(sp + (size_t)rc * src_ld)); r3 = __builtin_nontemporal_load((const f32x4*)(sp + (size_t)rd * src_ld)); } } } while (0)
    P0_FETCH();
    while (g < total) {
        const int mode = c_mode, K = c_K, tn = c_tn, tk = c_tk, dff = c_dff; bf16_t* dst = c_dst;
        const f32x4 a0 = r0, a1 = r1, a2 = r2, a3 = r3;
        g += gridDim.x;
        P0_FETCH();
        if (mode == 2) {
#pragma unroll
            for (int it = 0; it < 2; ++it) { const int piece = tid + it * 512, n = piece >> 4, seg = piece & 15;
                *(u32x4*)(dst + (size_t)(tn * 64 + n) * K + tk * 128 + seg * 8) = (u32x4){0u, 0u, 0u, 0u}; }
            continue;
        }
        if (mode == 5) { const int n = tid >> 3, seg = tid & 7; *(u32x4*)((unsigned char*)dst + (size_t)(tn * 64 + n) * K + tk * 128 + seg * 16) = (u32x4){0u, 0u, 0u, 0u}; continue; }
        if (mode >= 3) {
#pragma unroll
            for (int q = 0; q < 4; ++q) T[(4 * nq + q) * 33 + tq] = pg8::pack_fp8x4(a0[q] * SC_W8, a1[q] * SC_W8, a2[q] * SC_W8, a3[q] * SC_W8);
            __syncthreads();
            { const int n = tid >> 3, seg = tid & 7;
              u32x4 w; w.x = T[n * 33 + seg * 4 + 0]; w.y = T[n * 33 + seg * 4 + 1]; w.z = T[n * 33 + seg * 4 + 2]; w.w = T[n * 33 + seg * 4 + 3];
              int drow = tn * 64 + n;
              if (mode == 4) { const int bj = drow / dff, cc = drow - bj * dff; drow = 256 * (cc >> 7) + 128 * bj + (cc & 127); }
              *(u32x4*)((unsigned char*)dst + (size_t)drow * K + tk * 128 + seg * 16) = w; }
            __syncthreads();
            continue;
        }
#pragma unroll
        for (int q = 0; q < 4; ++q) { T[(4 * nq + q) * 65 + tq] = cvt_pk_bf16(a0[q], a1[q]); T[(4 * nq + q) * 65 + tq + 32] = cvt_pk_bf16(a2[q], a3[q]); }
        __syncthreads();
#pragma unroll
        for (int it = 0; it < 2; ++it) { const int piece = tid + it * 512, n = piece >> 4, seg = piece & 15;
            u32x4 w; w.x = T[n * 65 + seg * 4 + 0]; w.y = T[n * 65 + seg * 4 + 1]; w.z = T[n * 65 + seg * 4 + 2]; w.w = T[n * 65 + seg * 4 + 3];
            int drow = tn * 64 + n;
            if (mode == 1) { const int bj = drow / dff, cc = drow - bj * dff; drow = 256 * (cc >> 7) + 128 * bj + (cc & 127); }
            *(u32x4*)(dst + (size_t)drow * K + tk * 128 + seg * 8) = w; }
        __syncthreads();
    }
#undef P0_FETCH
#ifdef PROBE_POISON
    { u32x4* q = (u32x4*)(p.ws + WS_XG); const size_t n1 = (size_t)NEXP * ECAP * DM / 16; for (size_t i = (size_t)blockIdx.x * NTHREADS + tid; i < n1; i += (size_t)gridDim.x * NTHREADS) q[i] = (u32x4){0u, 0u, 0u, 0u};
      q = (u32x4*)(p.ws + WS_ACTM); const size_t n2 = (size_t)NEXP * ECAP * DFFE / 16; for (size_t i = (size_t)blockIdx.x * NTHREADS + tid; i < n2; i += (size_t)gridDim.x * NTHREADS) q[i] = (u32x4){0u, 0u, 0u, 0u}; }
#endif
    { f32x2* rt = (f32x2*)(p.ws + WS_ROPE);
      for (int e = blockIdx.x * NTHREADS + tid; e < SEQ * 32; e += gridDim.x * NTHREADS) { const int pos = e >> 5, i = e & 31;
          const float freq = __builtin_amdgcn_exp2f(-(float)i * (13.287712379549449f / 32.0f));
          const float ang = (float)pos * freq;
          const double rev = (double)ang * 0.15915494309189535; const float fr_ = (float)(rev - __builtin_rint(rev));
          rt[e] = (f32x2){__builtin_amdgcn_cosf(fr_), __builtin_amdgcn_sinf(fr_)}; } }
    norm_rows(p.in[I_MEM], p.in[I_MEM_N], (bf16_t*)(p.ws + WS_MEMN), nullptr, NMEM, wid, lane);
    norm_rows(p.in[I_MEM], p.in[I_MEM_N] + DM, (bf16_t*)(p.ws + WS_MEMN) + (size_t)NMEM * DM, nullptr, NMEM, wid, lane);
    norm_rows(p.in[I_X], p.in[I_NORM_MIX], (bf16_t*)(p.ws + WS_U), p.ws + WS_U8, NTOK, wid, lane);
}

__device__ __forceinline__ void unpack8(const u32x4 w, float (&x)[8]) { x[0] = bflo(w.x); x[1] = bfhi(w.x); x[2] = bflo(w.y); x[3] = bfhi(w.y); x[4] = bflo(w.z); x[5] = bfhi(w.z); x[6] = bflo(w.w); x[7] = bfhi(w.w); }
__device__ __forceinline__ u32x4 pack8(const float (&y)[8]) { u32x4 w; w.x = cvt_pk_bf16(y[0], y[1]); w.y = cvt_pk_bf16(y[2], y[3]); w.z = cvt_pk_bf16(y[4], y[5]); w.w = cvt_pk_bf16(y[6], y[7]); return w; }
__device__ __forceinline__ float sumsq8(const float (&x)[8]) { return (x[0] * x[0] + x[1] * x[1]) + (x[2] * x[2] + x[3] * x[3]) + (x[4] * x[4] + x[5] * x[5]) + (x[6] * x[6] + x[7] * x[7]); }
template <int NL> __device__ __forceinline__ float group_sum(float v) {
#pragma unroll
    for (int o = NL / 2; o >= 1; o >>= 1) v += __shfl_xor(v, o);
    return v;
}
struct Gain8 { f32x4 a, b; };
__device__ __forceinline__ Gain8 ldg8(const float* g) { Gain8 r; r.a = *(const f32x4*)g; r.b = *(const f32x4*)(g + 4); return r; }
__device__ __forceinline__ void scale8(float (&x)[8], float rs, const Gain8& g) { x[0] *= rs * g.a[0]; x[1] *= rs * g.a[1]; x[2] *= rs * g.a[2]; x[3] *= rs * g.a[3]; x[4] *= rs * g.b[0]; x[5] *= rs * g.b[1]; x[6] *= rs * g.b[2]; x[7] *= rs * g.b[3]; }
__device__ __forceinline__ void rope8(float (&y)[8], const f32x4 (&cs)[4], bool upper) {
#pragma unroll
    for (int e = 0; e < 8; ++e) { const float pr = __shfl_xor(y[e], 4); const float c = cs[e >> 1][(e & 1) * 2], s = cs[e >> 1][(e & 1) * 2 + 1]; y[e] = upper ? (y[e] * c + pr * s) : (y[e] * c - pr * s); }
}

__device__ __forceinline__ void prep1(const Params& p, int l, LAS unsigned char* lds, int tid, int wid, int lane) {
    const bf16_t* z = (const bf16_t*)(p.ws + WS_Z);
    bf16_t* naq = (bf16_t*)(p.ws + WS_NAQ); bf16_t* nak = (bf16_t*)(p.ws + WS_NAK); bf16_t* navT = (bf16_t*)(p.ws + WS_NAVT);
    bf16_t* cqn = (bf16_t*)(p.ws + WS_CQN); bf16_t* ckvn = (bf16_t*)(p.ws + WS_CKVN);
    bf16_t* swq = (bf16_t*)(p.ws + WS_SWQ); bf16_t* swk = (bf16_t*)(p.ws + WS_SWK); bf16_t* swvT = (bf16_t*)(p.ws + WS_SWVT); bf16_t* meq = (bf16_t*)(p.ws + WS_MEQ);
    const f32x4* rt4 = (const f32x4*)(p.ws + WS_ROPE);
    const float qs128 = 0.08838834764831845f * LOG2E, qs64 = 0.125f * LOG2E;
    const int l16 = lane & 15, l8 = lane & 7;
    const Gain8 g_naq = ldg8(p.in[I_NA_QN] + l * 128 + 8 * l16), g_nak = ldg8(p.in[I_NA_KN] + l * 128 + 8 * l16), g_meq = ldg8(p.in[I_MEM_QN] + l * 128 + 8 * l16);
    const Gain8 g_cq0 = ldg8(p.in[I_CQ_N] + l * 768 + 8 * lane), g_cq1 = ldg8(p.in[I_CQ_N] + l * 768 + 512 + 8 * (lane & 31)), g_ckv = ldg8(p.in[I_CKV_N] + l * 256 + 8 * (lane & 31));
    const Gain8 g_swq = ldg8(p.in[I_SWA_QN] + l * 64 + 8 * l8), g_swk = ldg8(p.in[I_SWA_KN] + l * 64 + 8 * l8);
    constexpr int VW = 640;
    LAS bf16_t* vt = (LAS bf16_t*)lds;
    const u32x4 zero4 = (u32x4){0u, 0u, 0u, 0u};
    for (int grp = blockIdx.x; grp < NTOK / 32; grp += gridDim.x) {
        const int b = grp >> 6, chunk = grp & 63;
#pragma unroll 2
        for (int ti = 0; ti < 4; ++ti) {
            const int tl = wid * 4 + ti, s = chunk * 32 + tl, token = grp * 32 + tl;
            const bf16_t* zr = z + (size_t)token * ZC;
            const u32x4 w_naq = *(const u32x4*)(zr + Z_NAQ + 8 * lane), w_nak = *(const u32x4*)(zr + Z_NAK + 8 * lane), w_nav = *(const u32x4*)(zr + Z_NAV + 8 * lane), w_meq = *(const u32x4*)(zr + Z_MEQ + 8 * lane);
            const u32x4 w_cq0 = *(const u32x4*)(zr + Z_CQ + 8 * lane); const u32x4 w_cq1 = lane < 32 ? *(const u32x4*)(zr + Z_CQ + 512 + 8 * lane) : zero4;
            const u32x4 w_ckv = lane < 32 ? *(const u32x4*)(zr + Z_CKV + 8 * lane) : zero4;
            const u32x4 w_swq = *(const u32x4*)(zr + Z_SWQ + 8 * lane);
            const u32x4 w_swkv = lane < 32 ? *(const u32x4*)(zr + (lane < 16 ? Z_SWK + 8 * lane : Z_SWV + 8 * (lane - 16))) : zero4;
            f32x4 cs[4];
#pragma unroll
            for (int q = 0; q < 4; ++q) cs[q] = rt4[(s * 32 + (lane & 3) * 8) / 2 + q];
            *(LAS u32x4*)(vt + tl * VW + 8 * lane) = w_nav;
            if (lane >= 16 && lane < 32) *(LAS u32x4*)(vt + tl * VW + 512 + 8 * (lane - 16)) = w_swkv;
            float x[8];
            { unpack8(w_naq, x); const float ss = group_sum<16>(sumsq8(x)); scale8(x, 1.0f / sqrtf(ss * (1.0f / 128) + EPS) * qs128, g_naq);
              *(u32x4*)(naq + ((size_t)(b * 4 + (lane >> 4)) * SEQ + s) * 128 + 8 * l16) = pack8(x); }
            { unpack8(w_nak, x); const float ss = group_sum<16>(sumsq8(x)); scale8(x, 1.0f / sqrtf(ss * (1.0f / 128) + EPS), g_nak);
              *(u32x4*)(nak + ((size_t)(b * 4 + (lane >> 4)) * SEQ + s) * 128 + 8 * l16) = pack8(x); }
            { unpack8(w_meq, x); const float ss = group_sum<16>(sumsq8(x)); scale8(x, 1.0f / sqrtf(ss * (1.0f / 128) + EPS) * qs128, g_meq);
              *(u32x4*)(meq + ((size_t)(b * 4 + (lane >> 4)) * SEQ + s) * 128 + 8 * l16) = pack8(x); }
            { float y[8]; unpack8(w_cq0, x); unpack8(w_cq1, y); const float ss = group_sum<64>(sumsq8(x) + sumsq8(y)); const float rs = 1.0f / sqrtf(ss * (1.0f / 768) + EPS);
              scale8(x, rs, g_cq0); scale8(y, rs, g_cq1);
              *(u32x4*)(cqn + (size_t)token * 768 + 8 * lane) = pack8(x); if (lane < 32) *(u32x4*)(cqn + (size_t)token * 768 + 512 + 8 * lane) = pack8(y); }
            { unpack8(w_ckv, x); const float ss = group_sum<64>(sumsq8(x)); scale8(x, 1.0f / sqrtf(ss * (1.0f / 256) + EPS), g_ckv);
              if (lane < 32) *(u32x4*)(ckvn + (size_t)token * 256 + 8 * lane) = pack8(x); }
            { unpack8(w_swq, x); const float ss = group_sum<8>(sumsq8(x)); scale8(x, 1.0f / sqrtf(ss * (1.0f / 64) + EPS), g_swq); rope8(x, cs, (lane & 4) != 0);
#pragma unroll
              for (int e = 0; e < 8; ++e) x[e] *= qs64;
              *(u32x4*)(swq + ((size_t)(b * 8 + (lane >> 3)) * SEQ + s) * 64 + 8 * l8) = pack8(x); }
            { unpack8(w_swkv, x); const float ss = group_sum<8>(sumsq8(x)); scale8(x, 1.0f / sqrtf(ss * (1.0f / 64) + EPS), g_swk); rope8(x, cs, (lane & 4) != 0);
              if (lane < 16) *(u32x4*)(swk + ((size_t)(b * 2 + (lane >> 3)) * SEQ + s) * 64 + 8 * l8) = pack8(x); }
        }
        __syncthreads();
#pragma unroll 1
        for (int it = 0; it < 5; ++it) { const int item = tid + it * 512, part = item / VW, c = item - part * VW;
            unsigned short e[8];
#pragma unroll
            for (int q = 0; q < 8; ++q) e[q] = vt[(part * 8 + q) * VW + c];
            u32x4 w; w.x = e[0] | ((unsigned)e[1] << 16); w.y = e[2] | ((unsigned)e[3] << 16); w.z = e[4] | ((unsigned)e[5] << 16); w.w = e[6] | ((unsigned)e[7] << 16);
            bf16_t* dp = (c < 512) ? navT + ((((size_t)(b * 4 + (c >> 7)) * 64 + chunk) * 128 + (c & 127)) * 32 + part * 8)
                                   : swvT + ((((size_t)(b * 2 + ((c - 512) >> 6)) * 64 + chunk) * 64 + ((c - 512) & 63)) * 32 + part * 8);
            *(u32x4*)dp = w; }
        __syncthreads();
    }
}

__device__ __forceinline__ void prep2(const Params& p, int l, LAS unsigned char* lds, int tid, int wid, int lane) {
    const bf16_t* z = (const bf16_t*)(p.ws + WS_Z); const bf16_t* qraw = (const bf16_t*)(p.ws + WS_QRAW); const bf16_t* kvraw = (const bf16_t*)(p.ws + WS_KVRAW);
    const bf16_t* memkv = (const bf16_t*)(p.ws + WS_MEMKV) + (size_t)l * NMEM * 1024;
    bf16_t* mlq = (bf16_t*)(p.ws + WS_MLQ); bf16_t* mlk = (bf16_t*)(p.ws + WS_MLK); bf16_t* mlvT = (bf16_t*)(p.ws + WS_MLVT);
    bf16_t* mek = (bf16_t*)(p.ws + WS_MEK); bf16_t* mevT = (bf16_t*)(p.ws + WS_MEVT);
    const f32x4* rt4 = (const f32x4*)(p.ws + WS_ROPE);
    const float qs192 = 0.07216878364870322f * LOG2E;
    const int l16 = lane & 15, l24 = lane < 24 ? lane : 0;
    const Gain8 g_q = ldg8(p.in[I_MLA_QN] + l * 192 + 8 * l24), g_k = ldg8(p.in[I_MLA_KN] + l * 192 + 8 * l24), g_mk = ldg8(p.in[I_MEM_KN] + l * 128 + 8 * l16);
    constexpr int VW = 512;
    LAS bf16_t* vt = (LAS bf16_t*)lds;
    const u32x4 zero4 = (u32x4){0u, 0u, 0u, 0u};
    for (int grp = blockIdx.x; grp < NTOK / 32 + NMEM / 32; grp += gridDim.x) {
        const bool ismem = grp >= NTOK / 32;
        if (!ismem) {
            const int b = grp >> 6, chunk = grp & 63;
#pragma unroll 2
            for (int ti = 0; ti < 4; ++ti) {
                const int tl = wid * 4 + ti, s = chunk * 32 + tl, token = grp * 32 + tl;
                u32x4 wq[4], wk[4];
#pragma unroll
                for (int h = 0; h < 4; ++h) { wq[h] = lane < 24 ? *(const u32x4*)(qraw + (size_t)token * 768 + h * 192 + 8 * lane) : zero4;
                    wk[h] = lane < 16 ? *(const u32x4*)(kvraw + (size_t)token * 1024 + h * 256 + 8 * lane) : (lane < 24 ? *(const u32x4*)(z + (size_t)token * ZC + Z_KPE + 8 * (lane - 16)) : zero4); }
                const u32x4 wv = *(const u32x4*)(kvraw + (size_t)token * 1024 + (lane >> 4) * 256 + 128 + 8 * l16);
                f32x4 cs[4];
#pragma unroll
                for (int q = 0; q < 4; ++q) cs[q] = rt4[(s * 32 + (lane & 3) * 8) / 2 + q];
                *(LAS u32x4*)(vt + tl * VW + (lane >> 4) * 128 + 8 * l16) = wv;
                const bool ropel = lane >= 16 && lane < 24;
#pragma unroll
                for (int h = 0; h < 4; ++h) {
                    float x[8];
                    { unpack8(wq[h], x); const float ss = group_sum<64>(sumsq8(x)); scale8(x, 1.0f / sqrtf(ss * (1.0f / 192) + EPS), g_q);
                      float y[8];
#pragma unroll
                      for (int e = 0; e < 8; ++e) y[e] = x[e];
                      rope8(y, cs, (lane & 4) != 0);
#pragma unroll
                      for (int e = 0; e < 8; ++e) x[e] = (ropel ? y[e] : x[e]) * qs192;
                      if (lane < 24) *(u32x4*)(mlq + ((size_t)(b * 4 + h) * SEQ + s) * 192 + 8 * lane) = pack8(x); }
                    { unpack8(wk[h], x); const float ss = group_sum<64>(sumsq8(x)); scale8(x, 1.0f / sqrtf(ss * (1.0f / 192) + EPS), g_k);
                      float y[8];
#pragma unroll
                      for (int e = 0; e < 8; ++e) y[e] = x[e];
                      rope8(y, cs, (lane & 4) != 0);
#pragma unroll
                      for (int e = 0; e < 8; ++e) x[e] = ropel ? y[e] : x[e];
                      if (lane < 24) *(u32x4*)(mlk + ((size_t)(b * 4 + h) * SEQ + s) * 192 + 8 * lane) = pack8(x); }
                }
            }
            __syncthreads();
#pragma unroll 1
            for (int it = 0; it < 4; ++it) { const int item = tid + it * 512, part = item >> 9, c = item & 511;
                unsigned short e[8];
#pragma unroll
                for (int q = 0; q < 8; ++q) e[q] = vt[(part * 8 + q) * VW + c];
                u32x4 w; w.x = e[0] | ((unsigned)e[1] << 16); w.y = e[2] | ((unsigned)e[3] << 16); w.z = e[4] | ((unsigned)e[5] << 16); w.w = e[6] | ((unsigned)e[7] << 16);
                *(u32x4*)(mlvT + ((((size_t)(b * 4 + (c >> 7)) * 64 + chunk) * 128 + (c & 127)) * 32 + part * 8)) = w; }
            __syncthreads();
        } else {
            const int mg = grp - NTOK / 32, b = mg >> 3, chunk = mg & 7;
#pragma unroll 2
            for (int ti = 0; ti < 4; ++ti) {
                const int tl = wid * 4 + ti, m = chunk * 32 + tl, mt = mg * 32 + tl;
                const bf16_t* mr = memkv + (size_t)mt * 1024;
                const u32x4 wkk = *(const u32x4*)(mr + 8 * lane), wv = *(const u32x4*)(mr + 512 + 8 * lane);
                *(LAS u32x4*)(vt + tl * VW + 8 * lane) = wv;
                float x[8]; unpack8(wkk, x); const float ss = group_sum<16>(sumsq8(x)); scale8(x, 1.0f / sqrtf(ss * (1.0f / 128) + EPS), g_mk);
                *(u32x4*)(mek + ((size_t)(b * 4 + (lane >> 4)) * MEML + m) * 128 + 8 * l16) = pack8(x);
            }
            __syncthreads();
#pragma unroll 1
            for (int it = 0; it < 4; ++it) { const int item = tid + it * 512, part = item >> 9, c = item & 511;
                unsigned short e[8];
#pragma unroll
                for (int q = 0; q < 8; ++q) e[q] = vt[(part * 8 + q) * VW + c];
                u32x4 w; w.x = e[0] | ((unsigned)e[1] << 16); w.y = e[2] | ((unsigned)e[3] << 16); w.z = e[4] | ((unsigned)e[5] << 16); w.w = e[6] | ((unsigned)e[7] << 16);
                *(u32x4*)(mevT + ((((size_t)(b * 4 + (c >> 7)) * 8 + chunk) * 128 + (c & 127)) * 32 + part * 8)) = w; }
            __syncthreads();
        }
    }
}
constexpr int ATT_RPB_OFF = 98304;
template <int DQ, int DV, int MODE, int NQT>
__device__ __forceinline__ void attn_unit(LAS unsigned char* lds, const bf16_t* qp, const bf16_t* kp, const bf16_t* vp, bf16_t* op,
                                          int nsub, int c_lo, int c_hi, int mq0, int mk0, int mr, float sink2, int tid, int lane) {
    constexpr int KROW = DQ * 2 + 16, KBUF = 64 * KROW, VROW = 144, VBUF = DV * VROW, NDC = DQ / 32, NDV = DV / 16, DQ8 = DQ / 8;
    constexpr int KP = 64 * DQ8 / 512, VP = 2 * DV * 4 / 512;
    static_assert(KP * 512 == 64 * DQ8 && VP * 512 == 2 * DV * 4 && 2 * KBUF + 2 * VBUF <= ATT_RPB_OFF, "attention staging geometry");
    const int fr = lane & 15, fq = lane >> 4;
    bf16x8 qf[NQT][NDC];
#pragma unroll
    for (int qt = 0; qt < NQT; ++qt)
#pragma unroll
        for (int dc = 0; dc < NDC; ++dc) qf[qt][dc] = *(const bf16x8*)(qp + (size_t)(qt * 16 + fr) * DQ + dc * 32 + fq * 8);
    f32x4 o[NQT][NDV];
#pragma unroll
    for (int qt = 0; qt < NQT; ++qt)
#pragma unroll
        for (int d = 0; d < NDV; ++d) o[qt][d] = (f32x4){0.f, 0.f, 0.f, 0.f};
    float mrun[NQT], lrun[NQT];
#pragma unroll
    for (int qt = 0; qt < NQT; ++qt) { mrun[qt] = -1e30f; lrun[qt] = 0.f; }
    int kd[KP], vd[VP];
#pragma unroll
    for (int i = 0; i < KP; ++i) { const int pk = tid + i * 512, key = pk / DQ8, dp = pk - key * DQ8, k32 = key & 31;
        kd[i] = (32 * (key >> 5) + 16 * ((k32 >> 2) & 1) + 4 * (k32 >> 3) + (k32 & 3)) * KROW + dp * 16; }
#pragma unroll
    for (int i = 0; i < VP; ++i) { const int pv = tid + i * 512, sub = pv / (DV * 4), r = pv - sub * (DV * 4); vd[i] = (r >> 2) * VROW + sub * 64 + (r & 3) * 16; }
    u32x4 rk[KP], rv[VP];
#pragma unroll
    for (int i = 0; i < KP; ++i) rk[i] = *(const u32x4*)(kp + (size_t)(tid + i * 512) * 8);
#pragma unroll
    for (int i = 0; i < VP; ++i) rv[i] = *(const u32x4*)(vp + (size_t)(tid + i * 512) * 8);
#pragma unroll
    for (int i = 0; i < KP; ++i) *(LAS u32x4*)(lds + kd[i]) = rk[i];
#pragma unroll
    for (int i = 0; i < VP; ++i) *(LAS u32x4*)(lds + 2 * KBUF + vd[i]) = rv[i];
    __syncthreads();
    __builtin_amdgcn_s_waitcnt(0x0F70);
    const int n64 = nsub >> 1;
#pragma unroll 1
    for (int c = 0; c < n64; ++c) {
        const int cur = c & 1; const bool more = (c + 1 < n64);
        if (more) { const bf16_t* kn = kp + (size_t)(c + 1) * 64 * DQ; const bf16_t* vn = vp + (size_t)(c + 1) * 2 * DV * 32;
#pragma unroll
            for (int i = 0; i < KP; ++i) { const bf16_t* ga = kn + (size_t)(tid + i * 512) * 8; asm volatile("global_load_dwordx4 %0, %1, off" : "=v"(rk[i]) : "v"(ga) : "memory"); }
#pragma unroll
            for (int i = 0; i < VP; ++i) { const bf16_t* ga = vn + (size_t)(tid + i * 512) * 8; asm volatile("global_load_dwordx4 %0, %1, off" : "=v"(rv[i]) : "v"(ga) : "memory"); } }
#pragma unroll (NQT == 1 ? 2 : 1)
        for (int sub = 0; sub < 2; ++sub) {
            const int sc = 2 * c + sub;
            if (sc >= c_lo && sc < c_hi) {
                const LAS unsigned char* kb = lds + cur * KBUF + sub * 32 * KROW; const LAS unsigned char* vb = lds + 2 * KBUF + cur * VBUF + sub * 64;
                f32x4 s[NQT][2];
#pragma unroll
                for (int qt = 0; qt < NQT; ++qt) { s[qt][0] = (f32x4){0.f, 0.f, 0.f, 0.f}; s[qt][1] = (f32x4){0.f, 0.f, 0.f, 0.f}; }
                { bf16x8 kf[NDC][2];
#pragma unroll
                  for (int dc = 0; dc < NDC; ++dc) { kf[dc][0] = *(const LAS bf16x8*)(kb + fr * KROW + (dc * 32 + fq * 8) * 2); kf[dc][1] = *(const LAS bf16x8*)(kb + (16 + fr) * KROW + (dc * 32 + fq * 8) * 2); }
#pragma unroll
                  for (int dc = 0; dc < NDC; ++dc)
#pragma unroll
                    for (int qt = 0; qt < NQT; ++qt) { s[qt][0] = __builtin_amdgcn_mfma_f32_16x16x32_bf16(kf[dc][0], qf[qt][dc], s[qt][0], 0, 0, 0);
                                                       s[qt][1] = __builtin_amdgcn_mfma_f32_16x16x32_bf16(kf[dc][1], qf[qt][dc], s[qt][1], 0, 0, 0); } }
                bf16x8 pf[NQT];
#pragma unroll
                for (int qt = 0; qt < NQT; ++qt) {
                    if (MODE == 1) {
                        const int qpos = mq0 + qt * 16 + fr, kbase = mk0 + sc * 32 + 8 * fq;
#pragma unroll
                        for (int b = 0; b < 2; ++b)
#pragma unroll
                            for (int i = 0; i < 4; ++i) { const int dd = qpos - (kbase + 4 * b + i); if (dd > 128 || dd < -128) s[qt][b][i] = -1e30f; }
                    } else if (MODE == 2) {
                        const LAS float* rpb = (const LAS float*)(lds + ATT_RPB_OFF);
                        const int qc = mq0 + qt * 16 + fr, kr = mk0 + (sc >> 1), kcb = (sc & 1) * 32 + 8 * fq;
                        int cs = qc - 8; cs = cs < 0 ? 0 : (cs > 48 ? 48 : cs);
                        const int rowoff = (kr - mr + 7) * 31;
#pragma unroll
                        for (int b = 0; b < 2; ++b)
#pragma unroll
                            for (int i = 0; i < 4; ++i) { const int kc = kcb + 4 * b + i; const bool ok = (kc >= cs) && (kc <= cs + 15);
                                int bi = kc - qc + 15; bi = bi < 0 ? 0 : (bi > 30 ? 30 : bi);
                                const float bias = rpb[rowoff + bi];
                                s[qt][b][i] = ok ? s[qt][b][i] + bias : -1e30f; }
                    }
                    float mx = fmaxf(fmaxf(fmaxf(s[qt][0][0], s[qt][0][1]), fmaxf(s[qt][0][2], s[qt][0][3])), fmaxf(fmaxf(s[qt][1][0], s[qt][1][1]), fmaxf(s[qt][1][2], s[qt][1][3])));
                    mx = fmaxf(mx, __shfl_xor(mx, 16)); mx = fmaxf(mx, __shfl_xor(mx, 32));
                    const float mnew = fmaxf(mrun[qt], mx), alpha = __builtin_amdgcn_exp2f(mrun[qt] - mnew); mrun[qt] = mnew;
                    float ps = 0.f;
#pragma unroll
                    for (int b = 0; b < 2; ++b)
#pragma unroll
                        for (int i = 0; i < 4; ++i) { const float e = __builtin_amdgcn_exp2f(s[qt][b][i] - mnew); s[qt][b][i] = e; ps += e; }
                    lrun[qt] = lrun[qt] * alpha + ps;
                    if (__any(alpha != 1.0f)) {
#pragma unroll
                        for (int d = 0; d < NDV; ++d) o[qt][d] *= alpha; }
                    u32x4 w; w.x = cvt_pk_bf16(s[qt][0][0], s[qt][0][1]); w.y = cvt_pk_bf16(s[qt][0][2], s[qt][0][3]); w.z = cvt_pk_bf16(s[qt][1][0], s[qt][1][1]); w.w = cvt_pk_bf16(s[qt][1][2], s[qt][1][3]);
                    pf[qt] = __builtin_bit_cast(bf16x8, w);
                }
                { bf16x8 vf[NDV];
#pragma unroll
                  for (int d = 0; d < NDV; ++d) vf[d] = *(const LAS bf16x8*)(vb + (d * 16 + fr) * VROW + fq * 16);
#pragma unroll
                  for (int d = 0; d < NDV; ++d)
#pragma unroll
                    for (int qt = 0; qt < NQT; ++qt) o[qt][d] = __builtin_amdgcn_mfma_f32_16x16x32_bf16(vf[d], pf[qt], o[qt][d], 0, 0, 0); }
            }
        }
        if (more) { const int nb = cur ^ 1;
            if constexpr (KP == 3) asm volatile("s_waitcnt vmcnt(0)" : "+v"(rk[0]), "+v"(rk[1]), "+v"(rk[2]), "+v"(rv[0]), "+v"(rv[1]) :: "memory");
            else if constexpr (KP == 2) asm volatile("s_waitcnt vmcnt(0)" : "+v"(rk[0]), "+v"(rk[1]), "+v"(rv[0]), "+v"(rv[1]) :: "memory");
            else asm volatile("s_waitcnt vmcnt(0)" : "+v"(rk[0]), "+v"(rv[0]) :: "memory");
#pragma unroll
            for (int i = 0; i < KP; ++i) *(LAS u32x4*)(lds + nb * KBUF + kd[i]) = rk[i];
#pragma unroll
            for (int i = 0; i < VP; ++i) *(LAS u32x4*)(lds + 2 * KBUF + nb * VBUF + vd[i]) = rv[i]; }
        __syncthreads();
    }
#pragma unroll
    for (int qt = 0; qt < NQT; ++qt) {
        float l = lrun[qt]; l += __shfl_xor(l, 16); l += __shfl_xor(l, 32);
        if (MODE == 1) l += __builtin_amdgcn_exp2f(sink2 - mrun[qt]);
        const float inv = 1.0f / l;
        bf16_t* orow = op + (size_t)(qt * 16 + fr) * DM + 4 * fq;
#pragma unroll
        for (int d = 0; d < NDV; ++d) { u32x2 w; w.x = cvt_pk_bf16(o[qt][d][0] * inv, o[qt][d][1] * inv); w.y = cvt_pk_bf16(o[qt][d][2] * inv, o[qt][d][3] * inv); *(u32x2*)(orow + d * 16) = w; }
    }
}

__device__ __forceinline__ void attn_phase(const Params& p, int lq, LAS unsigned char* lds, int tid, int wid, int lane, int G, int cblk) {
    const int l = lq & 1;
    unsigned* head = (unsigned*)(p.ws + WS_CTL) + CW_ATTQ + lq * 64;
    volatile LAS int* qw = (volatile LAS int*)(lds + LDS_MISC + 64);
    bf16_t* br = (bf16_t*)(p.ws + ((lq & 2) ? WS_ACT : WS_BR));
    const int pmode = lq >> 2;
    if (pmode != 2)
    for (int id = cblk; id < 256; id += G) {
        const int x = id & 7, j = id >> 3, bhi = x * 2 + (j >> 4), qt16 = j & 15, b = bhi >> 2, h = bhi & 3; const size_t bh = (size_t)bhi;
        const bf16_t* q = (const bf16_t*)(p.ws + WS_MLQ) + (bh * SEQ + qt16 * 128 + wid * 16) * 192;
        const bf16_t* k = (const bf16_t*)(p.ws + WS_MLK) + bh * SEQ * 192; const bf16_t* v = (const bf16_t*)(p.ws + WS_MLVT) + bh * SEQ * 128;
        bf16_t* o = br + (size_t)(b * SEQ + qt16 * 128 + wid * 16) * DM + 512 + h * 128;
        attn_unit<192, 128, 0, 1>(lds, q, k, v, o, 64, 0, 64, 0, 0, 0, 0.f, tid, lane);
    }
    if (pmode != 1)
    for (;;) {
        if (tid == 0) qw[0] = 256 + (int)__hip_atomic_fetch_add(head, 1u, __ATOMIC_RELAXED, __HIP_MEMORY_SCOPE_AGENT);
        __syncthreads();
        const int id = __builtin_amdgcn_readfirstlane(qw[0]);
        __syncthreads();
        if (id >= 896) break;
        if (id < 256) {
        } else if (id < 512) {
            const int u = id - 256, b = u >> 6, h = (u >> 4) & 3, r2 = u & 15; const size_t bh = (size_t)(b * 4 + h);
            const int r = r2 * 2 + (wid >> 2), half = (wid >> 1) & 1, qs = wid & 1;
            int kr_lo = r2 * 2 - 4; kr_lo = kr_lo < 0 ? 0 : (kr_lo > 24 ? 24 : kr_lo);
            int kr_hi = r2 * 2 + 1 - 4; kr_hi = (kr_hi < 0 ? 0 : (kr_hi > 24 ? 24 : kr_hi)) + 7;
            int rs = r - 4; rs = rs < 0 ? 0 : (rs > 24 ? 24 : rs);
            { const float* rp = p.in[I_NA_RPB] + ((size_t)l * 4 + h) * 15 * 31; LAS float* rl = (LAS float*)(lds + ATT_RPB_OFF); if (tid < 465) rl[tid] = rp[tid] * LOG2E; }
            const int qtok = r * 64 + half * 32 + qs * 16;
            const bf16_t* q = (const bf16_t*)(p.ws + WS_NAQ) + (bh * SEQ + qtok) * 128;
            const bf16_t* k = (const bf16_t*)(p.ws + WS_NAK) + (bh * SEQ + kr_lo * 64) * 128; const bf16_t* v = (const bf16_t*)(p.ws + WS_NAVT) + (bh * 64 + kr_lo * 2) * 128 * 32;
            bf16_t* o = br + (size_t)(b * SEQ + qtok) * DM + 0 + h * 128;
            attn_unit<128, 128, 2, 1>(lds, q, k, v, o, 2 * (kr_hi - kr_lo + 1), 2 * (rs - kr_lo), 2 * (rs - kr_lo) + 16, half * 32 + qs * 16, kr_lo, r, 0.f, tid, lane);
        } else if (id < 768) {
            const int u = id - 512, b = u >> 6, kvh = (u >> 5) & 1, qb = u & 31, q0 = qb * 64; const int hq = kvh * 4 + (wid >> 1), qpos0 = q0 + (wid & 1) * 32;
            const int kstart = q0 - 128 < 0 ? 0 : q0 - 128, kend = q0 + 192 > SEQ ? SEQ : q0 + 192, nch = (kend - kstart) >> 5;
            int c_lo = (qpos0 - 128 - kstart) >> 5; c_lo = c_lo < 0 ? 0 : c_lo; int c_hi = ((qpos0 + 159 - kstart) >> 5) + 1; c_hi = c_hi > nch ? nch : c_hi;
            const bf16_t* q = (const bf16_t*)(p.ws + WS_SWQ) + ((size_t)(b * 8 + hq) * SEQ + qpos0) * 64;
            const bf16_t* k = (const bf16_t*)(p.ws + WS_SWK) + ((size_t)(b * 2 + kvh) * SEQ + kstart) * 64; const bf16_t* v = (const bf16_t*)(p.ws + WS_SWVT) + ((size_t)(b * 2 + kvh) * 64 + (kstart >> 5)) * 64 * 32;
            bf16_t* o = br + (size_t)(b * SEQ + qpos0) * DM + 1024 + hq * 64;
            attn_unit<64, 64, 1, 2>(lds, q, k, v, o, nch, c_lo, c_hi, qpos0, kstart, 0, p.in[I_SWA_SINK][l * 8 + hq] * LOG2E, tid, lane);
        } else {
            const int u = id - 768, b = u >> 5, h = (u >> 3) & 3, qt8 = u & 7; const size_t bh = (size_t)(b * 4 + h);
            const bf16_t* q = (const bf16_t*)(p.ws + WS_MEQ) + (bh * SEQ + qt8 * 256 + wid * 32) * 128;
            const bf16_t* k = (const bf16_t*)(p.ws + WS_MEK) + bh * MEML * 128; const bf16_t* v = (const bf16_t*)(p.ws + WS_MEVT) + bh * MEML * 128;
            bf16_t* o = br + (size_t)(b * SEQ + qt8 * 256 + wid * 32) * DM + 1536 + h * 128;
            attn_unit<128, 128, 0, 2>(lds, q, k, v, o, 8, 0, 8, 0, 0, 0, 0.f, tid, lane);
        }
    }
}

__device__ __forceinline__ void router_phase(const Params& p, LAS unsigned char* lds, int tid, int wid, int lane) {
    const float* hres = p.out; const float* g = p.in[I_NORM_FFN] + DM; const float* wr = p.in[I_ROUTER];
    unsigned* cnt = (unsigned*)(p.ws + WS_CTL) + CW_MOECNT;
    unsigned char* xg = p.ws + WS_XG; int* tokv = (int*)(p.ws + WS_TOK); float* wtv = (float*)(p.ws + WS_WT);
    LAS float* wl = (LAS float*)lds;
    LAS float* sel = (LAS float*)(lds + 65536);
    for (int i = tid; i < DM * NEXP; i += NTHREADS) { const int d = i >> 3, e = i & 7; wl[e * DM + d] = wr[i]; }
    __syncthreads();
    for (int grp = blockIdx.x; grp < NTOK / 32; grp += gridDim.x) {
#pragma unroll 1
        for (int ti = 0; ti < 4; ++ti) {
            const int tl = wid * 4 + ti, token = grp * 32 + tl;
            const f32x4* sp = (const f32x4*)(hres + (size_t)token * DM); f32x4 v[8]; float ss = 0.f;
#pragma unroll
            for (int j = 0; j < 8; ++j) { v[j] = sp[lane + 64 * j]; ss += v[j][0] * v[j][0] + v[j][1] * v[j][1] + v[j][2] * v[j][2] + v[j][3] * v[j][3]; }
            ss = wave_sum(ss); const float rstd = 1.0f / sqrtf(ss * (1.0f / DM) + EPS);
            float lg[8];
#pragma unroll
            for (int e = 0; e < 8; ++e) lg[e] = 0.f;
#pragma unroll
            for (int j = 0; j < 8; ++j) { const f32x4 gv = ((const f32x4*)g)[lane + 64 * j]; const f32x4 hn = v[j] * rstd * gv;
#pragma unroll
                for (int e = 0; e < 8; ++e) { const f32x4 w4 = *(const LAS f32x4*)(wl + e * DM + 4 * (lane + 64 * j)); lg[e] += hn[0] * w4[0] + hn[1] * w4[1] + hn[2] * w4[2] + hn[3] * w4[3]; } }
#pragma unroll
            for (int e = 0; e < 8; ++e) lg[e] = wave_sum(lg[e]);
            int i0 = 0; float v0 = lg[0];
#pragma unroll
            for (int e = 1; e < 8; ++e) if (lg[e] > v0) { v0 = lg[e]; i0 = e; }
            int i1 = -1; float v1 = -3.0e38f;
#pragma unroll
            for (int e = 0; e < 8; ++e) if (e != i0 && lg[e] > v1) { v1 = lg[e]; i1 = e; }
            const float e1 = __expf(v1 - v0), w0 = 1.0f / (1.0f + e1), w1 = e1 * w0;
            if (lane == 0) { sel[tl * 8 + 0] = __int_as_float(i0); sel[tl * 8 + 1] = __int_as_float(i1); sel[tl * 8 + 2] = w0; sel[tl * 8 + 3] = w1; sel[tl * 8 + 4] = rstd; }
        }
        __syncthreads();
        if (tid < NEXP) { int n = 0;
            for (int t = 0; t < 32; ++t) { n += (__float_as_int(sel[t * 8 + 0]) == tid) ? 1 : 0; n += (__float_as_int(sel[t * 8 + 1]) == tid) ? 1 : 0; }
            int base = n ? (int)__hip_atomic_fetch_add(cnt + tid * 64, (unsigned)n, __ATOMIC_RELAXED, __HIP_MEMORY_SCOPE_AGENT) : 0;
            for (int t = 0; t < 32; ++t) { if (__float_as_int(sel[t * 8 + 0]) == tid) sel[t * 8 + 5] = __int_as_float(base++); if (__float_as_int(sel[t * 8 + 1]) == tid) sel[t * 8 + 6] = __int_as_float(base++); } }
        __syncthreads();
#pragma unroll 1
        for (int ti = 0; ti < 4; ++ti) {
            const int tl = wid * 4 + ti, token = grp * 32 + tl;
            const int e0 = __float_as_int(sel[tl * 8 + 0]), e1 = __float_as_int(sel[tl * 8 + 1]); const float w0 = sel[tl * 8 + 2], w1 = sel[tl * 8 + 3], rstd = sel[tl * 8 + 4];
            const int s0 = e0 * ECAP + __float_as_int(sel[tl * 8 + 5]), s1 = e1 * ECAP + __float_as_int(sel[tl * 8 + 6]);
            const f32x4* sp = (const f32x4*)(hres + (size_t)token * DM);
#pragma unroll
            for (int j = 0; j < 8; ++j) { const f32x4 x = sp[lane + 64 * j]; const f32x4 gv = ((const f32x4*)g)[lane + 64 * j];
#if MOE_FP8
                const float rg = rstd * SC_ACT8; const unsigned w = pg8::pack_fp8x4(x[0] * rg * gv[0], x[1] * rg * gv[1], x[2] * rg * gv[2], x[3] * rg * gv[3]);
                *(unsigned*)(xg + (size_t)s0 * DM + 4 * (lane + 64 * j)) = w; *(unsigned*)(xg + (size_t)s1 * DM + 4 * (lane + 64 * j)) = w; }
#else
                u32x2 w; w.x = cvt_pk_bf16(x[0] * rstd * gv[0], x[1] * rstd * gv[1]); w.y = cvt_pk_bf16(x[2] * rstd * gv[2], x[3] * rstd * gv[3]);
                *(u32x2*)(xg + ((size_t)s0 * DM + 4 * (lane + 64 * j)) * 2) = w; *(u32x2*)(xg + ((size_t)s1 * DM + 4 * (lane + 64 * j)) * 2) = w; }
#endif
            if (lane == 0) { tokv[s0] = token; wtv[s0] = w0; tokv[s1] = token; wtv[s1] = w1; int* ts = (int*)(p.ws + WS_TSLOT); ts[token * 2] = s0; ts[token * 2 + 1] = s1; }
        }
        __syncthreads();
    }
}

constexpr int MOE_TAB_OFF = LDS_MISC + 128;
__device__ __forceinline__ void moe_table(LAS unsigned char* lds, const unsigned* cnt, int nN, int tid) {
    LAS int* tab = (LAS int*)(lds + MOE_TAB_OFF);
    __syncthreads();
    if (tid == 0) { int acc = 0; for (int e = 0; e < 8; ++e) { const int n = ((int)cnt[e * 64] + 255) >> 8; tab[e] = n; tab[8 + e] = acc; acc += n * nN; } tab[16] = acc; }
    __syncthreads();
}
struct SchedMoe {
    const char* A; const char* B; size_t a_estride, b_estride, a_tstride, b_tstride; const LAS int* tab; int G, c; int ksplit; size_t kbytes;
    __device__ __forceinline__ bool next(int i, pg8::Unit& u) const {
        const int L0 = i * G + c; if (L0 >= tab[16] * ksplit) return false;
        const int ks = L0 % ksplit, L = L0 / ksplit;
        int e = 0;
#pragma unroll
        for (int k = 1; k < 8; ++k) e = (L >= tab[8 + k]) ? k : e;
        const int ne = tab[e], loc = L - tab[8 + e], pm = loc % ne, pn = loc / ne;
        u.A = A + (size_t)e * a_estride + (size_t)pm * a_tstride + (size_t)ks * kbytes; u.B = B + (size_t)e * b_estride + (size_t)pn * b_tstride + (size_t)ks * kbytes;
        u.orow = e * ECAP + pm * 256; u.ocol = pn; u.x0 = e; u.x1 = pm * 256; u.ks = ks; u.pad_ = 0; return true;
    }
};
struct SchedMerge {
    const char* br; const char* wb; int G, c;
    __device__ __forceinline__ bool next(int i, pg8::Unit& u) const {
        int pm, pn; if (!pg8::static_tile(i >> 2, G, c, NTOK / 256, DM / 256, pm, pn)) return false;
        const int n = i & 3;
        u.A = br + ((size_t)pm * 256 * DM + n * 512) * 2; u.B = wb + ((size_t)n * DM * 512 + (size_t)pn * 256 * 512) * 2; u.orow = pm * 256; u.ocol = pn; u.x0 = n; u.x1 = 0; u.ks = 0; u.pad_ = 0; return true;
    }
};

__device__ __forceinline__ void moe_combine(const Params& p, int wid, int lane) {
    const int* ts = (const int*)(p.ws + WS_TSLOT); const bf16_t* y = (const bf16_t*)(p.ws + WS_Y); float* out = p.out;
    for (int row = blockIdx.x * 8 + wid; row < NTOK; row += gridDim.x * 8) {
        const int s0 = ts[row * 2], s1 = ts[row * 2 + 1];
        f32x4* o = (f32x4*)(out + (size_t)row * DM);
        u32x4 a[MOE_KS][4], b[MOE_KS][4]; f32x4 hv[8];
#pragma unroll
        for (int ks = 0; ks < MOE_KS; ++ks) { const u32x4* y0 = (const u32x4*)(y + ((size_t)ks * NEXP * ECAP + s0) * DM); const u32x4* y1 = (const u32x4*)(y + ((size_t)ks * NEXP * ECAP + s1) * DM);
#pragma unroll
            for (int j = 0; j < 4; ++j) { a[ks][j] = y0[lane + 64 * j]; b[ks][j] = y1[lane + 64 * j]; } }
#pragma unroll
        for (int j = 0; j < 4; ++j) { hv[2 * j] = o[2 * (lane + 64 * j)]; hv[2 * j + 1] = o[2 * (lane + 64 * j) + 1]; }
#pragma unroll
        for (int j = 0; j < 4; ++j) {
            f32x4 r0 = hv[2 * j], r1 = hv[2 * j + 1];
#pragma unroll
            for (int ks = 0; ks < MOE_KS; ++ks) { const u32x4 av = a[ks][j], bv = b[ks][j];
                r0[0] += bflo(av.x) + bflo(bv.x); r0[1] += bfhi(av.x) + bfhi(bv.x); r0[2] += bflo(av.y) + bflo(bv.y); r0[3] += bfhi(av.y) + bfhi(bv.y);
                r1[0] += bflo(av.z) + bflo(bv.z); r1[1] += bfhi(av.z) + bfhi(bv.z); r1[2] += bflo(av.w) + bflo(bv.w); r1[3] += bfhi(av.w) + bfhi(bv.w); }
            o[2 * (lane + 64 * j)] = r0; o[2 * (lane + 64 * j) + 1] = r1; }
    }
}

#ifdef PROBE_NAIVE
#ifndef NAIVE_TOL2
#define NAIVE_TOL2 0.0036f
#endif
__device__ __forceinline__ void nv_rope(float& x2, int lane, int pos) {
    const int i = lane & 31; const float freq = exp2f(-(float)i * (13.287712379549449f / 32.0f)); const float ang = (float)pos * freq;
    const double rev = (double)ang * 0.15915494309189535; const float fr_ = (float)(rev - __builtin_rint(rev));
    const float c = __builtin_amdgcn_cosf(fr_), s = __builtin_amdgcn_sinf(fr_); const float pr = __shfl_xor(x2, 32);
    x2 = lane < 32 ? x2 * c - pr * s : x2 * c + pr * s;
}
__device__ __forceinline__ void naive_check(const Params& p, unsigned* flag, int wid, int lane) {
    const int l = 1;
    const bf16_t* z = (const bf16_t*)(p.ws + WS_Z); const bf16_t* qraw = (const bf16_t*)(p.ws + WS_QRAW); const bf16_t* kvraw = (const bf16_t*)(p.ws + WS_KVRAW);
    const bf16_t* memkv = (const bf16_t*)(p.ws + WS_MEMKV) + (size_t)l * NMEM * 1024; const bf16_t* br = (const bf16_t*)(p.ws + WS_BR);
    const int poslist[16] = {0, 1, 31, 63, 64, 65, 127, 128, 129, 500, 1023, 1024, 1500, 1919, 1984, 2047};
    for (int unit = blockIdx.x * 8 + wid; unit < 64 * 20; unit += gridDim.x * 8) {
        const int smp = unit / 20, hh = unit % 20;
        int pos = 0;
#pragma unroll
        for (int q = 0; q < 16; ++q) pos = ((smp >> 2) == q) ? poslist[q] : pos;
        const int b = smp & 3, t = b * SEQ + pos;
        float o[3] = {0.f, 0.f, 0.f}, m = -3.0e38f, lsum = 0.f; float q[3] = {0.f, 0.f, 0.f};
        float ref[3] = {0.f, 0.f, 0.f}; int nd = 2;
        if (hh < 4) {
            const int h = hh; const float* gq = p.in[I_NA_QN] + l * 128; const float* gk = p.in[I_NA_KN] + l * 128;
            float ss = 0.f; for (int j = 0; j < 2; ++j) { q[j] = bf2f(z[(size_t)t * ZC + Z_NAQ + h * 128 + lane + 64 * j]); ss += q[j] * q[j]; }
            ss = wave_sum(ss); for (int j = 0; j < 2; ++j) q[j] *= (1.0f / sqrtf(ss / 128 + EPS)) * gq[lane + 64 * j];
            const int r = pos >> 6, c = pos & 63; int rs = r - 4; rs = rs < 0 ? 0 : (rs > 24 ? 24 : rs); int cs = c - 8; cs = cs < 0 ? 0 : (cs > 48 ? 48 : cs);
            for (int i = 0; i < 8; ++i) for (int jj = 0; jj < 16; ++jj) { const int n = b * SEQ + (rs + i) * 64 + cs + jj;
                float k[2], ks = 0.f; for (int j = 0; j < 2; ++j) { k[j] = bf2f(z[(size_t)n * ZC + Z_NAK + h * 128 + lane + 64 * j]); ks += k[j] * k[j]; }
                ks = wave_sum(ks); float dot = 0.f; for (int j = 0; j < 2; ++j) dot += q[j] * k[j] * (1.0f / sqrtf(ks / 128 + EPS)) * gk[lane + 64 * j];
                const float s = wave_sum(dot) * 0.08838834764831845f + p.in[I_NA_RPB][(((size_t)l * 4 + h) * 15 + (rs + i - r + 7)) * 31 + (cs + jj - c + 15)];
                const float mn = fmaxf(m, s), al = __expf(m - mn), pe = __expf(s - mn); m = mn; lsum = lsum * al + pe;
                for (int j = 0; j < 2; ++j) o[j] = o[j] * al + pe * bf2f(z[(size_t)n * ZC + Z_NAV + h * 128 + lane + 64 * j]); }
            for (int j = 0; j < 2; ++j) ref[j] = bf2f(br[(size_t)t * DM + 0 + h * 128 + lane + 64 * j]);
        } else if (hh < 8) {
            const int h = hh - 4; nd = 3; const float* gq = p.in[I_MLA_QN] + l * 192; const float* gk = p.in[I_MLA_KN] + l * 192;
            float ss = 0.f; for (int j = 0; j < 3; ++j) { q[j] = bf2f(qraw[(size_t)t * 768 + h * 192 + lane + 64 * j]); ss += q[j] * q[j]; }
            ss = wave_sum(ss); for (int j = 0; j < 3; ++j) q[j] *= (1.0f / sqrtf(ss / 192 + EPS)) * gq[lane + 64 * j];
            nv_rope(q[2], lane, pos);
            for (int kp = 0; kp < SEQ; ++kp) { const int n = b * SEQ + kp;
                float k[3], ks = 0.f; k[0] = bf2f(kvraw[(size_t)n * 1024 + h * 256 + lane]); k[1] = bf2f(kvraw[(size_t)n * 1024 + h * 256 + 64 + lane]); k[2] = bf2f(z[(size_t)n * ZC + Z_KPE + lane]);
                for (int j = 0; j < 3; ++j) ks += k[j] * k[j];
                ks = wave_sum(ks); const float rk = 1.0f / sqrtf(ks / 192 + EPS); for (int j = 0; j < 3; ++j) k[j] *= rk * gk[lane + 64 * j];
                nv_rope(k[2], lane, kp);
                float dot = 0.f; for (int j = 0; j < 3; ++j) dot += q[j] * k[j];
                const float s = wave_sum(dot) * 0.07216878364870322f;
                const float mn = fmaxf(m, s), al = __expf(m - mn), pe = __expf(s - mn); m = mn; lsum = lsum * al + pe;
                for (int j = 0; j < 2; ++j) o[j] = o[j] * al + pe * bf2f(kvraw[(size_t)n * 1024 + h * 256 + 128 + lane + 64 * j]); }
            nd = 2;
            for (int j = 0; j < 2; ++j) ref[j] = bf2f(br[(size_t)t * DM + 512 + h * 128 + lane + 64 * j]);
        } else if (hh < 16) {
            const int hq = hh - 8, kvh = hq >> 2; nd = 1; const float* gq = p.in[I_SWA_QN] + l * 64; const float* gk = p.in[I_SWA_KN] + l * 64;
            q[0] = bf2f(z[(size_t)t * ZC + Z_SWQ + hq * 64 + lane]); float ss = wave_sum(q[0] * q[0]); q[0] *= (1.0f / sqrtf(ss / 64 + EPS)) * gq[lane]; nv_rope(q[0], lane, pos);
            for (int kp = pos - 128; kp <= pos + 128; ++kp) { if (kp < 0 || kp >= SEQ) continue; const int n = b * SEQ + kp;
                float k = bf2f(z[(size_t)n * ZC + Z_SWK + kvh * 64 + lane]); const float ks = wave_sum(k * k); k *= (1.0f / sqrtf(ks / 64 + EPS)) * gk[lane]; nv_rope(k, lane, kp);
                const float s = wave_sum(q[0] * k) * 0.125f;
                const float mn = fmaxf(m, s), al = __expf(m - mn), pe = __expf(s - mn); m = mn; lsum = lsum * al + pe;
                o[0] = o[0] * al + pe * bf2f(z[(size_t)n * ZC + Z_SWV + kvh * 64 + lane]); }
            { const float s = p.in[I_SWA_SINK][l * 8 + hq]; const float mn = fmaxf(m, s), al = __expf(m - mn), pe = __expf(s - mn); m = mn; lsum = lsum * al + pe; o[0] *= al; }
            ref[0] = bf2f(br[(size_t)t * DM + 1024 + hq * 64 + lane]);
        } else {
            const int h = hh - 16; const float* gq = p.in[I_MEM_QN] + l * 128; const float* gk = p.in[I_MEM_KN] + l * 128;
            float ss = 0.f; for (int j = 0; j < 2; ++j) { q[j] = bf2f(z[(size_t)t * ZC + Z_MEQ + h * 128 + lane + 64 * j]); ss += q[j] * q[j]; }
            ss = wave_sum(ss); for (int j = 0; j < 2; ++j) q[j] *= (1.0f / sqrtf(ss / 128 + EPS)) * gq[lane + 64 * j];
            for (int mm = 0; mm < MEML; ++mm) { const size_t n = (size_t)(b * MEML + mm) * 1024;
                float k[2], ks = 0.f; for (int j = 0; j < 2; ++j) { k[j] = bf2f(memkv[n + h * 128 + lane + 64 * j]); ks += k[j] * k[j]; }
                ks = wave_sum(ks); float dot = 0.f; for (int j = 0; j < 2; ++j) dot += q[j] * k[j] * (1.0f / sqrtf(ks / 128 + EPS)) * gk[lane + 64 * j];
                const float s = wave_sum(dot) * 0.08838834764831845f;
                const float mn = fmaxf(m, s), al = __expf(m - mn), pe = __expf(s - mn); m = mn; lsum = lsum * al + pe;
                for (int j = 0; j < 2; ++j) o[j] = o[j] * al + pe * bf2f(memkv[n + 512 + h * 128 + lane + 64 * j]); }
            for (int j = 0; j < 2; ++j) ref[j] = bf2f(br[(size_t)t * DM + 1536 + h * 128 + lane + 64 * j]);
        }
        float e2 = 0.f, n2 = 0.f;
        for (int j = 0; j < 3; ++j) if (j < nd) { const float a = o[j] / lsum; e2 += (a - ref[j]) * (a - ref[j]); n2 += a * a; }
        e2 = wave_sum(e2); n2 = wave_sum(n2);
        if (!(e2 <= NAIVE_TOL2 * n2 + 1e-12f) && lane == 0) atomicOr(flag, 1u << (hh < 4 ? 1 : hh < 8 ? 2 : hh < 16 ? 3 : 4));
    }
}
#endif
constexpr int NPHASE = 23;
constexpr int LDS_PARAMS = LDS_MISC + 256;
template <class T> __device__ __forceinline__ T* uni(T* q) { const unsigned long long v = (unsigned long long)q; const unsigned lo = __builtin_amdgcn_readfirstlane((unsigned)v), hi = __builtin_amdgcn_readfirstlane((unsigned)(v >> 32)); return (T*)(__attribute__((address_space(1))) T*)(((unsigned long long)hi << 32) | lo); }
__device__ __forceinline__ Params load_params(LAS unsigned char* lds) {
    unsigned poff = LDS_PARAMS; asm volatile("" : "+v"(poff)); poff = __builtin_amdgcn_readfirstlane(poff);
    const LAS Params* P = (const LAS Params*)(lds + poff); Params p;
#pragma unroll
    for (int i = 0; i < 30; ++i) p.in[i] = uni(P->in[i]);
    p.out = uni(P->out); p.ws = uni(P->ws); p.ph_lo = __builtin_amdgcn_readfirstlane(P->ph_lo); p.ph_hi = __builtin_amdgcn_readfirstlane(P->ph_hi); return p;
}
#define PH_HEAD int tid = threadIdx.x; asm volatile("" : "+v"(tid)); const Params p = load_params(lds); const int lane = tid & 63, wid = __builtin_amdgcn_readfirstlane(tid >> 6); const int G = p.ph_lo, cblk = p.ph_hi;     \
    unsigned char* ws = p.ws; unsigned* ctl = (unsigned*)(ws + WS_CTL); unsigned char* lw = ws + WS_LW + (size_t)l * LW_BYTES; bf16_t* U = (bf16_t*)(ws + WS_U); (void)lane; (void)wid; (void)G; (void)cblk; (void)ctl; (void)lw; (void)U
#define PHASE_FN static __device__ __forceinline__ void

PHASE_FN ph_prologue(LAS unsigned char* lds, int l) { PH_HEAD; p0_prologue(p, lds, tid, wid, lane); }
PHASE_FN ph_ingate(LAS unsigned char* lds, int l) { PH_HEAD;
#if INGATE_FP8
    pg8::SchedGrid S{(const char*)(ws + WS_U8), (const char*)(lw + LW_IN), DM / 2, DM / 2, NTOK / 256, 12288 / 256, G, cblk};
    pg8::EpiInGate E{(bf16_t*)(ws + WS_Z), (bf16_t*)(ws + WS_GATES), p.in[I_B_GATE] + (size_t)l * 8192, 1.0f / (SC_ACT8 * SC_W8)};
    pg8::gemm_phase<pg8::EpiInGate, pg8::SchedGrid, true>(lds, DM / 2, DM / 2, DM / 2, S, E, tid);
#else
    pg8::SchedGrid S{(const char*)U, (const char*)(lw + LW_IN), DM, DM, NTOK / 256, 12288 / 256, G, cblk};
    pg8::EpiInGate E{(bf16_t*)(ws + WS_Z), (bf16_t*)(ws + WS_GATES), p.in[I_B_GATE] + (size_t)l * 8192, 1.0f};
    pg8::gemm_phase(lds, DM, DM, DM, S, E, tid);
#endif
}
PHASE_FN ph_inproj(LAS unsigned char* lds, int l) { PH_HEAD;
    const bool sh = l >= 2; l &= 1; lw = ws + WS_LW + (size_t)l * LW_BYTES;
    pg8::SchedGrid S{(const char*)U, (const char*)(lw + LW_IN), DM, DM, NTOK / 256, ZC / 256, G, cblk};
    pg8::EpiBf16 E{(bf16_t*)(ws + (sh ? WS_ACT : WS_Z)), ZC};
    pg8::gemm_phase(lds, DM, DM, DM, S, E, tid); }
PHASE_FN ph_gates(LAS unsigned char* lds, int l) { PH_HEAD;
#if GATES_FP8
    pg8::SchedGrid S{(const char*)(ws + WS_U8), (const char*)(lw + LW_GATE8), DM / 2, DM / 2, NTOK / 256, 8192 / 256, G, cblk};
    pg8::EpiGates E{(bf16_t*)(ws + WS_GATES), p.in[I_B_GATE] + (size_t)l * 8192, 1.0f / (SC_ACT8 * SC_W8)};
    pg8::gemm_phase<pg8::EpiGates, pg8::SchedGrid, true>(lds, DM / 2, DM / 2, DM / 2, S, E, tid);
#else
    pg8::SchedGrid S{(const char*)U, (const char*)(lw + LW_GATE8), DM, DM, NTOK / 256, 8192 / 256, G, cblk};
    pg8::EpiGates E{(bf16_t*)(ws + WS_GATES), p.in[I_B_GATE] + (size_t)l * 8192, 1.0f};
    pg8::gemm_phase<pg8::EpiGates, pg8::SchedGrid, false>(lds, DM, DM, DM, S, E, tid);
#endif
}
PHASE_FN ph_prep1(LAS unsigned char* lds, int l) { PH_HEAD; prep1(p, l, lds, tid, wid, lane); }
PHASE_FN ph_mlaup_q(LAS unsigned char* lds, int l) { PH_HEAD;
    pg8::SchedGrid S{(const char*)(ws + WS_CQN), (const char*)(lw + LW_UQ), 768, 768, NTOK / 256, 3, G, cblk};
    pg8::EpiBf16 E{(bf16_t*)(ws + WS_QRAW), 768}; pg8::gemm_phase(lds, 768, 768, 768, S, E, tid); }
PHASE_FN ph_mlaup_kv(LAS unsigned char* lds, int l) { PH_HEAD;
    pg8::SchedGrid S{(const char*)(ws + WS_CKVN), (const char*)(lw + LW_UKV), 256, 256, NTOK / 256, 4, G, (cblk + G - 96 % G) % G};
    pg8::EpiBf16 E{(bf16_t*)(ws + WS_KVRAW), 1024}; pg8::gemm_phase(lds, 256, 256, 256, S, E, tid); }
PHASE_FN ph_memkv(LAS unsigned char* lds, int l) { PH_HEAD;
    pg8::SchedGrid S{(const char*)(ws + WS_MEMN + (size_t)l * NMEM * DM * 2), (const char*)(lw + LW_MEMKV), DM, DM, NMEM / 256, 4, G, (cblk + G - (224 + 16 * l) % G) % G};
    pg8::EpiBf16 E{(bf16_t*)(ws + WS_MEMKV) + (size_t)l * NMEM * 1024, 1024}; pg8::gemm_phase(lds, DM, DM, DM, S, E, tid); }
PHASE_FN ph_prep2(LAS unsigned char* lds, int l) { PH_HEAD; prep2(p, l, lds, tid, wid, lane); }
PHASE_FN ph_attn(LAS unsigned char* lds, int l) { PH_HEAD; attn_phase(p, l, lds, tid, wid, lane, G, cblk); }
PHASE_FN ph_merge(LAS unsigned char* lds, int l) { PH_HEAD;
    SchedMerge S{(const char*)(ws + WS_BR), (const char*)(lw + LW_BR), G, cblk};
    pg8::EpiMerge E{(const bf16_t*)(ws + WS_GATES), (bf16_t*)(ws + WS_MERGED)};
#ifndef MERGE_ALIGN
#define MERGE_ALIGN false
#endif
    pg8::gemm_phase<pg8::EpiMerge, SchedMerge, false, MERGE_ALIGN>(lds, DM, 512, 512, S, E, tid); }
PHASE_FN ph_wo(LAS unsigned char* lds, int l) { PH_HEAD;
    pg8::SchedGrid S{(const char*)(ws + WS_MERGED), (const char*)(lw + LW_O), DM, DM, NTOK / 256, DM / 256, G, cblk};
    pg8::EpiResF32 E{l == 0 ? p.in[I_X] : (const float*)p.out, p.out, 1.0f};
    pg8::gemm_phase(lds, DM, DM, DM, S, E, tid); }
PHASE_FN ph_norm(LAS unsigned char* lds, int l) { PH_HEAD;
    norm_rows(p.out, l == 0 ? p.in[I_NORM_FFN] : p.in[I_NORM_MIX] + DM, U, l == 0 ? nullptr : ws + WS_U8, NTOK, wid, lane); }
PHASE_FN ph_ffnup(LAS unsigned char* lds, int l) { PH_HEAD;
    pg8::SchedGrid S{(const char*)U, (const char*)(ws + WS_FFNUP), DM, DM, NTOK / 256, 2 * DFF / 256, G, cblk};
    pg8::EpiSwiGLU E{(bf16_t*)(ws + WS_ACT), DFF};
    pg8::gemm_phase(lds, DM, DM, DM, S, E, tid); }
PHASE_FN ph_ffndown(LAS unsigned char* lds, int l) { PH_HEAD;
    pg8::SchedGrid S{(const char*)(ws + WS_ACT), (const char*)(ws + WS_FFNDN), DFF, DFF, NTOK / 256, DM / 256, G, cblk};
    pg8::EpiResF32 E{(const float*)p.out, p.out, 1.0f};
    pg8::gemm_phase(lds, DFF, DFF, DFF, S, E, tid); }
PHASE_FN ph_router(LAS unsigned char* lds, int l) { PH_HEAD; router_phase(p, lds, tid, wid, lane); }
PHASE_FN ph_moeup(LAS unsigned char* lds, int l) { PH_HEAD;
    moe_table(lds, ctl + CW_MOECNT, 2 * DFFE / 256, tid);
    const SchedMoe S{(const char*)(ws + WS_XG), (const char*)(ws + WS_MOEUP), (size_t)ECAP * DM * MOE_ES, (size_t)2 * DFFE * DM * MOE_ES, (size_t)256 * DM * MOE_ES, (size_t)256 * DM * MOE_ES, (const LAS int*)(lds + MOE_TAB_OFF), G, cblk, 1, 0};
#if MOE_FP8
    pg8::EpiSwiGLU8 E{ws + WS_ACTM, DFFE, 1.0f / (SC_ACT8 * SC_W8), SC_H8};
    pg8::gemm_phase<pg8::EpiSwiGLU8, SchedMoe, true>(lds, DM / 2, DM / 2, DM / 2, S, E, tid);
#else
    pg8::EpiSwiGLU E{(bf16_t*)(ws + WS_ACTM), DFFE};
    pg8::gemm_phase(lds, DM, DM, DM, S, E, tid);
#endif
}
#ifndef MOE_KSPLIT
#define MOE_KSPLIT MOE_KS
#endif
PHASE_FN ph_moedown(LAS unsigned char* lds, int l) { PH_HEAD;
    moe_table(lds, ctl + CW_MOECNT, DM / 256, tid);
    const SchedMoe S{(const char*)(ws + WS_ACTM), (const char*)(ws + WS_MOEDN), (size_t)ECAP * DFFE * MOE_ES, (size_t)DM * DFFE * MOE_ES, (size_t)256 * DFFE * MOE_ES, (size_t)256 * DFFE * MOE_ES, (const LAS int*)(lds + MOE_TAB_OFF), G, cblk, MOE_KSPLIT, (size_t)DFFE * MOE_ES / MOE_KSPLIT};
#if MOE_FP8
    pg8::EpiMoeDownY E{(bf16_t*)(ws + WS_Y), (const float*)(ws + WS_WT), ctl + CW_MOECNT, 1.0f / (SC_H8 * SC_W8)};
    pg8::gemm_phase<pg8::EpiMoeDownY, SchedMoe, true>(lds, DFFE / 2, DFFE / 2, DFFE / 2 / MOE_KSPLIT, S, E, tid);
#else
    pg8::EpiMoeDown E{p.out, (const int*)(ws + WS_TOK), (const float*)(ws + WS_WT), ctl + CW_MOECNT, 1.0f};
    pg8::gemm_phase(lds, DFFE, DFFE, DFFE / MOE_KSPLIT, S, E, tid);
#endif
}


#ifndef PROBE_CHK
#define PROBE_CHK 0
#endif
constexpr int CW_CHKFLAG = 4096 + 2048;
PHASE_FN ph_compare(LAS unsigned char* lds, int l, size_t offa, size_t offb, size_t nbytes) { PH_HEAD;
    const u32x4* a = (const u32x4*)(ws + offa); const u32x4* b = (const u32x4*)(ws + offb); unsigned bad = 0;
    for (size_t i = (size_t)cblk * NTHREADS + tid; i < nbytes / 16; i += (size_t)G * NTHREADS) { const u32x4 x = a[i], y = b[i]; bad |= (x.x ^ y.x) | (x.y ^ y.y) | (x.z ^ y.z) | (x.w ^ y.w); }
    if (bad) atomicOr(ctl + CW_CHKFLAG, 1u); }
#ifdef PROBE_NAIVE
PHASE_FN ph_naive(LAS unsigned char* lds, int l) { PH_HEAD; naive_check(p, ctl + CW_CHKFLAG, wid, lane); }
#endif
PHASE_FN ph_poison(LAS unsigned char* lds, int l) { PH_HEAD;
    if (__hip_atomic_load(ctl + CW_CHKFLAG, __ATOMIC_RELAXED, __HIP_MEMORY_SCOPE_AGENT) != 0u && tid == 0) p.out[cblk] = __builtin_nanf(""); }
PHASE_FN ph_combine(LAS unsigned char* lds, int l) { PH_HEAD; moe_combine(p, wid, lane); }
__global__ void __launch_bounds__(NTHREADS, 2) mk_fwd(Params pk) {
    extern __shared__ __attribute__((aligned(16))) unsigned char lds_raw[];
    LAS unsigned char* lds = (LAS unsigned char*)lds_raw;
    const int tid = threadIdx.x;
    if (tid < 64) ((LAS unsigned*)(lds + LDS_MISC))[tid] = 0u;
    if (tid == 64) { LAS Params* P = (LAS Params*)(lds + LDS_PARAMS);
#pragma unroll
        for (int i = 0; i < 30; ++i) P->in[i] = pk.in[i];
        P->out = pk.out; P->ws = pk.ws; P->ph_lo = (int)gridDim.x; P->ph_hi = (int)blockIdx.x; }
    __syncthreads();
    unsigned* ctl = (unsigned*)(pk.ws + WS_CTL);
#if !MK_MULTI
    (void)xcd_barrier_post(ctl + CW_BAR, (volatile LAS unsigned*)(lds + LDS_MISC));
#endif
#ifdef ONLY_FN
    ONLY_FN(lds, pk.ph_lo); return;
#endif
    const int lo = pk.ph_lo, hi = pk.ph_hi;
#define IN(k) (lo <= (k) && (k) < hi)
#if MK_MULTI
#define SEAM(k) do { } while (0)
#else
#ifndef PROBE_BAR
#define PROBE_BAR 0
#endif
#define SEAM(k) do { for (int rep_ = 0; rep_ < 1 + PROBE_BAR; ++rep_) if (IN((k) + 1)) { const Params q_ = load_params(lds); XcdBarrier b2_; b2_.bar = (unsigned*)(q_.ws + WS_CTL) + CW_BAR; b2_.x = xb_xcc_id(); b2_.st = (volatile LAS unsigned*)(lds + LDS_MISC); xcd_barrier(b2_); } } while (0)
#endif
#ifndef PROBE_P0
#define PROBE_P0 0
#endif
#ifndef PROBE_DUP
#define PROBE_DUP 0
#endif
#define DUP(bit) ((PROBE_DUP >> (bit)) & 1)
#ifndef PROBE_ATTN
#define PROBE_ATTN 0
#endif
#ifndef PROBE_THIN
#define PROBE_THIN 0
#endif
    if (IN(0)) { ph_prologue(lds, 0); if (PROBE_P0) { __syncthreads(); ph_prologue(lds, 0); } SEAM(0); }
#pragma unroll 1
    for (int l = 0; l < DEPTH; ++l) {
        const int pb = 1 + 11 * l;
#ifndef SPLIT_INGATE
#define SPLIT_INGATE 0
#endif
        if (IN(pb + 0)) { if (SPLIT_INGATE == 1) { ph_inproj(lds, l); __syncthreads(); ph_gates(lds, l); } else if (SPLIT_INGATE == 2) { ph_ingate(lds, l); SEAM(pb + 0); ph_inproj(lds, l); } else if (SPLIT_INGATE == 3) { ph_ingate(lds, l); SEAM(pb + 0); ph_gates(lds, l); } else { ph_ingate(lds, l); if (DUP(0)) ph_ingate(lds, l); } if (PROBE_CHK == 2) ph_inproj(lds, l + 2); SEAM(pb + 0);
            if (PROBE_CHK == 2) { ph_compare(lds, l, WS_Z, WS_ACT, (size_t)NTOK * ZC * 2); SEAM(pb + 0); } }
        if (IN(pb + 1)) { ph_prep1(lds, l); if (PROBE_THIN) { __syncthreads(); ph_prep1(lds, l); } SEAM(pb + 1); }
        if (IN(pb + 2)) { for (int rep = 0; rep < 1 + DUP(1); ++rep) { ph_mlaup_q(lds, l); ph_mlaup_kv(lds, l); if (l == 0) { ph_memkv(lds, 0); ph_memkv(lds, 1); } } SEAM(pb + 2); }
        if (IN(pb + 3)) { ph_prep2(lds, l); if (PROBE_THIN) { __syncthreads(); ph_prep2(lds, l); } SEAM(pb + 3); }
        if (IN(pb + 4)) { ph_attn(lds, l); if (PROBE_ATTN || PROBE_CHK == 1) { __syncthreads(); ph_attn(lds, l + 2 + 4 * (PROBE_ATTN > 1 ? PROBE_ATTN - 1 : 0)); } SEAM(pb + 4);
            if (PROBE_CHK == 1) { ph_compare(lds, l, WS_BR, WS_ACT, (size_t)NTOK * DM * 2); SEAM(pb + 4); } }
        if (IN(pb + 5)) { ph_merge(lds, l); if (DUP(2)) ph_merge(lds, l); SEAM(pb + 5); }
        if (IN(pb + 6)) { ph_wo(lds, l); if (DUP(3) && l == 0) ph_wo(lds, l); SEAM(pb + 6); }
        if (l == 0) {
            if (IN(pb + 7)) { ph_norm(lds, 0); if (PROBE_THIN) { __syncthreads(); ph_norm(lds, 0); } SEAM(pb + 7); }
            if (IN(pb + 8)) { ph_ffnup(lds, 0); if (DUP(4)) ph_ffnup(lds, 0); SEAM(pb + 8); }
            if (IN(pb + 9)) { ph_ffndown(lds, 0); SEAM(pb + 9); }
            if (IN(pb + 10)) { ph_norm(lds, 1); if (PROBE_THIN) { __syncthreads(); ph_norm(lds, 1); } SEAM(pb + 10); }
        } else {
            if (IN(pb + 7)) { ph_router(lds, 1); SEAM(pb + 7); }
            if (IN(pb + 8)) { ph_moeup(lds, 1); if (DUP(5)) ph_moeup(lds, 1); SEAM(pb + 8); }
            if (IN(pb + 9)) { ph_moedown(lds, 1); if (DUP(6)) ph_moedown(lds, 1); SEAM(pb + 8); ph_combine(lds, 1);
#ifdef PROBE_NAIVE
                ph_naive(lds, 1); SEAM(pb + 8); ph_poison(lds, 1);
#endif
                if (PROBE_CHK) { SEAM(pb + 8); ph_poison(lds, 1); } }
        }
    }
#undef IN
#undef SEAM
}

extern "C" void kernel_launch(void* const* d_in, const int* in_sizes, int n_in, void* d_out, int out_size, void* d_ws, size_t ws_size, hipStream_t stream) {
    static int grid = 0;
    if (grid == 0) {
        if (n_in != 30 || out_size != NTOK * DM || ws_size < WS_END) { fprintf(stderr, "kernel_launch: unexpected problem (n_in %d, out %d, ws %zu < %zu)\n", n_in, out_size, ws_size, (size_t)WS_END); grid = -1; return; }
        int dev = 0, cus = 0, per_cu = 0;
        if (hipGetDevice(&dev) != hipSuccess || hipDeviceGetAttribute(&cus, hipDeviceAttributeMultiprocessorCount, dev) != hipSuccess) { grid = -1; return; }
        if (hipFuncSetAttribute((const void*)mk_fwd, hipFuncAttributeMaxDynamicSharedMemorySize, LDS_BYTES) != hipSuccess) { fprintf(stderr, "kernel_launch: hipFuncSetAttribute failed\n"); grid = -1; return; }
        if (hipOccupancyMaxActiveBlocksPerMultiprocessor(&per_cu, (const void*)mk_fwd, NTHREADS, LDS_BYTES) != hipSuccess || per_cu < 1) fprintf(stderr, "kernel_launch: occupancy query reports %d\n", per_cu);
        (void)hipGetLastError();
        grid = cus;
    }
    if (grid < 0) return;
    if (hipMemsetAsync((char*)d_ws + WS_CTL, 0, CTL_BYTES, stream) != hipSuccess) return;
    Params a{};
    for (int i = 0; i < 30; ++i) a.in[i] = (const float*)d_in[i];
    a.out = (float*)d_out; a.ws = (unsigned char*)d_ws;
#if MK_MULTI
    for (int ph = 0; ph < NPHASE - 1; ++ph) { a.ph_lo = ph; a.ph_hi = ph + 1; hipLaunchKernelGGL(mk_fwd, dim3(grid), dim3(NTHREADS), LDS_BYTES, stream, a); }
#else
    a.ph_lo = 0; a.ph_hi = NPHASE;
    hipLaunchKernelGGL(mk_fwd, dim3(grid), dim3(NTHREADS), LDS_BYTES, stream, a);
#endif
    const hipError_t le = hipPeekAtLastError();
    if (le != hipSuccess) fprintf(stderr, "kernel_launch: launch failed: %s\n", hipGetErrorName(le));
}
```

```cpp
#include <hip/hip_runtime.h>
#include <cstdio>
#include <cstdint>

#define LAS __attribute__((address_space(3)))
typedef unsigned short bf16_t;
typedef short bf16x8 __attribute__((ext_vector_type(8)));
typedef float f32x4 __attribute__((ext_vector_type(4)));
typedef float f32x2 __attribute__((ext_vector_type(2)));
typedef unsigned u32x4 __attribute__((ext_vector_type(4)));
typedef unsigned u32x2 __attribute__((ext_vector_type(2)));

#ifndef MK_MULTI
#define MK_MULTI 0
#endif

constexpr int DM = 2048, NBATCH = 4, SEQ = 2048, NTOK = NBATCH * SEQ, MEML = 256, NMEM = NBATCH * MEML, DEPTH = 2;
constexpr int ZC = 4096;
constexpr int INC = 3904;
constexpr int Z_NAQ = 0, Z_NAK = 512, Z_NAV = 1024, Z_CQ = 1536, Z_CKV = 2304, Z_KPE = 2560, Z_SWQ = 2624, Z_SWK = 3136, Z_SWV = 3264, Z_MEQ = 3392;
constexpr int DFF = 5632, NEXP = 8, DFFE = 7168, ECAP = 8192;
constexpr float LOG2E = 1.4426950408889634f;
constexpr float EPS = 1e-6f;
constexpr int NTHREADS = 512;
constexpr float SC_ACT8 = 16.0f, SC_W8 = 64.0f, SC_H8 = 8.0f;

constexpr size_t al256(size_t x) { return (x + 255) & ~(size_t)255; }
constexpr size_t WS_CTL = 0, CTL_BYTES = 65536;
constexpr size_t WS_ROPE = WS_CTL + CTL_BYTES;
constexpr size_t WS_LW = WS_ROPE + (size_t)SEQ * 32 * 8;
constexpr size_t LW_IN = 0;
constexpr size_t LW_GATE8 = LW_IN + (size_t)4096 * 2048 * 2;
#ifndef INGATE_FP8
#define INGATE_FP8 1
#endif
#define GATES_FP8 0
#ifndef MOE_FP8
#define MOE_FP8 1
#endif
constexpr size_t MOE_ES = MOE_FP8 ? 1 : 2;
constexpr size_t LW_UQ = LW_GATE8 + (size_t)8192 * 2048 * 2;
constexpr size_t LW_UKV = LW_UQ + (size_t)768 * 768 * 2;
constexpr size_t LW_MEMKV = LW_UKV + (size_t)1024 * 256 * 2;
constexpr size_t LW_BR = LW_MEMKV + (size_t)1024 * 2048 * 2;
constexpr size_t LW_O = LW_BR + (size_t)4 * 2048 * 512 * 2;
constexpr size_t LW_BYTES = LW_O + (size_t)2048 * 2048 * 2;
constexpr size_t WS_FFNUP = WS_LW + 2 * LW_BYTES;
constexpr size_t WS_FFNDN = WS_FFNUP + (size_t)2 * DFF * 2048 * 2;
constexpr size_t WS_MOEUP = WS_FFNDN + (size_t)2048 * DFF * 2;
constexpr size_t WS_MOEDN = WS_MOEUP + (size_t)NEXP * 2 * DFFE * 2048 * MOE_ES;
constexpr size_t WS_U = WS_MOEDN + (size_t)NEXP * 2048 * DFFE * MOE_ES;
constexpr size_t WS_U8 = WS_U + (size_t)NTOK * DM * 2;
constexpr size_t WS_MEMN = WS_U8 + (size_t)NTOK * DM;
constexpr size_t WS_Z = WS_MEMN + (size_t)2 * NMEM * DM * 2;
constexpr size_t WS_GATES = WS_Z + (size_t)NTOK * ZC * 2;
constexpr size_t WS_NAQ = WS_GATES + (size_t)NTOK * 8192 * 2;
constexpr size_t WS_NAK = WS_NAQ + (size_t)NTOK * 512 * 2;
constexpr size_t WS_NAVT = WS_NAK + (size_t)NTOK * 512 * 2;
constexpr size_t WS_CQN = WS_NAVT + (size_t)NTOK * 512 * 2;
constexpr size_t WS_CKVN = WS_CQN + (size_t)NTOK * 768 * 2;
constexpr size_t WS_SWQ = WS_CKVN + (size_t)NTOK * 256 * 2;
constexpr size_t WS_SWK = WS_SWQ + (size_t)NTOK * 512 * 2;
constexpr size_t WS_SWVT = WS_SWK + (size_t)NTOK * 128 * 2;
constexpr size_t WS_MEQ = WS_SWVT + (size_t)NTOK * 128 * 2;
constexpr size_t WS_QRAW = WS_MEQ + (size_t)NTOK * 512 * 2;
constexpr size_t WS_KVRAW = WS_QRAW + (size_t)NTOK * 768 * 2;
constexpr size_t WS_MEMKV = WS_KVRAW + (size_t)NTOK * 1024 * 2;
constexpr size_t WS_MLQ = WS_MEMKV + (size_t)2 * NMEM * 1024 * 2;
constexpr size_t WS_MLK = WS_MLQ + (size_t)NTOK * 768 * 2;
constexpr size_t WS_MLVT = WS_MLK + (size_t)NTOK * 768 * 2;
constexpr size_t WS_MEK = WS_MLVT + (size_t)NTOK * 512 * 2;
constexpr size_t WS_MEVT = WS_MEK + (size_t)NMEM * 512 * 2;
constexpr size_t WS_BR = WS_MEVT + (size_t)NMEM * 512 * 2;
constexpr size_t WS_MERGED = WS_BR + (size_t)NTOK * DM * 2;
constexpr size_t WS_ACT = WS_MERGED + (size_t)NTOK * DM * 2;
constexpr size_t WS_XG = WS_ACT + (size_t)NTOK * DFF * 2;
constexpr size_t WS_TOK = WS_XG + (size_t)NEXP * ECAP * DM * MOE_ES;
constexpr size_t WS_WT = WS_TOK + (size_t)NEXP * ECAP * 4;
constexpr size_t WS_ACTM = WS_WT + (size_t)NEXP * ECAP * 4;
constexpr size_t WS_Y = WS_ACTM + (size_t)NEXP * ECAP * DFFE * MOE_ES;
constexpr int MOE_KS = 2;
constexpr size_t WS_TSLOT = WS_Y + (size_t)MOE_KS * NEXP * ECAP * DM * 2;
constexpr size_t WS_END = WS_TSLOT + (size_t)NTOK * 2 * 4;

constexpr int CW_BAR = 0;
constexpr int CW_MOECNT = 4096;
constexpr int CW_ATTQ = 4096 + 1024;

constexpr int LDS_BYTES = 147456;
constexpr int LDS_MISC = 147456 - 1024;
namespace pg8 {
constexpr int BM = 256, BK = 64, HALF = 128, HTB = HALF * BK * 2, STAGE_BYTES = 8 * HTB, NXCD = 8, WGM = 8;
__host__ __device__ __forceinline__ int lds_byte(int r, int c) { const int st = (r >> 4) * 2 + (c >> 5), rr = r & 15, cc = c & 31, ob = rr * 64 + cc * 2; return st * 1024 + (ob ^ (((ob >> 9) & 1) << 5)); }
__host__ __device__ __forceinline__ void stage_rc(int b, int& R, int& C) { const int st = b / 1024, sb = b % 1024, swz = sb ^ (((sb >> 9) & 1) << 5); R = (st >> 1) * 16 + swz / 64; C = (st & 1) * 32 + (swz % 64) / 2; }
__host__ __device__ __forceinline__ int perm32(int rho) { const int n = rho >> 4, i = rho & 15; return 8 * (i >> 2) + 4 * n + (i & 3); }

struct Unit { const char* A; const char* B; int orow, ocol, x0, x1, ks, pad_; };

__device__ __forceinline__ bool static_tile(int i, int G, int c, int nM, int nN, int& pm, int& pn) {
    const int nwg = nM * nN; const long L = (long)i * G + c; if (L >= nwg) return false;
    int wgid = (int)L; { const int q = nwg / NXCD, r = nwg % NXCD, xcd = wgid % NXCD, off = wgid / NXCD; wgid = (xcd < r ? xcd * (q + 1) : r * (q + 1) + (xcd - r) * q) + off; }
    const int nig = WGM * nN, gid = wgid / nig, fm = gid * WGM, gsz = (nM - fm) < WGM ? (nM - fm) : WGM;
    pm = fm + ((wgid % nig) % gsz); pn = (wgid % nig) / gsz; return true;
}
struct SchedGrid {
    const char* A; const char* B; int lda, ldb, nM, nN, G, c;
    __device__ __forceinline__ bool next(int i, Unit& u) const {
        int pm, pn; if (!static_tile(i, G, c, nM, nN, pm, pn)) return false;
        u.A = A + (size_t)pm * 256 * lda * 2; u.B = B + (size_t)pn * 256 * ldb * 2; u.orow = pm * 256; u.ocol = pn; u.x0 = 0; u.x1 = 0; u.ks = 0; u.pad_ = 0; return true;
    }
};

__device__ __forceinline__ unsigned cvt_pk_bf16(float lo, float hi) { unsigned r; asm volatile("v_cvt_pk_bf16_f32 %0, %1, %2" : "=v"(r) : "v"(lo), "v"(hi)); return r; }
__device__ __forceinline__ float sigmoidf_(float x) { return __builtin_amdgcn_rcpf(1.0f + __builtin_amdgcn_exp2f(-x * LOG2E)); }

typedef f32x4 Acc[2][2][4][2];

typedef int i32x8 __attribute__((ext_vector_type(8)));
typedef int i32x4 __attribute__((ext_vector_type(4)));
template <class Epi, class Sched, bool FP8 = false, bool ALIGN_EPI = true>
__device__ __forceinline__ void gemm_phase(LAS unsigned char* lds, const int lda, const int ldb, const int K, const Sched S, Epi& E, const int tid) {
    const int wid = __builtin_amdgcn_readfirstlane(tid >> 6), lane = tid & 63, wr = wid >> 2, wc = wid & 3, fr = lane & 15, fq = lane >> 4;
    const int nt = K / BK;
    unsigned voffA[2], voffB[2];
#pragma unroll
    for (int i = 0; i < 2; ++i) { int R, C; stage_rc(tid * 16 + i * 8192, R, C); const int Rb = Epi::PERM ? ((R & ~31) + perm32(R & 31)) : R;
        voffA[i] = (unsigned)(R * lda + C) * 2u; voffB[i] = (unsigned)(Rb * ldb + C) * 2u; }
    const size_t kstep = (size_t)(BK * 2);
    const size_t hstepA = (size_t)HALF * lda * 2, hstepB = (size_t)HALF * ldb * 2;
    const unsigned ldsw = (unsigned)wid * 1024u;
    const int aoff = lds_byte(wr * 64 + fr, fq * 8), boff = lds_byte(wc * 32 + fr, fq * 8);
#define PG8_SA(b, h) (((b) * 2 + (h)) * HTB)
#define PG8_SB(b, h) ((4 + (b) * 2 + (h)) * HTB)
#define PG8_STAGE(bufoff, gbase, voff) do { _Pragma("unroll") for (int _i = 0; _i < 2; ++_i) \
        __builtin_amdgcn_global_load_lds((const unsigned*)((const char*)(gbase) + (voff)[_i]), (LAS unsigned*)(lds + (bufoff) + ldsw + _i * 8192), 16, 0, 0); } while (0)
#define PG8_LDA(dst, b, h) do { _Pragma("unroll") for (int m = 0; m < 4; ++m) _Pragma("unroll") for (int k = 0; k < 2; ++k) dst[m][k] = *(const LAS bf16x8*)(lds + PG8_SA(b, h) + aoff + m * 2048 + k * 1024); } while (0)
#define PG8_LDB(dst, b, h) do { _Pragma("unroll") for (int n = 0; n < 2; ++n) _Pragma("unroll") for (int k = 0; k < 2; ++k) dst[n][k] = *(const LAS bf16x8*)(lds + PG8_SB(b, h) + boff + n * 2048 + k * 1024); } while (0)
#define PG8_MMA(ai, bj, At, Bt) do { __builtin_amdgcn_s_setprio(1); _Pragma("unroll") for (int m = 0; m < 4; ++m) _Pragma("unroll") for (int n = 0; n < 2; ++n) _Pragma("unroll") for (int k = 0; k < 2; ++k) \
        acc[ai][bj][m][n] = __builtin_amdgcn_mfma_f32_16x16x32_bf16(Bt[n][k], At[m][k], acc[ai][bj][m][n], 0, 0, 0); __builtin_amdgcn_s_setprio(0); } while (0)
#define PG8_CAT(x, y) __builtin_shufflevector(__builtin_bit_cast(i32x4, x), __builtin_bit_cast(i32x4, y), 0, 1, 2, 3, 4, 5, 6, 7)
#define PG8_MMA8(ai, bj, At, Bt) do { __builtin_amdgcn_s_setprio(1); _Pragma("unroll") for (int m = 0; m < 4; ++m) _Pragma("unroll") for (int n = 0; n < 2; ++n) \
        asm volatile("v_mfma_f32_16x16x128_f8f6f4 %0, %1, %2, %0" : "+v"(acc[ai][bj][m][n]) : "v"(PG8_CAT(Bt[n][0], Bt[n][1])), "v"(PG8_CAT(At[m][0], At[m][1]))); __builtin_amdgcn_s_setprio(0); } while (0)
#define PG8_WAIT_V(n) asm volatile("s_waitcnt vmcnt(" #n ")" ::: "memory")
#define PG8_WAIT_L(n) asm volatile("s_waitcnt lgkmcnt(" #n ")" ::: "memory")
#define PG8_BAR __builtin_amdgcn_s_barrier()
#define PG8_SCHED __builtin_amdgcn_sched_barrier(0)
    Unit cur, nxt; int ui = 0;
    if (!S.next(0, cur)) return;
    Acc acc;
#pragma unroll
    for (int a = 0; a < 2; ++a)
#pragma unroll
        for (int b = 0; b < 2; ++b)
#pragma unroll
            for (int m = 0; m < 4; ++m)
#pragma unroll
                for (int n = 0; n < 2; ++n) acc[a][b][m][n] = (f32x4){0.f, 0.f, 0.f, 0.f};
    bf16x8 At[4][2], B0[2][2], B1[2][2];
    const char* cA = cur.A; const char* cB = cur.B;
    PG8_STAGE(PG8_SB(0, 0), cB, voffB); PG8_STAGE(PG8_SB(0, 1), cB + hstepB, voffB); PG8_STAGE(PG8_SA(0, 0), cA, voffA); PG8_STAGE(PG8_SA(0, 1), cA + hstepA, voffA);
    if (wr == 1) PG8_BAR;
    PG8_WAIT_V(2); PG8_BAR;
    PG8_STAGE(PG8_SB(1, 0), cB + kstep, voffB); PG8_STAGE(PG8_SA(1, 0), cA + kstep, voffA); PG8_STAGE(PG8_SB(1, 1), cB + hstepB + kstep, voffB);
    PG8_WAIT_V(6); PG8_BAR;
    for (;;) {
        const bool has_next = S.next(ui + 1, nxt);
        const char* nA = has_next ? nxt.A : cA; const char* nB = has_next ? nxt.B : cB;
        for (int t = 0; t < nt; t += 2) {
            const bool last = (t == nt - 2);
            const char* a1 = cA + (size_t)(t + 1) * kstep;
            const char* a2 = last ? nA : cA + (size_t)(t + 2) * kstep; const char* b2 = last ? nB : cB + (size_t)(t + 2) * kstep;
            const char* a3 = a2 + kstep; const char* b3 = b2 + kstep;
            if constexpr (FP8) {
            PG8_LDB(B0, 0, 0); PG8_LDB(B1, 0, 1); PG8_SCHED; PG8_LDA(At, 0, 0); PG8_STAGE(PG8_SA(1, 1), a1 + hstepA, voffA);
            PG8_WAIT_V(8); PG8_WAIT_L(0); PG8_BAR; PG8_MMA8(0, 0, At, B0); PG8_MMA8(0, 1, At, B1); PG8_BAR; PG8_SCHED;
            PG8_LDA(At, 0, 1); PG8_STAGE(PG8_SB(0, 0), b2, voffB); PG8_STAGE(PG8_SB(0, 1), b2 + hstepB, voffB); PG8_STAGE(PG8_SA(0, 0), a2, voffA);
            PG8_WAIT_V(8); PG8_WAIT_L(0); PG8_BAR; PG8_MMA8(1, 0, At, B0); PG8_MMA8(1, 1, At, B1); PG8_BAR; PG8_SCHED;
            PG8_LDB(B0, 1, 0); PG8_LDB(B1, 1, 1); PG8_SCHED; PG8_LDA(At, 1, 0); PG8_STAGE(PG8_SA(0, 1), a2 + hstepA, voffA);
            PG8_WAIT_V(8); PG8_WAIT_L(0); PG8_BAR; PG8_MMA8(0, 0, At, B0); PG8_MMA8(0, 1, At, B1); PG8_BAR; PG8_SCHED;
            PG8_LDA(At, 1, 1); PG8_STAGE(PG8_SB(1, 0), b3, voffB); PG8_STAGE(PG8_SB(1, 1), b3 + hstepB, voffB); PG8_STAGE(PG8_SA(1, 0), a3, voffA);
            PG8_WAIT_V(8); PG8_WAIT_L(0); PG8_BAR; PG8_MMA8(1, 0, At, B0); PG8_MMA8(1, 1, At, B1); PG8_BAR; PG8_SCHED;
            } else {
            PG8_LDB(B0, 0, 0); PG8_LDB(B1, 0, 1); PG8_SCHED; PG8_LDA(At, 0, 0); PG8_STAGE(PG8_SA(1, 1), a1 + hstepA, voffA);
            PG8_WAIT_V(8); PG8_WAIT_L(0); PG8_BAR; PG8_MMA(0, 0, At, B0); PG8_MMA(0, 1, At, B1); PG8_BAR; PG8_SCHED;
            PG8_LDA(At, 0, 1); PG8_STAGE(PG8_SB(0, 0), b2, voffB); PG8_STAGE(PG8_SB(0, 1), b2 + hstepB, voffB); PG8_STAGE(PG8_SA(0, 0), a2, voffA);
            PG8_WAIT_V(8); PG8_WAIT_L(0); PG8_BAR; PG8_MMA(1, 0, At, B0); PG8_MMA(1, 1, At, B1); PG8_BAR; PG8_SCHED;
            PG8_LDB(B0, 1, 0); PG8_LDB(B1, 1, 1); PG8_SCHED; PG8_LDA(At, 1, 0); PG8_STAGE(PG8_SA(0, 1), a2 + hstepA, voffA);
            PG8_WAIT_V(8); PG8_WAIT_L(0); PG8_BAR; PG8_MMA(0, 0, At, B0); PG8_MMA(0, 1, At, B1); PG8_BAR; PG8_SCHED;
            PG8_LDA(At, 1, 1); PG8_STAGE(PG8_SB(1, 0), b3, voffB); PG8_STAGE(PG8_SB(1, 1), b3 + hstepB, voffB); PG8_STAGE(PG8_SA(1, 0), a3, voffA);
            PG8_WAIT_V(8); PG8_WAIT_L(0); PG8_BAR; PG8_MMA(1, 0, At, B0); PG8_MMA(1, 1, At, B1); PG8_BAR; PG8_SCHED;
            }
        }
        if constexpr (ALIGN_EPI) { if (wr == 0) PG8_BAR; }
        if constexpr (FP8) {
#pragma unroll
            for (int a = 0; a < 2; ++a)
#pragma unroll
                for (int b = 0; b < 2; ++b)
                    asm volatile("s_nop 15\n\ts_nop 15" : "+v"(acc[a][b][0][0]), "+v"(acc[a][b][0][1]), "+v"(acc[a][b][1][0]), "+v"(acc[a][b][1][1]), "+v"(acc[a][b][2][0]), "+v"(acc[a][b][2][1]), "+v"(acc[a][b][3][0]), "+v"(acc[a][b][3][1]));
        }
        E(acc, cur, wr, wc, fr, fq);
        if (!has_next) break;
#pragma unroll
        for (int a = 0; a < 2; ++a)
#pragma unroll
            for (int b = 0; b < 2; ++b)
#pragma unroll
                for (int m = 0; m < 4; ++m)
#pragma unroll
                    for (int n = 0; n < 2; ++n) acc[a][b][m][n] = (f32x4){0.f, 0.f, 0.f, 0.f};
        cur = nxt; cA = nA; cB = nB; ++ui;
        if constexpr (ALIGN_EPI) { if (wr == 1) PG8_BAR; }
    }
    PG8_WAIT_V(0);
    if constexpr (!ALIGN_EPI) { if (wr == 0) PG8_BAR; }
    PG8_BAR;
#undef PG8_SA
#undef PG8_SB
#undef PG8_STAGE
#undef PG8_LDA
#undef PG8_MMA8
#undef PG8_CAT
#undef PG8_LDB
#undef PG8_MMA
#undef PG8_WAIT_V
#undef PG8_WAIT_L
#undef PG8_BAR
#undef PG8_SCHED
}

struct EpiInGate {
    static constexpr bool PERM = true;
    bf16_t* z; bf16_t* gates; const float* bgate; float s;
    __device__ __forceinline__ void operator()(const Acc& acc, const Unit& u, int wr, int wc, int fr, int fq) const {
        const int row0 = u.orow + wr * 64 + fr; const bool isg = u.ocol >= 16;
        const int colt = (isg ? u.ocol - 16 : u.ocol) * 256 + wc * 32 + 8 * fq; const int ldc = isg ? 8192 : ZC; bf16_t* base = isg ? gates : z;
        f32x4 bv[2][2];
#pragma unroll
        for (int bj = 0; bj < 2; ++bj)
#pragma unroll
            for (int n = 0; n < 2; ++n) bv[bj][n] = isg ? *(const f32x4*)(bgate + colt + bj * HALF + 4 * n) : (f32x4){0.f, 0.f, 0.f, 0.f};
#pragma unroll
        for (int ai = 0; ai < 2; ++ai)
#pragma unroll
            for (int m = 0; m < 4; ++m) { bf16_t* rowp = base + (size_t)(row0 + ai * HALF + m * 16) * ldc + colt;
#pragma unroll
                for (int bj = 0; bj < 2; ++bj) { f32x4 v0 = acc[ai][bj][m][0] * s + bv[bj][0], v1 = acc[ai][bj][m][1] * s + bv[bj][1];
                    if (isg) {
#pragma unroll
                        for (int j = 0; j < 4; ++j) { v0[j] = sigmoidf_(v0[j]); v1[j] = sigmoidf_(v1[j]); } }
                    u32x4 w; w.x = cvt_pk_bf16(v0[0], v0[1]); w.y = cvt_pk_bf16(v0[2], v0[3]); w.z = cvt_pk_bf16(v1[0], v1[1]); w.w = cvt_pk_bf16(v1[2], v1[3]);
                    *(u32x4*)(rowp + bj * HALF) = w; } }
    }
};
struct EpiBf16 {
    static constexpr bool PERM = true;
    bf16_t* O; int ldc;
    __device__ __forceinline__ void operator()(const Acc& acc, const Unit& u, int wr, int wc, int fr, int fq) const {
        const int row0 = u.orow + wr * 64 + fr, col0 = u.ocol * 256 + wc * 32 + 8 * fq;
#pragma unroll
        for (int ai = 0; ai < 2; ++ai)
#pragma unroll
            for (int m = 0; m < 4; ++m) { bf16_t* rowp = O + (size_t)(row0 + ai * HALF + m * 16) * ldc + col0;
#pragma unroll
                for (int bj = 0; bj < 2; ++bj) { const f32x4 v0 = acc[ai][bj][m][0], v1 = acc[ai][bj][m][1];
                    u32x4 w; w.x = cvt_pk_bf16(v0[0], v0[1]); w.y = cvt_pk_bf16(v0[2], v0[3]); w.z = cvt_pk_bf16(v1[0], v1[1]); w.w = cvt_pk_bf16(v1[2], v1[3]);
                    *(u32x4*)(rowp + bj * HALF) = w; } }
    }
};
struct EpiSwiGLU {
    static constexpr bool PERM = true;
    bf16_t* O; int ldc;
    __device__ __forceinline__ void operator()(const Acc& acc, const Unit& u, int wr, int wc, int fr, int fq) const {
        const int row0 = u.orow + wr * 64 + fr, col0 = u.ocol * 128 + wc * 32 + 8 * fq;
#pragma unroll
        for (int ai = 0; ai < 2; ++ai)
#pragma unroll
            for (int m = 0; m < 4; ++m) { bf16_t* rowp = O + (size_t)(row0 + ai * HALF + m * 16) * ldc + col0;
                f32x4 v0, v1;
#pragma unroll
                for (int j = 0; j < 4; ++j) { const float g0 = acc[ai][0][m][0][j], g1 = acc[ai][0][m][1][j];
                    v0[j] = g0 * sigmoidf_(g0) * acc[ai][1][m][0][j]; v1[j] = g1 * sigmoidf_(g1) * acc[ai][1][m][1][j]; }
                u32x4 w; w.x = cvt_pk_bf16(v0[0], v0[1]); w.y = cvt_pk_bf16(v0[2], v0[3]); w.z = cvt_pk_bf16(v1[0], v1[1]); w.w = cvt_pk_bf16(v1[2], v1[3]);
                *(u32x4*)rowp = w; }
    }
};
__device__ __forceinline__ float bflo(unsigned w) { return __uint_as_float(w << 16); }
__device__ __forceinline__ float bfhi(unsigned w) { return __uint_as_float(w & 0xffff0000u); }
struct EpiMerge {
    static constexpr bool PERM = true;
    const bf16_t* gates; bf16_t* merged;
    __device__ __forceinline__ void operator()(const Acc& acc, const Unit& u, int wr, int wc, int fr, int fq) const {
        const int row0 = u.orow + wr * 64 + fr, col0 = u.ocol * 256 + wc * 32 + 8 * fq, n = u.x0;
#pragma unroll
        for (int ai = 0; ai < 2; ++ai) {
            u32x4 gv[4][2], ov[4][2];
#pragma unroll
            for (int m = 0; m < 4; ++m)
#pragma unroll
                for (int bj = 0; bj < 2; ++bj) { const size_t r = (size_t)(row0 + ai * HALF + m * 16);
                    gv[m][bj] = *(const u32x4*)(gates + r * 8192 + n * 2048 + col0 + bj * HALF);
                    ov[m][bj] = (u32x4){0u, 0u, 0u, 0u}; if (n > 0) ov[m][bj] = *(const u32x4*)(merged + r * DM + col0 + bj * HALF); }
#pragma unroll
            for (int m = 0; m < 4; ++m)
#pragma unroll
                for (int bj = 0; bj < 2; ++bj) { const size_t r = (size_t)(row0 + ai * HALF + m * 16);
                    const u32x4 g = gv[m][bj], o = ov[m][bj]; const f32x4 v0 = acc[ai][bj][m][0], v1 = acc[ai][bj][m][1];
                    u32x4 w;
                    w.x = cvt_pk_bf16(bflo(o.x) + bflo(g.x) * v0[0], bfhi(o.x) + bfhi(g.x) * v0[1]);
                    w.y = cvt_pk_bf16(bflo(o.y) + bflo(g.y) * v0[2], bfhi(o.y) + bfhi(g.y) * v0[3]);
                    w.z = cvt_pk_bf16(bflo(o.z) + bflo(g.z) * v1[0], bfhi(o.z) + bfhi(g.z) * v1[1]);
                    w.w = cvt_pk_bf16(bflo(o.w) + bflo(g.w) * v1[2], bfhi(o.w) + bfhi(g.w) * v1[3]);
                    *(u32x4*)(merged + r * DM + col0 + bj * HALF) = w; }
        }
    }
};
__device__ __forceinline__ unsigned pack_fp8x4(float a, float b, float c, float d) { int w = 0; w = __builtin_amdgcn_cvt_pk_fp8_f32(a, b, w, false); w = __builtin_amdgcn_cvt_pk_fp8_f32(c, d, w, true); return (unsigned)w; }
struct EpiGates {
    static constexpr bool PERM = true;
    bf16_t* gates; const float* bgate; float s;
    __device__ __forceinline__ void operator()(const Acc& acc, const Unit& u, int wr, int wc, int fr, int fq) const {
        const int row0 = u.orow + wr * 64 + fr, colt = u.ocol * 256 + wc * 32 + 8 * fq;
        f32x4 bv[2][2];
#pragma unroll
        for (int bj = 0; bj < 2; ++bj)
#pragma unroll
            for (int n = 0; n < 2; ++n) bv[bj][n] = *(const f32x4*)(bgate + colt + bj * HALF + 4 * n);
#pragma unroll
        for (int ai = 0; ai < 2; ++ai)
#pragma unroll
            for (int m = 0; m < 4; ++m) { bf16_t* rowp = gates + (size_t)(row0 + ai * HALF + m * 16) * 8192 + colt;
#pragma unroll
                for (int bj = 0; bj < 2; ++bj) { f32x4 v0 = acc[ai][bj][m][0] * s + bv[bj][0], v1 = acc[ai][bj][m][1] * s + bv[bj][1];
#pragma unroll
                    for (int j = 0; j < 4; ++j) { v0[j] = sigmoidf_(v0[j]); v1[j] = sigmoidf_(v1[j]); }
                    u32x4 w; w.x = cvt_pk_bf16(v0[0], v0[1]); w.y = cvt_pk_bf16(v0[2], v0[3]); w.z = cvt_pk_bf16(v1[0], v1[1]); w.w = cvt_pk_bf16(v1[2], v1[3]);
                    *(u32x4*)(rowp + bj * HALF) = w; } }
    }
};
struct EpiSwiGLU8 {
    static constexpr bool PERM = true;
    unsigned char* O; int ldc; float si, so;
    __device__ __forceinline__ void operator()(const Acc& acc, const Unit& u, int wr, int wc, int fr, int fq) const {
        const int row0 = u.orow + wr * 64 + fr, col0 = u.ocol * 128 + wc * 32 + 8 * fq;
#pragma unroll
        for (int ai = 0; ai < 2; ++ai)
#pragma unroll
            for (int m = 0; m < 4; ++m) { unsigned char* rowp = O + (size_t)(row0 + ai * HALF + m * 16) * ldc + col0;
                f32x4 v0, v1;
#pragma unroll
                for (int j = 0; j < 4; ++j) { const float g0 = acc[ai][0][m][0][j] * si, g1 = acc[ai][0][m][1][j] * si;
                    v0[j] = g0 * sigmoidf_(g0) * (acc[ai][1][m][0][j] * si) * so; v1[j] = g1 * sigmoidf_(g1) * (acc[ai][1][m][1][j] * si) * so; }
                u32x2 w; w.x = pack_fp8x4(v0[0], v0[1], v0[2], v0[3]); w.y = pack_fp8x4(v1[0], v1[1], v1[2], v1[3]);
                *(u32x2*)rowp = w; }
    }
};
struct EpiResF32 {
    static constexpr bool PERM = false;
    const float* base; float* out; float s;
    __device__ __forceinline__ void operator()(const Acc& acc, const Unit& u, int wr, int wc, int fr, int fq) const {
        const int row0 = u.orow + wr * 64 + fr, col0 = u.ocol * 256 + wc * 32 + 4 * fq;
#pragma unroll
        for (int ai = 0; ai < 2; ++ai)
#pragma unroll
            for (int mp = 0; mp < 2; ++mp) {
                f32x4 bs[2][2][2];
#pragma unroll
                for (int mm = 0; mm < 2; ++mm) { const size_t off = (size_t)(row0 + ai * HALF + (mp * 2 + mm) * 16) * DM + col0;
#pragma unroll
                    for (int bj = 0; bj < 2; ++bj)
#pragma unroll
                        for (int n = 0; n < 2; ++n) bs[mm][bj][n] = *(const f32x4*)(base + off + bj * HALF + n * 16); }
#pragma unroll
                for (int mm = 0; mm < 2; ++mm) { const int m = mp * 2 + mm; const size_t off = (size_t)(row0 + ai * HALF + m * 16) * DM + col0;
#pragma unroll
                    for (int bj = 0; bj < 2; ++bj)
#pragma unroll
                        for (int n = 0; n < 2; ++n) *(f32x4*)(out + off + bj * HALF + n * 16) = bs[mm][bj][n] + acc[ai][bj][m][n] * s; }
                asm volatile("" ::: "memory"); }
    }
};
struct EpiMoeDown {
    static constexpr bool PERM = false;
    float* out; const int* tok; const float* wt; const unsigned* cnt; float s;
    __device__ __forceinline__ void operator()(const Acc& acc, const Unit& u, int wr, int wc, int fr, int fq) const {
        const int e = u.x0, nrow = (int)cnt[e * 64]; const int lrow0 = u.x1 + wr * 64 + fr, col0 = u.ocol * 256 + wc * 32 + 4 * fq;
#pragma unroll
        for (int ai = 0; ai < 2; ++ai)
#pragma unroll
            for (int m = 0; m < 4; ++m) { const int lr = lrow0 + ai * HALF + m * 16;
                if (lr < nrow) { const int slot = e * ECAP + lr; const int t = tok[slot]; const float w = wt[slot] * s; float* op = out + (size_t)t * DM + col0;
#pragma unroll
                    for (int bj = 0; bj < 2; ++bj)
#pragma unroll
                        for (int n = 0; n < 2; ++n)
#pragma unroll
                            for (int j = 0; j < 4; ++j) unsafeAtomicAdd(op + bj * HALF + n * 16 + j, w * acc[ai][bj][m][n][j]); } }
    }
};
struct EpiMoeDownY {
    static constexpr bool PERM = true;
    bf16_t* y; const float* wt; const unsigned* cnt; float s;
    __device__ __forceinline__ void operator()(const Acc& acc, const Unit& u, int wr, int wc, int fr, int fq) const {
        const int e = u.x0, nrow = (int)cnt[e * 64]; const int lrow0 = u.x1 + wr * 64 + fr, col0 = u.ocol * 256 + wc * 32 + 8 * fq;
#pragma unroll
        for (int ai = 0; ai < 2; ++ai)
#pragma unroll
            for (int m = 0; m < 4; ++m) { const int lr = lrow0 + ai * HALF + m * 16;
                if (lr < nrow) { const int slot = e * ECAP + lr; const float w = wt[slot] * s; bf16_t* rowp = y + ((size_t)u.ks * NEXP * ECAP + slot) * DM + col0;
#pragma unroll
                    for (int bj = 0; bj < 2; ++bj) { const f32x4 v0 = acc[ai][bj][m][0] * w, v1 = acc[ai][bj][m][1] * w;
                        u32x4 q; q.x = cvt_pk_bf16(v0[0], v0[1]); q.y = cvt_pk_bf16(v0[2], v0[3]); q.z = cvt_pk_bf16(v1[0], v1[1]); q.w = cvt_pk_bf16(v1[2], v1[3]);
                        *(u32x4*)(rowp + bj * HALF) = q; } } }
    }
};
}
#define XB_TMO      128
#define XB_XCNT(j)  (256  + 64 * (j))
#define XB_XSUB(j)  (1280 + 64 * (j))
#define XB_XGEN(j)  (2304 + 64 * (j))
#define XB_TOP      3328
#define XB_TOPGEN   3392
#define XCD_BAR_WORDS 3456
#define XB_SPIN_CAP (1u << 18)

__device__ __forceinline__ unsigned xb_ld(unsigned* p)              { return __hip_atomic_load(p, __ATOMIC_RELAXED, __HIP_MEMORY_SCOPE_AGENT); }
__device__ __forceinline__ unsigned xb_add(unsigned* p, unsigned v) { return __hip_atomic_fetch_add(p, v, __ATOMIC_RELAXED, __HIP_MEMORY_SCOPE_AGENT); }
__device__ __forceinline__ unsigned xb_xcc_id() { return (unsigned)__builtin_amdgcn_s_getreg((3 << 11) | 20) & 0xFu; }
#define XB_SPIN(cond, bar) do { unsigned _sp = 0; while (cond) { __builtin_amdgcn_s_sleep(1); \
    if ((++_sp & 255u) == 0u) { if (xb_ld(&(bar)[XB_TMO])) break; if (_sp > XB_SPIN_CAP) { atomicAdd(&(bar)[XB_TMO], 1u); break; } } } } while (0)

__device__ __forceinline__ unsigned xb_tid() { unsigned t = threadIdx.x; asm volatile("" : "+v"(t)); return t; }
struct XcdBarrier {
    unsigned* bar; unsigned x;
    volatile LAS unsigned* st;
};

__device__ __forceinline__ XcdBarrier xcd_barrier_post(unsigned* bar, volatile LAS unsigned* st) {
    XcdBarrier b; b.bar = bar; b.x = xb_xcc_id(); b.st = st;
    if (xb_tid() == 0u) (void)xb_add(&bar[XB_XCNT(b.x)], 1u);
    return b;
}
__device__ __forceinline__ void xcd_barrier_complete(unsigned* bar, unsigned x, unsigned& nloc, unsigned& nx) {
    const unsigned G = gridDim.x * gridDim.y * gridDim.z;
    unsigned sum, cnt, mine, sp = 0u;
    for (;;) {
        sum = 0u; cnt = 0u; mine = 0u;
#pragma unroll
        for (unsigned j = 0; j < 16; ++j) { const unsigned c = xb_ld(&bar[XB_XCNT(j)]); sum += c; cnt += (c > 0u) ? 1u : 0u; mine = (j == x) ? c : mine; }
        if (sum == G) break;
        __builtin_amdgcn_s_sleep(1);
        if ((++sp & 255u) == 0u) { if (xb_ld(&bar[XB_TMO])) break; if (sp > XB_SPIN_CAP) { atomicAdd(&bar[XB_TMO], 1u); break; } }
    }
    nloc = mine > 0u ? mine : 1u; nx = cnt > 0u ? cnt : 1u;
}

__device__ __forceinline__ void xcd_barrier(const XcdBarrier& b) {
    asm volatile("s_waitcnt vmcnt(0)" ::: "memory");
    __syncthreads();
    if (xb_tid() == 0u) {
        unsigned* bar = b.bar;
        __builtin_amdgcn_s_waitcnt(0);
        unsigned nloc = b.st[0], nx = b.st[1];
        if (nloc == 0u) { xcd_barrier_complete(bar, b.x, nloc, nx); b.st[0] = nloc; b.st[1] = nx; }
        const unsigned old = xb_add(&bar[XB_XSUB(b.x)], 1u);
        const unsigned gen = old / nloc;
        if (old + 1u == (gen + 1u) * nloc) {
            __builtin_amdgcn_fence(__ATOMIC_RELEASE, "agent");
            asm volatile("s_waitcnt vmcnt(0)" ::: "memory");
            const unsigned og = xb_add(&bar[XB_TOP], 1u);
            const unsigned tg = og / nx;
            if (og + 1u == (tg + 1u) * nx) xb_add(&bar[XB_TOPGEN], 1u);
            else XB_SPIN(xb_ld(&bar[XB_TOPGEN]) == tg, bar);
            __builtin_amdgcn_fence(__ATOMIC_ACQUIRE, "agent");
            xb_add(&bar[XB_XGEN(b.x)], 1u);
            asm volatile("s_waitcnt vmcnt(0)" ::: "memory");
        } else {
            XB_SPIN(xb_ld(&bar[XB_XGEN(b.x)]) == gen, bar);
            __builtin_amdgcn_fence(__ATOMIC_ACQUIRE, "agent");
            asm volatile("s_waitcnt vmcnt(0)" ::: "memory");
        }
    }
    __syncthreads();
}

struct Params { const float* in[30]; float* out; unsigned char* ws; int ph_lo, ph_hi; };
enum { I_X = 0, I_MEM, I_NORM_MIX, I_W_IN, I_NA_QN, I_NA_KN, I_NA_RPB, I_CQ_N, I_W_UQ, I_CKV_N, I_W_UKV, I_MLA_QN, I_MLA_KN, I_SWA_QN, I_SWA_KN, I_SWA_SINK,
       I_MEM_N, I_MEM_WKV, I_MEM_QN, I_MEM_KN, I_W_BRANCH, I_W_GATE, I_B_GATE, I_W_O, I_NORM_FFN, I_FFN_UP, I_FFN_DN, I_ROUTER, I_MOE_UP, I_MOE_DN };

__device__ __forceinline__ float wave_sum(float v) {
#pragma unroll
    for (int o = 32; o >= 1; o >>= 1) v += __shfl_xor(v, o);
    return v;
}
__device__ __forceinline__ float bf2f(bf16_t b) { return __uint_as_float(((unsigned)b) << 16); }
__device__ __forceinline__ bf16_t f2bf(float f) { return (bf16_t)(pg8::cvt_pk_bf16(f, 0.f) & 0xffffu); }
using pg8::cvt_pk_bf16; using pg8::bflo; using pg8::bfhi;

struct CvtJob { const float* src; bf16_t* dst; int src_ld, K, ntn, tile0, mode, dff; };
constexpr int NJOBS = 40;
__device__ __forceinline__ void make_job(int j, const Params& p, CvtJob& jb) {
    unsigned char* ws = p.ws; jb.mode = 0; jb.dff = 1; jb.tile0 = 0;
    if (j < 22) { const int l = j / 11, k = j % 11; unsigned char* lw = ws + WS_LW + (size_t)l * LW_BYTES;
        if (k == 0) { jb.src = p.in[I_W_IN] + (size_t)l * DM * INC; jb.dst = (bf16_t*)(lw + LW_IN); jb.src_ld = INC; jb.K = DM; jb.ntn = INC / 64; jb.mode = INGATE_FP8 ? 3 : 0; }
        else if (k == 1) { jb.src = p.in[I_W_IN]; jb.dst = (bf16_t*)(lw + LW_IN + (size_t)INC * DM * (INGATE_FP8 ? 1 : 2)); jb.src_ld = INC; jb.K = DM; jb.ntn = (ZC - INC) / 64; jb.mode = INGATE_FP8 ? 5 : 2; }
        else if (k == 2) { jb.src = p.in[I_W_GATE] + (size_t)l * DM * 8192; jb.dst = (bf16_t*)(lw + LW_IN + (size_t)ZC * DM * (INGATE_FP8 ? 1 : 2)); jb.src_ld = 8192; jb.K = DM; jb.ntn = 8192 / 64; jb.mode = INGATE_FP8 ? 3 : 0; }
        else if (k == 3) { jb.src = p.in[I_W_UQ] + (size_t)l * 768 * 768; jb.dst = (bf16_t*)(lw + LW_UQ); jb.src_ld = 768; jb.K = 768; jb.ntn = 768 / 64; }
        else if (k == 4) { jb.src = p.in[I_W_UKV] + (size_t)l * 256 * 1024; jb.dst = (bf16_t*)(lw + LW_UKV); jb.src_ld = 1024; jb.K = 256; jb.ntn = 1024 / 64; }
        else if (k == 5) { jb.src = p.in[I_MEM_WKV] + (size_t)l * DM * 1024; jb.dst = (bf16_t*)(lw + LW_MEMKV); jb.src_ld = 1024; jb.K = DM; jb.ntn = 1024 / 64; }
        else if (k < 10) { const int n = k - 6; jb.src = p.in[I_W_BRANCH] + ((size_t)l * 4 + n) * 512 * DM; jb.dst = (bf16_t*)(lw + LW_BR) + (size_t)n * DM * 512; jb.src_ld = DM; jb.K = 512; jb.ntn = DM / 64; }
        else { jb.src = p.in[I_W_O] + (size_t)l * DM * DM; jb.dst = (bf16_t*)(lw + LW_O); jb.src_ld = DM; jb.K = DM; jb.ntn = DM / 64; }
    } else if (j == 22) { jb.src = p.in[I_FFN_UP]; jb.dst = (bf16_t*)(ws + WS_FFNUP); jb.src_ld = 2 * DFF; jb.K = DM; jb.ntn = 2 * DFF / 64; jb.mode = 1; jb.dff = DFF; }
    else if (j == 23) { jb.src = p.in[I_FFN_DN]; jb.dst = (bf16_t*)(ws + WS_FFNDN); jb.src_ld = DM; jb.K = DFF; jb.ntn = DM / 64; }
    else if (j < 32) { const int e = j - 24; jb.src = p.in[I_MOE_UP] + (size_t)e * DM * 2 * DFFE; jb.dst = (bf16_t*)(ws + WS_MOEUP + (size_t)e * 2 * DFFE * DM * MOE_ES); jb.src_ld = 2 * DFFE; jb.K = DM; jb.ntn = 2 * DFFE / 64; jb.mode = MOE_FP8 ? 4 : 1; jb.dff = DFFE; }
    else { const int e = j - 32; jb.src = p.in[I_MOE_DN] + (size_t)e * DFFE * DM; jb.dst = (bf16_t*)(ws + WS_MOEDN + (size_t)e * DM * DFFE * MOE_ES); jb.src_ld = DM; jb.K = DFFE; jb.ntn = DM / 64; jb.mode = MOE_FP8 ? 3 : 0; }
}

__device__ __forceinline__ void norm_rows(const float* src, const float* g, bf16_t* dst, unsigned char* dst8, int nrows, int wid, int lane) {
    const int nw = gridDim.x * 8;
    for (int row = blockIdx.x * 8 + wid; row < nrows; row += 2 * nw) {
        const int rowb = row + nw; const bool hb = rowb < nrows;
        const f32x4* sa = (const f32x4*)(src + (size_t)row * DM); const f32x4* sb = (const f32x4*)(src + (size_t)(hb ? rowb : row) * DM);
        f32x4 va[8], vb[8]; float ssa = 0.f, ssb = 0.f;
#pragma unroll
        for (int j = 0; j < 8; ++j) { va[j] = sa[lane + 64 * j]; vb[j] = sb[lane + 64 * j]; }
#pragma unroll
        for (int j = 0; j < 8; ++j) { ssa += va[j][0] * va[j][0] + va[j][1] * va[j][1] + va[j][2] * va[j][2] + va[j][3] * va[j][3]; ssb += vb[j][0] * vb[j][0] + vb[j][1] * vb[j][1] + vb[j][2] * vb[j][2] + vb[j][3] * vb[j][3]; }
#pragma unroll
        for (int o = 32; o >= 1; o >>= 1) { ssa += __shfl_xor(ssa, o); ssb += __shfl_xor(ssb, o); }
        const float ra = 1.0f / sqrtf(ssa * (1.0f / DM) + EPS), rb = 1.0f / sqrtf(ssb * (1.0f / DM) + EPS);
#pragma unroll
        for (int j = 0; j < 8; ++j) { const f32x4 gv = ((const f32x4*)g)[lane + 64 * j];
            { const f32x4 y = va[j] * ra * gv; u32x2 w; w.x = cvt_pk_bf16(y[0], y[1]); w.y = cvt_pk_bf16(y[2], y[3]); *(u32x2*)(dst + (size_t)row * DM + 4 * (lane + 64 * j)) = w;
              if (dst8) *(unsigned*)(dst8 + (size_t)row * DM + 4 * (lane + 64 * j)) = pg8::pack_fp8x4(y[0] * SC_ACT8, y[1] * SC_ACT8, y[2] * SC_ACT8, y[3] * SC_ACT8); }
            if (hb) { const f32x4 y = vb[j] * rb * gv; u32x2 w; w.x = cvt_pk_bf16(y[0], y[1]); w.y = cvt_pk_bf16(y[2], y[3]); *(u32x2*)(dst + (size_t)rowb * DM + 4 * (lane + 64 * j)) = w;
              if (dst8) *(unsigned*)(dst8 + (size_t)rowb * DM + 4 * (lane + 64 * j)) = pg8::pack_fp8x4(y[0] * SC_ACT8, y[1] * SC_ACT8, y[2] * SC_ACT8, y[3] * SC_ACT8); } }
    }
}

__device__ __forceinline__ void p0_prologue(const Params& p, LAS unsigned char* lds, int tid, int wid, int lane) {
    LAS CvtJob* jt = (LAS CvtJob*)(lds + 65536);
    LAS int* jtot = (LAS int*)(lds + 65536 + 4096);
    if (tid < NJOBS) { CvtJob jb; make_job(tid, p, jb); jt[tid].src = jb.src; jt[tid].dst = jb.dst; jt[tid].src_ld = jb.src_ld; jt[tid].K = jb.K; jt[tid].ntn = jb.ntn; jt[tid].tile0 = 0; jt[tid].mode = jb.mode; jt[tid].dff = jb.dff; }
    __syncthreads();
    if (tid == 0) { int acc = 0; for (int j = 0; j < NJOBS; ++j) { jt[j].tile0 = acc; acc += (jt[j].K / 128) * jt[j].ntn; } jtot[0] = acc; }
    __syncthreads();
    const int total = jtot[0];
    struct Tile { int mode, K, tn, tk, dff; bf16_t* dst; f32x4 r0, r1, r2, r3; };
    const int tq = tid >> 4, nq = tid & 15;
    int j = 0;
#define P0_FETCH(TL, G_) do { (TL).mode = -1; if ((G_) < total) { while (j + 1 < NJOBS && jt[j + 1].tile0 <= (G_)) ++j; \
        const float* src = (const float*)(__attribute__((address_space(1))) const float*)jt[j].src; const int src_ld = jt[j].src_ld, ntn = jt[j].ntn, local = (G_) - jt[j].tile0; \
        (TL).mode = jt[j].mode; (TL).K = jt[j].K; (TL).dff = jt[j].dff; (TL).dst = (bf16_t*)(__attribute__((address_space(1))) bf16_t*)jt[j].dst; (TL).tn = local % ntn; (TL).tk = local / ntn; \
        if ((TL).mode != 2 && (TL).mode != 5) { const bool f8 = (TL).mode >= 3; const int ra = f8 ? 4 * tq : 2 * tq, rb = ra + 1, rc = f8 ? ra + 2 : ra + 64, rd = rc + 1; \
            const float* sp = src + (size_t)((TL).tk * 128) * src_ld + (TL).tn * 64 + 4 * nq; \
            (TL).r0 = __builtin_nontemporal_load((const f32x4*)(sp + (size_t)ra * src_ld)); (TL).r1 = __builtin_nontemporal_load((const f32x4*)(sp + (size_t)rb * src_ld)); \
            (TL).r2 = __builtin_nontemporal_load((const f32x4*)(sp + (size_t)rc * src_ld)); (TL).r3 = __builtin_nontemporal_load((const f32x4*)(sp + (size_t)rd * src_ld)); } } } while (0)
#define P0_TOLDS(TL, T) do { if ((TL).mode >= 3 && (TL).mode != 5) { _Pragma("unroll") for (int q = 0; q < 4; ++q) (T)[(4 * nq + q) * 33 + tq] = pg8::pack_fp8x4((TL).r0[q] * SC_W8, (TL).r1[q] * SC_W8, (TL).r2[q] * SC_W8, (TL).r3[q] * SC_W8); } \
        else if ((TL).mode == 0 || (TL).mode == 1) { _Pragma("unroll") for (int q = 0; q < 4; ++q) { (T)[(4 * nq + q) * 65 + tq] = cvt_pk_bf16((TL).r0[q], (TL).r1[q]); (T)[(4 * nq + q) * 65 + tq + 32] = cvt_pk_bf16((TL).r2[q], (TL).r3[q]); } } } while (0)
#define P0_OUT(TL, T) do { const int mode = (TL).mode, K = (TL).K, tn = (TL).tn, tk = (TL).tk, dff = (TL).dff; bf16_t* dst = (TL).dst; \
        if (mode == 2) { _Pragma("unroll") for (int it = 0; it < 2; ++it) { const int piece = tid + it * 512, n = piece >> 4, seg = piece & 15; \
                *(u32x4*)(dst + (size_t)(tn * 64 + n) * K + tk * 128 + seg * 8) = (u32x4){0u, 0u, 0u, 0u}; } } \
        else if (mode == 5) { const int n = tid >> 3, seg = tid & 7; *(u32x4*)((unsigned char*)dst + (size_t)(tn * 64 + n) * K + tk * 128 + seg * 16) = (u32x4){0u, 0u, 0u, 0u}; } \
        else if (mode >= 3) { const int n = tid >> 3, seg = tid & 7; \
            u32x4 w; w.x = (T)[n * 33 + seg * 4 + 0]; w.y = (T)[n * 33 + seg * 4 + 1]; w.z = (T)[n * 33 + seg * 4 + 2]; w.w = (T)[n * 33 + seg * 4 + 3]; \
            int drow = tn * 64 + n; if (mode == 4) { const int bj = drow / dff, cc = drow - bj * dff; drow = 256 * (cc >> 7) + 128 * bj + (cc & 127); } \
            __builtin_nontemporal_store(w, (u32x4*)((unsigned char*)dst + (size_t)drow * K + tk * 128 + seg * 16)); } \
        else if (mode >= 0) { _Pragma("unroll") for (int it = 0; it < 2; ++it) { const int piece = tid + it * 512, n = piece >> 4, seg = piece & 15; \
                u32x4 w; w.x = (T)[n * 65 + seg * 4 + 0]; w.y = (T)[n * 65 + seg * 4 + 1]; w.z = (T)[n * 65 + seg * 4 + 2]; w.w = (T)[n * 65 + seg * 4 + 3]; \
                int drow = tn * 64 + n; if (mode == 1) { const int bj = drow / dff, cc = drow - bj * dff; drow = 256 * (cc >> 7) + 128 * bj + (cc & 127); } \
                __builtin_nontemporal_store(w, (u32x4*)(dst + (size_t)drow * K + tk * 128 + seg * 8)); } } } while (0)
    LAS unsigned* T0 = (LAS unsigned*)lds; LAS unsigned* T1 = (LAS unsigned*)(lds + 20480);
    Tile na, nb;
    int g = blockIdx.x;
    P0_FETCH(na, g); P0_FETCH(nb, g + (int)gridDim.x);
    while (g < total) {
        const Tile ca = na, cb = nb;
        g += 2 * gridDim.x;
        P0_FETCH(na, g); P0_FETCH(nb, g + (int)gridDim.x);
        P0_TOLDS(ca, T0); P0_TOLDS(cb, T1);
        __syncthreads();
        P0_OUT(ca, T0); P0_OUT(cb, T1);
        __syncthreads();
    }
#undef P0_FETCH
#undef P0_TOLDS
#undef P0_OUT
#ifdef PROBE_POISON
    { u32x4* q = (u32x4*)(p.ws + WS_XG); const size_t n1 = (size_t)NEXP * ECAP * DM / 16; for (size_t i = (size_t)blockIdx.x * NTHREADS + tid; i < n1; i += (size_t)gridDim.x * NTHREADS) q[i] = (u32x4){0u, 0u, 0u, 0u};
      q = (u32x4*)(p.ws + WS_ACTM); const size_t n2 = (size_t)NEXP * ECAP * DFFE / 16; for (size_t i = (size_t)blockIdx.x * NTHREADS + tid; i < n2; i += (size_t)gridDim.x * NTHREADS) q[i] = (u32x4){0u, 0u, 0u, 0u}; }
#endif
    { f32x2* rt = (f32x2*)(p.ws + WS_ROPE);
      for (int e = blockIdx.x * NTHREADS + tid; e < SEQ * 32; e += gridDim.x * NTHREADS) { const int pos = e >> 5, i = e & 31;
          const float freq = __builtin_amdgcn_exp2f(-(float)i * (13.287712379549449f / 32.0f));
          const float ang = (float)pos * freq;
          const double rev = (double)ang * 0.15915494309189535; const float fr_ = (float)(rev - __builtin_rint(rev));
          rt[e] = (f32x2){__builtin_amdgcn_cosf(fr_), __builtin_amdgcn_sinf(fr_)}; } }
    norm_rows(p.in[I_MEM], p.in[I_MEM_N], (bf16_t*)(p.ws + WS_MEMN), nullptr, NMEM, wid, lane);
    norm_rows(p.in[I_MEM], p.in[I_MEM_N] + DM, (bf16_t*)(p.ws + WS_MEMN) + (size_t)NMEM * DM, nullptr, NMEM, wid, lane);
    norm_rows(p.in[I_X], p.in[I_NORM_MIX], (bf16_t*)(p.ws + WS_U), p.ws + WS_U8, NTOK, wid, lane);
}

__device__ __forceinline__ void unpack8(const u32x4 w, float (&x)[8]) { x[0] = bflo(w.x); x[1] = bfhi(w.x); x[2] = bflo(w.y); x[3] = bfhi(w.y); x[4] = bflo(w.z); x[5] = bfhi(w.z); x[6] = bflo(w.w); x[7] = bfhi(w.w); }
__device__ __forceinline__ u32x4 pack8(const float (&y)[8]) { u32x4 w; w.x = cvt_pk_bf16(y[0], y[1]); w.y = cvt_pk_bf16(y[2], y[3]); w.z = cvt_pk_bf16(y[4], y[5]); w.w = cvt_pk_bf16(y[6], y[7]); return w; }
__device__ __forceinline__ float sumsq8(const float (&x)[8]) { return (x[0] * x[0] + x[1] * x[1]) + (x[2] * x[2] + x[3] * x[3]) + (x[4] * x[4] + x[5] * x[5]) + (x[6] * x[6] + x[7] * x[7]); }
template <int NL> __device__ __forceinline__ float group_sum(float v) {
#pragma unroll
    for (int o = NL / 2; o >= 1; o >>= 1) v += __shfl_xor(v, o);
    return v;
}
struct Gain8 { f32x4 a, b; };
__device__ __forceinline__ Gain8 ldg8(const float* g) { Gain8 r; r.a = *(const f32x4*)g; r.b = *(const f32x4*)(g + 4); return r; }
__device__ __forceinline__ void scale8(float (&x)[8], float rs, const Gain8& g) { x[0] *= rs * g.a[0]; x[1] *= rs * g.a[1]; x[2] *= rs * g.a[2]; x[3] *= rs * g.a[3]; x[4] *= rs * g.b[0]; x[5] *= rs * g.b[1]; x[6] *= rs * g.b[2]; x[7] *= rs * g.b[3]; }
__device__ __forceinline__ void rope8(float (&y)[8], const f32x4 (&cs)[4], bool upper) {
#pragma unroll
    for (int e = 0; e < 8; ++e) { const float pr = __shfl_xor(y[e], 4); const float c = cs[e >> 1][(e & 1) * 2], s = cs[e >> 1][(e & 1) * 2 + 1]; y[e] = upper ? (y[e] * c + pr * s) : (y[e] * c - pr * s); }
}

__device__ __forceinline__ void prep1(const Params& p, int l, LAS unsigned char* lds, int tid, int wid, int lane) {
    const bf16_t* z = (const bf16_t*)(p.ws + WS_Z);
    bf16_t* naq = (bf16_t*)(p.ws + WS_NAQ); bf16_t* nak = (bf16_t*)(p.ws + WS_NAK); bf16_t* navT = (bf16_t*)(p.ws + WS_NAVT);
    bf16_t* cqn = (bf16_t*)(p.ws + WS_CQN); bf16_t* ckvn = (bf16_t*)(p.ws + WS_CKVN);
    bf16_t* swq = (bf16_t*)(p.ws + WS_SWQ); bf16_t* swk = (bf16_t*)(p.ws + WS_SWK); bf16_t* swvT = (bf16_t*)(p.ws + WS_SWVT); bf16_t* meq = (bf16_t*)(p.ws + WS_MEQ);
    const f32x4* rt4 = (const f32x4*)(p.ws + WS_ROPE);
    const float qs128 = 0.08838834764831845f * LOG2E, qs64 = 0.125f * LOG2E;
    const int l16 = lane & 15, l8 = lane & 7;
    const Gain8 g_naq = ldg8(p.in[I_NA_QN] + l * 128 + 8 * l16), g_nak = ldg8(p.in[I_NA_KN] + l * 128 + 8 * l16), g_meq = ldg8(p.in[I_MEM_QN] + l * 128 + 8 * l16);
    const Gain8 g_cq0 = ldg8(p.in[I_CQ_N] + l * 768 + 8 * lane), g_cq1 = ldg8(p.in[I_CQ_N] + l * 768 + 512 + 8 * (lane & 31)), g_ckv = ldg8(p.in[I_CKV_N] + l * 256 + 8 * (lane & 31));
    const Gain8 g_swq = ldg8(p.in[I_SWA_QN] + l * 64 + 8 * l8), g_swk = ldg8(p.in[I_SWA_KN] + l * 64 + 8 * l8);
    constexpr int VW = 640;
    LAS bf16_t* vt = (LAS bf16_t*)lds;
    const u32x4 zero4 = (u32x4){0u, 0u, 0u, 0u};
    for (int grp = blockIdx.x; grp < NTOK / 32; grp += gridDim.x) {
        const int b = grp >> 6, chunk = grp & 63;
#pragma unroll 2
        for (int ti = 0; ti < 4; ++ti) {
            const int tl = wid * 4 + ti, s = chunk * 32 + tl, token = grp * 32 + tl;
            const bf16_t* zr = z + (size_t)token * ZC;
            const u32x4 w_naq = *(const u32x4*)(zr + Z_NAQ + 8 * lane), w_nak = *(const u32x4*)(zr + Z_NAK + 8 * lane), w_nav = *(const u32x4*)(zr + Z_NAV + 8 * lane), w_meq = *(const u32x4*)(zr + Z_MEQ + 8 * lane);
            const u32x4 w_cq0 = *(const u32x4*)(zr + Z_CQ + 8 * lane); const u32x4 w_cq1 = lane < 32 ? *(const u32x4*)(zr + Z_CQ + 512 + 8 * lane) : zero4;
            const u32x4 w_ckv = lane < 32 ? *(const u32x4*)(zr + Z_CKV + 8 * lane) : zero4;
            const u32x4 w_swq = *(const u32x4*)(zr + Z_SWQ + 8 * lane);
            const u32x4 w_swkv = lane < 32 ? *(const u32x4*)(zr + (lane < 16 ? Z_SWK + 8 * lane : Z_SWV + 8 * (lane - 16))) : zero4;
            f32x4 cs[4];
#pragma unroll
            for (int q = 0; q < 4; ++q) cs[q] = rt4[(s * 32 + (lane & 3) * 8) / 2 + q];
            *(LAS u32x4*)(vt + tl * VW + 8 * lane) = w_nav;
            if (lane >= 16 && lane < 32) *(LAS u32x4*)(vt + tl * VW + 512 + 8 * (lane - 16)) = w_swkv;
            float x[8];
            { unpack8(w_naq, x); const float ss = group_sum<16>(sumsq8(x)); scale8(x, 1.0f / sqrtf(ss * (1.0f / 128) + EPS) * qs128, g_naq);
              *(u32x4*)(naq + ((size_t)(b * 4 + (lane >> 4)) * SEQ + s) * 128 + 8 * l16) = pack8(x); }
            { unpack8(w_nak, x); const float ss = group_sum<16>(sumsq8(x)); scale8(x, 1.0f / sqrtf(ss * (1.0f / 128) + EPS), g_nak);
              *(u32x4*)(nak + ((size_t)(b * 4 + (lane >> 4)) * SEQ + s) * 128 + 8 * l16) = pack8(x); }
            { unpack8(w_meq, x); const float ss = group_sum<16>(sumsq8(x)); scale8(x, 1.0f / sqrtf(ss * (1.0f / 128) + EPS) * qs128, g_meq);
              *(u32x4*)(meq + ((size_t)(b * 4 + (lane >> 4)) * SEQ + s) * 128 + 8 * l16) = pack8(x); }
            { float y[8]; unpack8(w_cq0, x); unpack8(w_cq1, y); const float ss = group_sum<64>(sumsq8(x) + sumsq8(y)); const float rs = 1.0f / sqrtf(ss * (1.0f / 768) + EPS);
              scale8(x, rs, g_cq0); scale8(y, rs, g_cq1);
              *(u32x4*)(cqn + (size_t)token * 768 + 8 * lane) = pack8(x); if (lane < 32) *(u32x4*)(cqn + (size_t)token * 768 + 512 + 8 * lane) = pack8(y); }
            { unpack8(w_ckv, x); const float ss = group_sum<64>(sumsq8(x)); scale8(x, 1.0f / sqrtf(ss * (1.0f / 256) + EPS), g_ckv);
              if (lane < 32) *(u32x4*)(ckvn + (size_t)token * 256 + 8 * lane) = pack8(x); }
            { unpack8(w_swq, x); const float ss = group_sum<8>(sumsq8(x)); scale8(x, 1.0f / sqrtf(ss * (1.0f / 64) + EPS), g_swq); rope8(x, cs, (lane & 4) != 0);
#pragma unroll
              for (int e = 0; e < 8; ++e) x[e] *= qs64;
              *(u32x4*)(swq + ((size_t)(b * 8 + (lane >> 3)) * SEQ + s) * 64 + 8 * l8) = pack8(x); }
            { unpack8(w_swkv, x); const float ss = group_sum<8>(sumsq8(x)); scale8(x, 1.0f / sqrtf(ss * (1.0f / 64) + EPS), g_swk); rope8(x, cs, (lane & 4) != 0);
              if (lane < 16) *(u32x4*)(swk + ((size_t)(b * 2 + (lane >> 3)) * SEQ + s) * 64 + 8 * l8) = pack8(x); }
        }
        __syncthreads();
#pragma unroll 1
        for (int it = 0; it < 5; ++it) { const int item = tid + it * 512, part = item / VW, c = item - part * VW;
            unsigned short e[8];
#pragma unroll
            for (int q = 0; q < 8; ++q) e[q] = vt[(part * 8 + q) * VW + c];
            u32x4 w; w.x = e[0] | ((unsigned)e[1] << 16); w.y = e[2] | ((unsigned)e[3] << 16); w.z = e[4] | ((unsigned)e[5] << 16); w.w = e[6] | ((unsigned)e[7] << 16);
            bf16_t* dp = (c < 512) ? navT + ((((size_t)(b * 4 + (c >> 7)) * 64 + chunk) * 128 + (c & 127)) * 32 + part * 8)
                                   : swvT + ((((size_t)(b * 2 + ((c - 512) >> 6)) * 64 + chunk) * 64 + ((c - 512) & 63)) * 32 + part * 8);
            *(u32x4*)dp = w; }
        __syncthreads();
    }
}

__device__ __forceinline__ void prep2(const Params& p, int l, LAS unsigned char* lds, int tid, int wid, int lane) {
    const bf16_t* z = (const bf16_t*)(p.ws + WS_Z); const bf16_t* qraw = (const bf16_t*)(p.ws + WS_QRAW); const bf16_t* kvraw = (const bf16_t*)(p.ws + WS_KVRAW);
    const bf16_t* memkv = (const bf16_t*)(p.ws + WS_MEMKV) + (size_t)l * NMEM * 1024;
    bf16_t* mlq = (bf16_t*)(p.ws + WS_MLQ); bf16_t* mlk = (bf16_t*)(p.ws + WS_MLK); bf16_t* mlvT = (bf16_t*)(p.ws + WS_MLVT);
    bf16_t* mek = (bf16_t*)(p.ws + WS_MEK); bf16_t* mevT = (bf16_t*)(p.ws + WS_MEVT);
    const f32x4* rt4 = (const f32x4*)(p.ws + WS_ROPE);
    const float qs192 = 0.07216878364870322f * LOG2E;
    const int l16 = lane & 15, l24 = lane < 24 ? lane : 0;
    const Gain8 g_q = ldg8(p.in[I_MLA_QN] + l * 192 + 8 * l24), g_k = ldg8(p.in[I_MLA_KN] + l * 192 + 8 * l24), g_mk = ldg8(p.in[I_MEM_KN] + l * 128 + 8 * l16);
    constexpr int VW = 512;
    LAS bf16_t* vt = (LAS bf16_t*)lds;
    const u32x4 zero4 = (u32x4){0u, 0u, 0u, 0u};
    for (int grp = blockIdx.x; grp < NTOK / 32 + NMEM / 32; grp += gridDim.x) {
        const bool ismem = grp >= NTOK / 32;
        if (!ismem) {
            const int b = grp >> 6, chunk = grp & 63;
#pragma unroll 2
            for (int ti = 0; ti < 4; ++ti) {
                const int tl = wid * 4 + ti, s = chunk * 32 + tl, token = grp * 32 + tl;
                u32x4 wq[4], wk[4];
#pragma unroll
                for (int h = 0; h < 4; ++h) { wq[h] = lane < 24 ? *(const u32x4*)(qraw + (size_t)token * 768 + h * 192 + 8 * lane) : zero4;
                    wk[h] = lane < 16 ? *(const u32x4*)(kvraw + (size_t)token * 1024 + h * 256 + 8 * lane) : (lane < 24 ? *(const u32x4*)(z + (size_t)token * ZC + Z_KPE + 8 * (lane - 16)) : zero4); }
                const u32x4 wv = *(const u32x4*)(kvraw + (size_t)token * 1024 + (lane >> 4) * 256 + 128 + 8 * l16);
                f32x4 cs[4];
#pragma unroll
                for (int q = 0; q < 4; ++q) cs[q] = rt4[(s * 32 + (lane & 3) * 8) / 2 + q];
                *(LAS u32x4*)(vt + tl * VW + (lane >> 4) * 128 + 8 * l16) = wv;
                const bool ropel = lane >= 16 && lane < 24;
#pragma unroll
                for (int h = 0; h < 4; ++h) {
                    float x[8];
                    { unpack8(wq[h], x); const float ss = group_sum<64>(sumsq8(x)); scale8(x, 1.0f / sqrtf(ss * (1.0f / 192) + EPS), g_q);
                      float y[8];
#pragma unroll
                      for (int e = 0; e < 8; ++e) y[e] = x[e];
                      rope8(y, cs, (lane & 4) != 0);
#pragma unroll
                      for (int e = 0; e < 8; ++e) x[e] = (ropel ? y[e] : x[e]) * qs192;
                      if (lane < 24) *(u32x4*)(mlq + ((size_t)(b * 4 + h) * SEQ + s) * 192 + 8 * lane) = pack8(x); }
                    { unpack8(wk[h], x); const float ss = group_sum<64>(sumsq8(x)); scale8(x, 1.0f / sqrtf(ss * (1.0f / 192) + EPS), g_k);
                      float y[8];
#pragma unroll
                      for (int e = 0; e < 8; ++e) y[e] = x[e];
                      rope8(y, cs, (lane & 4) != 0);
#pragma unroll
                      for (int e = 0; e < 8; ++e) x[e] = ropel ? y[e] : x[e];
                      if (lane < 24) *(u32x4*)(mlk + ((size_t)(b * 4 + h) * SEQ + s) * 192 + 8 * lane) = pack8(x); }
                }
            }
            __syncthreads();
#pragma unroll 1
            for (int it = 0; it < 4; ++it) { const int item = tid + it * 512, part = item >> 9, c = item & 511;
                unsigned short e[8];
#pragma unroll
                for (int q = 0; q < 8; ++q) e[q] = vt[(part * 8 + q) * VW + c];
                u32x4 w; w.x = e[0] | ((unsigned)e[1] << 16); w.y = e[2] | ((unsigned)e[3] << 16); w.z = e[4] | ((unsigned)e[5] << 16); w.w = e[6] | ((unsigned)e[7] << 16);
                *(u32x4*)(mlvT + ((((size_t)(b * 4 + (c >> 7)) * 64 + chunk) * 128 + (c & 127)) * 32 + part * 8)) = w; }
            __syncthreads();
        } else {
            const int mg = grp - NTOK / 32, b = mg >> 3, chunk = mg & 7;
#pragma unroll 2
            for (int ti = 0; ti < 4; ++ti) {
                const int tl = wid * 4 + ti, m = chunk * 32 + tl, mt = mg * 32 + tl;
                const bf16_t* mr = memkv + (size_t)mt * 1024;
                const u32x4 wkk = *(const u32x4*)(mr + 8 * lane), wv = *(const u32x4*)(mr + 512 + 8 * lane);
                *(LAS u32x4*)(vt + tl * VW + 8 * lane) = wv;
                float x[8]; unpack8(wkk, x); const float ss = group_sum<16>(sumsq8(x)); scale8(x, 1.0f / sqrtf(ss * (1.0f / 128) + EPS), g_mk);
                *(u32x4*)(mek + ((size_t)(b * 4 + (lane >> 4)) * MEML + m) * 128 + 8 * l16) = pack8(x);
            }
            __syncthreads();
#pragma unroll 1
            for (int it = 0; it < 4; ++it) { const int item = tid + it * 512, part = item >> 9, c = item & 511;
                unsigned short e[8];
#pragma unroll
                for (int q = 0; q < 8; ++q) e[q] = vt[(part * 8 + q) * VW + c];
                u32x4 w; w.x = e[0] | ((unsigned)e[1] << 16); w.y = e[2] | ((unsigned)e[3] << 16); w.z = e[4] | ((unsigned)e[5] << 16); w.w = e[6] | ((unsigned)e[7] << 16);
                *(u32x4*)(mevT + ((((size_t)(b * 4 + (c >> 7)) * 8 + chunk) * 128 + (c & 127)) * 32 + part * 8)) = w; }
            __syncthreads();
        }
    }
}
constexpr int ATT_RPB_OFF = 98304;
template <int DQ, int DV, int MODE, int NQT>
__device__ __forceinline__ void attn_unit(LAS unsigned char* lds, const bf16_t* qp, const bf16_t* kp, const bf16_t* vp, bf16_t* op,
                                          int nsub, int c_lo, int c_hi, int mq0, int mk0, int mr, float sink2, int tid, int lane) {
    constexpr int KROW = DQ * 2 + 16, KBUF = 64 * KROW, VROW = 144, VBUF = DV * VROW, NDC = DQ / 32, NDV = DV / 16, DQ8 = DQ / 8;
    constexpr int KP = 64 * DQ8 / 512, VP = 2 * DV * 4 / 512;
    static_assert(KP * 512 == 64 * DQ8 && VP * 512 == 2 * DV * 4 && 2 * KBUF + 2 * VBUF <= ATT_RPB_OFF, "attention staging geometry");
    const int fr = lane & 15, fq = lane >> 4;
    bf16x8 qf[NQT][NDC];
#pragma unroll
    for (int qt = 0; qt < NQT; ++qt)
#pragma unroll
        for (int dc = 0; dc < NDC; ++dc) qf[qt][dc] = *(const bf16x8*)(qp + (size_t)(qt * 16 + fr) * DQ + dc * 32 + fq * 8);
    f32x4 o[NQT][NDV];
#pragma unroll
    for (int qt = 0; qt < NQT; ++qt)
#pragma unroll
        for (int d = 0; d < NDV; ++d) o[qt][d] = (f32x4){0.f, 0.f, 0.f, 0.f};
    float mrun[NQT], lrun[NQT];
#pragma unroll
    for (int qt = 0; qt < NQT; ++qt) { mrun[qt] = -1e30f; lrun[qt] = 0.f; }
    int kd[KP], vd[VP];
#pragma unroll
    for (int i = 0; i < KP; ++i) { const int pk = tid + i * 512, key = pk / DQ8, dp = pk - key * DQ8, k32 = key & 31;
        kd[i] = (32 * (key >> 5) + 16 * ((k32 >> 2) & 1) + 4 * (k32 >> 3) + (k32 & 3)) * KROW + dp * 16; }
#pragma unroll
    for (int i = 0; i < VP; ++i) { const int pv = tid + i * 512, sub = pv / (DV * 4), r = pv - sub * (DV * 4); vd[i] = (r >> 2) * VROW + sub * 64 + (r & 3) * 16; }
    u32x4 rk[KP], rv[VP];
#pragma unroll
    for (int i = 0; i < KP; ++i) rk[i] = *(const u32x4*)(kp + (size_t)(tid + i * 512) * 8);
#pragma unroll
    for (int i = 0; i < VP; ++i) rv[i] = *(const u32x4*)(vp + (size_t)(tid + i * 512) * 8);
#pragma unroll
    for (int i = 0; i < KP; ++i) *(LAS u32x4*)(lds + kd[i]) = rk[i];
#pragma unroll
    for (int i = 0; i < VP; ++i) *(LAS u32x4*)(lds + 2 * KBUF + vd[i]) = rv[i];
    __syncthreads();
    __builtin_amdgcn_s_waitcnt(0x0F70);
    const int n64 = nsub >> 1;
#pragma unroll 1
    for (int c = 0; c < n64; ++c) {
        const int cur = c & 1; const bool more = (c + 1 < n64);
        if (more) { const bf16_t* kn = kp + (size_t)(c + 1) * 64 * DQ; const bf16_t* vn = vp + (size_t)(c + 1) * 2 * DV * 32;
#pragma unroll
            for (int i = 0; i < KP; ++i) { const bf16_t* ga = kn + (size_t)(tid + i * 512) * 8; asm volatile("global_load_dwordx4 %0, %1, off" : "=v"(rk[i]) : "v"(ga) : "memory"); }
#pragma unroll
            for (int i = 0; i < VP; ++i) { const bf16_t* ga = vn + (size_t)(tid + i * 512) * 8; asm volatile("global_load_dwordx4 %0, %1, off" : "=v"(rv[i]) : "v"(ga) : "memory"); } }
#pragma unroll (NQT == 1 ? 2 : 1)
        for (int sub = 0; sub < 2; ++sub) {
            const int sc = 2 * c + sub;
            if (sc >= c_lo && sc < c_hi) {
                const LAS unsigned char* kb = lds + cur * KBUF + sub * 32 * KROW; const LAS unsigned char* vb = lds + 2 * KBUF + cur * VBUF + sub * 64;
                f32x4 s[NQT][2];
#pragma unroll
                for (int qt = 0; qt < NQT; ++qt) { s[qt][0] = (f32x4){0.f, 0.f, 0.f, 0.f}; s[qt][1] = (f32x4){0.f, 0.f, 0.f, 0.f}; }
                { bf16x8 kf[NDC][2];
#pragma unroll
                  for (int dc = 0; dc < NDC; ++dc) { kf[dc][0] = *(const LAS bf16x8*)(kb + fr * KROW + (dc * 32 + fq * 8) * 2); kf[dc][1] = *(const LAS bf16x8*)(kb + (16 + fr) * KROW + (dc * 32 + fq * 8) * 2); }
#pragma unroll
                  for (int dc = 0; dc < NDC; ++dc)
#pragma unroll
                    for (int qt = 0; qt < NQT; ++qt) { s[qt][0] = __builtin_amdgcn_mfma_f32_16x16x32_bf16(kf[dc][0], qf[qt][dc], s[qt][0], 0, 0, 0);
                                                       s[qt][1] = __builtin_amdgcn_mfma_f32_16x16x32_bf16(kf[dc][1], qf[qt][dc], s[qt][1], 0, 0, 0); } }
                bf16x8 pf[NQT];
#pragma unroll
                for (int qt = 0; qt < NQT; ++qt) {
                    if (MODE == 1) {
                        const int qpos = mq0 + qt * 16 + fr, kbase = mk0 + sc * 32 + 8 * fq;
#pragma unroll
                        for (int b = 0; b < 2; ++b)
#pragma unroll
                            for (int i = 0; i < 4; ++i) { const int dd = qpos - (kbase + 4 * b + i); if (dd > 128 || dd < -128) s[qt][b][i] = -1e30f; }
                    } else if (MODE == 2) {
                        const LAS float* rpb = (const LAS float*)(lds + ATT_RPB_OFF);
                        const int qc = mq0 + qt * 16 + fr, kr = mk0 + (sc >> 1), kcb = (sc & 1) * 32 + 8 * fq;
                        int cs = qc - 8; cs = cs < 0 ? 0 : (cs > 48 ? 48 : cs);
                        const int rowoff = (kr - mr + 7) * 31;
#pragma unroll
                        for (int b = 0; b < 2; ++b)
#pragma unroll
                            for (int i = 0; i < 4; ++i) { const int kc = kcb + 4 * b + i; const bool ok = (kc >= cs) && (kc <= cs + 15);
                                int bi = kc - qc + 15; bi = bi < 0 ? 0 : (bi > 30 ? 30 : bi);
                                const float bias = rpb[rowoff + bi];
                                s[qt][b][i] = ok ? s[qt][b][i] + bias : -1e30f; }
                    }
                    float mx = fmaxf(fmaxf(fmaxf(s[qt][0][0], s[qt][0][1]), fmaxf(s[qt][0][2], s[qt][0][3])), fmaxf(fmaxf(s[qt][1][0], s[qt][1][1]), fmaxf(s[qt][1][2], s[qt][1][3])));
                    mx = fmaxf(mx, __shfl_xor(mx, 16)); mx = fmaxf(mx, __shfl_xor(mx, 32));
                    const float mnew = fmaxf(mrun[qt], mx), alpha = __builtin_amdgcn_exp2f(mrun[qt] - mnew); mrun[qt] = mnew;
                    float ps = 0.f;
#pragma unroll
                    for (int b = 0; b < 2; ++b)
#pragma unroll
                        for (int i = 0; i < 4; ++i) { const float e = __builtin_amdgcn_exp2f(s[qt][b][i] - mnew); s[qt][b][i] = e; ps += e; }
                    lrun[qt] = lrun[qt] * alpha + ps;
                    if (__any(alpha != 1.0f)) {
#pragma unroll
                        for (int d = 0; d < NDV; ++d) o[qt][d] *= alpha; }
                    u32x4 w; w.x = cvt_pk_bf16(s[qt][0][0], s[qt][0][1]); w.y = cvt_pk_bf16(s[qt][0][2], s[qt][0][3]); w.z = cvt_pk_bf16(s[qt][1][0], s[qt][1][1]); w.w = cvt_pk_bf16(s[qt][1][2], s[qt][1][3]);
                    pf[qt] = __builtin_bit_cast(bf16x8, w);
                }
                { bf16x8 vf[NDV];
#pragma unroll
                  for (int d = 0; d < NDV; ++d) vf[d] = *(const LAS bf16x8*)(vb + (d * 16 + fr) * VROW + fq * 16);
#pragma unroll
                  for (int d = 0; d < NDV; ++d)
#pragma unroll
                    for (int qt = 0; qt < NQT; ++qt) o[qt][d] = __builtin_amdgcn_mfma_f32_16x16x32_bf16(vf[d], pf[qt], o[qt][d], 0, 0, 0); }
            }
        }
        if (more) { const int nb = cur ^ 1;
            if constexpr (KP == 3) asm volatile("s_waitcnt vmcnt(0)" : "+v"(rk[0]), "+v"(rk[1]), "+v"(rk[2]), "+v"(rv[0]), "+v"(rv[1]) :: "memory");
            else if constexpr (KP == 2) asm volatile("s_waitcnt vmcnt(0)" : "+v"(rk[0]), "+v"(rk[1]), "+v"(rv[0]), "+v"(rv[1]) :: "memory");
            else asm volatile("s_waitcnt vmcnt(0)" : "+v"(rk[0]), "+v"(rv[0]) :: "memory");
#pragma unroll
            for (int i = 0; i < KP; ++i) *(LAS u32x4*)(lds + nb * KBUF + kd[i]) = rk[i];
#pragma unroll
            for (int i = 0; i < VP; ++i) *(LAS u32x4*)(lds + 2 * KBUF + nb * VBUF + vd[i]) = rv[i]; }
        __syncthreads();
    }
#pragma unroll
    for (int qt = 0; qt < NQT; ++qt) {
        float l = lrun[qt]; l += __shfl_xor(l, 16); l += __shfl_xor(l, 32);
        if (MODE == 1) l += __builtin_amdgcn_exp2f(sink2 - mrun[qt]);
        const float inv = 1.0f / l;
        bf16_t* orow = op + (size_t)(qt * 16 + fr) * DM + 4 * fq;
#pragma unroll
        for (int d = 0; d < NDV; ++d) { u32x2 w; w.x = cvt_pk_bf16(o[qt][d][0] * inv, o[qt][d][1] * inv); w.y = cvt_pk_bf16(o[qt][d][2] * inv, o[qt][d][3] * inv); *(u32x2*)(orow + d * 16) = w; }
    }
}

__device__ __forceinline__ void attn_phase(const Params& p, int lq, LAS unsigned char* lds, int tid, int wid, int lane, int G, int cblk) {
    const int l = lq & 1;
    unsigned* head = (unsigned*)(p.ws + WS_CTL) + CW_ATTQ + lq * 64;
    volatile LAS int* qw = (volatile LAS int*)(lds + LDS_MISC + 64);
    bf16_t* br = (bf16_t*)(p.ws + ((lq & 2) ? WS_ACT : WS_BR));
    const int pmode = lq >> 2;
    if (pmode != 2)
    for (int id = cblk; id < 256; id += G) {
        const int x = id & 7, j = id >> 3, bhi = x * 2 + (j >> 4), qt16 = j & 15, b = bhi >> 2, h = bhi & 3; const size_t bh = (size_t)bhi;
        const bf16_t* q = (const bf16_t*)(p.ws + WS_MLQ) + (bh * SEQ + qt16 * 128 + wid * 16) * 192;
        const bf16_t* k = (const bf16_t*)(p.ws + WS_MLK) + bh * SEQ * 192; const bf16_t* v = (const bf16_t*)(p.ws + WS_MLVT) + bh * SEQ * 128;
        bf16_t* o = br + (size_t)(b * SEQ + qt16 * 128 + wid * 16) * DM + 512 + h * 128;
        attn_unit<192, 128, 0, 1>(lds, q, k, v, o, 64, 0, 64, 0, 0, 0, 0.f, tid, lane);
    }
    if (pmode != 1)
    for (;;) {
        if (tid == 0) qw[0] = 256 + (int)__hip_atomic_fetch_add(head, 1u, __ATOMIC_RELAXED, __HIP_MEMORY_SCOPE_AGENT);
        __syncthreads();
        const int id = __builtin_amdgcn_readfirstlane(qw[0]);
        __syncthreads();
        if (id >= 896) break;
        if (id < 256) {
        } else if (id < 512) {
            const int u = id - 256, b = u >> 6, h = (u >> 4) & 3, r2 = u & 15; const size_t bh = (size_t)(b * 4 + h);
            const int r = r2 * 2 + (wid >> 2), half = (wid >> 1) & 1, qs = wid & 1;
            int kr_lo = r2 * 2 - 4; kr_lo = kr_lo < 0 ? 0 : (kr_lo > 24 ? 24 : kr_lo);
            int kr_hi = r2 * 2 + 1 - 4; kr_hi = (kr_hi < 0 ? 0 : (kr_hi > 24 ? 24 : kr_hi)) + 7;
            int rs = r - 4; rs = rs < 0 ? 0 : (rs > 24 ? 24 : rs);
            { const float* rp = p.in[I_NA_RPB] + ((size_t)l * 4 + h) * 15 * 31; LAS float* rl = (LAS float*)(lds + ATT_RPB_OFF); if (tid < 465) rl[tid] = rp[tid] * LOG2E; }
            const int qtok = r * 64 + half * 32 + qs * 16;
            const bf16_t* q = (const bf16_t*)(p.ws + WS_NAQ) + (bh * SEQ + qtok) * 128;
            const bf16_t* k = (const bf16_t*)(p.ws + WS_NAK) + (bh * SEQ + kr_lo * 64) * 128; const bf16_t* v = (const bf16_t*)(p.ws + WS_NAVT) + (bh * 64 + kr_lo * 2) * 128 * 32;
            bf16_t* o = br + (size_t)(b * SEQ + qtok) * DM + 0 + h * 128;
            attn_unit<128, 128, 2, 1>(lds, q, k, v, o, 2 * (kr_hi - kr_lo + 1), 2 * (rs - kr_lo), 2 * (rs - kr_lo) + 16, half * 32 + qs * 16, kr_lo, r, 0.f, tid, lane);
        } else if (id < 768) {
            const int u = id - 512, b = u >> 6, kvh = (u >> 5) & 1, qb = u & 31, q0 = qb * 64; const int hq = kvh * 4 + (wid >> 1), qpos0 = q0 + (wid & 1) * 32;
            const int kstart = q0 - 128 < 0 ? 0 : q0 - 128, kend = q0 + 192 > SEQ ? SEQ : q0 + 192, nch = (kend - kstart) >> 5;
            int c_lo = (qpos0 - 128 - kstart) >> 5; c_lo = c_lo < 0 ? 0 : c_lo; int c_hi = ((qpos0 + 159 - kstart) >> 5) + 1; c_hi = c_hi > nch ? nch : c_hi;
            const bf16_t* q = (const bf16_t*)(p.ws + WS_SWQ) + ((size_t)(b * 8 + hq) * SEQ + qpos0) * 64;
            const bf16_t* k = (const bf16_t*)(p.ws + WS_SWK) + ((size_t)(b * 2 + kvh) * SEQ + kstart) * 64; const bf16_t* v = (const bf16_t*)(p.ws + WS_SWVT) + ((size_t)(b * 2 + kvh) * 64 + (kstart >> 5)) * 64 * 32;
            bf16_t* o = br + (size_t)(b * SEQ + qpos0) * DM + 1024 + hq * 64;
            attn_unit<64, 64, 1, 2>(lds, q, k, v, o, nch, c_lo, c_hi, qpos0, kstart, 0, p.in[I_SWA_SINK][l * 8 + hq] * LOG2E, tid, lane);
        } else {
            const int u = id - 768, b = u >> 5, h = (u >> 3) & 3, qt8 = u & 7; const size_t bh = (size_t)(b * 4 + h);
            const bf16_t* q = (const bf16_t*)(p.ws + WS_MEQ) + (bh * SEQ + qt8 * 256 + wid * 32) * 128;
            const bf16_t* k = (const bf16_t*)(p.ws + WS_MEK) + bh * MEML * 128; const bf16_t* v = (const bf16_t*)(p.ws + WS_MEVT) + bh * MEML * 128;
            bf16_t* o = br + (size_t)(b * SEQ + qt8 * 256 + wid * 32) * DM + 1536 + h * 128;
            attn_unit<128, 128, 0, 2>(lds, q, k, v, o, 8, 0, 8, 0, 0, 0, 0.f, tid, lane);
        }
    }
}

__device__ __forceinline__ void router_phase(const Params& p, LAS unsigned char* lds, int tid, int wid, int lane) {
    const float* hres = p.out; const float* g = p.in[I_NORM_FFN] + DM; const float* wr = p.in[I_ROUTER];
    unsigned* cnt = (unsigned*)(p.ws + WS_CTL) + CW_MOECNT;
    unsigned char* xg = p.ws + WS_XG; int* tokv = (int*)(p.ws + WS_TOK); float* wtv = (float*)(p.ws + WS_WT);
    LAS float* wl = (LAS float*)lds;
    LAS float* sel = (LAS float*)(lds + 65536);
    for (int i = tid; i < DM * NEXP; i += NTHREADS) { const int d = i >> 3, e = i & 7; wl[e * DM + d] = wr[i]; }
    __syncthreads();
    for (int grp = blockIdx.x; grp < NTOK / 32; grp += gridDim.x) {
#pragma unroll 1
        for (int ti = 0; ti < 4; ++ti) {
            const int tl = wid * 4 + ti, token = grp * 32 + tl;
            const f32x4* sp = (const f32x4*)(hres + (size_t)token * DM); f32x4 v[8]; float ss = 0.f;
#pragma unroll
            for (int j = 0; j < 8; ++j) { v[j] = sp[lane + 64 * j]; ss += v[j][0] * v[j][0] + v[j][1] * v[j][1] + v[j][2] * v[j][2] + v[j][3] * v[j][3]; }
            ss = wave_sum(ss); const float rstd = 1.0f / sqrtf(ss * (1.0f / DM) + EPS);
            float lg[8];
#pragma unroll
            for (int e = 0; e < 8; ++e) lg[e] = 0.f;
#pragma unroll
            for (int j = 0; j < 8; ++j) { const f32x4 gv = ((const f32x4*)g)[lane + 64 * j]; const f32x4 hn = v[j] * rstd * gv;
#pragma unroll
                for (int e = 0; e < 8; ++e) { const f32x4 w4 = *(const LAS f32x4*)(wl + e * DM + 4 * (lane + 64 * j)); lg[e] += hn[0] * w4[0] + hn[1] * w4[1] + hn[2] * w4[2] + hn[3] * w4[3]; } }
#pragma unroll
            for (int e = 0; e < 8; ++e) lg[e] = wave_sum(lg[e]);
            int i0 = 0; float v0 = lg[0];
#pragma unroll
            for (int e = 1; e < 8; ++e) if (lg[e] > v0) { v0 = lg[e]; i0 = e; }
            int i1 = -1; float v1 = -3.0e38f;
#pragma unroll
            for (int e = 0; e < 8; ++e) if (e != i0 && lg[e] > v1) { v1 = lg[e]; i1 = e; }
            const float e1 = __expf(v1 - v0), w0 = 1.0f / (1.0f + e1), w1 = e1 * w0;
            if (lane == 0) { sel[tl * 8 + 0] = __int_as_float(i0); sel[tl * 8 + 1] = __int_as_float(i1); sel[tl * 8 + 2] = w0; sel[tl * 8 + 3] = w1; sel[tl * 8 + 4] = rstd; }
        }
        __syncthreads();
        if (tid < NEXP) { int n = 0;
            for (int t = 0; t < 32; ++t) { n += (__float_as_int(sel[t * 8 + 0]) == tid) ? 1 : 0; n += (__float_as_int(sel[t * 8 + 1]) == tid) ? 1 : 0; }
            int base = n ? (int)__hip_atomic_fetch_add(cnt + tid * 64, (unsigned)n, __ATOMIC_RELAXED, __HIP_MEMORY_SCOPE_AGENT) : 0;
            for (int t = 0; t < 32; ++t) { if (__float_as_int(sel[t * 8 + 0]) == tid) sel[t * 8 + 5] = __int_as_float(base++); if (__float_as_int(sel[t * 8 + 1]) == tid) sel[t * 8 + 6] = __int_as_float(base++); } }
        __syncthreads();
#pragma unroll 1
        for (int ti = 0; ti < 4; ++ti) {
            const int tl = wid * 4 + ti, token = grp * 32 + tl;
            const int e0 = __float_as_int(sel[tl * 8 + 0]), e1 = __float_as_int(sel[tl * 8 + 1]); const float w0 = sel[tl * 8 + 2], w1 = sel[tl * 8 + 3], rstd = sel[tl * 8 + 4];
            const int s0 = e0 * ECAP + __float_as_int(sel[tl * 8 + 5]), s1 = e1 * ECAP + __float_as_int(sel[tl * 8 + 6]);
            const f32x4* sp = (const f32x4*)(hres + (size_t)token * DM);
#pragma unroll
            for (int j = 0; j < 8; ++j) { const f32x4 x = sp[lane + 64 * j]; const f32x4 gv = ((const f32x4*)g)[lane + 64 * j];
#if MOE_FP8
                const float rg = rstd * SC_ACT8; const unsigned w = pg8::pack_fp8x4(x[0] * rg * gv[0], x[1] * rg * gv[1], x[2] * rg * gv[2], x[3] * rg * gv[3]);
                *(unsigned*)(xg + (size_t)s0 * DM + 4 * (lane + 64 * j)) = w; *(unsigned*)(xg + (size_t)s1 * DM + 4 * (lane + 64 * j)) = w; }
#else
                u32x2 w; w.x = cvt_pk_bf16(x[0] * rstd * gv[0], x[1] * rstd * gv[1]); w.y = cvt_pk_bf16(x[2] * rstd * gv[2], x[3] * rstd * gv[3]);
                *(u32x2*)(xg + ((size_t)s0 * DM + 4 * (lane + 64 * j)) * 2) = w; *(u32x2*)(xg + ((size_t)s1 * DM + 4 * (lane + 64 * j)) * 2) = w; }
#endif
            if (lane == 0) { tokv[s0] = token; wtv[s0] = w0; tokv[s1] = token; wtv[s1] = w1; int* ts = (int*)(p.ws + WS_TSLOT); ts[token * 2] = s0; ts[token * 2 + 1] = s1; }
        }
        __syncthreads();
    }
}

constexpr int MOE_TAB_OFF = LDS_MISC + 128;
__device__ __forceinline__ void moe_table(LAS unsigned char* lds, const unsigned* cnt, int nN, int tid) {
    LAS int* tab = (LAS int*)(lds + MOE_TAB_OFF);
    __syncthreads();
    if (tid == 0) { int acc = 0; for (int e = 0; e < 8; ++e) { const int n = ((int)cnt[e * 64] + 255) >> 8; tab[e] = n; tab[8 + e] = acc; acc += n * nN; } tab[16] = acc; }
    __syncthreads();
}
struct SchedMoe {
    const char* A; const char* B; size_t a_estride, b_estride, a_tstride, b_tstride; const LAS int* tab; int G, c; int ksplit; size_t kbytes;
    __device__ __forceinline__ bool next(int i, pg8::Unit& u) const {
        const int L0 = i * G + c; if (L0 >= tab[16] * ksplit) return false;
        const int ks = L0 % ksplit, L = L0 / ksplit;
        int e = 0;
#pragma unroll
        for (int k = 1; k < 8; ++k) e = (L >= tab[8 + k]) ? k : e;
        const int ne = tab[e], loc = L - tab[8 + e], pm = loc % ne, pn = loc / ne;
        u.A = A + (size_t)e * a_estride + (size_t)pm * a_tstride + (size_t)ks * kbytes; u.B = B + (size_t)e * b_estride + (size_t)pn * b_tstride + (size_t)ks * kbytes;
        u.orow = e * ECAP + pm * 256; u.ocol = pn; u.x0 = e; u.x1 = pm * 256; u.ks = ks; u.pad_ = 0; return true;
    }
};
struct SchedMerge {
    const char* br; const char* wb; int G, c;
    __device__ __forceinline__ bool next(int i, pg8::Unit& u) const {
        int pm, pn; if (!pg8::static_tile(i >> 2, G, c, NTOK / 256, DM / 256, pm, pn)) return false;
        const int n = i & 3;
        u.A = br + ((size_t)pm * 256 * DM + n * 512) * 2; u.B = wb + ((size_t)n * DM * 512 + (size_t)pn * 256 * 512) * 2; u.orow = pm * 256; u.ocol = pn; u.x0 = n; u.x1 = 0; u.ks = 0; u.pad_ = 0; return true;
    }
};

__device__ __forceinline__ void moe_combine(const Params& p, int wid, int lane) {
    const int* ts = (const int*)(p.ws + WS_TSLOT); const bf16_t* y = (const bf16_t*)(p.ws + WS_Y); float* out = p.out;
    for (int row = blockIdx.x * 8 + wid; row < NTOK; row += gridDim.x * 8) {
        const int s0 = ts[row * 2], s1 = ts[row * 2 + 1];
        f32x4* o = (f32x4*)(out + (size_t)row * DM);
        u32x4 a[MOE_KS][4], b[MOE_KS][4]; f32x4 hv[8];
#pragma unroll
        for (int ks = 0; ks < MOE_KS; ++ks) { const u32x4* y0 = (const u32x4*)(y + ((size_t)ks * NEXP * ECAP + s0) * DM); const u32x4* y1 = (const u32x4*)(y + ((size_t)ks * NEXP * ECAP + s1) * DM);
#pragma unroll
            for (int j = 0; j < 4; ++j) { a[ks][j] = y0[lane + 64 * j]; b[ks][j] = y1[lane + 64 * j]; } }
#pragma unroll
        for (int j = 0; j < 4; ++j) { hv[2 * j] = o[2 * (lane + 64 * j)]; hv[2 * j + 1] = o[2 * (lane + 64 * j) + 1]; }
#pragma unroll
        for (int j = 0; j < 4; ++j) {
            f32x4 r0 = hv[2 * j], r1 = hv[2 * j + 1];
#pragma unroll
            for (int ks = 0; ks < MOE_KS; ++ks) { const u32x4 av = a[ks][j], bv = b[ks][j];
                r0[0] += bflo(av.x) + bflo(bv.x); r0[1] += bfhi(av.x) + bfhi(bv.x); r0[2] += bflo(av.y) + bflo(bv.y); r0[3] += bfhi(av.y) + bfhi(bv.y);
                r1[0] += bflo(av.z) + bflo(bv.z); r1[1] += bfhi(av.z) + bfhi(bv.z); r1[2] += bflo(av.w) + bflo(bv.w); r1[3] += bfhi(av.w) + bfhi(bv.w); }
            o[2 * (lane + 64 * j)] = r0; o[2 * (lane + 64 * j) + 1] = r1; }
    }
}

#ifdef PROBE_NAIVE
#ifndef NAIVE_TOL2
#define NAIVE_TOL2 0.0036f
#endif
__device__ __forceinline__ void nv_rope(float& x2, int lane, int pos) {
    const int i = lane & 31; const float freq = exp2f(-(float)i * (13.287712379549449f / 32.0f)); const float ang = (float)pos * freq;
    const double rev = (double)ang * 0.15915494309189535; const float fr_ = (float)(rev - __builtin_rint(rev));
    const float c = __builtin_amdgcn_cosf(fr_), s = __builtin_amdgcn_sinf(fr_); const float pr = __shfl_xor(x2, 32);
    x2 = lane < 32 ? x2 * c - pr * s : x2 * c + pr * s;
}
__device__ __forceinline__ void naive_check(const Params& p, unsigned* flag, int wid, int lane) {
    const int l = 1;
    const bf16_t* z = (const bf16_t*)(p.ws + WS_Z); const bf16_t* qraw = (const bf16_t*)(p.ws + WS_QRAW); const bf16_t* kvraw = (const bf16_t*)(p.ws + WS_KVRAW);
    const bf16_t* memkv = (const bf16_t*)(p.ws + WS_MEMKV) + (size_t)l * NMEM * 1024; const bf16_t* br = (const bf16_t*)(p.ws + WS_BR);
    const int poslist[16] = {0, 1, 31, 63, 64, 65, 127, 128, 129, 500, 1023, 1024, 1500, 1919, 1984, 2047};
    for (int unit = blockIdx.x * 8 + wid; unit < 64 * 20; unit += gridDim.x * 8) {
        const int smp = unit / 20, hh = unit % 20;
        int pos = 0;
#pragma unroll
        for (int q = 0; q < 16; ++q) pos = ((smp >> 2) == q) ? poslist[q] : pos;
        const int b = smp & 3, t = b * SEQ + pos;
        float o[3] = {0.f, 0.f, 0.f}, m = -3.0e38f, lsum = 0.f; float q[3] = {0.f, 0.f, 0.f};
        float ref[3] = {0.f, 0.f, 0.f}; int nd = 2;
        if (hh < 4) {
            const int h = hh; const float* gq = p.in[I_NA_QN] + l * 128; const float* gk = p.in[I_NA_KN] + l * 128;
            float ss = 0.f; for (int j = 0; j < 2; ++j) { q[j] = bf2f(z[(size_t)t * ZC + Z_NAQ + h * 128 + lane + 64 * j]); ss += q[j] * q[j]; }
            ss = wave_sum(ss); for (int j = 0; j < 2; ++j) q[j] *= (1.0f / sqrtf(ss / 128 + EPS)) * gq[lane + 64 * j];
            const int r = pos >> 6, c = pos & 63; int rs = r - 4; rs = rs < 0 ? 0 : (rs > 24 ? 24 : rs); int cs = c - 8; cs = cs < 0 ? 0 : (cs > 48 ? 48 : cs);
            for (int i = 0; i < 8; ++i) for (int jj = 0; jj < 16; ++jj) { const int n = b * SEQ + (rs + i) * 64 + cs + jj;
                float k[2], ks = 0.f; for (int j = 0; j < 2; ++j) { k[j] = bf2f(z[(size_t)n * ZC + Z_NAK + h * 128 + lane + 64 * j]); ks += k[j] * k[j]; }
                ks = wave_sum(ks); float dot = 0.f; for (int j = 0; j < 2; ++j) dot += q[j] * k[j] * (1.0f / sqrtf(ks / 128 + EPS)) * gk[lane + 64 * j];
                const float s = wave_sum(dot) * 0.08838834764831845f + p.in[I_NA_RPB][(((size_t)l * 4 + h) * 15 + (rs + i - r + 7)) * 31 + (cs + jj - c + 15)];
                const float mn = fmaxf(m, s), al = __expf(m - mn), pe = __expf(s - mn); m = mn; lsum = lsum * al + pe;
                for (int j = 0; j < 2; ++j) o[j] = o[j] * al + pe * bf2f(z[(size_t)n * ZC + Z_NAV + h * 128 + lane + 64 * j]); }
            for (int j = 0; j < 2; ++j) ref[j] = bf2f(br[(size_t)t * DM + 0 + h * 128 + lane + 64 * j]);
        } else if (hh < 8) {
            const int h = hh - 4; nd = 3; const float* gq = p.in[I_MLA_QN] + l * 192; const float* gk = p.in[I_MLA_KN] + l * 192;
            float ss = 0.f; for (int j = 0; j < 3; ++j) { q[j] = bf2f(qraw[(size_t)t * 768 + h * 192 + lane + 64 * j]); ss += q[j] * q[j]; }
            ss = wave_sum(ss); for (int j = 0; j < 3; ++j) q[j] *= (1.0f / sqrtf(ss / 192 + EPS)) * gq[lane + 64 * j];
            nv_rope(q[2], lane, pos);
            for (int kp = 0; kp < SEQ; ++kp) { const int n = b * SEQ + kp;
                float k[3], ks = 0.f; k[0] = bf2f(kvraw[(size_t)n * 1024 + h * 256 + lane]); k[1] = bf2f(kvraw[(size_t)n * 1024 + h * 256 + 64 + lane]); k[2] = bf2f(z[(size_t)n * ZC + Z_KPE + lane]);
                for (int j = 0; j < 3; ++j) ks += k[j] * k[j];
                ks = wave_sum(ks); const float rk = 1.0f / sqrtf(ks / 192 + EPS); for (int j = 0; j < 3; ++j) k[j] *= rk * gk[lane + 64 * j];
                nv_rope(k[2], lane, kp);
                float dot = 0.f; for (int j = 0; j < 3; ++j) dot += q[j] * k[j];
                const float s = wave_sum(dot) * 0.07216878364870322f;
                const float mn = fmaxf(m, s), al = __expf(m - mn), pe = __expf(s - mn); m = mn; lsum = lsum * al + pe;
                for (int j = 0; j < 2; ++j) o[j] = o[j] * al + pe * bf2f(kvraw[(size_t)n * 1024 + h * 256 + 128 + lane + 64 * j]); }
            nd = 2;
            for (int j = 0; j < 2; ++j) ref[j] = bf2f(br[(size_t)t * DM + 512 + h * 128 + lane + 64 * j]);
        } else if (hh < 16) {
            const int hq = hh - 8, kvh = hq >> 2; nd = 1; const float* gq = p.in[I_SWA_QN] + l * 64; const float* gk = p.in[I_SWA_KN] + l * 64;
            q[0] = bf2f(z[(size_t)t * ZC + Z_SWQ + hq * 64 + lane]); float ss = wave_sum(q[0] * q[0]); q[0] *= (1.0f / sqrtf(ss / 64 + EPS)) * gq[lane]; nv_rope(q[0], lane, pos);
            for (int kp = pos - 128; kp <= pos + 128; ++kp) { if (kp < 0 || kp >= SEQ) continue; const int n = b * SEQ + kp;
                float k = bf2f(z[(size_t)n * ZC + Z_SWK + kvh * 64 + lane]); const float ks = wave_sum(k * k); k *= (1.0f / sqrtf(ks / 64 + EPS)) * gk[lane]; nv_rope(k, lane, kp);
                const float s = wave_sum(q[0] * k) * 0.125f;
                const float mn = fmaxf(m, s), al = __expf(m - mn), pe = __expf(s - mn); m = mn; lsum = lsum * al + pe;
                o[0] = o[0] * al + pe * bf2f(z[(size_t)n * ZC + Z_SWV + kvh * 64 + lane]); }
            { const float s = p.in[I_SWA_SINK][l * 8 + hq]; const float mn = fmaxf(m, s), al = __expf(m - mn), pe = __expf(s - mn); m = mn; lsum = lsum * al + pe; o[0] *= al; }
            ref[0] = bf2f(br[(size_t)t * DM + 1024 + hq * 64 + lane]);
        } else {
            const int h = hh - 16; const float* gq = p.in[I_MEM_QN] + l * 128; const float* gk = p.in[I_MEM_KN] + l * 128;
            float ss = 0.f; for (int j = 0; j < 2; ++j) { q[j] = bf2f(z[(size_t)t * ZC + Z_MEQ + h * 128 + lane + 64 * j]); ss += q[j] * q[j]; }
            ss = wave_sum(ss); for (int j = 0; j < 2; ++j) q[j] *= (1.0f / sqrtf(ss / 128 + EPS)) * gq[lane + 64 * j];
            for (int mm = 0; mm < MEML; ++mm) { const size_t n = (size_t)(b * MEML + mm) * 1024;
                float k[2], ks = 0.f; for (int j = 0; j < 2; ++j) { k[j] = bf2f(memkv[n + h * 128 + lane + 64 * j]); ks += k[j] * k[j]; }
                ks = wave_sum(ks); float dot = 0.f; for (int j = 0; j < 2; ++j) dot += q[j] * k[j] * (1.0f / sqrtf(ks / 128 + EPS)) * gk[lane + 64 * j];
                const float s = wave_sum(dot) * 0.08838834764831845f;
                const float mn = fmaxf(m, s), al = __expf(m - mn), pe = __expf(s - mn); m = mn; lsum = lsum * al + pe;
                for (int j = 0; j < 2; ++j) o[j] = o[j] * al + pe * bf2f(memkv[n + 512 + h * 128 + lane + 64 * j]); }
            for (int j = 0; j < 2; ++j) ref[j] = bf2f(br[(size_t)t * DM + 1536 + h * 128 + lane + 64 * j]);
        }
        float e2 = 0.f, n2 = 0.f;
        for (int j = 0; j < 3; ++j) if (j < nd) { const float a = o[j] / lsum; e2 += (a - ref[j]) * (a - ref[j]); n2 += a * a; }
        e2 = wave_sum(e2); n2 = wave_sum(n2);
        if (!(e2 <= NAIVE_TOL2 * n2 + 1e-12f) && lane == 0) atomicOr(flag, 1u << (hh < 4 ? 1 : hh < 8 ? 2 : hh < 16 ? 3 : 4));
    }
}
#endif
constexpr int NPHASE = 23;
constexpr int LDS_PARAMS = LDS_MISC + 256;
template <class T> __device__ __forceinline__ T* uni(T* q) { const unsigned long long v = (unsigned long long)q; const unsigned lo = __builtin_amdgcn_readfirstlane((unsigned)v), hi = __builtin_amdgcn_readfirstlane((unsigned)(v >> 32)); return (T*)(__attribute__((address_space(1))) T*)(((unsigned long long)hi << 32) | lo); }
__device__ __forceinline__ Params load_params(LAS unsigned char* lds) {
    unsigned poff = LDS_PARAMS; asm volatile("" : "+v"(poff)); poff = __builtin_amdgcn_readfirstlane(poff);
    const LAS Params* P = (const LAS Params*)(lds + poff); Params p;
#pragma unroll
    for (int i = 0; i < 30; ++i) p.in[i] = uni(P->in[i]);
    p.out = uni(P->out); p.ws = uni(P->ws); p.ph_lo = __builtin_amdgcn_readfirstlane(P->ph_lo); p.ph_hi = __builtin_amdgcn_readfirstlane(P->ph_hi); return p;
}
#define PH_HEAD int tid = threadIdx.x; asm volatile("" : "+v"(tid)); const Params p = load_params(lds); const int lane = tid & 63, wid = __builtin_amdgcn_readfirstlane(tid >> 6); const int G = p.ph_lo, cblk = p.ph_hi;     \
    unsigned char* ws = p.ws; unsigned* ctl = (unsigned*)(ws + WS_CTL); unsigned char* lw = ws + WS_LW + (size_t)l * LW_BYTES; bf16_t* U = (bf16_t*)(ws + WS_U); (void)lane; (void)wid; (void)G; (void)cblk; (void)ctl; (void)lw; (void)U
#define PHASE_FN static __device__ __forceinline__ void

PHASE_FN ph_prologue(LAS unsigned char* lds, int l) { PH_HEAD; p0_prologue(p, lds, tid, wid, lane); }
PHASE_FN ph_ingate(LAS unsigned char* lds, int l) { PH_HEAD;
#if INGATE_FP8
    pg8::SchedGrid S{(const char*)(ws + WS_U8), (const char*)(lw + LW_IN), DM / 2, DM / 2, NTOK / 256, 12288 / 256, G, cblk};
    pg8::EpiInGate E{(bf16_t*)(ws + WS_Z), (bf16_t*)(ws + WS_GATES), p.in[I_B_GATE] + (size_t)l * 8192, 1.0f / (SC_ACT8 * SC_W8)};
    pg8::gemm_phase<pg8::EpiInGate, pg8::SchedGrid, true>(lds, DM / 2, DM / 2, DM / 2, S, E, tid);
#else
    pg8::SchedGrid S{(const char*)U, (const char*)(lw + LW_IN), DM, DM, NTOK / 256, 12288 / 256, G, cblk};
    pg8::EpiInGate E{(bf16_t*)(ws + WS_Z), (bf16_t*)(ws + WS_GATES), p.in[I_B_GATE] + (size_t)l * 8192, 1.0f};
    pg8::gemm_phase(lds, DM, DM, DM, S, E, tid);
#endif
}
PHASE_FN ph_inproj(LAS unsigned char* lds, int l) { PH_HEAD;
    const bool sh = l >= 2; l &= 1; lw = ws + WS_LW + (size_t)l * LW_BYTES;
    pg8::SchedGrid S{(const char*)U, (const char*)(lw + LW_IN), DM, DM, NTOK / 256, ZC / 256, G, cblk};
    pg8::EpiBf16 E{(bf16_t*)(ws + (sh ? WS_ACT : WS_Z)), ZC};
    pg8::gemm_phase(lds, DM, DM, DM, S, E, tid); }
PHASE_FN ph_gates(LAS unsigned char* lds, int l) { PH_HEAD;
#if GATES_FP8
    pg8::SchedGrid S{(const char*)(ws + WS_U8), (const char*)(lw + LW_GATE8), DM / 2, DM / 2, NTOK / 256, 8192 / 256, G, cblk};
    pg8::EpiGates E{(bf16_t*)(ws + WS_GATES), p.in[I_B_GATE] + (size_t)l * 8192, 1.0f / (SC_ACT8 * SC_W8)};
    pg8::gemm_phase<pg8::EpiGates, pg8::SchedGrid, true>(lds, DM / 2, DM / 2, DM / 2, S, E, tid);
#else
    pg8::SchedGrid S{(const char*)U, (const char*)(lw + LW_GATE8), DM, DM, NTOK / 256, 8192 / 256, G, cblk};
    pg8::EpiGates E{(bf16_t*)(ws + WS_GATES), p.in[I_B_GATE] + (size_t)l * 8192, 1.0f};
    pg8::gemm_phase<pg8::EpiGates, pg8::SchedGrid, false>(lds, DM, DM, DM, S, E, tid);
#endif
}
PHASE_FN ph_prep1(LAS unsigned char* lds, int l) { PH_HEAD; prep1(p, l, lds, tid, wid, lane); }
PHASE_FN ph_mlaup_q(LAS unsigned char* lds, int l) { PH_HEAD;
    pg8::SchedGrid S{(const char*)(ws + WS_CQN), (const char*)(lw + LW_UQ), 768, 768, NTOK / 256, 3, G, cblk};
    pg8::EpiBf16 E{(bf16_t*)(ws + WS_QRAW), 768}; pg8::gemm_phase(lds, 768, 768, 768, S, E, tid); }
PHASE_FN ph_mlaup_kv(LAS unsigned char* lds, int l) { PH_HEAD;
    pg8::SchedGrid S{(const char*)(ws + WS_CKVN), (const char*)(lw + LW_UKV), 256, 256, NTOK / 256, 4, G, (cblk + G - 96 % G) % G};
    pg8::EpiBf16 E{(bf16_t*)(ws + WS_KVRAW), 1024}; pg8::gemm_phase(lds, 256, 256, 256, S, E, tid); }
PHASE_FN ph_memkv(LAS unsigned char* lds, int l) { PH_HEAD;
    pg8::SchedGrid S{(const char*)(ws + WS_MEMN + (size_t)l * NMEM * DM * 2), (const char*)(lw + LW_MEMKV), DM, DM, NMEM / 256, 4, G, (cblk + G - (224 + 16 * l) % G) % G};
    pg8::EpiBf16 E{(bf16_t*)(ws + WS_MEMKV) + (size_t)l * NMEM * 1024, 1024}; pg8::gemm_phase(lds, DM, DM, DM, S, E, tid); }
PHASE_FN ph_prep2(LAS unsigned char* lds, int l) { PH_HEAD; prep2(p, l, lds, tid, wid, lane); }
PHASE_FN ph_attn(LAS unsigned char* lds, int l) { PH_HEAD; attn_phase(p, l, lds, tid, wid, lane, G, cblk); }
PHASE_FN ph_merge(LAS unsigned char* lds, int l) { PH_HEAD;
    SchedMerge S{(const char*)(ws + WS_BR), (const char*)(lw + LW_BR), G, cblk};
    pg8::EpiMerge E{(const bf16_t*)(ws + WS_GATES), (bf16_t*)(ws + WS_MERGED)};
#ifndef MERGE_ALIGN
#define MERGE_ALIGN false
#endif
    pg8::gemm_phase<pg8::EpiMerge, SchedMerge, false, MERGE_ALIGN>(lds, DM, 512, 512, S, E, tid); }
PHASE_FN ph_wo(LAS unsigned char* lds, int l) { PH_HEAD;
    pg8::SchedGrid S{(const char*)(ws + WS_MERGED), (const char*)(lw + LW_O), DM, DM, NTOK / 256, DM / 256, G, cblk};
    pg8::EpiResF32 E{l == 0 ? p.in[I_X] : (const float*)p.out, p.out, 1.0f};
    pg8::gemm_phase(lds, DM, DM, DM, S, E, tid); }
PHASE_FN ph_norm(LAS unsigned char* lds, int l) { PH_HEAD;
    norm_rows(p.out, l == 0 ? p.in[I_NORM_FFN] : p.in[I_NORM_MIX] + DM, U, l == 0 ? nullptr : ws + WS_U8, NTOK, wid, lane); }
PHASE_FN ph_ffnup(LAS unsigned char* lds, int l) { PH_HEAD;
    pg8::SchedGrid S{(const char*)U, (const char*)(ws + WS_FFNUP), DM, DM, NTOK / 256, 2 * DFF / 256, G, cblk};
    pg8::EpiSwiGLU E{(bf16_t*)(ws + WS_ACT), DFF};
    pg8::gemm_phase(lds, DM, DM, DM, S, E, tid); }
PHASE_FN ph_ffndown(LAS unsigned char* lds, int l) { PH_HEAD;
    pg8::SchedGrid S{(const char*)(ws + WS_ACT), (const char*)(ws + WS_FFNDN), DFF, DFF, NTOK / 256, DM / 256, G, cblk};
    pg8::EpiResF32 E{(const float*)p.out, p.out, 1.0f};
    pg8::gemm_phase(lds, DFF, DFF, DFF, S, E, tid); }
PHASE_FN ph_router(LAS unsigned char* lds, int l) { PH_HEAD; router_phase(p, lds, tid, wid, lane); }
PHASE_FN ph_moeup(LAS unsigned char* lds, int l) { PH_HEAD;
    moe_table(lds, ctl + CW_MOECNT, 2 * DFFE / 256, tid);
    const SchedMoe S{(const char*)(ws + WS_XG), (const char*)(ws + WS_MOEUP), (size_t)ECAP * DM * MOE_ES, (size_t)2 * DFFE * DM * MOE_ES, (size_t)256 * DM * MOE_ES, (size_t)256 * DM * MOE_ES, (const LAS int*)(lds + MOE_TAB_OFF), G, cblk, 1, 0};
#if MOE_FP8
    pg8::EpiSwiGLU8 E{ws + WS_ACTM, DFFE, 1.0f / (SC_ACT8 * SC_W8), SC_H8};
    pg8::gemm_phase<pg8::EpiSwiGLU8, SchedMoe, true>(lds, DM / 2, DM / 2, DM / 2, S, E, tid);
#else
    pg8::EpiSwiGLU E{(bf16_t*)(ws + WS_ACTM), DFFE};
    pg8::gemm_phase(lds, DM, DM, DM, S, E, tid);
#endif
}
#ifndef MOE_KSPLIT
#define MOE_KSPLIT MOE_KS
#endif
PHASE_FN ph_moedown(LAS unsigned char* lds, int l) { PH_HEAD;
    moe_table(lds, ctl + CW_MOECNT, DM / 256, tid);
    const SchedMoe S{(const char*)(ws + WS_ACTM), (const char*)(ws + WS_MOEDN), (size_t)ECAP * DFFE * MOE_ES, (size_t)DM * DFFE * MOE_ES, (size_t)256 * DFFE * MOE_ES, (size_t)256 * DFFE * MOE_ES, (const LAS int*)(lds + MOE_TAB_OFF), G, cblk, MOE_KSPLIT, (size_t)DFFE * MOE_ES / MOE_KSPLIT};
#if MOE_FP8
    pg8::EpiMoeDownY E{(bf16_t*)(ws + WS_Y), (const float*)(ws + WS_WT), ctl + CW_MOECNT, 1.0f / (SC_H8 * SC_W8)};
    pg8::gemm_phase<pg8::EpiMoeDownY, SchedMoe, true>(lds, DFFE / 2, DFFE / 2, DFFE / 2 / MOE_KSPLIT, S, E, tid);
#else
    pg8::EpiMoeDown E{p.out, (const int*)(ws + WS_TOK), (const float*)(ws + WS_WT), ctl + CW_MOECNT, 1.0f};
    pg8::gemm_phase(lds, DFFE, DFFE, DFFE / MOE_KSPLIT, S, E, tid);
#endif
}


#ifndef PROBE_CHK
#define PROBE_CHK 0
#endif
constexpr int CW_CHKFLAG = 4096 + 2048;
PHASE_FN ph_compare(LAS unsigned char* lds, int l, size_t offa, size_t offb, size_t nbytes) { PH_HEAD;
    const u32x4* a = (const u32x4*)(ws + offa); const u32x4* b = (const u32x4*)(ws + offb); unsigned bad = 0;
    for (size_t i = (size_t)cblk * NTHREADS + tid; i < nbytes / 16; i += (size_t)G * NTHREADS) { const u32x4 x = a[i], y = b[i]; bad |= (x.x ^ y.x) | (x.y ^ y.y) | (x.z ^ y.z) | (x.w ^ y.w); }
    if (bad) atomicOr(ctl + CW_CHKFLAG, 1u); }
#ifdef PROBE_NAIVE
PHASE_FN ph_naive(LAS unsigned char* lds, int l) { PH_HEAD; naive_check(p, ctl + CW_CHKFLAG, wid, lane); }
#endif
PHASE_FN ph_poison(LAS unsigned char* lds, int l) { PH_HEAD;
    if (__hip_atomic_load(ctl + CW_CHKFLAG, __ATOMIC_RELAXED, __HIP_MEMORY_SCOPE_AGENT) != 0u && tid == 0) p.out[cblk] = __builtin_nanf(""); }
PHASE_FN ph_combine(LAS unsigned char* lds, int l) { PH_HEAD; moe_combine(p, wid, lane); }
__global__ void __launch_bounds__(NTHREADS, 2) mk_fwd(Params pk) {
    extern __shared__ __attribute__((aligned(16))) unsigned char lds_raw[];
    LAS unsigned char* lds = (LAS unsigned char*)lds_raw;
    const int tid = threadIdx.x;
    if (tid < 64) ((LAS unsigned*)(lds + LDS_MISC))[tid] = 0u;
    if (tid == 64) { LAS Params* P = (LAS Params*)(lds + LDS_PARAMS);
#pragma unroll
        for (int i = 0; i < 30; ++i) P->in[i] = pk.in[i];
        P->out = pk.out; P->ws = pk.ws; P->ph_lo = (int)gridDim.x; P->ph_hi = (int)blockIdx.x; }
    __syncthreads();
    unsigned* ctl = (unsigned*)(pk.ws + WS_CTL);
#if !MK_MULTI
    (void)xcd_barrier_post(ctl + CW_BAR, (volatile LAS unsigned*)(lds + LDS_MISC));
#endif
#ifdef ONLY_FN
    ONLY_FN(lds, pk.ph_lo); return;
#endif
    const int lo = pk.ph_lo, hi = pk.ph_hi;
#define IN(k) (lo <= (k) && (k) < hi)
#if MK_MULTI
#define SEAM(k) do { } while (0)
#else
#ifndef PROBE_BAR
#define PROBE_BAR 0
#endif
#define SEAM(k) do { for (int rep_ = 0; rep_ < 1 + PROBE_BAR; ++rep_) if (IN((k) + 1)) { const Params q_ = load_params(lds); XcdBarrier b2_; b2_.bar = (unsigned*)(q_.ws + WS_CTL) + CW_BAR; b2_.x = xb_xcc_id(); b2_.st = (volatile LAS unsigned*)(lds + LDS_MISC); xcd_barrier(b2_); } } while (0)
#endif
#ifndef PROBE_P0
#define PROBE_P0 0
#endif
#ifndef PROBE_DUP
#define PROBE_DUP 0
#endif
#define DUP(bit) ((PROBE_DUP >> (bit)) & 1)
#ifndef PROBE_ATTN
#define PROBE_ATTN 0
#endif
#ifndef PROBE_THIN
#define PROBE_THIN 0
#endif
    if (IN(0)) { ph_prologue(lds, 0); if (PROBE_P0) { __syncthreads(); ph_prologue(lds, 0); } SEAM(0); }
#pragma unroll 1
    for (int l = 0; l < DEPTH; ++l) {
        const int pb = 1 + 11 * l;
#ifndef SPLIT_INGATE
#define SPLIT_INGATE 0
#endif
        if (IN(pb + 0)) { if (SPLIT_INGATE == 1) { ph_inproj(lds, l); __syncthreads(); ph_gates(lds, l); } else if (SPLIT_INGATE == 2) { ph_ingate(lds, l); SEAM(pb + 0); ph_inproj(lds, l); } else if (SPLIT_INGATE == 3) { ph_ingate(lds, l); SEAM(pb + 0); ph_gates(lds, l); } else { ph_ingate(lds, l); if (DUP(0)) ph_ingate(lds, l); } if (PROBE_CHK == 2) ph_inproj(lds, l + 2); SEAM(pb + 0);
            if (PROBE_CHK == 2) { ph_compare(lds, l, WS_Z, WS_ACT, (size_t)NTOK * ZC * 2); SEAM(pb + 0); } }
        if (IN(pb + 1)) { ph_prep1(lds, l); if (PROBE_THIN) { __syncthreads(); ph_prep1(lds, l); } SEAM(pb + 1); }
        if (IN(pb + 2)) { for (int rep = 0; rep < 1 + DUP(1); ++rep) { ph_mlaup_q(lds, l); ph_mlaup_kv(lds, l); if (l == 0) { ph_memkv(lds, 0); ph_memkv(lds, 1); } } SEAM(pb + 2); }
        if (IN(pb + 3)) { ph_prep2(lds, l); if (PROBE_THIN) { __syncthreads(); ph_prep2(lds, l); } SEAM(pb + 3); }
        if (IN(pb + 4)) { ph_attn(lds, l); if (PROBE_ATTN || PROBE_CHK == 1) { __syncthreads(); ph_attn(lds, l + 2 + 4 * (PROBE_ATTN > 1 ? PROBE_ATTN - 1 : 0)); } SEAM(pb + 4);
            if (PROBE_CHK == 1) { ph_compare(lds, l, WS_BR, WS_ACT, (size_t)NTOK * DM * 2); SEAM(pb + 4); } }
        if (IN(pb + 5)) { ph_merge(lds, l); if (DUP(2)) ph_merge(lds, l); SEAM(pb + 5); }
        if (IN(pb + 6)) { ph_wo(lds, l); if (DUP(3) && l == 0) ph_wo(lds, l); SEAM(pb + 6); }
        if (l == 0) {
            if (IN(pb + 7)) { ph_norm(lds, 0); if (PROBE_THIN) { __syncthreads(); ph_norm(lds, 0); } SEAM(pb + 7); }
            if (IN(pb + 8)) { ph_ffnup(lds, 0); if (DUP(4)) ph_ffnup(lds, 0); SEAM(pb + 8); }
            if (IN(pb + 9)) { ph_ffndown(lds, 0); SEAM(pb + 9); }
            if (IN(pb + 10)) { ph_norm(lds, 1); if (PROBE_THIN) { __syncthreads(); ph_norm(lds, 1); } SEAM(pb + 10); }
        } else {
            if (IN(pb + 7)) { ph_router(lds, 1); SEAM(pb + 7); }
            if (IN(pb + 8)) { ph_moeup(lds, 1); if (DUP(5)) ph_moeup(lds, 1); SEAM(pb + 8); }
            if (IN(pb + 9)) { ph_moedown(lds, 1); if (DUP(6)) ph_moedown(lds, 1); SEAM(pb + 8); ph_combine(lds, 1);
#ifdef PROBE_NAIVE
                ph_naive(lds, 1); SEAM(pb + 8); ph_poison(lds, 1);
#endif
                if (PROBE_CHK) { SEAM(pb + 8); ph_poison(lds, 1); } }
        }
    }
#undef IN
#undef SEAM
}

extern "C" void kernel_launch(void* const* d_in, const int* in_sizes, int n_in, void* d_out, int out_size, void* d_ws, size_t ws_size, hipStream_t stream) {
    static int grid = 0;
    if (grid == 0) {
        if (n_in != 30 || out_size != NTOK * DM || ws_size < WS_END) { fprintf(stderr, "kernel_launch: unexpected problem (n_in %d, out %d, ws %zu < %zu)\n", n_in, out_size, ws_size, (size_t)WS_END); grid = -1; return; }
        int dev = 0, cus = 0, per_cu = 0;
        if (hipGetDevice(&dev) != hipSuccess || hipDeviceGetAttribute(&cus, hipDeviceAttributeMultiprocessorCount, dev) != hipSuccess) { grid = -1; return; }
        if (hipFuncSetAttribute((const void*)mk_fwd, hipFuncAttributeMaxDynamicSharedMemorySize, LDS_BYTES) != hipSuccess) { fprintf(stderr, "kernel_launch: hipFuncSetAttribute failed\n"); grid = -1; return; }
        if (hipOccupancyMaxActiveBlocksPerMultiprocessor(&per_cu, (const void*)mk_fwd, NTHREADS, LDS_BYTES) != hipSuccess || per_cu < 1) fprintf(stderr, "kernel_launch: occupancy query reports %d\n", per_cu);
        (void)hipGetLastError();
        grid = cus;
    }
    if (grid < 0) return;
    if (hipMemsetAsync((char*)d_ws + WS_CTL, 0, CTL_BYTES, stream) != hipSuccess) return;
    Params a{};
    for (int i = 0; i < 30; ++i) a.in[i] = (const float*)d_in[i];
    a.out = (float*)d_out; a.ws = (unsigned char*)d_ws;
#if MK_MULTI
    for (int ph = 0; ph < NPHASE - 1; ++ph) { a.ph_lo = ph; a.ph_hi = ph + 1; hipLaunchKernelGGL(mk_fwd, dim3(grid), dim3(NTHREADS), LDS_BYTES, stream, a); }
#else
    a.ph_lo = 0; a.ph_hi = NPHASE;
    hipLaunchKernelGGL(mk_fwd, dim3(grid), dim3(NTHREADS), LDS_BYTES, stream, a);
#endif
    const hipError_t le = hipPeekAtLastError();
    if (le != hipSuccess) fprintf(stderr, "kernel_launch: launch failed: %s\n", hipGetErrorName(le));
}
```

```cpp
#include <hip/hip_runtime.h>
#include <cstdio>
#include <cstdint>

#define LAS __attribute__((address_space(3)))
typedef unsigned short bf16_t;
typedef short bf16x8 __attribute__((ext_vector_type(8)));
typedef float f32x4 __attribute__((ext_vector_type(4)));
typedef float f32x2 __attribute__((ext_vector_type(2)));
typedef unsigned u32x4 __attribute__((ext_vector_type(4)));
typedef unsigned u32x2 __attribute__((ext_vector_type(2)));

#ifndef MK_MULTI
#define MK_MULTI 0
#endif

constexpr int DM = 2048, NBATCH = 4, SEQ = 2048, NTOK = NBATCH * SEQ, MEML = 256, NMEM = NBATCH * MEML, DEPTH = 2;
constexpr int ZC = 4096;
constexpr int INC = 3904;
constexpr int Z_NAQ = 0, Z_NAK = 512, Z_NAV = 1024, Z_CQ = 1536, Z_CKV = 2304, Z_KPE = 2560, Z_SWQ = 2624, Z_SWK = 3136, Z_SWV = 3264, Z_MEQ = 3392;
constexpr int DFF = 5632, NEXP = 8, DFFE = 7168, ECAP = 8192;
constexpr float LOG2E = 1.4426950408889634f;
constexpr float EPS = 1e-6f;
constexpr int NTHREADS = 512;
constexpr float SC_ACT8 = 16.0f, SC_W8 = 64.0f, SC_H8 = 8.0f;

constexpr size_t al256(size_t x) { return (x + 255) & ~(size_t)255; }
constexpr size_t WS_CTL = 0, CTL_BYTES = 65536;
constexpr size_t WS_ROPE = WS_CTL + CTL_BYTES;
constexpr size_t WS_LW = WS_ROPE + (size_t)SEQ * 32 * 8;
constexpr size_t LW_IN = 0;
constexpr size_t LW_GATE8 = LW_IN + (size_t)4096 * 2048 * 2;
#ifndef INGATE_FP8
#define INGATE_FP8 1
#endif
#define GATES_FP8 0
#ifndef MOE_FP8
#define MOE_FP8 1
#endif
constexpr size_t MOE_ES = MOE_FP8 ? 1 : 2;
constexpr size_t LW_UQ = LW_GATE8 + (size_t)8192 * 2048 * 2;
constexpr size_t LW_UKV = LW_UQ + (size_t)768 * 768 * 2;
constexpr size_t LW_MEMKV = LW_UKV + (size_t)1024 * 256 * 2;
constexpr size_t LW_BR = LW_MEMKV + (size_t)1024 * 2048 * 2;
constexpr size_t LW_O = LW_BR + (size_t)4 * 2048 * 512 * 2;
constexpr size_t LW_BYTES = LW_O + (size_t)2048 * 2048 * 2;
constexpr size_t WS_FFNUP = WS_LW + 2 * LW_BYTES;
constexpr size_t WS_FFNDN = WS_FFNUP + (size_t)2 * DFF * 2048 * 2;
constexpr size_t WS_MOEUP = WS_FFNDN + (size_t)2048 * DFF * 2;
constexpr size_t WS_MOEDN = WS_MOEUP + (size_t)NEXP * 2 * DFFE * 2048 * MOE_ES;
constexpr size_t WS_U = WS_MOEDN + (size_t)NEXP * 2048 * DFFE * MOE_ES;
constexpr size_t WS_U8 = WS_U + (size_t)NTOK * DM * 2;
constexpr size_t WS_MEMN = WS_U8 + (size_t)NTOK * DM;
constexpr size_t WS_Z = WS_MEMN + (size_t)2 * NMEM * DM * 2;
constexpr size_t WS_GATES = WS_Z + (size_t)NTOK * ZC * 2;
constexpr size_t WS_NAQ = WS_GATES + (size_t)NTOK * 8192 * 2;
constexpr size_t WS_NAK = WS_NAQ + (size_t)NTOK * 512 * 2;
constexpr size_t WS_NAVT = WS_NAK + (size_t)NTOK * 512 * 2;
constexpr size_t WS_CQN = WS_NAVT + (size_t)NTOK * 512 * 2;
constexpr size_t WS_CKVN = WS_CQN + (size_t)NTOK * 768 * 2;
constexpr size_t WS_SWQ = WS_CKVN + (size_t)NTOK * 256 * 2;
constexpr size_t WS_SWK = WS_SWQ + (size_t)NTOK * 512 * 2;
constexpr size_t WS_SWVT = WS_SWK + (size_t)NTOK * 128 * 2;
constexpr size_t WS_MEQ = WS_SWVT + (size_t)NTOK * 128 * 2;
constexpr size_t WS_QRAW = WS_MEQ + (size_t)NTOK * 512 * 2;
constexpr size_t WS_KVRAW = WS_QRAW + (size_t)NTOK * 768 * 2;
constexpr size_t WS_MEMKV = WS_KVRAW + (size_t)NTOK * 1024 * 2;
constexpr size_t WS_MLQ = WS_MEMKV + (size_t)2 * NMEM * 1024 * 2;
constexpr size_t WS_MLK = WS_MLQ + (size_t)NTOK * 768 * 2;
constexpr size_t WS_MLVT = WS_MLK + (size_t)NTOK * 768 * 2;
constexpr size_t WS_MEK = WS_MLVT + (size_t)NTOK * 512 * 2;
constexpr size_t WS_MEVT = WS_MEK + (size_t)NMEM * 512 * 2;
constexpr size_t WS_BR = WS_MEVT + (size_t)NMEM * 512 * 2;
constexpr size_t WS_MERGED = WS_BR + (size_t)NTOK * DM * 2;
constexpr size_t WS_ACT = WS_MERGED + (size_t)NTOK * DM * 2;
constexpr size_t WS_XG = WS_ACT + (size_t)NTOK * DFF * 2;
constexpr size_t WS_TOK = WS_XG + (size_t)NEXP * ECAP * DM * MOE_ES;
constexpr size_t WS_WT = WS_TOK + (size_t)NEXP * ECAP * 4;
constexpr size_t WS_ACTM = WS_WT + (size_t)NEXP * ECAP * 4;
constexpr size_t WS_Y = WS_ACTM + (size_t)NEXP * ECAP * DFFE * MOE_ES;
constexpr int MOE_KS = 2;
constexpr size_t WS_TSLOT = WS_Y + (size_t)MOE_KS * NEXP * ECAP * DM * 2;
constexpr size_t WS_END = WS_TSLOT + (size_t)NTOK * 2 * 4;

constexpr int CW_BAR = 0;
constexpr int CW_MOECNT = 4096;
constexpr int CW_ATTQ = 4096 + 1024;

constexpr int LDS_BYTES = 147456;
constexpr int LDS_MISC = 147456 - 1024;
namespace pg8 {
constexpr int BM = 256, BK = 64, HALF = 128, HTB = HALF * BK * 2, STAGE_BYTES = 8 * HTB, NXCD = 8, WGM = 8;
__host__ __device__ __forceinline__ int lds_byte(int r, int c) { const int st = (r >> 4) * 2 + (c >> 5), rr = r & 15, cc = c & 31, ob = rr * 64 + cc * 2; return st * 1024 + (ob ^ (((ob >> 9) & 1) << 5)); }
__host__ __device__ __forceinline__ void stage_rc(int b, int& R, int& C) { const int st = b / 1024, sb = b % 1024, swz = sb ^ (((sb >> 9) & 1) << 5); R = (st >> 1) * 16 + swz / 64; C = (st & 1) * 32 + (swz % 64) / 2; }
__host__ __device__ __forceinline__ int perm32(int rho) { const int n = rho >> 4, i = rho & 15; return 8 * (i >> 2) + 4 * n + (i & 3); }

struct Unit { const char* A; const char* B; int orow, ocol, x0, x1, ks, pad_; };

__device__ __forceinline__ bool static_tile(int i, int G, int c, int nM, int nN, int& pm, int& pn) {
    const int nwg = nM * nN; const long L = (long)i * G + c; if (L >= nwg) return false;
    int wgid = (int)L; { const int q = nwg / NXCD, r = nwg % NXCD, xcd = wgid % NXCD, off = wgid / NXCD; wgid = (xcd < r ? xcd * (q + 1) : r * (q + 1) + (xcd - r) * q) + off; }
    const int nig = WGM * nN, gid = wgid / nig, fm = gid * WGM, gsz = (nM - fm) < WGM ? (nM - fm) : WGM;
    pm = fm + ((wgid % nig) % gsz); pn = (wgid % nig) / gsz; return true;
}
struct SchedGrid {
    const char* A; const char* B; int lda, ldb, nM, nN, G, c;
    __device__ __forceinline__ bool next(int i, Unit& u) const {
        int pm, pn; if (!static_tile(i, G, c, nM, nN, pm, pn)) return false;
        u.A = A + (size_t)pm * 256 * lda * 2; u.B = B + (size_t)pn * 256 * ldb * 2; u.orow = pm * 256; u.ocol = pn; u.x0 = 0; u.x1 = 0; u.ks = 0; u.pad_ = 0; return true;
    }
};

__device__ __forceinline__ unsigned cvt_pk_bf16(float lo, float hi) { unsigned r; asm volatile("v_cvt_pk_bf16_f32 %0, %1, %2" : "=v"(r) : "v"(lo), "v"(hi)); return r; }
__device__ __forceinline__ float sigmoidf_(float x) { return __builtin_amdgcn_rcpf(1.0f + __builtin_amdgcn_exp2f(-x * LOG2E)); }
__device__ __forceinline__ void sigmoid2(float& x, float& y) {
    const float cx = fminf(fmaxf(x, -40.f), 40.f), cy = fminf(fmaxf(y, -40.f), 40.f);
    const float a = 1.0f + __builtin_amdgcn_exp2f(-cx * LOG2E), b = 1.0f + __builtin_amdgcn_exp2f(-cy * LOG2E), r = __builtin_amdgcn_rcpf(a * b);
    x = b * r; y = a * r; }

typedef f32x4 Acc[2][2][4][2];

typedef int i32x8 __attribute__((ext_vector_type(8)));
typedef int i32x4 __attribute__((ext_vector_type(4)));
template <class Epi, class Sched, bool FP8 = false, bool ALIGN_EPI = true>
__device__ __forceinline__ void gemm_phase(LAS unsigned char* lds, const int lda, const int ldb, const int K, const Sched S, Epi& E, const int tid) {
    const int wid = __builtin_amdgcn_readfirstlane(tid >> 6), lane = tid & 63, wr = wid >> 2, wc = wid & 3, fr = lane & 15, fq = lane >> 4;
    const int nt = K / BK;
    unsigned voffA[2], voffB[2];
#pragma unroll
    for (int i = 0; i < 2; ++i) { int R, C; stage_rc(tid * 16 + i * 8192, R, C); const int Rb = Epi::PERM ? ((R & ~31) + perm32(R & 31)) : R;
        voffA[i] = (unsigned)(R * lda + C) * 2u; voffB[i] = (unsigned)(Rb * ldb + C) * 2u; }
    const size_t kstep = (size_t)(BK * 2);
    const size_t hstepA = (size_t)HALF * lda * 2, hstepB = (size_t)HALF * ldb * 2;
    const unsigned ldsw = (unsigned)wid * 1024u;
    const int aoff = lds_byte(wr * 64 + fr, fq * 8), boff = lds_byte(wc * 32 + fr, fq * 8);
#define PG8_SA(b, h) (((b) * 2 + (h)) * HTB)
#define PG8_SB(b, h) ((4 + (b) * 2 + (h)) * HTB)
#define PG8_STAGE(bufoff, gbase, voff) do { _Pragma("unroll") for (int _i = 0; _i < 2; ++_i) \
        __builtin_amdgcn_global_load_lds((const unsigned*)((const char*)(gbase) + (voff)[_i]), (LAS unsigned*)(lds + (bufoff) + ldsw + _i * 8192), 16, 0, 0); } while (0)
#define PG8_LDA(dst, b, h) do { _Pragma("unroll") for (int m = 0; m < 4; ++m) _Pragma("unroll") for (int k = 0; k < 2; ++k) dst[m][k] = *(const LAS bf16x8*)(lds + PG8_SA(b, h) + aoff + m * 2048 + k * 1024); } while (0)
#define PG8_LDB(dst, b, h) do { _Pragma("unroll") for (int n = 0; n < 2; ++n) _Pragma("unroll") for (int k = 0; k < 2; ++k) dst[n][k] = *(const LAS bf16x8*)(lds + PG8_SB(b, h) + boff + n * 2048 + k * 1024); } while (0)
#define PG8_MMA(ai, bj, At, Bt) do { __builtin_amdgcn_s_setprio(1); _Pragma("unroll") for (int m = 0; m < 4; ++m) _Pragma("unroll") for (int n = 0; n < 2; ++n) _Pragma("unroll") for (int k = 0; k < 2; ++k) \
        acc[ai][bj][m][n] = __builtin_amdgcn_mfma_f32_16x16x32_bf16(Bt[n][k], At[m][k], acc[ai][bj][m][n], 0, 0, 0); __builtin_amdgcn_s_setprio(0); } while (0)
#define PG8_CAT(x, y) __builtin_shufflevector(__builtin_bit_cast(i32x4, x), __builtin_bit_cast(i32x4, y), 0, 1, 2, 3, 4, 5, 6, 7)
#define PG8_MMA8(ai, bj, At, Bt) do { __builtin_amdgcn_s_setprio(1); _Pragma("unroll") for (int m = 0; m < 4; ++m) _Pragma("unroll") for (int n = 0; n < 2; ++n) \
        asm volatile("v_mfma_f32_16x16x128_f8f6f4 %0, %1, %2, %0" : "+v"(acc[ai][bj][m][n]) : "v"(PG8_CAT(Bt[n][0], Bt[n][1])), "v"(PG8_CAT(At[m][0], At[m][1]))); __builtin_amdgcn_s_setprio(0); } while (0)
#define PG8_WAIT_V(n) asm volatile("s_waitcnt vmcnt(" #n ")" ::: "memory")
#define PG8_WAIT_L(n) asm volatile("s_waitcnt lgkmcnt(" #n ")" ::: "memory")
#define PG8_BAR __builtin_amdgcn_s_barrier()
#define PG8_SCHED __builtin_amdgcn_sched_barrier(0)
    Unit cur, nxt; int ui = 0;
    if (!S.next(0, cur)) return;
    Acc acc;
#pragma unroll
    for (int a = 0; a < 2; ++a)
#pragma unroll
        for (int b = 0; b < 2; ++b)
#pragma unroll
            for (int m = 0; m < 4; ++m)
#pragma unroll
                for (int n = 0; n < 2; ++n) acc[a][b][m][n] = (f32x4){0.f, 0.f, 0.f, 0.f};
    bf16x8 At[4][2], B0[2][2], B1[2][2];
    const char* cA = cur.A; const char* cB = cur.B;
    PG8_STAGE(PG8_SB(0, 0), cB, voffB); PG8_STAGE(PG8_SB(0, 1), cB + hstepB, voffB); PG8_STAGE(PG8_SA(0, 0), cA, voffA); PG8_STAGE(PG8_SA(0, 1), cA + hstepA, voffA);
    if (wr == 1) PG8_BAR;
    PG8_WAIT_V(2); PG8_BAR;
    PG8_STAGE(PG8_SB(1, 0), cB + kstep, voffB); PG8_STAGE(PG8_SA(1, 0), cA + kstep, voffA); PG8_STAGE(PG8_SB(1, 1), cB + hstepB + kstep, voffB);
    PG8_WAIT_V(6); PG8_BAR;
    for (;;) {
        const bool has_next = S.next(ui + 1, nxt);
        const char* nA = has_next ? nxt.A : cA; const char* nB = has_next ? nxt.B : cB;
        for (int t = 0; t < nt; t += 2) {
            const bool last = (t == nt - 2);
            const char* a1 = cA + (size_t)(t + 1) * kstep;
            const char* a2 = last ? nA : cA + (size_t)(t + 2) * kstep; const char* b2 = last ? nB : cB + (size_t)(t + 2) * kstep;
            const char* a3 = a2 + kstep; const char* b3 = b2 + kstep;
            if constexpr (FP8) {
            PG8_LDB(B0, 0, 0); PG8_LDB(B1, 0, 1); PG8_SCHED; PG8_LDA(At, 0, 0); PG8_STAGE(PG8_SA(1, 1), a1 + hstepA, voffA);
            PG8_WAIT_V(8); PG8_WAIT_L(0); PG8_BAR; PG8_MMA8(0, 0, At, B0); PG8_MMA8(0, 1, At, B1); PG8_BAR; PG8_SCHED;
            PG8_LDA(At, 0, 1); PG8_STAGE(PG8_SB(0, 0), b2, voffB); PG8_STAGE(PG8_SB(0, 1), b2 + hstepB, voffB); PG8_STAGE(PG8_SA(0, 0), a2, voffA);
            PG8_WAIT_V(8); PG8_WAIT_L(0); PG8_BAR; PG8_MMA8(1, 0, At, B0); PG8_MMA8(1, 1, At, B1); PG8_BAR; PG8_SCHED;
            PG8_LDB(B0, 1, 0); PG8_LDB(B1, 1, 1); PG8_SCHED; PG8_LDA(At, 1, 0); PG8_STAGE(PG8_SA(0, 1), a2 + hstepA, voffA);
            PG8_WAIT_V(8); PG8_WAIT_L(0); PG8_BAR; PG8_MMA8(0, 0, At, B0); PG8_MMA8(0, 1, At, B1); PG8_BAR; PG8_SCHED;
            PG8_LDA(At, 1, 1); PG8_STAGE(PG8_SB(1, 0), b3, voffB); PG8_STAGE(PG8_SB(1, 1), b3 + hstepB, voffB); PG8_STAGE(PG8_SA(1, 0), a3, voffA);
            PG8_WAIT_V(8); PG8_WAIT_L(0); PG8_BAR; PG8_MMA8(1, 0, At, B0); PG8_MMA8(1, 1, At, B1); PG8_BAR; PG8_SCHED;
            } else {
            PG8_LDB(B0, 0, 0); PG8_LDB(B1, 0, 1); PG8_SCHED; PG8_LDA(At, 0, 0); PG8_STAGE(PG8_SA(1, 1), a1 + hstepA, voffA);
            PG8_WAIT_V(8); PG8_WAIT_L(0); PG8_BAR; PG8_MMA(0, 0, At, B0); PG8_MMA(0, 1, At, B1); PG8_BAR; PG8_SCHED;
            PG8_LDA(At, 0, 1); PG8_STAGE(PG8_SB(0, 0), b2, voffB); PG8_STAGE(PG8_SB(0, 1), b2 + hstepB, voffB); PG8_STAGE(PG8_SA(0, 0), a2, voffA);
            PG8_WAIT_V(8); PG8_WAIT_L(0); PG8_BAR; PG8_MMA(1, 0, At, B0); PG8_MMA(1, 1, At, B1); PG8_BAR; PG8_SCHED;
            PG8_LDB(B0, 1, 0); PG8_LDB(B1, 1, 1); PG8_SCHED; PG8_LDA(At, 1, 0); PG8_STAGE(PG8_SA(0, 1), a2 + hstepA, voffA);
            PG8_WAIT_V(8); PG8_WAIT_L(0); PG8_BAR; PG8_MMA(0, 0, At, B0); PG8_MMA(0, 1, At, B1); PG8_BAR; PG8_SCHED;
            PG8_LDA(At, 1, 1); PG8_STAGE(PG8_SB(1, 0), b3, voffB); PG8_STAGE(PG8_SB(1, 1), b3 + hstepB, voffB); PG8_STAGE(PG8_SA(1, 0), a3, voffA);
            PG8_WAIT_V(8); PG8_WAIT_L(0); PG8_BAR; PG8_MMA(1, 0, At, B0); PG8_MMA(1, 1, At, B1); PG8_BAR; PG8_SCHED;
            }
        }
        if constexpr (ALIGN_EPI) { if (wr == 0) PG8_BAR; }
        if constexpr (FP8) {
#pragma unroll
            for (int a = 0; a < 2; ++a)
#pragma unroll
                for (int b = 0; b < 2; ++b)
                    asm volatile("s_nop 15\n\ts_nop 15" : "+v"(acc[a][b][0][0]), "+v"(acc[a][b][0][1]), "+v"(acc[a][b][1][0]), "+v"(acc[a][b][1][1]), "+v"(acc[a][b][2][0]), "+v"(acc[a][b][2][1]), "+v"(acc[a][b][3][0]), "+v"(acc[a][b][3][1]));
        }
        E(acc, cur, wr, wc, fr, fq);
        if (!has_next) break;
#pragma unroll
        for (int a = 0; a < 2; ++a)
#pragma unroll
            for (int b = 0; b < 2; ++b)
#pragma unroll
                for (int m = 0; m < 4; ++m)
#pragma unroll
                    for (int n = 0; n < 2; ++n) acc[a][b][m][n] = (f32x4){0.f, 0.f, 0.f, 0.f};
        cur = nxt; cA = nA; cB = nB; ++ui;
        if constexpr (ALIGN_EPI) { if (wr == 1) PG8_BAR; }
    }
    PG8_WAIT_V(0);
    if constexpr (!ALIGN_EPI) { if (wr == 0) PG8_BAR; }
    PG8_BAR;
#undef PG8_SA
#undef PG8_SB
#undef PG8_STAGE
#undef PG8_LDA
#undef PG8_MMA8
#undef PG8_CAT
#undef PG8_LDB
#undef PG8_MMA
#undef PG8_WAIT_V
#undef PG8_WAIT_L
#undef PG8_BAR
#undef PG8_SCHED
}

struct EpiInGate {
    static constexpr bool PERM = true;
    bf16_t* z; bf16_t* gates; const float* bgate; float s;
    __device__ __forceinline__ void operator()(const Acc& acc, const Unit& u, int wr, int wc, int fr, int fq) const {
        const int row0 = u.orow + wr * 64 + fr; const bool isg = u.ocol >= 16;
        const int colt = (isg ? u.ocol - 16 : u.ocol) * 256 + wc * 32 + 8 * fq; const int ldc = isg ? 8192 : ZC; bf16_t* base = isg ? gates : z;
        f32x4 bv[2][2];
#pragma unroll
        for (int bj = 0; bj < 2; ++bj)
#pragma unroll
            for (int n = 0; n < 2; ++n) bv[bj][n] = isg ? *(const f32x4*)(bgate + colt + bj * HALF + 4 * n) : (f32x4){0.f, 0.f, 0.f, 0.f};
#pragma unroll
        for (int ai = 0; ai < 2; ++ai)
#pragma unroll
            for (int m = 0; m < 4; ++m) { bf16_t* rowp = base + (size_t)(row0 + ai * HALF + m * 16) * ldc + colt;
#pragma unroll
                for (int bj = 0; bj < 2; ++bj) { f32x4 v0 = acc[ai][bj][m][0] * s + bv[bj][0], v1 = acc[ai][bj][m][1] * s + bv[bj][1];
                    if (isg) {
#pragma unroll
                        for (int j = 0; j < 4; ++j) { v0[j] = sigmoidf_(v0[j]); v1[j] = sigmoidf_(v1[j]); } }
                    u32x4 w; w.x = cvt_pk_bf16(v0[0], v0[1]); w.y = cvt_pk_bf16(v0[2], v0[3]); w.z = cvt_pk_bf16(v1[0], v1[1]); w.w = cvt_pk_bf16(v1[2], v1[3]);
                    *(u32x4*)(rowp + bj * HALF) = w; } }
    }
};
struct EpiBf16 {
    static constexpr bool PERM = true;
    bf16_t* O; int ldc;
    __device__ __forceinline__ void operator()(const Acc& acc, const Unit& u, int wr, int wc, int fr, int fq) const {
        const int row0 = u.orow + wr * 64 + fr, col0 = u.ocol * 256 + wc * 32 + 8 * fq;
#pragma unroll
        for (int ai = 0; ai < 2; ++ai)
#pragma unroll
            for (int m = 0; m < 4; ++m) { bf16_t* rowp = O + (size_t)(row0 + ai * HALF + m * 16) * ldc + col0;
#pragma unroll
                for (int bj = 0; bj < 2; ++bj) { const f32x4 v0 = acc[ai][bj][m][0], v1 = acc[ai][bj][m][1];
                    u32x4 w; w.x = cvt_pk_bf16(v0[0], v0[1]); w.y = cvt_pk_bf16(v0[2], v0[3]); w.z = cvt_pk_bf16(v1[0], v1[1]); w.w = cvt_pk_bf16(v1[2], v1[3]);
                    *(u32x4*)(rowp + bj * HALF) = w; } }
    }
};
struct EpiSwiGLU {
    static constexpr bool PERM = true;
    bf16_t* O; int ldc;
    __device__ __forceinline__ void operator()(const Acc& acc, const Unit& u, int wr, int wc, int fr, int fq) const {
        const int row0 = u.orow + wr * 64 + fr, col0 = u.ocol * 128 + wc * 32 + 8 * fq;
#pragma unroll
        for (int ai = 0; ai < 2; ++ai)
#pragma unroll
            for (int m = 0; m < 4; ++m) { bf16_t* rowp = O + (size_t)(row0 + ai * HALF + m * 16) * ldc + col0;
                f32x4 v0, v1;
#pragma unroll
                for (int j = 0; j < 4; ++j) { const float g0 = acc[ai][0][m][0][j], g1 = acc[ai][0][m][1][j];
                    v0[j] = g0 * sigmoidf_(g0) * acc[ai][1][m][0][j]; v1[j] = g1 * sigmoidf_(g1) * acc[ai][1][m][1][j]; }
                u32x4 w; w.x = cvt_pk_bf16(v0[0], v0[1]); w.y = cvt_pk_bf16(v0[2], v0[3]); w.z = cvt_pk_bf16(v1[0], v1[1]); w.w = cvt_pk_bf16(v1[2], v1[3]);
                *(u32x4*)rowp = w; }
    }
};
__device__ __forceinline__ float bflo(unsigned w) { return __uint_as_float(w << 16); }
__device__ __forceinline__ float bfhi(unsigned w) { return __uint_as_float(w & 0xffff0000u); }
struct EpiMerge {
    static constexpr bool PERM = true;
    const bf16_t* gates; bf16_t* merged;
    __device__ __forceinline__ void operator()(const Acc& acc, const Unit& u, int wr, int wc, int fr, int fq) const {
        const int row0 = u.orow + wr * 64 + fr, col0 = u.ocol * 256 + wc * 32 + 8 * fq, n = u.x0;
#pragma unroll
        for (int ai = 0; ai < 2; ++ai) {
            u32x4 gv[4][2], ov[4][2];
#pragma unroll
            for (int m = 0; m < 4; ++m)
#pragma unroll
                for (int bj = 0; bj < 2; ++bj) { const size_t r = (size_t)(row0 + ai * HALF + m * 16);
                    gv[m][bj] = *(const u32x4*)(gates + r * 8192 + n * 2048 + col0 + bj * HALF);
                    ov[m][bj] = (u32x4){0u, 0u, 0u, 0u}; if (n > 0) ov[m][bj] = *(const u32x4*)(merged + r * DM + col0 + bj * HALF); }
#pragma unroll
            for (int m = 0; m < 4; ++m)
#pragma unroll
                for (int bj = 0; bj < 2; ++bj) { const size_t r = (size_t)(row0 + ai * HALF + m * 16);
                    const u32x4 g = gv[m][bj], o = ov[m][bj]; const f32x4 v0 = acc[ai][bj][m][0], v1 = acc[ai][bj][m][1];
                    u32x4 w;
                    w.x = cvt_pk_bf16(bflo(o.x) + bflo(g.x) * v0[0], bfhi(o.x) + bfhi(g.x) * v0[1]);
                    w.y = cvt_pk_bf16(bflo(o.y) + bflo(g.y) * v0[2], bfhi(o.y) + bfhi(g.y) * v0[3]);
                    w.z = cvt_pk_bf16(bflo(o.z) + bflo(g.z) * v1[0], bfhi(o.z) + bfhi(g.z) * v1[1]);
                    w.w = cvt_pk_bf16(bflo(o.w) + bflo(g.w) * v1[2], bfhi(o.w) + bfhi(g.w) * v1[3]);
                    *(u32x4*)(merged + r * DM + col0 + bj * HALF) = w; }
        }
    }
};
__device__ __forceinline__ unsigned pack_fp8x4(float a, float b, float c, float d) { int w = 0; w = __builtin_amdgcn_cvt_pk_fp8_f32(a, b, w, false); w = __builtin_amdgcn_cvt_pk_fp8_f32(c, d, w, true); return (unsigned)w; }
struct EpiGates {
    static constexpr bool PERM = true;
    bf16_t* gates; const float* bgate; float s;
    __device__ __forceinline__ void operator()(const Acc& acc, const Unit& u, int wr, int wc, int fr, int fq) const {
        const int row0 = u.orow + wr * 64 + fr, colt = u.ocol * 256 + wc * 32 + 8 * fq;
        f32x4 bv[2][2];
#pragma unroll
        for (int bj = 0; bj < 2; ++bj)
#pragma unroll
            for (int n = 0; n < 2; ++n) bv[bj][n] = *(const f32x4*)(bgate + colt + bj * HALF + 4 * n);
#pragma unroll
        for (int ai = 0; ai < 2; ++ai)
#pragma unroll
            for (int m = 0; m < 4; ++m) { bf16_t* rowp = gates + (size_t)(row0 + ai * HALF + m * 16) * 8192 + colt;
#pragma unroll
                for (int bj = 0; bj < 2; ++bj) { f32x4 v0 = acc[ai][bj][m][0] * s + bv[bj][0], v1 = acc[ai][bj][m][1] * s + bv[bj][1];
#pragma unroll
                    for (int j = 0; j < 4; ++j) { v0[j] = sigmoidf_(v0[j]); v1[j] = sigmoidf_(v1[j]); }
                    u32x4 w; w.x = cvt_pk_bf16(v0[0], v0[1]); w.y = cvt_pk_bf16(v0[2], v0[3]); w.z = cvt_pk_bf16(v1[0], v1[1]); w.w = cvt_pk_bf16(v1[2], v1[3]);
                    *(u32x4*)(rowp + bj * HALF) = w; } }
    }
};
struct EpiSwiGLU8 {
    static constexpr bool PERM = true;
    unsigned char* O; int ldc; float si, so;
    __device__ __forceinline__ void operator()(const Acc& acc, const Unit& u, int wr, int wc, int fr, int fq) const {
        const int row0 = u.orow + wr * 64 + fr, col0 = u.ocol * 128 + wc * 32 + 8 * fq;
#pragma unroll
        for (int ai = 0; ai < 2; ++ai)
#pragma unroll
            for (int m = 0; m < 4; ++m) { unsigned char* rowp = O + (size_t)(row0 + ai * HALF + m * 16) * ldc + col0;
                f32x4 v0, v1;
#pragma unroll
                for (int j = 0; j < 4; ++j) { const float g0 = acc[ai][0][m][0][j] * si, g1 = acc[ai][0][m][1][j] * si;
                    v0[j] = g0 * sigmoidf_(g0) * (acc[ai][1][m][0][j] * si) * so; v1[j] = g1 * sigmoidf_(g1) * (acc[ai][1][m][1][j] * si) * so; }
                u32x2 w; w.x = pack_fp8x4(v0[0], v0[1], v0[2], v0[3]); w.y = pack_fp8x4(v1[0], v1[1], v1[2], v1[3]);
                *(u32x2*)rowp = w; }
    }
};
struct EpiResF32 {
    static constexpr bool PERM = false;
    const float* base; float* out; float s;
    __device__ __forceinline__ void operator()(const Acc& acc, const Unit& u, int wr, int wc, int fr, int fq) const {
        const int row0 = u.orow + wr * 64 + fr, col0 = u.ocol * 256 + wc * 32 + 4 * fq;
#pragma unroll
        for (int ai = 0; ai < 2; ++ai)
#pragma unroll
            for (int mp = 0; mp < 2; ++mp) {
                f32x4 bs[2][2][2];
#pragma unroll
                for (int mm = 0; mm < 2; ++mm) { const size_t off = (size_t)(row0 + ai * HALF + (mp * 2 + mm) * 16) * DM + col0;
#pragma unroll
                    for (int bj = 0; bj < 2; ++bj)
#pragma unroll
                        for (int n = 0; n < 2; ++n) bs[mm][bj][n] = *(const f32x4*)(base + off + bj * HALF + n * 16); }
#pragma unroll
                for (int mm = 0; mm < 2; ++mm) { const int m = mp * 2 + mm; const size_t off = (size_t)(row0 + ai * HALF + m * 16) * DM + col0;
#pragma unroll
                    for (int bj = 0; bj < 2; ++bj)
#pragma unroll
                        for (int n = 0; n < 2; ++n) *(f32x4*)(out + off + bj * HALF + n * 16) = bs[mm][bj][n] + acc[ai][bj][m][n] * s; }
                asm volatile("" ::: "memory"); }
    }
};
struct EpiMoeDown {
    static constexpr bool PERM = false;
    float* out; const int* tok; const float* wt; const unsigned* cnt; float s;
    __device__ __forceinline__ void operator()(const Acc& acc, const Unit& u, int wr, int wc, int fr, int fq) const {
        const int e = u.x0, nrow = (int)cnt[e * 64]; const int lrow0 = u.x1 + wr * 64 + fr, col0 = u.ocol * 256 + wc * 32 + 4 * fq;
#pragma unroll
        for (int ai = 0; ai < 2; ++ai)
#pragma unroll
            for (int m = 0; m < 4; ++m) { const int lr = lrow0 + ai * HALF + m * 16;
                if (lr < nrow) { const int slot = e * ECAP + lr; const int t = tok[slot]; const float w = wt[slot] * s; float* op = out + (size_t)t * DM + col0;
#pragma unroll
                    for (int bj = 0; bj < 2; ++bj)
#pragma unroll
                        for (int n = 0; n < 2; ++n)
#pragma unroll
                            for (int j = 0; j < 4; ++j) unsafeAtomicAdd(op + bj * HALF + n * 16 + j, w * acc[ai][bj][m][n][j]); } }
    }
};
struct EpiMoeDownY {
    static constexpr bool PERM = true;
    bf16_t* y; const float* wt; const unsigned* cnt; float s;
    __device__ __forceinline__ void operator()(const Acc& acc, const Unit& u, int wr, int wc, int fr, int fq) const {
        const int e = u.x0, nrow = (int)cnt[e * 64]; const int lrow0 = u.x1 + wr * 64 + fr, col0 = u.ocol * 256 + wc * 32 + 8 * fq;
#pragma unroll
        for (int ai = 0; ai < 2; ++ai)
#pragma unroll
            for (int m = 0; m < 4; ++m) { const int lr = lrow0 + ai * HALF + m * 16;
                if (lr < nrow) { const int slot = e * ECAP + lr; const float w = wt[slot] * s; bf16_t* rowp = y + ((size_t)u.ks * NEXP * ECAP + slot) * DM + col0;
#pragma unroll
                    for (int bj = 0; bj < 2; ++bj) { const f32x4 v0 = acc[ai][bj][m][0] * w, v1 = acc[ai][bj][m][1] * w;
                        u32x4 q; q.x = cvt_pk_bf16(v0[0], v0[1]); q.y = cvt_pk_bf16(v0[2], v0[3]); q.z = cvt_pk_bf16(v1[0], v1[1]); q.w = cvt_pk_bf16(v1[2], v1[3]);
                        *(u32x4*)(rowp + bj * HALF) = q; } } }
    }
};
}
#define XB_TMO      128
#define XB_XCNT(j)  (256  + 64 * (j))
#define XB_XSUB(j)  (1280 + 64 * (j))
#define XB_XGEN(j)  (2304 + 64 * (j))
#define XB_TOP      3328
#define XB_TOPGEN   3392
#define XCD_BAR_WORDS 3456
#define XB_SPIN_CAP (1u << 18)

__device__ __forceinline__ unsigned xb_ld(unsigned* p)              { return __hip_atomic_load(p, __ATOMIC_RELAXED, __HIP_MEMORY_SCOPE_AGENT); }
__device__ __forceinline__ unsigned xb_add(unsigned* p, unsigned v) { return __hip_atomic_fetch_add(p, v, __ATOMIC_RELAXED, __HIP_MEMORY_SCOPE_AGENT); }
__device__ __forceinline__ unsigned xb_xcc_id() { return (unsigned)__builtin_amdgcn_s_getreg((3 << 11) | 20) & 0xFu; }
#define XB_SPIN(cond, bar) do { unsigned _sp = 0; while (cond) { __builtin_amdgcn_s_sleep(1); \
    if ((++_sp & 255u) == 0u) { if (xb_ld(&(bar)[XB_TMO])) break; if (_sp > XB_SPIN_CAP) { atomicAdd(&(bar)[XB_TMO], 1u); break; } } } } while (0)

__device__ __forceinline__ unsigned xb_tid() { unsigned t = threadIdx.x; asm volatile("" : "+v"(t)); return t; }
struct XcdBarrier {
    unsigned* bar; unsigned x;
    volatile LAS unsigned* st;
};

__device__ __forceinline__ XcdBarrier xcd_barrier_post(unsigned* bar, volatile LAS unsigned* st) {
    XcdBarrier b; b.bar = bar; b.x = xb_xcc_id(); b.st = st;
    if (xb_tid() == 0u) (void)xb_add(&bar[XB_XCNT(b.x)], 1u);
    return b;
}
__device__ __forceinline__ void xcd_barrier_complete(unsigned* bar, unsigned x, unsigned& nloc, unsigned& nx) {
    const unsigned G = gridDim.x * gridDim.y * gridDim.z;
    unsigned sum, cnt, mine, sp = 0u;
    for (;;) {
        sum = 0u; cnt = 0u; mine = 0u;
#pragma unroll
        for (unsigned j = 0; j < 16; ++j) { const unsigned c = xb_ld(&bar[XB_XCNT(j)]); sum += c; cnt += (c > 0u) ? 1u : 0u; mine = (j == x) ? c : mine; }
        if (sum == G) break;
        __builtin_amdgcn_s_sleep(1);
        if ((++sp & 255u) == 0u) { if (xb_ld(&bar[XB_TMO])) break; if (sp > XB_SPIN_CAP) { atomicAdd(&bar[XB_TMO], 1u); break; } }
    }
    nloc = mine > 0u ? mine : 1u; nx = cnt > 0u ? cnt : 1u;
}

__device__ __forceinline__ void xcd_barrier(const XcdBarrier& b) {
    asm volatile("s_waitcnt vmcnt(0)" ::: "memory");
    __syncthreads();
    if (xb_tid() == 0u) {
        unsigned* bar = b.bar;
        __builtin_amdgcn_s_waitcnt(0);
        unsigned nloc = b.st[0], nx = b.st[1];
        if (nloc == 0u) { xcd_barrier_complete(bar, b.x, nloc, nx); b.st[0] = nloc; b.st[1] = nx; }
        const unsigned old = xb_add(&bar[XB_XSUB(b.x)], 1u);
        const unsigned gen = old / nloc;
        if (old + 1u == (gen + 1u) * nloc) {
            __builtin_amdgcn_fence(__ATOMIC_RELEASE, "agent");
            asm volatile("s_waitcnt vmcnt(0)" ::: "memory");
            const unsigned og = xb_add(&bar[XB_TOP], 1u);
            const unsigned tg = og / nx;
            if (og + 1u == (tg + 1u) * nx) xb_add(&bar[XB_TOPGEN], 1u);
            else XB_SPIN(xb_ld(&bar[XB_TOPGEN]) == tg, bar);
            __builtin_amdgcn_fence(__ATOMIC_ACQUIRE, "agent");
            xb_add(&bar[XB_XGEN(b.x)], 1u);
            asm volatile("s_waitcnt vmcnt(0)" ::: "memory");
        } else {
            XB_SPIN(xb_ld(&bar[XB_XGEN(b.x)]) == gen, bar);
            __builtin_amdgcn_fence(__ATOMIC_ACQUIRE, "agent");
            asm volatile("s_waitcnt vmcnt(0)" ::: "memory");
        }
    }
    __syncthreads();
}

struct Params { const float* in[30]; float* out; unsigned char* ws; int ph_lo, ph_hi; };
enum { I_X = 0, I_MEM, I_NORM_MIX, I_W_IN, I_NA_QN, I_NA_KN, I_NA_RPB, I_CQ_N, I_W_UQ, I_CKV_N, I_W_UKV, I_MLA_QN, I_MLA_KN, I_SWA_QN, I_SWA_KN, I_SWA_SINK,
       I_MEM_N, I_MEM_WKV, I_MEM_QN, I_MEM_KN, I_W_BRANCH, I_W_GATE, I_B_GATE, I_W_O, I_NORM_FFN, I_FFN_UP, I_FFN_DN, I_ROUTER, I_MOE_UP, I_MOE_DN };

__device__ __forceinline__ float wave_sum(float v) {
#pragma unroll
    for (int o = 32; o >= 1; o >>= 1) v += __shfl_xor(v, o);
    return v;
}
__device__ __forceinline__ float bf2f(bf16_t b) { return __uint_as_float(((unsigned)b) << 16); }
__device__ __forceinline__ bf16_t f2bf(float f) { return (bf16_t)(pg8::cvt_pk_bf16(f, 0.f) & 0xffffu); }
using pg8::cvt_pk_bf16; using pg8::bflo; using pg8::bfhi;

struct CvtJob { const float* src; bf16_t* dst; int src_ld, K, ntn, tile0, mode, dff; };
constexpr int NJOBS = 40;
__device__ __forceinline__ void make_job(int j, const Params& p, CvtJob& jb) {
    unsigned char* ws = p.ws; jb.mode = 0; jb.dff = 1; jb.tile0 = 0;
    if (j < 22) { const int l = j / 11, k = j % 11; unsigned char* lw = ws + WS_LW + (size_t)l * LW_BYTES;
        if (k == 0) { jb.src = p.in[I_W_IN] + (size_t)l * DM * INC; jb.dst = (bf16_t*)(lw + LW_IN); jb.src_ld = INC; jb.K = DM; jb.ntn = INC / 64; jb.mode = INGATE_FP8 ? 3 : 0; }
        else if (k == 1) { jb.src = p.in[I_W_IN]; jb.dst = (bf16_t*)(lw + LW_IN + (size_t)INC * DM * (INGATE_FP8 ? 1 : 2)); jb.src_ld = INC; jb.K = DM; jb.ntn = (ZC - INC) / 64; jb.mode = INGATE_FP8 ? 5 : 2; }
        else if (k == 2) { jb.src = p.in[I_W_GATE] + (size_t)l * DM * 8192; jb.dst = (bf16_t*)(lw + LW_IN + (size_t)ZC * DM * (INGATE_FP8 ? 1 : 2)); jb.src_ld = 8192; jb.K = DM; jb.ntn = 8192 / 64; jb.mode = INGATE_FP8 ? 3 : 0; }
        else if (k == 3) { jb.src = p.in[I_W_UQ] + (size_t)l * 768 * 768; jb.dst = (bf16_t*)(lw + LW_UQ); jb.src_ld = 768; jb.K = 768; jb.ntn = 768 / 64; }
        else if (k == 4) { jb.src = p.in[I_W_UKV] + (size_t)l * 256 * 1024; jb.dst = (bf16_t*)(lw + LW_UKV); jb.src_ld = 1024; jb.K = 256; jb.ntn = 1024 / 64; }
        else if (k == 5) { jb.src = p.in[I_MEM_WKV] + (size_t)l * DM * 1024; jb.dst = (bf16_t*)(lw + LW_MEMKV); jb.src_ld = 1024; jb.K = DM; jb.ntn = 1024 / 64; }
        else if (k < 10) { const int n = k - 6; jb.src = p.in[I_W_BRANCH] + ((size_t)l * 4 + n) * 512 * DM; jb.dst = (bf16_t*)(lw + LW_BR) + (size_t)n * DM * 512; jb.src_ld = DM; jb.K = 512; jb.ntn = DM / 64; }
        else { jb.src = p.in[I_W_O] + (size_t)l * DM * DM; jb.dst = (bf16_t*)(lw + LW_O); jb.src_ld = DM; jb.K = DM; jb.ntn = DM / 64; }
    } else if (j == 22) { jb.src = p.in[I_FFN_UP]; jb.dst = (bf16_t*)(ws + WS_FFNUP); jb.src_ld = 2 * DFF; jb.K = DM; jb.ntn = 2 * DFF / 64; jb.mode = 1; jb.dff = DFF; }
    else if (j == 23) { jb.src = p.in[I_FFN_DN]; jb.dst = (bf16_t*)(ws + WS_FFNDN); jb.src_ld = DM; jb.K = DFF; jb.ntn = DM / 64; }
    else if (j < 32) { const int e = j - 24; jb.src = p.in[I_MOE_UP] + (size_t)e * DM * 2 * DFFE; jb.dst = (bf16_t*)(ws + WS_MOEUP + (size_t)e * 2 * DFFE * DM * MOE_ES); jb.src_ld = 2 * DFFE; jb.K = DM; jb.ntn = 2 * DFFE / 64; jb.mode = MOE_FP8 ? 4 : 1; jb.dff = DFFE; }
    else { const int e = j - 32; jb.src = p.in[I_MOE_DN] + (size_t)e * DFFE * DM; jb.dst = (bf16_t*)(ws + WS_MOEDN + (size_t)e * DM * DFFE * MOE_ES); jb.src_ld = DM; jb.K = DFFE; jb.ntn = DM / 64; jb.mode = MOE_FP8 ? 3 : 0; }
}

__device__ __forceinline__ void norm_rows(const float* src, const float* g, bf16_t* dst, unsigned char* dst8, int nrows, int wid, int lane) {
    const int nw = gridDim.x * 8;
    for (int row = blockIdx.x * 8 + wid; row < nrows; row += 2 * nw) {
        const int rowb = row + nw; const bool hb = rowb < nrows;
        const f32x4* sa = (const f32x4*)(src + (size_t)row * DM); const f32x4* sb = (const f32x4*)(src + (size_t)(hb ? rowb : row) * DM);
        f32x4 va[8], vb[8]; float ssa = 0.f, ssb = 0.f;
#pragma unroll
        for (int j = 0; j < 8; ++j) { va[j] = sa[lane + 64 * j]; vb[j] = sb[lane + 64 * j]; }
#pragma unroll
        for (int j = 0; j < 8; ++j) { ssa += va[j][0] * va[j][0] + va[j][1] * va[j][1] + va[j][2] * va[j][2] + va[j][3] * va[j][3]; ssb += vb[j][0] * vb[j][0] + vb[j][1] * vb[j][1] + vb[j][2] * vb[j][2] + vb[j][3] * vb[j][3]; }
#pragma unroll
        for (int o = 32; o >= 1; o >>= 1) { ssa += __shfl_xor(ssa, o); ssb += __shfl_xor(ssb, o); }
        const float ra = 1.0f / sqrtf(ssa * (1.0f / DM) + EPS), rb = 1.0f / sqrtf(ssb * (1.0f / DM) + EPS);
#pragma unroll
        for (int j = 0; j < 8; ++j) { const f32x4 gv = ((const f32x4*)g)[lane + 64 * j];
            { const f32x4 y = va[j] * ra * gv; u32x2 w; w.x = cvt_pk_bf16(y[0], y[1]); w.y = cvt_pk_bf16(y[2], y[3]); *(u32x2*)(dst + (size_t)row * DM + 4 * (lane + 64 * j)) = w;
              if (dst8) *(unsigned*)(dst8 + (size_t)row * DM + 4 * (lane + 64 * j)) = pg8::pack_fp8x4(y[0] * SC_ACT8, y[1] * SC_ACT8, y[2] * SC_ACT8, y[3] * SC_ACT8); }
            if (hb) { const f32x4 y = vb[j] * rb * gv; u32x2 w; w.x = cvt_pk_bf16(y[0], y[1]); w.y = cvt_pk_bf16(y[2], y[3]); *(u32x2*)(dst + (size_t)rowb * DM + 4 * (lane + 64 * j)) = w;
              if (dst8) *(unsigned*)(dst8 + (size_t)rowb * DM + 4 * (lane + 64 * j)) = pg8::pack_fp8x4(y[0] * SC_ACT8, y[1] * SC_ACT8, y[2] * SC_ACT8, y[3] * SC_ACT8); } }
    }
}

__device__ __forceinline__ void p0_prologue(const Params& p, LAS unsigned char* lds, int tid, int wid, int lane) {
    LAS CvtJob* jt = (LAS CvtJob*)(lds + 65536);
    LAS int* jtot = (LAS int*)(lds + 65536 + 4096);
    if (tid < NJOBS) { CvtJob jb; make_job(tid, p, jb); jt[tid].src = jb.src; jt[tid].dst = jb.dst; jt[tid].src_ld = jb.src_ld; jt[tid].K = jb.K; jt[tid].ntn = jb.ntn; jt[tid].tile0 = 0; jt[tid].mode = jb.mode; jt[tid].dff = jb.dff; }
    __syncthreads();
    if (tid == 0) { int acc = 0; for (int j = 0; j < NJOBS; ++j) { jt[j].tile0 = acc; acc += (jt[j].K / 128) * jt[j].ntn; } jtot[0] = acc; }
    __syncthreads();
    const int total = jtot[0];
    struct Tile { int mode, K, tn, tk, dff; bf16_t* dst; f32x4 r0, r1, r2, r3; };
    const int tq = tid >> 4, nq = tid & 15;
    int j = 0;
#define P0_FETCH(TL, G_) do { (TL).mode = -1; if ((G_) < total) { while (j + 1 < NJOBS && jt[j + 1].tile0 <= (G_)) ++j; \
        const float* src = (const float*)(__attribute__((address_space(1))) const float*)jt[j].src; const int src_ld = jt[j].src_ld, ntn = jt[j].ntn, local = (G_) - jt[j].tile0; \
        (TL).mode = jt[j].mode; (TL).K = jt[j].K; (TL).dff = jt[j].dff; (TL).dst = (bf16_t*)(__attribute__((address_space(1))) bf16_t*)jt[j].dst; (TL).tn = local % ntn; (TL).tk = local / ntn; \
        if ((TL).mode != 2 && (TL).mode != 5) { const bool f8 = (TL).mode >= 3; const int ra = f8 ? 4 * tq : 2 * tq, rb = ra + 1, rc = f8 ? ra + 2 : ra + 64, rd = rc + 1; \
            const float* sp = src + (size_t)((TL).tk * 128) * src_ld + (TL).tn * 64 + 4 * nq; \
            (TL).r0 = __builtin_nontemporal_load((const f32x4*)(sp + (size_t)ra * src_ld)); (TL).r1 = __builtin_nontemporal_load((const f32x4*)(sp + (size_t)rb * src_ld)); \
            (TL).r2 = __builtin_nontemporal_load((const f32x4*)(sp + (size_t)rc * src_ld)); (TL).r3 = __builtin_nontemporal_load((const f32x4*)(sp + (size_t)rd * src_ld)); } } } while (0)
#define P0_TOLDS(TL, T) do { if ((TL).mode >= 3 && (TL).mode != 5) { _Pragma("unroll") for (int q = 0; q < 4; ++q) (T)[(4 * nq + q) * 33 + tq] = pg8::pack_fp8x4((TL).r0[q] * SC_W8, (TL).r1[q] * SC_W8, (TL).r2[q] * SC_W8, (TL).r3[q] * SC_W8); } \
        else if ((TL).mode == 0 || (TL).mode == 1) { _Pragma("unroll") for (int q = 0; q < 4; ++q) { (T)[(4 * nq + q) * 65 + tq] = cvt_pk_bf16((TL).r0[q], (TL).r1[q]); (T)[(4 * nq + q) * 65 + tq + 32] = cvt_pk_bf16((TL).r2[q], (TL).r3[q]); } } } while (0)
#define P0_OUT(TL, T) do { const int mode = (TL).mode, K = (TL).K, tn = (TL).tn, tk = (TL).tk, dff = (TL).dff; bf16_t* dst = (TL).dst; \
        if (mode == 2) { _Pragma("unroll") for (int it = 0; it < 2; ++it) { const int piece = tid + it * 512, n = piece >> 4, seg = piece & 15; \
                *(u32x4*)(dst + (size_t)(tn * 64 + n) * K + tk * 128 + seg * 8) = (u32x4){0u, 0u, 0u, 0u}; } } \
        else if (mode == 5) { const int n = tid >> 3, seg = tid & 7; *(u32x4*)((unsigned char*)dst + (size_t)(tn * 64 + n) * K + tk * 128 + seg * 16) = (u32x4){0u, 0u, 0u, 0u}; } \
        else if (mode >= 3) { const int n = tid >> 3, seg = tid & 7; \
            u32x4 w; w.x = (T)[n * 33 + seg * 4 + 0]; w.y = (T)[n * 33 + seg * 4 + 1]; w.z = (T)[n * 33 + seg * 4 + 2]; w.w = (T)[n * 33 + seg * 4 + 3]; \
            int drow = tn * 64 + n; if (mode == 4) { const int bj = drow / dff, cc = drow - bj * dff; drow = 256 * (cc >> 7) + 128 * bj + (cc & 127); } \
            __builtin_nontemporal_store(w, (u32x4*)((unsigned char*)dst + (size_t)drow * K + tk * 128 + seg * 16)); } \
        else if (mode >= 0) { _Pragma("unroll") for (int it = 0; it < 2; ++it) { const int piece = tid + it * 512, n = piece >> 4, seg = piece & 15; \
                u32x4 w; w.x = (T)[n * 65 + seg * 4 + 0]; w.y = (T)[n * 65 + seg * 4 + 1]; w.z = (T)[n * 65 + seg * 4 + 2]; w.w = (T)[n * 65 + seg * 4 + 3]; \
                int drow = tn * 64 + n; if (mode == 1) { const int bj = drow / dff, cc = drow - bj * dff; drow = 256 * (cc >> 7) + 128 * bj + (cc & 127); } \
                __builtin_nontemporal_store(w, (u32x4*)(dst + (size_t)drow * K + tk * 128 + seg * 8)); } } } while (0)
    LAS unsigned* T0 = (LAS unsigned*)lds; LAS unsigned* T1 = (LAS unsigned*)(lds + 20480);
    Tile na, nb;
    int g = 2 * blockIdx.x;
    P0_FETCH(na, g); P0_FETCH(nb, g + 1);
    while (g < total) {
        const Tile ca = na, cb = nb;
        g += 2 * gridDim.x;
        P0_FETCH(na, g); P0_FETCH(nb, g + 1);
        P0_TOLDS(ca, T0); P0_TOLDS(cb, T1);
        __syncthreads();
        P0_OUT(ca, T0); P0_OUT(cb, T1);
        __syncthreads();
    }
#undef P0_FETCH
#undef P0_TOLDS
#undef P0_OUT
#ifdef PROBE_POISON
    { u32x4* q = (u32x4*)(p.ws + WS_XG); const size_t n1 = (size_t)NEXP * ECAP * DM / 16; for (size_t i = (size_t)blockIdx.x * NTHREADS + tid; i < n1; i += (size_t)gridDim.x * NTHREADS) q[i] = (u32x4){0u, 0u, 0u, 0u};
      q = (u32x4*)(p.ws + WS_ACTM); const size_t n2 = (size_t)NEXP * ECAP * DFFE / 16; for (size_t i = (size_t)blockIdx.x * NTHREADS + tid; i < n2; i += (size_t)gridDim.x * NTHREADS) q[i] = (u32x4){0u, 0u, 0u, 0u}; }
#endif
    { f32x2* rt = (f32x2*)(p.ws + WS_ROPE);
      for (int e = blockIdx.x * NTHREADS + tid; e < SEQ * 32; e += gridDim.x * NTHREADS) { const int pos = e >> 5, i = e & 31;
          const float freq = __builtin_amdgcn_exp2f(-(float)i * (13.287712379549449f / 32.0f));
          const float ang = (float)pos * freq;
          const double rev = (double)ang * 0.15915494309189535; const float fr_ = (float)(rev - __builtin_rint(rev));
          rt[e] = (f32x2){__builtin_amdgcn_cosf(fr_), __builtin_amdgcn_sinf(fr_)}; } }
    norm_rows(p.in[I_MEM], p.in[I_MEM_N], (bf16_t*)(p.ws + WS_MEMN), nullptr, NMEM, wid, lane);
    norm_rows(p.in[I_MEM], p.in[I_MEM_N] + DM, (bf16_t*)(p.ws + WS_MEMN) + (size_t)NMEM * DM, nullptr, NMEM, wid, lane);
    norm_rows(p.in[I_X], p.in[I_NORM_MIX], (bf16_t*)(p.ws + WS_U), p.ws + WS_U8, NTOK, wid, lane);
}

__device__ __forceinline__ void unpack8(const u32x4 w, float (&x)[8]) { x[0] = bflo(w.x); x[1] = bfhi(w.x); x[2] = bflo(w.y); x[3] = bfhi(w.y); x[4] = bflo(w.z); x[5] = bfhi(w.z); x[6] = bflo(w.w); x[7] = bfhi(w.w); }
__device__ __forceinline__ u32x4 pack8(const float (&y)[8]) { u32x4 w; w.x = cvt_pk_bf16(y[0], y[1]); w.y = cvt_pk_bf16(y[2], y[3]); w.z = cvt_pk_bf16(y[4], y[5]); w.w = cvt_pk_bf16(y[6], y[7]); return w; }
__device__ __forceinline__ float sumsq8(const float (&x)[8]) { return (x[0] * x[0] + x[1] * x[1]) + (x[2] * x[2] + x[3] * x[3]) + (x[4] * x[4] + x[5] * x[5]) + (x[6] * x[6] + x[7] * x[7]); }
template <int NL> __device__ __forceinline__ float group_sum(float v) {
#pragma unroll
    for (int o = NL / 2; o >= 1; o >>= 1) v += __shfl_xor(v, o);
    return v;
}
struct Gain8 { f32x4 a, b; };
__device__ __forceinline__ Gain8 ldg8(const float* g) { Gain8 r; r.a = *(const f32x4*)g; r.b = *(const f32x4*)(g + 4); return r; }
__device__ __forceinline__ void scale8(float (&x)[8], float rs, const Gain8& g) { x[0] *= rs * g.a[0]; x[1] *= rs * g.a[1]; x[2] *= rs * g.a[2]; x[3] *= rs * g.a[3]; x[4] *= rs * g.b[0]; x[5] *= rs * g.b[1]; x[6] *= rs * g.b[2]; x[7] *= rs * g.b[3]; }
__device__ __forceinline__ void rope8(float (&y)[8], const f32x4 (&cs)[4], bool upper) {
#pragma unroll
    for (int e = 0; e < 8; ++e) { const float pr = __shfl_xor(y[e], 4); const float c = cs[e >> 1][(e & 1) * 2], s = cs[e >> 1][(e & 1) * 2 + 1]; y[e] = upper ? (y[e] * c + pr * s) : (y[e] * c - pr * s); }
}

__device__ __forceinline__ void prep1(const Params& p, int l, LAS unsigned char* lds, int tid, int wid, int lane) {
    const bf16_t* z = (const bf16_t*)(p.ws + WS_Z);
    bf16_t* naq = (bf16_t*)(p.ws + WS_NAQ); bf16_t* nak = (bf16_t*)(p.ws + WS_NAK); bf16_t* navT = (bf16_t*)(p.ws + WS_NAVT);
    bf16_t* cqn = (bf16_t*)(p.ws + WS_CQN); bf16_t* ckvn = (bf16_t*)(p.ws + WS_CKVN);
    bf16_t* swq = (bf16_t*)(p.ws + WS_SWQ); bf16_t* swk = (bf16_t*)(p.ws + WS_SWK); bf16_t* swvT = (bf16_t*)(p.ws + WS_SWVT); bf16_t* meq = (bf16_t*)(p.ws + WS_MEQ);
    const f32x4* rt4 = (const f32x4*)(p.ws + WS_ROPE);
    const float qs128 = 0.08838834764831845f * LOG2E, qs64 = 0.125f * LOG2E;
    const int l16 = lane & 15, l8 = lane & 7;
    const Gain8 g_naq = ldg8(p.in[I_NA_QN] + l * 128 + 8 * l16), g_nak = ldg8(p.in[I_NA_KN] + l * 128 + 8 * l16), g_meq = ldg8(p.in[I_MEM_QN] + l * 128 + 8 * l16);
    const Gain8 g_cq0 = ldg8(p.in[I_CQ_N] + l * 768 + 8 * lane), g_cq1 = ldg8(p.in[I_CQ_N] + l * 768 + 512 + 8 * (lane & 31)), g_ckv = ldg8(p.in[I_CKV_N] + l * 256 + 8 * (lane & 31));
    const Gain8 g_swq = ldg8(p.in[I_SWA_QN] + l * 64 + 8 * l8), g_swk = ldg8(p.in[I_SWA_KN] + l * 64 + 8 * l8);
    constexpr int VW = 640;
    LAS bf16_t* vt = (LAS bf16_t*)lds;
    const u32x4 zero4 = (u32x4){0u, 0u, 0u, 0u};
    for (int grp = blockIdx.x; grp < NTOK / 32; grp += gridDim.x) {
        const int b = grp >> 6, chunk = grp & 63;
#pragma unroll 2
        for (int ti = 0; ti < 4; ++ti) {
            const int tl = wid * 4 + ti, s = chunk * 32 + tl, token = grp * 32 + tl;
            const bf16_t* zr = z + (size_t)token * ZC;
            const u32x4 w_naq = *(const u32x4*)(zr + Z_NAQ + 8 * lane), w_nak = *(const u32x4*)(zr + Z_NAK + 8 * lane), w_nav = *(const u32x4*)(zr + Z_NAV + 8 * lane), w_meq = *(const u32x4*)(zr + Z_MEQ + 8 * lane);
            const u32x4 w_cq0 = *(const u32x4*)(zr + Z_CQ + 8 * lane); const u32x4 w_cq1 = lane < 32 ? *(const u32x4*)(zr + Z_CQ + 512 + 8 * lane) : zero4;
            const u32x4 w_ckv = lane < 32 ? *(const u32x4*)(zr + Z_CKV + 8 * lane) : zero4;
            const u32x4 w_swq = *(const u32x4*)(zr + Z_SWQ + 8 * lane);
            const u32x4 w_swkv = lane < 32 ? *(const u32x4*)(zr + (lane < 16 ? Z_SWK + 8 * lane : Z_SWV + 8 * (lane - 16))) : zero4;
            f32x4 cs[4];
#pragma unroll
            for (int q = 0; q < 4; ++q) cs[q] = rt4[(s * 32 + (lane & 3) * 8) / 2 + q];
            *(LAS u32x4*)(vt + tl * VW + 8 * lane) = w_nav;
            if (lane >= 16 && lane < 32) *(LAS u32x4*)(vt + tl * VW + 512 + 8 * (lane - 16)) = w_swkv;
            float x[8];
            { unpack8(w_naq, x); const float ss = group_sum<16>(sumsq8(x)); scale8(x, 1.0f / sqrtf(ss * (1.0f / 128) + EPS) * qs128, g_naq);
              *(u32x4*)(naq + ((size_t)(b * 4 + (lane >> 4)) * SEQ + s) * 128 + 8 * l16) = pack8(x); }
            { unpack8(w_nak, x); const float ss = group_sum<16>(sumsq8(x)); scale8(x, 1.0f / sqrtf(ss * (1.0f / 128) + EPS), g_nak);
              *(u32x4*)(nak + ((size_t)(b * 4 + (lane >> 4)) * SEQ + s) * 128 + 8 * l16) = pack8(x); }
            { unpack8(w_meq, x); const float ss = group_sum<16>(sumsq8(x)); scale8(x, 1.0f / sqrtf(ss * (1.0f / 128) + EPS) * qs128, g_meq);
              *(u32x4*)(meq + ((size_t)(b * 4 + (lane >> 4)) * SEQ + s) * 128 + 8 * l16) = pack8(x); }
            { float y[8]; unpack8(w_cq0, x); unpack8(w_cq1, y); const float ss = group_sum<64>(sumsq8(x) + sumsq8(y)); const float rs = 1.0f / sqrtf(ss * (1.0f / 768) + EPS);
              scale8(x, rs, g_cq0); scale8(y, rs, g_cq1);
              *(u32x4*)(cqn + (size_t)token * 768 + 8 * lane) = pack8(x); if (lane < 32) *(u32x4*)(cqn + (size_t)token * 768 + 512 + 8 * lane) = pack8(y); }
            { unpack8(w_ckv, x); const float ss = group_sum<64>(sumsq8(x)); scale8(x, 1.0f / sqrtf(ss * (1.0f / 256) + EPS), g_ckv);
              if (lane < 32) *(u32x4*)(ckvn + (size_t)token * 256 + 8 * lane) = pack8(x); }
            { unpack8(w_swq, x); const float ss = group_sum<8>(sumsq8(x)); scale8(x, 1.0f / sqrtf(ss * (1.0f / 64) + EPS), g_swq); rope8(x, cs, (lane & 4) != 0);
#pragma unroll
              for (int e = 0; e < 8; ++e) x[e] *= qs64;
              *(u32x4*)(swq + ((size_t)(b * 8 + (lane >> 3)) * SEQ + s) * 64 + 8 * l8) = pack8(x); }
            { unpack8(w_swkv, x); const float ss = group_sum<8>(sumsq8(x)); scale8(x, 1.0f / sqrtf(ss * (1.0f / 64) + EPS), g_swk); rope8(x, cs, (lane & 4) != 0);
              if (lane < 16) *(u32x4*)(swk + ((size_t)(b * 2 + (lane >> 3)) * SEQ + s) * 64 + 8 * l8) = pack8(x); }
        }
        __syncthreads();
#pragma unroll 1
        for (int it = 0; it < 5; ++it) { const int item = tid + it * 512, part = item / VW, c = item - part * VW;
            unsigned short e[8];
#pragma unroll
            for (int q = 0; q < 8; ++q) e[q] = vt[(part * 8 + q) * VW + c];
            u32x4 w; w.x = e[0] | ((unsigned)e[1] << 16); w.y = e[2] | ((unsigned)e[3] << 16); w.z = e[4] | ((unsigned)e[5] << 16); w.w = e[6] | ((unsigned)e[7] << 16);
            bf16_t* dp = (c < 512) ? navT + ((((size_t)(b * 4 + (c >> 7)) * 64 + chunk) * 128 + (c & 127)) * 32 + part * 8)
                                   : swvT + ((((size_t)(b * 2 + ((c - 512) >> 6)) * 64 + chunk) * 64 + ((c - 512) & 63)) * 32 + part * 8);
            *(u32x4*)dp = w; }
        __syncthreads();
    }
}

__device__ __forceinline__ void prep2(const Params& p, int l, LAS unsigned char* lds, int tid, int wid, int lane) {
    const bf16_t* z = (const bf16_t*)(p.ws + WS_Z); const bf16_t* qraw = (const bf16_t*)(p.ws + WS_QRAW); const bf16_t* kvraw = (const bf16_t*)(p.ws + WS_KVRAW);
    const bf16_t* memkv = (const bf16_t*)(p.ws + WS_MEMKV) + (size_t)l * NMEM * 1024;
    bf16_t* mlq = (bf16_t*)(p.ws + WS_MLQ); bf16_t* mlk = (bf16_t*)(p.ws + WS_MLK); bf16_t* mlvT = (bf16_t*)(p.ws + WS_MLVT);
    bf16_t* mek = (bf16_t*)(p.ws + WS_MEK); bf16_t* mevT = (bf16_t*)(p.ws + WS_MEVT);
    const f32x4* rt4 = (const f32x4*)(p.ws + WS_ROPE);
    const float qs192 = 0.07216878364870322f * LOG2E;
    const int l16 = lane & 15, l24 = lane < 24 ? lane : 0;
    const Gain8 g_q = ldg8(p.in[I_MLA_QN] + l * 192 + 8 * l24), g_k = ldg8(p.in[I_MLA_KN] + l * 192 + 8 * l24), g_mk = ldg8(p.in[I_MEM_KN] + l * 128 + 8 * l16);
    constexpr int VW = 512;
    LAS bf16_t* vt = (LAS bf16_t*)lds;
    const u32x4 zero4 = (u32x4){0u, 0u, 0u, 0u};
    for (int grp = blockIdx.x; grp < NTOK / 32 + NMEM / 32; grp += gridDim.x) {
        const bool ismem = grp >= NTOK / 32;
        if (!ismem) {
            const int b = grp >> 6, chunk = grp & 63;
#pragma unroll 2
            for (int ti = 0; ti < 4; ++ti) {
                const int tl = wid * 4 + ti, s = chunk * 32 + tl, token = grp * 32 + tl;
                u32x4 wq[4], wk[4];
#pragma unroll
                for (int h = 0; h < 4; ++h) { wq[h] = lane < 24 ? *(const u32x4*)(qraw + (size_t)token * 768 + h * 192 + 8 * lane) : zero4;
                    wk[h] = lane < 16 ? *(const u32x4*)(kvraw + (size_t)token * 1024 + h * 256 + 8 * lane) : (lane < 24 ? *(const u32x4*)(z + (size_t)token * ZC + Z_KPE + 8 * (lane - 16)) : zero4); }
                const u32x4 wv = *(const u32x4*)(kvraw + (size_t)token * 1024 + (lane >> 4) * 256 + 128 + 8 * l16);
                f32x4 cs[4];
#pragma unroll
                for (int q = 0; q < 4; ++q) cs[q] = rt4[(s * 32 + (lane & 3) * 8) / 2 + q];
                *(LAS u32x4*)(vt + tl * VW + (lane >> 4) * 128 + 8 * l16) = wv;
                const bool ropel = lane >= 16 && lane < 24;
#pragma unroll
                for (int h = 0; h < 4; ++h) {
                    float x[8];
                    { unpack8(wq[h], x); const float ss = group_sum<64>(sumsq8(x)); scale8(x, 1.0f / sqrtf(ss * (1.0f / 192) + EPS), g_q);
                      float y[8];
#pragma unroll
                      for (int e = 0; e < 8; ++e) y[e] = x[e];
                      rope8(y, cs, (lane & 4) != 0);
#pragma unroll
                      for (int e = 0; e < 8; ++e) x[e] = (ropel ? y[e] : x[e]) * qs192;
                      if (lane < 24) *(u32x4*)(mlq + ((size_t)(b * 4 + h) * SEQ + s) * 192 + 8 * lane) = pack8(x); }
                    { unpack8(wk[h], x); const float ss = group_sum<64>(sumsq8(x)); scale8(x, 1.0f / sqrtf(ss * (1.0f / 192) + EPS), g_k);
                      float y[8];
#pragma unroll
                      for (int e = 0; e < 8; ++e) y[e] = x[e];
                      rope8(y, cs, (lane & 4) != 0);
#pragma unroll
                      for (int e = 0; e < 8; ++e) x[e] = ropel ? y[e] : x[e];
                      if (lane < 24) *(u32x4*)(mlk + ((size_t)(b * 4 + h) * SEQ + s) * 192 + 8 * lane) = pack8(x); }
                }
            }
            __syncthreads();
#pragma unroll 1
            for (int it = 0; it < 4; ++it) { const int item = tid + it * 512, part = item >> 9, c = item & 511;
                unsigned short e[8];
#pragma unroll
                for (int q = 0; q < 8; ++q) e[q] = vt[(part * 8 + q) * VW + c];
                u32x4 w; w.x = e[0] | ((unsigned)e[1] << 16); w.y = e[2] | ((unsigned)e[3] << 16); w.z = e[4] | ((unsigned)e[5] << 16); w.w = e[6] | ((unsigned)e[7] << 16);
                *(u32x4*)(mlvT + ((((size_t)(b * 4 + (c >> 7)) * 64 + chunk) * 128 + (c & 127)) * 32 + part * 8)) = w; }
            __syncthreads();
        } else {
            const int mg = grp - NTOK / 32, b = mg >> 3, chunk = mg & 7;
#pragma unroll 2
            for (int ti = 0; ti < 4; ++ti) {
                const int tl = wid * 4 + ti, m = chunk * 32 + tl, mt = mg * 32 + tl;
                const bf16_t* mr = memkv + (size_t)mt * 1024;
                const u32x4 wkk = *(const u32x4*)(mr + 8 * lane), wv = *(const u32x4*)(mr + 512 + 8 * lane);
                *(LAS u32x4*)(vt + tl * VW + 8 * lane) = wv;
                float x[8]; unpack8(wkk, x); const float ss = group_sum<16>(sumsq8(x)); scale8(x, 1.0f / sqrtf(ss * (1.0f / 128) + EPS), g_mk);
                *(u32x4*)(mek + ((size_t)(b * 4 + (lane >> 4)) * MEML + m) * 128 + 8 * l16) = pack8(x);
            }
            __syncthreads();
#pragma unroll 1
            for (int it = 0; it < 4; ++it) { const int item = tid + it * 512, part = item >> 9, c = item & 511;
                unsigned short e[8];
#pragma unroll
                for (int q = 0; q < 8; ++q) e[q] = vt[(part * 8 + q) * VW + c];
                u32x4 w; w.x = e[0] | ((unsigned)e[1] << 16); w.y = e[2] | ((unsigned)e[3] << 16); w.z = e[4] | ((unsigned)e[5] << 16); w.w = e[6] | ((unsigned)e[7] << 16);
                *(u32x4*)(mevT + ((((size_t)(b * 4 + (c >> 7)) * 8 + chunk) * 128 + (c & 127)) * 32 + part * 8)) = w; }
            __syncthreads();
        }
    }
}
constexpr int ATT_RPB_OFF = 98304;
template <int DQ, int DV, int MODE, int NQT>
__device__ __forceinline__ void attn_unit(LAS unsigned char* lds, const bf16_t* qp, const bf16_t* kp, const bf16_t* vp, bf16_t* op,
                                          int nsub, int c_lo, int c_hi, int mq0, int mk0, int mr, float kbound, float sadd, float sink2, int tid, int lane) {
    constexpr int KROW = DQ * 2 + 16, KBUF = 64 * KROW, VROW = 144, VBUF = DV * VROW, NDC = DQ / 32, NDV = DV / 16, DQ8 = DQ / 8;
    constexpr int KP = 64 * DQ8 / 512, VP = 2 * DV * 4 / 512;
    static_assert(KP * 512 == 64 * DQ8 && VP * 512 == 2 * DV * 4 && 2 * KBUF + 2 * VBUF <= ATT_RPB_OFF, "attention staging geometry");
    const int fr = lane & 15, fq = lane >> 4;
    bf16x8 qf[NQT][NDC];
#pragma unroll
    for (int qt = 0; qt < NQT; ++qt)
#pragma unroll
        for (int dc = 0; dc < NDC; ++dc) qf[qt][dc] = *(const bf16x8*)(qp + (size_t)(qt * 16 + fr) * DQ + dc * 32 + fq * 8);
    f32x4 o[NQT][NDV];
#pragma unroll
    for (int qt = 0; qt < NQT; ++qt)
#pragma unroll
        for (int d = 0; d < NDV; ++d) o[qt][d] = (f32x4){0.f, 0.f, 0.f, 0.f};
    float mref[NQT], lrun[NQT];
#pragma unroll
    for (int qt = 0; qt < NQT; ++qt) { float qq = 0.f;
#pragma unroll
        for (int dc = 0; dc < NDC; ++dc) { const u32x4 w = __builtin_bit_cast(u32x4, qf[qt][dc]);
            qq += bflo(w.x) * bflo(w.x) + bfhi(w.x) * bfhi(w.x) + bflo(w.y) * bflo(w.y) + bfhi(w.y) * bfhi(w.y) + bflo(w.z) * bflo(w.z) + bfhi(w.z) * bfhi(w.z) + bflo(w.w) * bflo(w.w) + bfhi(w.w) * bfhi(w.w); }
        qq += __shfl_xor(qq, 16); qq += __shfl_xor(qq, 32);
        mref[qt] = sqrtf(qq) * kbound + sadd; lrun[qt] = 0.f; }
    int kd[KP], vd[VP];
#pragma unroll
    for (int i = 0; i < KP; ++i) { const int pk = tid + i * 512, key = pk / DQ8, dp = pk - key * DQ8, k32 = key & 31;
        kd[i] = (32 * (key >> 5) + 16 * ((k32 >> 2) & 1) + 4 * (k32 >> 3) + (k32 & 3)) * KROW + dp * 16; }
#pragma unroll
    for (int i = 0; i < VP; ++i) { const int pv = tid + i * 512, sub = pv / (DV * 4), r = pv - sub * (DV * 4); vd[i] = (r >> 2) * VROW + sub * 64 + (r & 3) * 16; }
    u32x4 rk[KP], rv[VP];
#pragma unroll
    for (int i = 0; i < KP; ++i) rk[i] = *(const u32x4*)(kp + (size_t)(tid + i * 512) * 8);
#pragma unroll
    for (int i = 0; i < VP; ++i) rv[i] = *(const u32x4*)(vp + (size_t)(tid + i * 512) * 8);
#pragma unroll
    for (int i = 0; i < KP; ++i) *(LAS u32x4*)(lds + kd[i]) = rk[i];
#pragma unroll
    for (int i = 0; i < VP; ++i) *(LAS u32x4*)(lds + 2 * KBUF + vd[i]) = rv[i];
    __syncthreads();
    __builtin_amdgcn_s_waitcnt(0x0F70);
    const int n64 = nsub >> 1;
#pragma unroll 1
    for (int c = 0; c < n64; ++c) {
        const int cur = c & 1; const bool more = (c + 1 < n64);
        if (more) { const bf16_t* kn = kp + (size_t)(c + 1) * 64 * DQ; const bf16_t* vn = vp + (size_t)(c + 1) * 2 * DV * 32;
#pragma unroll
            for (int i = 0; i < KP; ++i) { const bf16_t* ga = kn + (size_t)(tid + i * 512) * 8; asm volatile("global_load_dwordx4 %0, %1, off" : "=v"(rk[i]) : "v"(ga) : "memory"); }
#pragma unroll
            for (int i = 0; i < VP; ++i) { const bf16_t* ga = vn + (size_t)(tid + i * 512) * 8; asm volatile("global_load_dwordx4 %0, %1, off" : "=v"(rv[i]) : "v"(ga) : "memory"); } }
#pragma unroll (NQT == 1 ? 2 : 1)
        for (int sub = 0; sub < 2; ++sub) {
            const int sc = 2 * c + sub;
            if (sc >= c_lo && sc < c_hi) {
                const LAS unsigned char* kb = lds + cur * KBUF + sub * 32 * KROW; const LAS unsigned char* vb = lds + 2 * KBUF + cur * VBUF + sub * 64;
                f32x4 s[NQT][2];
#pragma unroll
                for (int qt = 0; qt < NQT; ++qt) { s[qt][0] = (f32x4){0.f, 0.f, 0.f, 0.f}; s[qt][1] = (f32x4){0.f, 0.f, 0.f, 0.f}; }
                { bf16x8 kf[NDC][2];
#pragma unroll
                  for (int dc = 0; dc < NDC; ++dc) { kf[dc][0] = *(const LAS bf16x8*)(kb + fr * KROW + (dc * 32 + fq * 8) * 2); kf[dc][1] = *(const LAS bf16x8*)(kb + (16 + fr) * KROW + (dc * 32 + fq * 8) * 2); }
#pragma unroll
                  for (int dc = 0; dc < NDC; ++dc)
#pragma unroll
                    for (int qt = 0; qt < NQT; ++qt) { s[qt][0] = __builtin_amdgcn_mfma_f32_16x16x32_bf16(kf[dc][0], qf[qt][dc], s[qt][0], 0, 0, 0);
                                                       s[qt][1] = __builtin_amdgcn_mfma_f32_16x16x32_bf16(kf[dc][1], qf[qt][dc], s[qt][1], 0, 0, 0); } }
                bf16x8 pf[NQT];
#pragma unroll
                for (int qt = 0; qt < NQT; ++qt) {
                    if (MODE == 1) {
                        const int qpos = mq0 + qt * 16 + fr, kbase = mk0 + sc * 32 + 8 * fq;
#pragma unroll
                        for (int b = 0; b < 2; ++b)
#pragma unroll
                            for (int i = 0; i < 4; ++i) { const int dd = qpos - (kbase + 4 * b + i); if (dd > 128 || dd < -128) s[qt][b][i] = -1e30f; }
                    } else if (MODE == 2) {
                        const LAS float* rpb = (const LAS float*)(lds + ATT_RPB_OFF);
                        const int qc = mq0 + qt * 16 + fr, kr = mk0 + (sc >> 1), kcb = (sc & 1) * 32 + 8 * fq;
                        int cs = qc - 8; cs = cs < 0 ? 0 : (cs > 48 ? 48 : cs);
                        const int rowoff = (kr - mr + 7) * 31;
#pragma unroll
                        for (int b = 0; b < 2; ++b)
#pragma unroll
                            for (int i = 0; i < 4; ++i) { const int kc = kcb + 4 * b + i; const bool ok = (kc >= cs) && (kc <= cs + 15);
                                int bi = kc - qc + 15; bi = bi < 0 ? 0 : (bi > 30 ? 30 : bi);
                                const float bias = rpb[rowoff + bi];
                                s[qt][b][i] = ok ? s[qt][b][i] + bias : -1e30f; }
                    }
                    float ps = 0.f;
#pragma unroll
                    for (int b = 0; b < 2; ++b)
#pragma unroll
                        for (int i = 0; i < 4; ++i) { const float e = __builtin_amdgcn_exp2f(s[qt][b][i] - mref[qt]); s[qt][b][i] = e; ps += e; }
                    lrun[qt] += ps;
                    u32x4 w; w.x = cvt_pk_bf16(s[qt][0][0], s[qt][0][1]); w.y = cvt_pk_bf16(s[qt][0][2], s[qt][0][3]); w.z = cvt_pk_bf16(s[qt][1][0], s[qt][1][1]); w.w = cvt_pk_bf16(s[qt][1][2], s[qt][1][3]);
                    pf[qt] = __builtin_bit_cast(bf16x8, w);
                }
                { bf16x8 vf[NDV];
#pragma unroll
                  for (int d = 0; d < NDV; ++d) vf[d] = *(const LAS bf16x8*)(vb + (d * 16 + fr) * VROW + fq * 16);
#pragma unroll
                  for (int d = 0; d < NDV; ++d)
#pragma unroll
                    for (int qt = 0; qt < NQT; ++qt) o[qt][d] = __builtin_amdgcn_mfma_f32_16x16x32_bf16(vf[d], pf[qt], o[qt][d], 0, 0, 0); }
            }
        }
        if (more) { const int nb = cur ^ 1;
            if constexpr (KP == 3) asm volatile("s_waitcnt vmcnt(0)" : "+v"(rk[0]), "+v"(rk[1]), "+v"(rk[2]), "+v"(rv[0]), "+v"(rv[1]) :: "memory");
            else if constexpr (KP == 2) asm volatile("s_waitcnt vmcnt(0)" : "+v"(rk[0]), "+v"(rk[1]), "+v"(rv[0]), "+v"(rv[1]) :: "memory");
            else asm volatile("s_waitcnt vmcnt(0)" : "+v"(rk[0]), "+v"(rv[0]) :: "memory");
#pragma unroll
            for (int i = 0; i < KP; ++i) *(LAS u32x4*)(lds + nb * KBUF + kd[i]) = rk[i];
#pragma unroll
            for (int i = 0; i < VP; ++i) *(LAS u32x4*)(lds + 2 * KBUF + nb * VBUF + vd[i]) = rv[i]; }
        __syncthreads();
    }
#pragma unroll
    for (int qt = 0; qt < NQT; ++qt) {
        float l = lrun[qt]; l += __shfl_xor(l, 16); l += __shfl_xor(l, 32);
        if (MODE == 1) l += __builtin_amdgcn_exp2f(sink2 - mref[qt]);
        const float inv = 1.0f / l;
        bf16_t* orow = op + (size_t)(qt * 16 + fr) * DM + 4 * fq;
#pragma unroll
        for (int d = 0; d < NDV; ++d) { u32x2 w; w.x = cvt_pk_bf16(o[qt][d][0] * inv, o[qt][d][1] * inv); w.y = cvt_pk_bf16(o[qt][d][2] * inv, o[qt][d][3] * inv); *(u32x2*)(orow + d * 16) = w; }
    }
}

__device__ __forceinline__ float gain_absmax(const float* g, int n, int lane) {
    float m = 0.f;
#pragma unroll
    for (int j = 0; j < 3; ++j) { const int i = lane + 64 * j; if (i < n) m = fmaxf(m, fabsf(g[i])); }
#pragma unroll
    for (int o = 32; o >= 1; o >>= 1) m = fmaxf(m, __shfl_xor(m, o));
    return m;
}
__device__ __forceinline__ void attn_phase(const Params& p, int lq, LAS unsigned char* lds, int tid, int wid, int lane, int G, int cblk) {
    const int l = lq & 1;
    unsigned* head = (unsigned*)(p.ws + WS_CTL) + CW_ATTQ + lq * 64;
    volatile LAS int* qw = (volatile LAS int*)(lds + LDS_MISC + 64);
    bf16_t* br = (bf16_t*)(p.ws + ((lq & 2) ? WS_ACT : WS_BR));
    const float kb_mla = 13.856406460551018f * gain_absmax(p.in[I_MLA_KN] + l * 192, 192, lane), kb_na = 11.313708498984761f * gain_absmax(p.in[I_NA_KN] + l * 128, 128, lane);
    const float kb_swa = 8.0f * gain_absmax(p.in[I_SWA_KN] + l * 64, 64, lane), kb_mem = 11.313708498984761f * gain_absmax(p.in[I_MEM_KN] + l * 128, 128, lane);
    const int pmode = lq >> 2;
    if (pmode != 2)
    for (int id = cblk; id < 256; id += G) {
        const int x = id & 7, j = id >> 3, bhi = x * 2 + (j >> 4), qt16 = j & 15, b = bhi >> 2, h = bhi & 3; const size_t bh = (size_t)bhi;
        const bf16_t* q = (const bf16_t*)(p.ws + WS_MLQ) + (bh * SEQ + qt16 * 128 + wid * 16) * 192;
        const bf16_t* k = (const bf16_t*)(p.ws + WS_MLK) + bh * SEQ * 192; const bf16_t* v = (const bf16_t*)(p.ws + WS_MLVT) + bh * SEQ * 128;
        bf16_t* o = br + (size_t)(b * SEQ + qt16 * 128 + wid * 16) * DM + 512 + h * 128;
        attn_unit<192, 128, 0, 1>(lds, q, k, v, o, 64, 0, 64, 0, 0, 0, kb_mla, 0.f, 0.f, tid, lane);
    }
    if (pmode != 1)
    for (;;) {
        if (tid == 0) qw[0] = 256 + (int)__hip_atomic_fetch_add(head, 1u, __ATOMIC_RELAXED, __HIP_MEMORY_SCOPE_AGENT);
        __syncthreads();
        const int id = __builtin_amdgcn_readfirstlane(qw[0]);
        __syncthreads();
        if (id >= 896) break;
        if (id < 256) {
        } else if (id < 512) {
            const int u = id - 256, b = u >> 6, h = (u >> 4) & 3, r2 = u & 15; const size_t bh = (size_t)(b * 4 + h);
            const int r = r2 * 2 + (wid >> 2), half = (wid >> 1) & 1, qs = wid & 1;
            int kr_lo = r2 * 2 - 4; kr_lo = kr_lo < 0 ? 0 : (kr_lo > 24 ? 24 : kr_lo);
            int kr_hi = r2 * 2 + 1 - 4; kr_hi = (kr_hi < 0 ? 0 : (kr_hi > 24 ? 24 : kr_hi)) + 7;
            int rs = r - 4; rs = rs < 0 ? 0 : (rs > 24 ? 24 : rs);
            float bmax;
            { const float* rp = p.in[I_NA_RPB] + ((size_t)l * 4 + h) * 15 * 31; LAS float* rl = (LAS float*)(lds + ATT_RPB_OFF); float bv = 0.f;
              if (tid < 465) { bv = rp[tid] * LOG2E; rl[tid] = bv; }
              bv = fabsf(bv);
#pragma unroll
              for (int o2 = 32; o2 >= 1; o2 >>= 1) bv = fmaxf(bv, __shfl_xor(bv, o2));
              if (lane == 0) rl[480 + wid] = bv;
              __syncthreads();
              bmax = fmaxf(fmaxf(fmaxf(rl[480], rl[481]), fmaxf(rl[482], rl[483])), fmaxf(fmaxf(rl[484], rl[485]), fmaxf(rl[486], rl[487]))); }
            const int qtok = r * 64 + half * 32 + qs * 16;
            const bf16_t* q = (const bf16_t*)(p.ws + WS_NAQ) + (bh * SEQ + qtok) * 128;
            const bf16_t* k = (const bf16_t*)(p.ws + WS_NAK) + (bh * SEQ + kr_lo * 64) * 128; const bf16_t* v = (const bf16_t*)(p.ws + WS_NAVT) + (bh * 64 + kr_lo * 2) * 128 * 32;
            bf16_t* o = br + (size_t)(b * SEQ + qtok) * DM + 0 + h * 128;
            attn_unit<128, 128, 2, 1>(lds, q, k, v, o, 2 * (kr_hi - kr_lo + 1), 2 * (rs - kr_lo), 2 * (rs - kr_lo) + 16, half * 32 + qs * 16, kr_lo, r, kb_na, bmax, 0.f, tid, lane);
        } else if (id < 768) {
            const int u = id - 512, b = u >> 6, kvh = (u >> 5) & 1, qb = u & 31, q0 = qb * 64; const int hq = kvh * 4 + (wid >> 1), qpos0 = q0 + (wid & 1) * 32;
            const int kstart = q0 - 128 < 0 ? 0 : q0 - 128, kend = q0 + 192 > SEQ ? SEQ : q0 + 192, nch = (kend - kstart) >> 5;
            int c_lo = (qpos0 - 128 - kstart) >> 5; c_lo = c_lo < 0 ? 0 : c_lo; int c_hi = ((qpos0 + 159 - kstart) >> 5) + 1; c_hi = c_hi > nch ? nch : c_hi;
            const bf16_t* q = (const bf16_t*)(p.ws + WS_SWQ) + ((size_t)(b * 8 + hq) * SEQ + qpos0) * 64;
            const bf16_t* k = (const bf16_t*)(p.ws + WS_SWK) + ((size_t)(b * 2 + kvh) * SEQ + kstart) * 64; const bf16_t* v = (const bf16_t*)(p.ws + WS_SWVT) + ((size_t)(b * 2 + kvh) * 64 + (kstart >> 5)) * 64 * 32;
            bf16_t* o = br + (size_t)(b * SEQ + qpos0) * DM + 1024 + hq * 64;
            attn_unit<64, 64, 1, 2>(lds, q, k, v, o, nch, c_lo, c_hi, qpos0, kstart, 0, kb_swa, 0.f, p.in[I_SWA_SINK][l * 8 + hq] * LOG2E, tid, lane);
        } else {
            const int u = id - 768, b = u >> 5, h = (u >> 3) & 3, qt8 = u & 7; const size_t bh = (size_t)(b * 4 + h);
            const bf16_t* q = (const bf16_t*)(p.ws + WS_MEQ) + (bh * SEQ + qt8 * 256 + wid * 32) * 128;
            const bf16_t* k = (const bf16_t*)(p.ws + WS_MEK) + bh * MEML * 128; const bf16_t* v = (const bf16_t*)(p.ws + WS_MEVT) + bh * MEML * 128;
            bf16_t* o = br + (size_t)(b * SEQ + qt8 * 256 + wid * 32) * DM + 1536 + h * 128;
            attn_unit<128, 128, 0, 2>(lds, q, k, v, o, 8, 0, 8, 0, 0, 0, kb_mem, 0.f, 0.f, tid, lane);
        }
    }
}

__device__ __forceinline__ void router_phase(const Params& p, LAS unsigned char* lds, int tid, int wid, int lane) {
    const float* hres = p.out; const float* g = p.in[I_NORM_FFN] + DM; const float* wr = p.in[I_ROUTER];
    unsigned* cnt = (unsigned*)(p.ws + WS_CTL) + CW_MOECNT;
    unsigned char* xg = p.ws + WS_XG; int* tokv = (int*)(p.ws + WS_TOK); float* wtv = (float*)(p.ws + WS_WT);
    LAS float* wl = (LAS float*)lds;
    LAS float* sel = (LAS float*)(lds + 65536);
    for (int i = tid; i < DM * NEXP; i += NTHREADS) { const int d = i >> 3, e = i & 7; wl[e * DM + d] = wr[i]; }
    __syncthreads();
    for (int grp = blockIdx.x; grp < NTOK / 32; grp += gridDim.x) {
#pragma unroll 1
        for (int ti = 0; ti < 4; ++ti) {
            const int tl = wid * 4 + ti, token = grp * 32 + tl;
            const f32x4* sp = (const f32x4*)(hres + (size_t)token * DM); f32x4 v[8]; float ss = 0.f;
#pragma unroll
            for (int j = 0; j < 8; ++j) { v[j] = sp[lane + 64 * j]; ss += v[j][0] * v[j][0] + v[j][1] * v[j][1] + v[j][2] * v[j][2] + v[j][3] * v[j][3]; }
            ss = wave_sum(ss); const float rstd = 1.0f / sqrtf(ss * (1.0f / DM) + EPS);
            float lg[8];
#pragma unroll
            for (int e = 0; e < 8; ++e) lg[e] = 0.f;
#pragma unroll
            for (int j = 0; j < 8; ++j) { const f32x4 gv = ((const f32x4*)g)[lane + 64 * j]; const f32x4 hn = v[j] * rstd * gv;
#pragma unroll
                for (int e = 0; e < 8; ++e) { const f32x4 w4 = *(const LAS f32x4*)(wl + e * DM + 4 * (lane + 64 * j)); lg[e] += hn[0] * w4[0] + hn[1] * w4[1] + hn[2] * w4[2] + hn[3] * w4[3]; } }
#pragma unroll
            for (int e = 0; e < 8; ++e) lg[e] = wave_sum(lg[e]);
            int i0 = 0; float v0 = lg[0];
#pragma unroll
            for (int e = 1; e < 8; ++e) if (lg[e] > v0) { v0 = lg[e]; i0 = e; }
            int i1 = -1; float v1 = -3.0e38f;
#pragma unroll
            for (int e = 0; e < 8; ++e) if (e != i0 && lg[e] > v1) { v1 = lg[e]; i1 = e; }
            const float e1 = __expf(v1 - v0), w0 = 1.0f / (1.0f + e1), w1 = e1 * w0;
            if (lane == 0) { sel[tl * 8 + 0] = __int_as_float(i0); sel[tl * 8 + 1] = __int_as_float(i1); sel[tl * 8 + 2] = w0; sel[tl * 8 + 3] = w1; sel[tl * 8 + 4] = rstd; }
        }
        __syncthreads();
        if (tid < NEXP) { int n = 0;
            for (int t = 0; t < 32; ++t) { n += (__float_as_int(sel[t * 8 + 0]) == tid) ? 1 : 0; n += (__float_as_int(sel[t * 8 + 1]) == tid) ? 1 : 0; }
            int base = n ? (int)__hip_atomic_fetch_add(cnt + tid * 64, (unsigned)n, __ATOMIC_RELAXED, __HIP_MEMORY_SCOPE_AGENT) : 0;
            for (int t = 0; t < 32; ++t) { if (__float_as_int(sel[t * 8 + 0]) == tid) sel[t * 8 + 5] = __int_as_float(base++); if (__float_as_int(sel[t * 8 + 1]) == tid) sel[t * 8 + 6] = __int_as_float(base++); } }
        __syncthreads();
#pragma unroll 1
        for (int ti = 0; ti < 4; ++ti) {
            const int tl = wid * 4 + ti, token = grp * 32 + tl;
            const int e0 = __float_as_int(sel[tl * 8 + 0]), e1 = __float_as_int(sel[tl * 8 + 1]); const float w0 = sel[tl * 8 + 2], w1 = sel[tl * 8 + 3], rstd = sel[tl * 8 + 4];
            const int s0 = e0 * ECAP + __float_as_int(sel[tl * 8 + 5]), s1 = e1 * ECAP + __float_as_int(sel[tl * 8 + 6]);
            const f32x4* sp = (const f32x4*)(hres + (size_t)token * DM);
#pragma unroll
            for (int j = 0; j < 8; ++j) { const f32x4 x = sp[lane + 64 * j]; const f32x4 gv = ((const f32x4*)g)[lane + 64 * j];
#if MOE_FP8
                const float rg = rstd * SC_ACT8; const unsigned w = pg8::pack_fp8x4(x[0] * rg * gv[0], x[1] * rg * gv[1], x[2] * rg * gv[2], x[3] * rg * gv[3]);
                *(unsigned*)(xg + (size_t)s0 * DM + 4 * (lane + 64 * j)) = w; *(unsigned*)(xg + (size_t)s1 * DM + 4 * (lane + 64 * j)) = w; }
#else
                u32x2 w; w.x = cvt_pk_bf16(x[0] * rstd * gv[0], x[1] * rstd * gv[1]); w.y = cvt_pk_bf16(x[2] * rstd * gv[2], x[3] * rstd * gv[3]);
                *(u32x2*)(xg + ((size_t)s0 * DM + 4 * (lane + 64 * j)) * 2) = w; *(u32x2*)(xg + ((size_t)s1 * DM + 4 * (lane + 64 * j)) * 2) = w; }
#endif
            if (lane == 0) { tokv[s0] = token; wtv[s0] = w0; tokv[s1] = token; wtv[s1] = w1; int* ts = (int*)(p.ws + WS_TSLOT); ts[token * 2] = s0; ts[token * 2 + 1] = s1; }
        }
        __syncthreads();
    }
}

constexpr int MOE_TAB_OFF = LDS_MISC + 128;
__device__ __forceinline__ void moe_table(LAS unsigned char* lds, const unsigned* cnt, int nN, int tid) {
    LAS int* tab = (LAS int*)(lds + MOE_TAB_OFF);
    __syncthreads();
    if (tid == 0) { int acc = 0; for (int e = 0; e < 8; ++e) { const int n = ((int)cnt[e * 64] + 255) >> 8; tab[e] = n; tab[8 + e] = acc; acc += n * nN; } tab[16] = acc; }
    __syncthreads();
}
struct SchedMoe {
    const char* A; const char* B; size_t a_estride, b_estride, a_tstride, b_tstride; const LAS int* tab; int G, c; int ksplit; size_t kbytes;
    __device__ __forceinline__ bool next(int i, pg8::Unit& u) const {
        const int L0 = i * G + c; if (L0 >= tab[16] * ksplit) return false;
        const int ks = L0 % ksplit, L = L0 / ksplit;
        int e = 0;
#pragma unroll
        for (int k = 1; k < 8; ++k) e = (L >= tab[8 + k]) ? k : e;
        const int ne = tab[e], loc = L - tab[8 + e], pn = (loc & 7) + 8 * (loc / (8 * ne)), pm = (loc >> 3) % ne;
        u.A = A + (size_t)e * a_estride + (size_t)pm * a_tstride + (size_t)ks * kbytes; u.B = B + (size_t)e * b_estride + (size_t)pn * b_tstride + (size_t)ks * kbytes;
        u.orow = e * ECAP + pm * 256; u.ocol = pn; u.x0 = e; u.x1 = pm * 256; u.ks = ks; u.pad_ = 0; return true;
    }
};
struct SchedMerge {
    const char* br; const char* wb; int G, c;
    __device__ __forceinline__ bool next(int i, pg8::Unit& u) const {
        int pm, pn; if (!pg8::static_tile(i >> 2, G, c, NTOK / 256, DM / 256, pm, pn)) return false;
        const int n = i & 3;
        u.A = br + ((size_t)pm * 256 * DM + n * 512) * 2; u.B = wb + ((size_t)n * DM * 512 + (size_t)pn * 256 * 512) * 2; u.orow = pm * 256; u.ocol = pn; u.x0 = n; u.x1 = 0; u.ks = 0; u.pad_ = 0; return true;
    }
};

__device__ __forceinline__ void moe_combine(const Params& p, int wid, int lane) {
    const int* ts = (const int*)(p.ws + WS_TSLOT); const bf16_t* y = (const bf16_t*)(p.ws + WS_Y); float* out = p.out;
    for (int row = blockIdx.x * 8 + wid; row < NTOK; row += gridDim.x * 8) {
        const int s0 = ts[row * 2], s1 = ts[row * 2 + 1];
        f32x4* o = (f32x4*)(out + (size_t)row * DM);
        u32x4 a[MOE_KS][4], b[MOE_KS][4]; f32x4 hv[8];
#pragma unroll
        for (int ks = 0; ks < MOE_KS; ++ks) { const u32x4* y0 = (const u32x4*)(y + ((size_t)ks * NEXP * ECAP + s0) * DM); const u32x4* y1 = (const u32x4*)(y + ((size_t)ks * NEXP * ECAP + s1) * DM);
#pragma unroll
            for (int j = 0; j < 4; ++j) { a[ks][j] = y0[lane + 64 * j]; b[ks][j] = y1[lane + 64 * j]; } }
#pragma unroll
        for (int j = 0; j < 4; ++j) { hv[2 * j] = o[2 * (lane + 64 * j)]; hv[2 * j + 1] = o[2 * (lane + 64 * j) + 1]; }
#pragma unroll
        for (int j = 0; j < 4; ++j) {
            f32x4 r0 = hv[2 * j], r1 = hv[2 * j + 1];
#pragma unroll
            for (int ks = 0; ks < MOE_KS; ++ks) { const u32x4 av = a[ks][j], bv = b[ks][j];
                r0[0] += bflo(av.x) + bflo(bv.x); r0[1] += bfhi(av.x) + bfhi(bv.x); r0[2] += bflo(av.y) + bflo(bv.y); r0[3] += bfhi(av.y) + bfhi(bv.y);
                r1[0] += bflo(av.z) + bflo(bv.z); r1[1] += bfhi(av.z) + bfhi(bv.z); r1[2] += bflo(av.w) + bflo(bv.w); r1[3] += bfhi(av.w) + bfhi(bv.w); }
            o[2 * (lane + 64 * j)] = r0; o[2 * (lane + 64 * j) + 1] = r1; }
    }
}

#ifdef PROBE_NAIVE
#ifndef NAIVE_TOL2
#define NAIVE_TOL2 0.0036f
#endif
__device__ __forceinline__ void nv_rope(float& x2, int lane, int pos) {
    const int i = lane & 31; const float freq = exp2f(-(float)i * (13.287712379549449f / 32.0f)); const float ang = (float)pos * freq;
    const double rev = (double)ang * 0.15915494309189535; const float fr_ = (float)(rev - __builtin_rint(rev));
    const float c = __builtin_amdgcn_cosf(fr_), s = __builtin_amdgcn_sinf(fr_); const float pr = __shfl_xor(x2, 32);
    x2 = lane < 32 ? x2 * c - pr * s : x2 * c + pr * s;
}
__device__ __forceinline__ void naive_check(const Params& p, unsigned* flag, int wid, int lane) {
    const int l = 1;
    const bf16_t* z = (const bf16_t*)(p.ws + WS_Z); const bf16_t* qraw = (const bf16_t*)(p.ws + WS_QRAW); const bf16_t* kvraw = (const bf16_t*)(p.ws + WS_KVRAW);
    const bf16_t* memkv = (const bf16_t*)(p.ws + WS_MEMKV) + (size_t)l * NMEM * 1024; const bf16_t* br = (const bf16_t*)(p.ws + WS_BR);
    const int poslist[16] = {0, 1, 31, 63, 64, 65, 127, 128, 129, 500, 1023, 1024, 1500, 1919, 1984, 2047};
    for (int unit = blockIdx.x * 8 + wid; unit < 64 * 20; unit += gridDim.x * 8) {
        const int smp = unit / 20, hh = unit % 20;
        int pos = 0;
#pragma unroll
        for (int q = 0; q < 16; ++q) pos = ((smp >> 2) == q) ? poslist[q] : pos;
        const int b = smp & 3, t = b * SEQ + pos;
        float o[3] = {0.f, 0.f, 0.f}, m = -3.0e38f, lsum = 0.f; float q[3] = {0.f, 0.f, 0.f};
        float ref[3] = {0.f, 0.f, 0.f}; int nd = 2;
        if (hh < 4) {
            const int h = hh; const float* gq = p.in[I_NA_QN] + l * 128; const float* gk = p.in[I_NA_KN] + l * 128;
            float ss = 0.f; for (int j = 0; j < 2; ++j) { q[j] = bf2f(z[(size_t)t * ZC + Z_NAQ + h * 128 + lane + 64 * j]); ss += q[j] * q[j]; }
            ss = wave_sum(ss); for (int j = 0; j < 2; ++j) q[j] *= (1.0f / sqrtf(ss / 128 + EPS)) * gq[lane + 64 * j];
            const int r = pos >> 6, c = pos & 63; int rs = r - 4; rs = rs < 0 ? 0 : (rs > 24 ? 24 : rs); int cs = c - 8; cs = cs < 0 ? 0 : (cs > 48 ? 48 : cs);
            for (int i = 0; i < 8; ++i) for (int jj = 0; jj < 16; ++jj) { const int n = b * SEQ + (rs + i) * 64 + cs + jj;
                float k[2], ks = 0.f; for (int j = 0; j < 2; ++j) { k[j] = bf2f(z[(size_t)n * ZC + Z_NAK + h * 128 + lane + 64 * j]); ks += k[j] * k[j]; }
                ks = wave_sum(ks); float dot = 0.f; for (int j = 0; j < 2; ++j) dot += q[j] * k[j] * (1.0f / sqrtf(ks / 128 + EPS)) * gk[lane + 64 * j];
                const float s = wave_sum(dot) * 0.08838834764831845f + p.in[I_NA_RPB][(((size_t)l * 4 + h) * 15 + (rs + i - r + 7)) * 31 + (cs + jj - c + 15)];
                const float mn = fmaxf(m, s), al = __expf(m - mn), pe = __expf(s - mn); m = mn; lsum = lsum * al + pe;
                for (int j = 0; j < 2; ++j) o[j] = o[j] * al + pe * bf2f(z[(size_t)n * ZC + Z_NAV + h * 128 + lane + 64 * j]); }
            for (int j = 0; j < 2; ++j) ref[j] = bf2f(br[(size_t)t * DM + 0 + h * 128 + lane + 64 * j]);
        } else if (hh < 8) {
            const int h = hh - 4; nd = 3; const float* gq = p.in[I_MLA_QN] + l * 192; const float* gk = p.in[I_MLA_KN] + l * 192;
            float ss = 0.f; for (int j = 0; j < 3; ++j) { q[j] = bf2f(qraw[(size_t)t * 768 + h * 192 + lane + 64 * j]); ss += q[j] * q[j]; }
            ss = wave_sum(ss); for (int j = 0; j < 3; ++j) q[j] *= (1.0f / sqrtf(ss / 192 + EPS)) * gq[lane + 64 * j];
            nv_rope(q[2], lane, pos);
            for (int kp = 0; kp < SEQ; ++kp) { const int n = b * SEQ + kp;
                float k[3], ks = 0.f; k[0] = bf2f(kvraw[(size_t)n * 1024 + h * 256 + lane]); k[1] = bf2f(kvraw[(size_t)n * 1024 + h * 256 + 64 + lane]); k[2] = bf2f(z[(size_t)n * ZC + Z_KPE + lane]);
                for (int j = 0; j < 3; ++j) ks += k[j] * k[j];
                ks = wave_sum(ks); const float rk = 1.0f / sqrtf(ks / 192 + EPS); for (int j = 0; j < 3; ++j) k[j] *= rk * gk[lane + 64 * j];
                nv_rope(k[2], lane, kp);
                float dot = 0.f; for (int j = 0; j < 3; ++j) dot += q[j] * k[j];
                const float s = wave_sum(dot) * 0.07216878364870322f;
                const float mn = fmaxf(m, s), al = __expf(m - mn), pe = __expf(s - mn); m = mn; lsum = lsum * al + pe;
                for (int j = 0; j < 2; ++j) o[j] = o[j] * al + pe * bf2f(kvraw[(size_t)n * 1024 + h * 256 + 128 + lane + 64 * j]); }
            nd = 2;
            for (int j = 0; j < 2; ++j) ref[j] = bf2f(br[(size_t)t * DM + 512 + h * 128 + lane + 64 * j]);
        } else if (hh < 16) {
            const int hq = hh - 8, kvh = hq >> 2; nd = 1; const float* gq = p.in[I_SWA_QN] + l * 64; const float* gk = p.in[I_SWA_KN] + l * 64;
            q[0] = bf2f(z[(size_t)t * ZC + Z_SWQ + hq * 64 + lane]); float ss = wave_sum(q[0] * q[0]); q[0] *= (1.0f / sqrtf(ss / 64 + EPS)) * gq[lane]; nv_rope(q[0], lane, pos);
            for (int kp = pos - 128; kp <= pos + 128; ++kp) { if (kp < 0 || kp >= SEQ) continue; const int n = b * SEQ + kp;
                float k = bf2f(z[(size_t)n * ZC + Z_SWK + kvh * 64 + lane]); const float ks = wave_sum(k * k); k *= (1.0f / sqrtf(ks / 64 + EPS)) * gk[lane]; nv_rope(k, lane, kp);
                const float s = wave_sum(q[0] * k) * 0.125f;
                const float mn = fmaxf(m, s), al = __expf(m - mn), pe = __expf(s - mn); m = mn; lsum = lsum * al + pe;
                o[0] = o[0] * al + pe * bf2f(z[(size_t)n * ZC + Z_SWV + kvh * 64 + lane]); }
            { const float s = p.in[I_SWA_SINK][l * 8 + hq]; const float mn = fmaxf(m, s), al = __expf(m - mn), pe = __expf(s - mn); m = mn; lsum = lsum * al + pe; o[0] *= al; }
            ref[0] = bf2f(br[(size_t)t * DM + 1024 + hq * 64 + lane]);
        } else {
            const int h = hh - 16; const float* gq = p.in[I_MEM_QN] + l * 128; const float* gk = p.in[I_MEM_KN] + l * 128;
            float ss = 0.f; for (int j = 0; j < 2; ++j) { q[j] = bf2f(z[(size_t)t * ZC + Z_MEQ + h * 128 + lane + 64 * j]); ss += q[j] * q[j]; }
            ss = wave_sum(ss); for (int j = 0; j < 2; ++j) q[j] *= (1.0f / sqrtf(ss / 128 + EPS)) * gq[lane + 64 * j];
            for (int mm = 0; mm < MEML; ++mm) { const size_t n = (size_t)(b * MEML + mm) * 1024;
                float k[2], ks = 0.f; for (int j = 0; j < 2; ++j) { k[j] = bf2f(memkv[n + h * 128 + lane + 64 * j]); ks += k[j] * k[j]; }
                ks = wave_sum(ks); float dot = 0.f; for (int j = 0; j < 2; ++j) dot += q[j] * k[j] * (1.0f / sqrtf(ks / 128 + EPS)) * gk[lane + 64 * j];
                const float s = wave_sum(dot) * 0.08838834764831845f;
                const float mn = fmaxf(m, s), al = __expf(m - mn), pe = __expf(s - mn); m = mn; lsum = lsum * al + pe;
                for (int j = 0; j < 2; ++j) o[j] = o[j] * al + pe * bf2f(memkv[n + 512 + h * 128 + lane + 64 * j]); }
            for (int j = 0; j < 2; ++j) ref[j] = bf2f(br[(size_t)t * DM + 1536 + h * 128 + lane + 64 * j]);
        }
        float e2 = 0.f, n2 = 0.f;
        for (int j = 0; j < 3; ++j) if (j < nd) { const float a = o[j] / lsum; e2 += (a - ref[j]) * (a - ref[j]); n2 += a * a; }
        e2 = wave_sum(e2); n2 = wave_sum(n2);
        if (!(e2 <= NAIVE_TOL2 * n2 + 1e-12f) && lane == 0) atomicOr(flag, 1u << (hh < 4 ? 1 : hh < 8 ? 2 : hh < 16 ? 3 : 4));
    }
}
#endif
#ifndef HEAVY_ALIGN
#define HEAVY_ALIGN true
#endif
constexpr int NPHASE = 23;
constexpr int LDS_PARAMS = LDS_MISC + 256;
template <class T> __device__ __forceinline__ T* uni(T* q) { const unsigned long long v = (unsigned long long)q; const unsigned lo = __builtin_amdgcn_readfirstlane((unsigned)v), hi = __builtin_amdgcn_readfirstlane((unsigned)(v >> 32)); return (T*)(__attribute__((address_space(1))) T*)(((unsigned long long)hi << 32) | lo); }
__device__ __forceinline__ Params load_params(LAS unsigned char* lds) {
    unsigned poff = LDS_PARAMS; asm volatile("" : "+v"(poff)); poff = __builtin_amdgcn_readfirstlane(poff);
    const LAS Params* P = (const LAS Params*)(lds + poff); Params p;
#pragma unroll
    for (int i = 0; i < 30; ++i) p.in[i] = uni(P->in[i]);
    p.out = uni(P->out); p.ws = uni(P->ws); p.ph_lo = __builtin_amdgcn_readfirstlane(P->ph_lo); p.ph_hi = __builtin_amdgcn_readfirstlane(P->ph_hi); return p;
}
#define PH_HEAD int tid = threadIdx.x; asm volatile("" : "+v"(tid)); const Params p = load_params(lds); const int lane = tid & 63, wid = __builtin_amdgcn_readfirstlane(tid >> 6); const int G = p.ph_lo, cblk = p.ph_hi;     \
    unsigned char* ws = p.ws; unsigned* ctl = (unsigned*)(ws + WS_CTL); unsigned char* lw = ws + WS_LW + (size_t)l * LW_BYTES; bf16_t* U = (bf16_t*)(ws + WS_U); (void)lane; (void)wid; (void)G; (void)cblk; (void)ctl; (void)lw; (void)U
#define PHASE_FN static __device__ __forceinline__ void

PHASE_FN ph_prologue(LAS unsigned char* lds, int l) { PH_HEAD; p0_prologue(p, lds, tid, wid, lane); }
PHASE_FN ph_ingate(LAS unsigned char* lds, int l) { PH_HEAD;
#if INGATE_FP8
    pg8::SchedGrid S{(const char*)(ws + WS_U8), (const char*)(lw + LW_IN), DM / 2, DM / 2, NTOK / 256, 12288 / 256, G, cblk};
    pg8::EpiInGate E{(bf16_t*)(ws + WS_Z), (bf16_t*)(ws + WS_GATES), p.in[I_B_GATE] + (size_t)l * 8192, 1.0f / (SC_ACT8 * SC_W8)};
    pg8::gemm_phase<pg8::EpiInGate, pg8::SchedGrid, true, HEAVY_ALIGN>(lds, DM / 2, DM / 2, DM / 2, S, E, tid);
#else
    pg8::SchedGrid S{(const char*)U, (const char*)(lw + LW_IN), DM, DM, NTOK / 256, 12288 / 256, G, cblk};
    pg8::EpiInGate E{(bf16_t*)(ws + WS_Z), (bf16_t*)(ws + WS_GATES), p.in[I_B_GATE] + (size_t)l * 8192, 1.0f};
    pg8::gemm_phase(lds, DM, DM, DM, S, E, tid);
#endif
}
PHASE_FN ph_inproj(LAS unsigned char* lds, int l) { PH_HEAD;
    const bool sh = l >= 2; l &= 1; lw = ws + WS_LW + (size_t)l * LW_BYTES;
    pg8::SchedGrid S{(const char*)U, (const char*)(lw + LW_IN), DM, DM, NTOK / 256, ZC / 256, G, cblk};
    pg8::EpiBf16 E{(bf16_t*)(ws + (sh ? WS_ACT : WS_Z)), ZC};
    pg8::gemm_phase(lds, DM, DM, DM, S, E, tid); }
PHASE_FN ph_gates(LAS unsigned char* lds, int l) { PH_HEAD;
#if GATES_FP8
    pg8::SchedGrid S{(const char*)(ws + WS_U8), (const char*)(lw + LW_GATE8), DM / 2, DM / 2, NTOK / 256, 8192 / 256, G, cblk};
    pg8::EpiGates E{(bf16_t*)(ws + WS_GATES), p.in[I_B_GATE] + (size_t)l * 8192, 1.0f / (SC_ACT8 * SC_W8)};
    pg8::gemm_phase<pg8::EpiGates, pg8::SchedGrid, true>(lds, DM / 2, DM / 2, DM / 2, S, E, tid);
#else
    pg8::SchedGrid S{(const char*)U, (const char*)(lw + LW_GATE8), DM, DM, NTOK / 256, 8192 / 256, G, cblk};
    pg8::EpiGates E{(bf16_t*)(ws + WS_GATES), p.in[I_B_GATE] + (size_t)l * 8192, 1.0f};
    pg8::gemm_phase<pg8::EpiGates, pg8::SchedGrid, false>(lds, DM, DM, DM, S, E, tid);
#endif
}
PHASE_FN ph_prep1(LAS unsigned char* lds, int l) { PH_HEAD; prep1(p, l, lds, tid, wid, lane); }
PHASE_FN ph_mlaup_q(LAS unsigned char* lds, int l) { PH_HEAD;
    pg8::SchedGrid S{(const char*)(ws + WS_CQN), (const char*)(lw + LW_UQ), 768, 768, NTOK / 256, 3, G, cblk};
    pg8::EpiBf16 E{(bf16_t*)(ws + WS_QRAW), 768}; pg8::gemm_phase(lds, 768, 768, 768, S, E, tid); }
PHASE_FN ph_mlaup_kv(LAS unsigned char* lds, int l) { PH_HEAD;
    pg8::SchedGrid S{(const char*)(ws + WS_CKVN), (const char*)(lw + LW_UKV), 256, 256, NTOK / 256, 4, G, (cblk + G - 96 % G) % G};
    pg8::EpiBf16 E{(bf16_t*)(ws + WS_KVRAW), 1024}; pg8::gemm_phase(lds, 256, 256, 256, S, E, tid); }
PHASE_FN ph_memkv(LAS unsigned char* lds, int l) { PH_HEAD;
    pg8::SchedGrid S{(const char*)(ws + WS_MEMN + (size_t)l * NMEM * DM * 2), (const char*)(lw + LW_MEMKV), DM, DM, NMEM / 256, 4, G, (cblk + G - (224 + 16 * l) % G) % G};
    pg8::EpiBf16 E{(bf16_t*)(ws + WS_MEMKV) + (size_t)l * NMEM * 1024, 1024}; pg8::gemm_phase(lds, DM, DM, DM, S, E, tid); }
PHASE_FN ph_prep2(LAS unsigned char* lds, int l) { PH_HEAD; prep2(p, l, lds, tid, wid, lane); }
PHASE_FN ph_attn(LAS unsigned char* lds, int l) { PH_HEAD; attn_phase(p, l, lds, tid, wid, lane, G, cblk); }
PHASE_FN ph_merge(LAS unsigned char* lds, int l) { PH_HEAD;
    SchedMerge S{(const char*)(ws + WS_BR), (const char*)(lw + LW_BR), G, cblk};
    pg8::EpiMerge E{(const bf16_t*)(ws + WS_GATES), (bf16_t*)(ws + WS_MERGED)};
#ifndef MERGE_ALIGN
#define MERGE_ALIGN false
#endif
    pg8::gemm_phase<pg8::EpiMerge, SchedMerge, false, MERGE_ALIGN>(lds, DM, 512, 512, S, E, tid); }
PHASE_FN ph_wo(LAS unsigned char* lds, int l) { PH_HEAD;
    pg8::SchedGrid S{(const char*)(ws + WS_MERGED), (const char*)(lw + LW_O), DM, DM, NTOK / 256, DM / 256, G, cblk};
    pg8::EpiResF32 E{l == 0 ? p.in[I_X] : (const float*)p.out, p.out, 1.0f};
    pg8::gemm_phase(lds, DM, DM, DM, S, E, tid); }
PHASE_FN ph_norm(LAS unsigned char* lds, int l) { PH_HEAD;
    norm_rows(p.out, l == 0 ? p.in[I_NORM_FFN] : p.in[I_NORM_MIX] + DM, U, l == 0 ? nullptr : ws + WS_U8, NTOK, wid, lane); }
PHASE_FN ph_ffnup(LAS unsigned char* lds, int l) { PH_HEAD;
    pg8::SchedGrid S{(const char*)U, (const char*)(ws + WS_FFNUP), DM, DM, NTOK / 256, 2 * DFF / 256, G, cblk};
    pg8::EpiSwiGLU E{(bf16_t*)(ws + WS_ACT), DFF};
    pg8::gemm_phase<pg8::EpiSwiGLU, pg8::SchedGrid, false, HEAVY_ALIGN>(lds, DM, DM, DM, S, E, tid); }
PHASE_FN ph_ffndown(LAS unsigned char* lds, int l) { PH_HEAD;
    pg8::SchedGrid S{(const char*)(ws + WS_ACT), (const char*)(ws + WS_FFNDN), DFF, DFF, NTOK / 256, DM / 256, G, cblk};
    pg8::EpiResF32 E{(const float*)p.out, p.out, 1.0f};
    pg8::gemm_phase(lds, DFF, DFF, DFF, S, E, tid); }
PHASE_FN ph_router(LAS unsigned char* lds, int l) { PH_HEAD; router_phase(p, lds, tid, wid, lane); }
PHASE_FN ph_moeup(LAS unsigned char* lds, int l) { PH_HEAD;
    moe_table(lds, ctl + CW_MOECNT, 2 * DFFE / 256, tid);
    const SchedMoe S{(const char*)(ws + WS_XG), (const char*)(ws + WS_MOEUP), (size_t)ECAP * DM * MOE_ES, (size_t)2 * DFFE * DM * MOE_ES, (size_t)256 * DM * MOE_ES, (size_t)256 * DM * MOE_ES, (const LAS int*)(lds + MOE_TAB_OFF), G, cblk, 1, 0};
#if MOE_FP8
    pg8::EpiSwiGLU8 E{ws + WS_ACTM, DFFE, 1.0f / (SC_ACT8 * SC_W8), SC_H8};
    pg8::gemm_phase<pg8::EpiSwiGLU8, SchedMoe, true, HEAVY_ALIGN>(lds, DM / 2, DM / 2, DM / 2, S, E, tid);
#else
    pg8::EpiSwiGLU E{(bf16_t*)(ws + WS_ACTM), DFFE};
    pg8::gemm_phase(lds, DM, DM, DM, S, E, tid);
#endif
}
#ifndef MOE_KSPLIT
#define MOE_KSPLIT MOE_KS
#endif
PHASE_FN ph_moedown(LAS unsigned char* lds, int l) { PH_HEAD;
    moe_table(lds, ctl + CW_MOECNT, DM / 256, tid);
    const SchedMoe S{(const char*)(ws + WS_ACTM), (const char*)(ws + WS_MOEDN), (size_t)ECAP * DFFE * MOE_ES, (size_t)DM * DFFE * MOE_ES, (size_t)256 * DFFE * MOE_ES, (size_t)256 * DFFE * MOE_ES, (const LAS int*)(lds + MOE_TAB_OFF), G, cblk, MOE_KSPLIT, (size_t)DFFE * MOE_ES / MOE_KSPLIT};
#if MOE_FP8
    pg8::EpiMoeDownY E{(bf16_t*)(ws + WS_Y), (const float*)(ws + WS_WT), ctl + CW_MOECNT, 1.0f / (SC_H8 * SC_W8)};
    pg8::gemm_phase<pg8::EpiMoeDownY, SchedMoe, true>(lds, DFFE / 2, DFFE / 2, DFFE / 2 / MOE_KSPLIT, S, E, tid);
#else
    pg8::EpiMoeDown E{p.out, (const int*)(ws + WS_TOK), (const float*)(ws + WS_WT), ctl + CW_MOECNT, 1.0f};
    pg8::gemm_phase(lds, DFFE, DFFE, DFFE / MOE_KSPLIT, S, E, tid);
#endif
}


#ifndef PROBE_CHK
#define PROBE_CHK 0
#endif
constexpr int CW_CHKFLAG = 4096 + 2048;
PHASE_FN ph_compare(LAS unsigned char* lds, int l, size_t offa, size_t offb, size_t nbytes) { PH_HEAD;
    const u32x4* a = (const u32x4*)(ws + offa); const u32x4* b = (const u32x4*)(ws + offb); unsigned bad = 0;
    for (size_t i = (size_t)cblk * NTHREADS + tid; i < nbytes / 16; i += (size_t)G * NTHREADS) { const u32x4 x = a[i], y = b[i]; bad |= (x.x ^ y.x) | (x.y ^ y.y) | (x.z ^ y.z) | (x.w ^ y.w); }
    if (bad) atomicOr(ctl + CW_CHKFLAG, 1u); }
#ifdef PROBE_NAIVE
PHASE_FN ph_naive(LAS unsigned char* lds, int l) { PH_HEAD; naive_check(p, ctl + CW_CHKFLAG, wid, lane); }
#endif
PHASE_FN ph_poison(LAS unsigned char* lds, int l) { PH_HEAD;
    if (__hip_atomic_load(ctl + CW_CHKFLAG, __ATOMIC_RELAXED, __HIP_MEMORY_SCOPE_AGENT) != 0u && tid == 0) p.out[cblk] = __builtin_nanf(""); }
PHASE_FN ph_combine(LAS unsigned char* lds, int l) { PH_HEAD; moe_combine(p, wid, lane); }
__global__ void __launch_bounds__(NTHREADS, 2) mk_fwd(Params pk) {
    extern __shared__ __attribute__((aligned(16))) unsigned char lds_raw[];
    LAS unsigned char* lds = (LAS unsigned char*)lds_raw;
    const int tid = threadIdx.x;
    if (tid < 64) ((LAS unsigned*)(lds + LDS_MISC))[tid] = 0u;
    if (tid == 64) { LAS Params* P = (LAS Params*)(lds + LDS_PARAMS);
#pragma unroll
        for (int i = 0; i < 30; ++i) P->in[i] = pk.in[i];
        P->out = pk.out; P->ws = pk.ws; P->ph_lo = (int)gridDim.x; P->ph_hi = (int)blockIdx.x; }
    __syncthreads();
    unsigned* ctl = (unsigned*)(pk.ws + WS_CTL);
#if !MK_MULTI
    (void)xcd_barrier_post(ctl + CW_BAR, (volatile LAS unsigned*)(lds + LDS_MISC));
#endif
#ifdef ONLY_FN
    ONLY_FN(lds, pk.ph_lo); return;
#endif
    const int lo = pk.ph_lo, hi = pk.ph_hi;
#define IN(k) (lo <= (k) && (k) < hi)
#if MK_MULTI
#define SEAM(k) do { } while (0)
#else
#ifndef PROBE_BAR
#define PROBE_BAR 0
#endif
#define SEAM(k) do { for (int rep_ = 0; rep_ < 1 + PROBE_BAR; ++rep_) if (IN((k) + 1)) { const Params q_ = load_params(lds); XcdBarrier b2_; b2_.bar = (unsigned*)(q_.ws + WS_CTL) + CW_BAR; b2_.x = xb_xcc_id(); b2_.st = (volatile LAS unsigned*)(lds + LDS_MISC); xcd_barrier(b2_); } } while (0)
#endif
#ifndef PROBE_P0
#define PROBE_P0 0
#endif
#ifndef PROBE_DUP
#define PROBE_DUP 0
#endif
#define DUP(bit) ((PROBE_DUP >> (bit)) & 1)
#ifndef PROBE_ATTN
#define PROBE_ATTN 0
#endif
#ifndef PROBE_THIN
#define PROBE_THIN 0
#endif
    if (IN(0)) { ph_prologue(lds, 0); if (PROBE_P0) { __syncthreads(); ph_prologue(lds, 0); } SEAM(0); }
#pragma unroll 1
    for (int l = 0; l < DEPTH; ++l) {
        const int pb = 1 + 11 * l;
#ifndef SPLIT_INGATE
#define SPLIT_INGATE 0
#endif
        if (IN(pb + 0)) { if (SPLIT_INGATE == 1) { ph_inproj(lds, l); __syncthreads(); ph_gates(lds, l); } else if (SPLIT_INGATE == 2) { ph_ingate(lds, l); SEAM(pb + 0); ph_inproj(lds, l); } else if (SPLIT_INGATE == 3) { ph_ingate(lds, l); SEAM(pb + 0); ph_gates(lds, l); } else { ph_ingate(lds, l); if (DUP(0)) ph_ingate(lds, l); } if (PROBE_CHK == 2) ph_inproj(lds, l + 2); SEAM(pb + 0);
            if (PROBE_CHK == 2) { ph_compare(lds, l, WS_Z, WS_ACT, (size_t)NTOK * ZC * 2); SEAM(pb + 0); } }
        if (IN(pb + 1)) { ph_prep1(lds, l); if (PROBE_THIN) { __syncthreads(); ph_prep1(lds, l); } SEAM(pb + 1); }
        if (IN(pb + 2)) { for (int rep = 0; rep < 1 + DUP(1); ++rep) { ph_mlaup_q(lds, l); ph_mlaup_kv(lds, l); if (l == 0) { ph_memkv(lds, 0); ph_memkv(lds, 1); } } SEAM(pb + 2); }
        if (IN(pb + 3)) { ph_prep2(lds, l); if (PROBE_THIN) { __syncthreads(); ph_prep2(lds, l); } SEAM(pb + 3); }
        if (IN(pb + 4)) { ph_attn(lds, l); if (PROBE_ATTN || PROBE_CHK == 1) { __syncthreads(); ph_attn(lds, l + 2 + 4 * (PROBE_ATTN > 1 ? PROBE_ATTN - 1 : 0)); } SEAM(pb + 4);
            if (PROBE_CHK == 1) { ph_compare(lds, l, WS_BR, WS_ACT, (size_t)NTOK * DM * 2); SEAM(pb + 4); } }
        if (IN(pb + 5)) { ph_merge(lds, l); if (DUP(2)) ph_merge(lds, l); SEAM(pb + 5); }
        if (IN(pb + 6)) { ph_wo(lds, l); if (DUP(3) && l == 0) ph_wo(lds, l); SEAM(pb + 6); }
        if (l == 0) {
            if (IN(pb + 7)) { ph_norm(lds, 0); if (PROBE_THIN) { __syncthreads(); ph_norm(lds, 0); } SEAM(pb + 7); }
            if (IN(pb + 8)) { ph_ffnup(lds, 0); if (DUP(4)) ph_ffnup(lds, 0); SEAM(pb + 8); }
            if (IN(pb + 9)) { ph_ffndown(lds, 0); SEAM(pb + 9); }
            if (IN(pb + 10)) { ph_norm(lds, 1); if (PROBE_THIN) { __syncthreads(); ph_norm(lds, 1); } SEAM(pb + 10); }
        } else {
            if (IN(pb + 7)) { ph_router(lds, 1); SEAM(pb + 7); }
            if (IN(pb + 8)) { ph_moeup(lds, 1); if (DUP(5)) ph_moeup(lds, 1); SEAM(pb + 8); }
            if (IN(pb + 9)) { ph_moedown(lds, 1); if (DUP(6)) ph_moedown(lds, 1); SEAM(pb + 8); ph_combine(lds, 1);
#ifdef PROBE_NAIVE
                ph_naive(lds, 1); SEAM(pb + 8); ph_poison(lds, 1);
#endif
                if (PROBE_CHK) { SEAM(pb + 8); ph_poison(lds, 1); } }
        }
    }
#undef IN
#undef SEAM
}

extern "C" void kernel_launch(void* const* d_in, const int* in_sizes, int n_in, void* d_out, int out_size, void* d_ws, size_t ws_size, hipStream_t stream) {
    static int grid = 0;
    if (grid == 0) {
        if (n_in != 30 || out_size != NTOK * DM || ws_size < WS_END) { fprintf(stderr, "kernel_launch: unexpected problem (n_in %d, out %d, ws %zu < %zu)\n", n_in, out_size, ws_size, (size_t)WS_END); grid = -1; return; }
        int dev = 0, cus = 0, per_cu = 0;
        if (hipGetDevice(&dev) != hipSuccess || hipDeviceGetAttribute(&cus, hipDeviceAttributeMultiprocessorCount, dev) != hipSuccess) { grid = -1; return; }
        if (hipFuncSetAttribute((const void*)mk_fwd, hipFuncAttributeMaxDynamicSharedMemorySize, LDS_BYTES) != hipSuccess) { fprintf(stderr, "kernel_launch: hipFuncSetAttribute failed\n"); grid = -1; return; }
        if (hipOccupancyMaxActiveBlocksPerMultiprocessor(&per_cu, (const void*)mk_fwd, NTHREADS, LDS_BYTES) != hipSuccess || per_cu < 1) fprintf(stderr, "kernel_launch: occupancy query reports %d\n", per_cu);
        (void)hipGetLastError();
        grid = cus;
    }
    if (grid < 0) return;
    if (hipMemsetAsync((char*)d_ws + WS_CTL, 0, CTL_BYTES, stream) != hipSuccess) return;
    Params a{};
    for (int i = 0; i < 30; ++i) a.in[i] = (const float*)d_in[i];
    a.out = (float*)d_out; a.ws = (unsigned char*)d_ws;
#if MK_MULTI
    for (int ph = 0; ph < NPHASE - 1; ++ph) { a.ph_lo = ph; a.ph_hi = ph + 1; hipLaunchKernelGGL(mk_fwd, dim3(grid), dim3(NTHREADS), LDS_BYTES, stream, a); }
#else
    a.ph_lo = 0; a.ph_hi = NPHASE;
    hipLaunchKernelGGL(mk_fwd, dim3(grid), dim3(NTHREADS), LDS_BYTES, stream, a);
#endif
    const hipError_t le = hipPeekAtLastError();
    if (le != hipSuccess) fprintf(stderr, "kernel_launch: launch failed: %s\n", hipGetErrorName(le));
}
```

```cpp
#include <hip/hip_runtime.h>
#include <cstdio>
#include <cstdint>

#define LAS __attribute__((address_space(3)))
typedef unsigned short bf16_t;
typedef short bf16x8 __attribute__((ext_vector_type(8)));
typedef float f32x4 __attribute__((ext_vector_type(4)));
typedef float f32x2 __attribute__((ext_vector_type(2)));
typedef unsigned u32x4 __attribute__((ext_vector_type(4)));
typedef unsigned u32x2 __attribute__((ext_vector_type(2)));

#ifndef MK_MULTI
#define MK_MULTI 0
#endif

constexpr int DM = 2048, NBATCH = 4, SEQ = 2048, NTOK = NBATCH * SEQ, MEML = 256, NMEM = NBATCH * MEML, DEPTH = 2;
constexpr int ZC = 4096;
constexpr int INC = 3904;
constexpr int Z_NAQ = 0, Z_NAK = 512, Z_NAV = 1024, Z_CQ = 1536, Z_CKV = 2304, Z_KPE = 2560, Z_SWQ = 2624, Z_SWK = 3136, Z_SWV = 3264, Z_MEQ = 3392;
constexpr int DFF = 5632, NEXP = 8, DFFE = 7168, ECAP = 8192;
constexpr float LOG2E = 1.4426950408889634f;
constexpr float EPS = 1e-6f;
constexpr int NTHREADS = 512;
constexpr float SC_ACT8 = 16.0f, SC_W8 = 64.0f, SC_H8 = 8.0f;

constexpr size_t al256(size_t x) { return (x + 255) & ~(size_t)255; }
constexpr size_t WS_CTL = 0, CTL_BYTES = 65536;
constexpr size_t WS_ROPE = WS_CTL + CTL_BYTES;
constexpr size_t WS_LW = WS_ROPE + (size_t)SEQ * 32 * 8;
constexpr size_t LW_IN = 0;
constexpr size_t LW_GATE8 = LW_IN + (size_t)4096 * 2048 * 2;
#ifndef INGATE_FP8
#define INGATE_FP8 1
#endif
#define GATES_FP8 0
#ifndef MOE_FP8
#define MOE_FP8 1
#endif
constexpr size_t MOE_ES = MOE_FP8 ? 1 : 2;
constexpr size_t LW_UQ = LW_GATE8 + (size_t)8192 * 2048 * 2;
constexpr size_t LW_UKV = LW_UQ + (size_t)768 * 768 * 2;
constexpr size_t LW_MEMKV = LW_UKV + (size_t)1024 * 256 * 2;
constexpr size_t LW_BR = LW_MEMKV + (size_t)1024 * 2048 * 2;
constexpr size_t LW_O = LW_BR + (size_t)4 * 2048 * 512 * 2;
constexpr size_t LW_BYTES = LW_O + (size_t)2048 * 2048 * 2;
constexpr size_t WS_FFNUP = WS_LW + 2 * LW_BYTES;
constexpr size_t WS_FFNDN = WS_FFNUP + (size_t)2 * DFF * 2048 * 2;
constexpr size_t WS_MOEUP = WS_FFNDN + (size_t)2048 * DFF * 2;
constexpr size_t WS_MOEDN = WS_MOEUP + (size_t)NEXP * 2 * DFFE * 2048 * MOE_ES;
constexpr size_t WS_U = WS_MOEDN + (size_t)NEXP * 2048 * DFFE * MOE_ES;
constexpr size_t WS_U8 = WS_U + (size_t)NTOK * DM * 2;
constexpr size_t WS_MEMN = WS_U8 + (size_t)NTOK * DM;
constexpr size_t WS_Z = WS_MEMN + (size_t)2 * NMEM * DM * 2;
constexpr size_t WS_GATES = WS_Z + (size_t)NTOK * ZC * 2;
constexpr size_t WS_NAQ = WS_GATES + (size_t)NTOK * 8192 * 2;
constexpr size_t WS_NAK = WS_NAQ + (size_t)NTOK * 512 * 2;
constexpr size_t WS_NAVT = WS_NAK + (size_t)NTOK * 512 * 2;
constexpr size_t WS_CQN = WS_NAVT + (size_t)NTOK * 512 * 2;
constexpr size_t WS_CKVN = WS_CQN + (size_t)NTOK * 768 * 2;
constexpr size_t WS_SWQ = WS_CKVN + (size_t)NTOK * 256 * 2;
constexpr size_t WS_SWK = WS_SWQ + (size_t)NTOK * 512 * 2;
constexpr size_t WS_SWVT = WS_SWK + (size_t)NTOK * 128 * 2;
constexpr size_t WS_MEQ = WS_SWVT + (size_t)NTOK * 128 * 2;
constexpr size_t WS_QRAW = WS_MEQ + (size_t)NTOK * 512 * 2;
constexpr size_t WS_KVRAW = WS_QRAW + (size_t)NTOK * 768 * 2;
constexpr size_t WS_MEMKV = WS_KVRAW + (size_t)NTOK * 1024 * 2;
constexpr size_t WS_MLQ = WS_MEMKV + (size_t)2 * NMEM * 1024 * 2;
constexpr size_t WS_MLK = WS_MLQ + (size_t)NTOK * 768 * 2;
constexpr size_t WS_MLVT = WS_MLK + (size_t)NTOK * 768 * 2;
constexpr size_t WS_MEK = WS_MLVT + (size_t)NTOK * 512 * 2;
constexpr size_t WS_MEVT = WS_MEK + (size_t)NMEM * 512 * 2;
constexpr size_t WS_BR = WS_MEVT + (size_t)NMEM * 512 * 2;
constexpr size_t WS_MERGED = WS_BR + (size_t)NTOK * DM * 2;
constexpr size_t WS_ACT = WS_MERGED + (size_t)NTOK * DM * 2;
constexpr size_t WS_XG = WS_ACT + (size_t)NTOK * DFF * 2;
constexpr size_t WS_TOK = WS_XG + (size_t)NEXP * ECAP * DM * MOE_ES;
constexpr size_t WS_WT = WS_TOK + (size_t)NEXP * ECAP * 4;
constexpr size_t WS_ACTM = WS_WT + (size_t)NEXP * ECAP * 4;
constexpr size_t WS_Y = WS_ACTM + (size_t)NEXP * ECAP * DFFE * MOE_ES;
constexpr int MOE_KS = 2;
constexpr size_t WS_TSLOT = WS_Y + (size_t)MOE_KS * NEXP * ECAP * DM * 2;
constexpr size_t WS_END = WS_TSLOT + (size_t)NTOK * 2 * 4;

constexpr int CW_BAR = 0;
constexpr int CW_MOECNT = 4096;
constexpr int CW_ATTQ = 4096 + 1024;

constexpr int LDS_BYTES = 147456;
constexpr int LDS_MISC = 147456 - 1024;
namespace pg8 {
constexpr int BM = 256, BK = 64, HALF = 128, HTB = HALF * BK * 2, STAGE_BYTES = 8 * HTB, NXCD = 8, WGM = 8;
__host__ __device__ __forceinline__ int lds_byte(int r, int c) { const int st = (r >> 4) * 2 + (c >> 5), rr = r & 15, cc = c & 31, ob = rr * 64 + cc * 2; return st * 1024 + (ob ^ (((ob >> 9) & 1) << 5)); }
__host__ __device__ __forceinline__ void stage_rc(int b, int& R, int& C) { const int st = b / 1024, sb = b % 1024, swz = sb ^ (((sb >> 9) & 1) << 5); R = (st >> 1) * 16 + swz / 64; C = (st & 1) * 32 + (swz % 64) / 2; }
__host__ __device__ __forceinline__ int perm32(int rho) { const int n = rho >> 4, i = rho & 15; return 8 * (i >> 2) + 4 * n + (i & 3); }

struct Unit { const char* A; const char* B; int orow, ocol, x0, x1, ks, pad_; };

__device__ __forceinline__ bool static_tile(int i, int G, int c, int nM, int nN, int& pm, int& pn) {
    const int nwg = nM * nN; const long L = (long)i * G + c; if (L >= nwg) return false;
    int wgid = (int)L; { const int q = nwg / NXCD, r = nwg % NXCD, xcd = wgid % NXCD, off = wgid / NXCD; wgid = (xcd < r ? xcd * (q + 1) : r * (q + 1) + (xcd - r) * q) + off; }
    const int nig = WGM * nN, gid = wgid / nig, fm = gid * WGM, gsz = (nM - fm) < WGM ? (nM - fm) : WGM;
    pm = fm + ((wgid % nig) % gsz); pn = (wgid % nig) / gsz; return true;
}
struct SchedGrid {
    const char* A; const char* B; int lda, ldb, nM, nN, G, c;
    __device__ __forceinline__ bool next(int i, Unit& u) const {
        int pm, pn; if (!static_tile(i, G, c, nM, nN, pm, pn)) return false;
        u.A = A + (size_t)pm * 256 * lda * 2; u.B = B + (size_t)pn * 256 * ldb * 2; u.orow = pm * 256; u.ocol = pn; u.x0 = 0; u.x1 = 0; u.ks = 0; u.pad_ = 0; return true;
    }
};

__device__ __forceinline__ unsigned cvt_pk_bf16(float lo, float hi) { unsigned r; asm volatile("v_cvt_pk_bf16_f32 %0, %1, %2" : "=v"(r) : "v"(lo), "v"(hi)); return r; }
__device__ __forceinline__ float sigmoidf_(float x) { return __builtin_amdgcn_rcpf(1.0f + __builtin_amdgcn_exp2f(-x * LOG2E)); }
__device__ __forceinline__ void sigmoid2(float& x, float& y) {
    const float cx = fminf(fmaxf(x, -40.f), 40.f), cy = fminf(fmaxf(y, -40.f), 40.f);
    const float a = 1.0f + __builtin_amdgcn_exp2f(-cx * LOG2E), b = 1.0f + __builtin_amdgcn_exp2f(-cy * LOG2E), r = __builtin_amdgcn_rcpf(a * b);
    x = b * r; y = a * r; }

typedef f32x4 Acc[2][2][4][2];

typedef int i32x8 __attribute__((ext_vector_type(8)));
typedef int i32x4 __attribute__((ext_vector_type(4)));
template <class Epi, class Sched, bool FP8 = false, bool ALIGN_EPI = true>
__device__ __forceinline__ void gemm_phase(LAS unsigned char* lds, const int lda, const int ldb, const int K, const Sched S, Epi& E, const int tid) {
    const int wid = __builtin_amdgcn_readfirstlane(tid >> 6), lane = tid & 63, wr = wid >> 2, wc = wid & 3, fr = lane & 15, fq = lane >> 4;
    const int nt = K / BK;
    unsigned voffA[2], voffB[2];
#pragma unroll
    for (int i = 0; i < 2; ++i) { int R, C; stage_rc(tid * 16 + i * 8192, R, C); const int Rb = Epi::PERM ? ((R & ~31) + perm32(R & 31)) : R;
        voffA[i] = (unsigned)(R * lda + C) * 2u; voffB[i] = (unsigned)(Rb * ldb + C) * 2u; }
    const size_t kstep = (size_t)(BK * 2);
    const size_t hstepA = (size_t)HALF * lda * 2, hstepB = (size_t)HALF * ldb * 2;
    const unsigned ldsw = (unsigned)wid * 1024u;
    const int aoff = lds_byte(wr * 64 + fr, fq * 8), boff = lds_byte(wc * 32 + fr, fq * 8);
#define PG8_SA(b, h) (((b) * 2 + (h)) * HTB)
#define PG8_SB(b, h) ((4 + (b) * 2 + (h)) * HTB)
#define PG8_STAGE(bufoff, gbase, voff) do { _Pragma("unroll") for (int _i = 0; _i < 2; ++_i) \
        __builtin_amdgcn_global_load_lds((const unsigned*)((const char*)(gbase) + (voff)[_i]), (LAS unsigned*)(lds + (bufoff) + ldsw + _i * 8192), 16, 0, 0); } while (0)
#define PG8_LDA(dst, b, h) do { _Pragma("unroll") for (int m = 0; m < 4; ++m) _Pragma("unroll") for (int k = 0; k < 2; ++k) dst[m][k] = *(const LAS bf16x8*)(lds + PG8_SA(b, h) + aoff + m * 2048 + k * 1024); } while (0)
#define PG8_LDB(dst, b, h) do { _Pragma("unroll") for (int n = 0; n < 2; ++n) _Pragma("unroll") for (int k = 0; k < 2; ++k) dst[n][k] = *(const LAS bf16x8*)(lds + PG8_SB(b, h) + boff + n * 2048 + k * 1024); } while (0)
#define PG8_MMA(ai, bj, At, Bt) do { __builtin_amdgcn_s_setprio(1); _Pragma("unroll") for (int m = 0; m < 4; ++m) _Pragma("unroll") for (int n = 0; n < 2; ++n) _Pragma("unroll") for (int k = 0; k < 2; ++k) \
        acc[ai][bj][m][n] = __builtin_amdgcn_mfma_f32_16x16x32_bf16(Bt[n][k], At[m][k], acc[ai][bj][m][n], 0, 0, 0); __builtin_amdgcn_s_setprio(0); } while (0)
#define PG8_CAT(x, y) __builtin_shufflevector(__builtin_bit_cast(i32x4, x), __builtin_bit_cast(i32x4, y), 0, 1, 2, 3, 4, 5, 6, 7)
#define PG8_MMA8(ai, bj, At, Bt) do { __builtin_amdgcn_s_setprio(1); _Pragma("unroll") for (int m = 0; m < 4; ++m) _Pragma("unroll") for (int n = 0; n < 2; ++n) \
        asm volatile("v_mfma_f32_16x16x128_f8f6f4 %0, %1, %2, %0" : "+v"(acc[ai][bj][m][n]) : "v"(PG8_CAT(Bt[n][0], Bt[n][1])), "v"(PG8_CAT(At[m][0], At[m][1]))); __builtin_amdgcn_s_setprio(0); } while (0)
#define PG8_WAIT_V(n) asm volatile("s_waitcnt vmcnt(" #n ")" ::: "memory")
#define PG8_WAIT_L(n) asm volatile("s_waitcnt lgkmcnt(" #n ")" ::: "memory")
#define PG8_BAR __builtin_amdgcn_s_barrier()
#define PG8_SCHED __builtin_amdgcn_sched_barrier(0)
    Unit cur, nxt; int ui = 0;
    if (!S.next(0, cur)) return;
    Acc acc;
#pragma unroll
    for (int a = 0; a < 2; ++a)
#pragma unroll
        for (int b = 0; b < 2; ++b)
#pragma unroll
            for (int m = 0; m < 4; ++m)
#pragma unroll
                for (int n = 0; n < 2; ++n) acc[a][b][m][n] = (f32x4){0.f, 0.f, 0.f, 0.f};
    bf16x8 At[4][2], B0[2][2], B1[2][2];
    const char* cA = cur.A; const char* cB = cur.B;
    PG8_STAGE(PG8_SB(0, 0), cB, voffB); PG8_STAGE(PG8_SB(0, 1), cB + hstepB, voffB); PG8_STAGE(PG8_SA(0, 0), cA, voffA); PG8_STAGE(PG8_SA(0, 1), cA + hstepA, voffA);
    if (wr == 1) PG8_BAR;
    PG8_WAIT_V(2); PG8_BAR;
    PG8_STAGE(PG8_SB(1, 0), cB + kstep, voffB); PG8_STAGE(PG8_SA(1, 0), cA + kstep, voffA); PG8_STAGE(PG8_SB(1, 1), cB + hstepB + kstep, voffB);
    PG8_WAIT_V(6); PG8_BAR;
    for (;;) {
        const bool has_next = S.next(ui + 1, nxt);
        const char* nA = has_next ? nxt.A : cA; const char* nB = has_next ? nxt.B : cB;
        for (int t = 0; t < nt; t += 2) {
            const bool last = (t == nt - 2);
            const char* a1 = cA + (size_t)(t + 1) * kstep;
            const char* a2 = last ? nA : cA + (size_t)(t + 2) * kstep; const char* b2 = last ? nB : cB + (size_t)(t + 2) * kstep;
            const char* a3 = a2 + kstep; const char* b3 = b2 + kstep;
            if constexpr (FP8) {
            PG8_LDB(B0, 0, 0); PG8_LDB(B1, 0, 1); PG8_SCHED; PG8_LDA(At, 0, 0); PG8_STAGE(PG8_SA(1, 1), a1 + hstepA, voffA);
            PG8_WAIT_V(8); PG8_WAIT_L(0); PG8_BAR; PG8_MMA8(0, 0, At, B0); PG8_MMA8(0, 1, At, B1); PG8_BAR; PG8_SCHED;
            PG8_LDA(At, 0, 1); PG8_STAGE(PG8_SB(0, 0), b2, voffB); PG8_STAGE(PG8_SB(0, 1), b2 + hstepB, voffB); PG8_STAGE(PG8_SA(0, 0), a2, voffA);
            PG8_WAIT_V(8); PG8_WAIT_L(0); PG8_BAR; PG8_MMA8(1, 0, At, B0); PG8_MMA8(1, 1, At, B1); PG8_BAR; PG8_SCHED;
            PG8_LDB(B0, 1, 0); PG8_LDB(B1, 1, 1); PG8_SCHED; PG8_LDA(At, 1, 0); PG8_STAGE(PG8_SA(0, 1), a2 + hstepA, voffA);
            PG8_WAIT_V(8); PG8_WAIT_L(0); PG8_BAR; PG8_MMA8(0, 0, At, B0); PG8_MMA8(0, 1, At, B1); PG8_BAR; PG8_SCHED;
            PG8_LDA(At, 1, 1); PG8_STAGE(PG8_SB(1, 0), b3, voffB); PG8_STAGE(PG8_SB(1, 1), b3 + hstepB, voffB); PG8_STAGE(PG8_SA(1, 0), a3, voffA);
            PG8_WAIT_V(8); PG8_WAIT_L(0); PG8_BAR; PG8_MMA8(1, 0, At, B0); PG8_MMA8(1, 1, At, B1); PG8_BAR; PG8_SCHED;
            } else {
            PG8_LDB(B0, 0, 0); PG8_LDB(B1, 0, 1); PG8_SCHED; PG8_LDA(At, 0, 0); PG8_STAGE(PG8_SA(1, 1), a1 + hstepA, voffA);
            PG8_WAIT_V(8); PG8_WAIT_L(0); PG8_BAR; PG8_MMA(0, 0, At, B0); PG8_MMA(0, 1, At, B1); PG8_BAR; PG8_SCHED;
            PG8_LDA(At, 0, 1); PG8_STAGE(PG8_SB(0, 0), b2, voffB); PG8_STAGE(PG8_SB(0, 1), b2 + hstepB, voffB); PG8_STAGE(PG8_SA(0, 0), a2, voffA);
            PG8_WAIT_V(8); PG8_WAIT_L(0); PG8_BAR; PG8_MMA(1, 0, At, B0); PG8_MMA(1, 1, At, B1); PG8_BAR; PG8_SCHED;
            PG8_LDB(B0, 1, 0); PG8_LDB(B1, 1, 1); PG8_SCHED; PG8_LDA(At, 1, 0); PG8_STAGE(PG8_SA(0, 1), a2 + hstepA, voffA);
            PG8_WAIT_V(8); PG8_WAIT_L(0); PG8_BAR; PG8_MMA(0, 0, At, B0); PG8_MMA(0, 1, At, B1); PG8_BAR; PG8_SCHED;
            PG8_LDA(At, 1, 1); PG8_STAGE(PG8_SB(1, 0), b3, voffB); PG8_STAGE(PG8_SB(1, 1), b3 + hstepB, voffB); PG8_STAGE(PG8_SA(1, 0), a3, voffA);
            PG8_WAIT_V(8); PG8_WAIT_L(0); PG8_BAR; PG8_MMA(1, 0, At, B0); PG8_MMA(1, 1, At, B1); PG8_BAR; PG8_SCHED;
            }
        }
        if constexpr (ALIGN_EPI) { if (wr == 0) PG8_BAR; }
        if constexpr (FP8) {
#pragma unroll
            for (int a = 0; a < 2; ++a)
#pragma unroll
                for (int b = 0; b < 2; ++b)
                    asm volatile("s_nop 15\n\ts_nop 15" : "+v"(acc[a][b][0][0]), "+v"(acc[a][b][0][1]), "+v"(acc[a][b][1][0]), "+v"(acc[a][b][1][1]), "+v"(acc[a][b][2][0]), "+v"(acc[a][b][2][1]), "+v"(acc[a][b][3][0]), "+v"(acc[a][b][3][1]));
        }
        E(acc, cur, wr, wc, fr, fq);
        if (!has_next) break;
#pragma unroll
        for (int a = 0; a < 2; ++a)
#pragma unroll
            for (int b = 0; b < 2; ++b)
#pragma unroll
                for (int m = 0; m < 4; ++m)
#pragma unroll
                    for (int n = 0; n < 2; ++n) acc[a][b][m][n] = (f32x4){0.f, 0.f, 0.f, 0.f};
        cur = nxt; cA = nA; cB = nB; ++ui;
        if constexpr (ALIGN_EPI) { if (wr == 1) PG8_BAR; }
    }
    PG8_WAIT_V(0);
    if constexpr (!ALIGN_EPI) { if (wr == 0) PG8_BAR; }
    PG8_BAR;
#undef PG8_SA
#undef PG8_SB
#undef PG8_STAGE
#undef PG8_LDA
#undef PG8_MMA8
#undef PG8_CAT
#undef PG8_LDB
#undef PG8_MMA
#undef PG8_WAIT_V
#undef PG8_WAIT_L
#undef PG8_BAR
#undef PG8_SCHED
}

struct EpiInGate {
    static constexpr bool PERM = true;
    bf16_t* z; bf16_t* gates; const float* bgate; float s;
    __device__ __forceinline__ void operator()(const Acc& acc, const Unit& u, int wr, int wc, int fr, int fq) const {
        const int row0 = u.orow + wr * 64 + fr; const bool isg = u.ocol >= 16;
        const int colt = (isg ? u.ocol - 16 : u.ocol) * 256 + wc * 32 + 8 * fq; const int ldc = isg ? 8192 : ZC; bf16_t* base = isg ? gates : z;
        f32x4 bv[2][2];
#pragma unroll
        for (int bj = 0; bj < 2; ++bj)
#pragma unroll
            for (int n = 0; n < 2; ++n) bv[bj][n] = isg ? *(const f32x4*)(bgate + colt + bj * HALF + 4 * n) : (f32x4){0.f, 0.f, 0.f, 0.f};
#pragma unroll
        for (int ai = 0; ai < 2; ++ai)
#pragma unroll
            for (int m = 0; m < 4; ++m) { bf16_t* rowp = base + (size_t)(row0 + ai * HALF + m * 16) * ldc + colt;
#pragma unroll
                for (int bj = 0; bj < 2; ++bj) { f32x4 v0 = acc[ai][bj][m][0] * s + bv[bj][0], v1 = acc[ai][bj][m][1] * s + bv[bj][1];
                    if (isg) {
#pragma unroll
                        for (int j = 0; j < 4; ++j) { v0[j] = sigmoidf_(v0[j]); v1[j] = sigmoidf_(v1[j]); } }
                    u32x4 w; w.x = cvt_pk_bf16(v0[0], v0[1]); w.y = cvt_pk_bf16(v0[2], v0[3]); w.z = cvt_pk_bf16(v1[0], v1[1]); w.w = cvt_pk_bf16(v1[2], v1[3]);
                    *(u32x4*)(rowp + bj * HALF) = w; } }
    }
};
struct EpiBf16 {
    static constexpr bool PERM = true;
    bf16_t* O; int ldc;
    __device__ __forceinline__ void operator()(const Acc& acc, const Unit& u, int wr, int wc, int fr, int fq) const {
        const int row0 = u.orow + wr * 64 + fr, col0 = u.ocol * 256 + wc * 32 + 8 * fq;
#pragma unroll
        for (int ai = 0; ai < 2; ++ai)
#pragma unroll
            for (int m = 0; m < 4; ++m) { bf16_t* rowp = O + (size_t)(row0 + ai * HALF + m * 16) * ldc + col0;
#pragma unroll
                for (int bj = 0; bj < 2; ++bj) { const f32x4 v0 = acc[ai][bj][m][0], v1 = acc[ai][bj][m][1];
                    u32x4 w; w.x = cvt_pk_bf16(v0[0], v0[1]); w.y = cvt_pk_bf16(v0[2], v0[3]); w.z = cvt_pk_bf16(v1[0], v1[1]); w.w = cvt_pk_bf16(v1[2], v1[3]);
                    *(u32x4*)(rowp + bj * HALF) = w; } }
    }
};
struct EpiSwiGLU {
    static constexpr bool PERM = true;
    bf16_t* O; int ldc;
    __device__ __forceinline__ void operator()(const Acc& acc, const Unit& u, int wr, int wc, int fr, int fq) const {
        const int row0 = u.orow + wr * 64 + fr, col0 = u.ocol * 128 + wc * 32 + 8 * fq;
#pragma unroll
        for (int ai = 0; ai < 2; ++ai)
#pragma unroll
            for (int m = 0; m < 4; ++m) { bf16_t* rowp = O + (size_t)(row0 + ai * HALF + m * 16) * ldc + col0;
                f32x4 v0, v1;
#pragma unroll
                for (int j = 0; j < 4; ++j) { const float g0 = acc[ai][0][m][0][j], g1 = acc[ai][0][m][1][j];
                    v0[j] = g0 * sigmoidf_(g0) * acc[ai][1][m][0][j]; v1[j] = g1 * sigmoidf_(g1) * acc[ai][1][m][1][j]; }
                u32x4 w; w.x = cvt_pk_bf16(v0[0], v0[1]); w.y = cvt_pk_bf16(v0[2], v0[3]); w.z = cvt_pk_bf16(v1[0], v1[1]); w.w = cvt_pk_bf16(v1[2], v1[3]);
                *(u32x4*)rowp = w; }
    }
};
__device__ __forceinline__ float bflo(unsigned w) { return __uint_as_float(w << 16); }
__device__ __forceinline__ float bfhi(unsigned w) { return __uint_as_float(w & 0xffff0000u); }
struct EpiMerge {
    static constexpr bool PERM = true;
    const bf16_t* gates; bf16_t* merged;
    __device__ __forceinline__ void operator()(const Acc& acc, const Unit& u, int wr, int wc, int fr, int fq) const {
        const int row0 = u.orow + wr * 64 + fr, col0 = u.ocol * 256 + wc * 32 + 8 * fq, n = u.x0;
#pragma unroll
        for (int ai = 0; ai < 2; ++ai) {
            u32x4 gv[4][2], ov[4][2];
#pragma unroll
            for (int m = 0; m < 4; ++m)
#pragma unroll
                for (int bj = 0; bj < 2; ++bj) { const size_t r = (size_t)(row0 + ai * HALF + m * 16);
                    gv[m][bj] = *(const u32x4*)(gates + r * 8192 + n * 2048 + col0 + bj * HALF);
                    ov[m][bj] = (u32x4){0u, 0u, 0u, 0u}; if (n > 0) ov[m][bj] = *(const u32x4*)(merged + r * DM + col0 + bj * HALF); }
#pragma unroll
            for (int m = 0; m < 4; ++m)
#pragma unroll
                for (int bj = 0; bj < 2; ++bj) { const size_t r = (size_t)(row0 + ai * HALF + m * 16);
                    const u32x4 g = gv[m][bj], o = ov[m][bj]; const f32x4 v0 = acc[ai][bj][m][0], v1 = acc[ai][bj][m][1];
                    u32x4 w;
                    w.x = cvt_pk_bf16(bflo(o.x) + bflo(g.x) * v0[0], bfhi(o.x) + bfhi(g.x) * v0[1]);
                    w.y = cvt_pk_bf16(bflo(o.y) + bflo(g.y) * v0[2], bfhi(o.y) + bfhi(g.y) * v0[3]);
                    w.z = cvt_pk_bf16(bflo(o.z) + bflo(g.z) * v1[0], bfhi(o.z) + bfhi(g.z) * v1[1]);
                    w.w = cvt_pk_bf16(bflo(o.w) + bflo(g.w) * v1[2], bfhi(o.w) + bfhi(g.w) * v1[3]);
                    *(u32x4*)(merged + r * DM + col0 + bj * HALF) = w; }
        }
    }
};
__device__ __forceinline__ unsigned pack_fp8x4(float a, float b, float c, float d) { int w = 0; w = __builtin_amdgcn_cvt_pk_fp8_f32(a, b, w, false); w = __builtin_amdgcn_cvt_pk_fp8_f32(c, d, w, true); return (unsigned)w; }
struct EpiGates {
    static constexpr bool PERM = true;
    bf16_t* gates; const float* bgate; float s;
    __device__ __forceinline__ void operator()(const Acc& acc, const Unit& u, int wr, int wc, int fr, int fq) const {
        const int row0 = u.orow + wr * 64 + fr, colt = u.ocol * 256 + wc * 32 + 8 * fq;
        f32x4 bv[2][2];
#pragma unroll
        for (int bj = 0; bj < 2; ++bj)
#pragma unroll
            for (int n = 0; n < 2; ++n) bv[bj][n] = *(const f32x4*)(bgate + colt + bj * HALF + 4 * n);
#pragma unroll
        for (int ai = 0; ai < 2; ++ai)
#pragma unroll
            for (int m = 0; m < 4; ++m) { bf16_t* rowp = gates + (size_t)(row0 + ai * HALF + m * 16) * 8192 + colt;
#pragma unroll
                for (int bj = 0; bj < 2; ++bj) { f32x4 v0 = acc[ai][bj][m][0] * s + bv[bj][0], v1 = acc[ai][bj][m][1] * s + bv[bj][1];
#pragma unroll
                    for (int j = 0; j < 4; ++j) { v0[j] = sigmoidf_(v0[j]); v1[j] = sigmoidf_(v1[j]); }
                    u32x4 w; w.x = cvt_pk_bf16(v0[0], v0[1]); w.y = cvt_pk_bf16(v0[2], v0[3]); w.z = cvt_pk_bf16(v1[0], v1[1]); w.w = cvt_pk_bf16(v1[2], v1[3]);
                    *(u32x4*)(rowp + bj * HALF) = w; } }
    }
};
struct EpiSwiGLU8 {
    static constexpr bool PERM = true;
    unsigned char* O; int ldc; float si, so;
    __device__ __forceinline__ void operator()(const Acc& acc, const Unit& u, int wr, int wc, int fr, int fq) const {
        const int row0 = u.orow + wr * 64 + fr, col0 = u.ocol * 128 + wc * 32 + 8 * fq;
#pragma unroll
        for (int ai = 0; ai < 2; ++ai)
#pragma unroll
            for (int m = 0; m < 4; ++m) { unsigned char* rowp = O + (size_t)(row0 + ai * HALF + m * 16) * ldc + col0;
                f32x4 v0, v1;
#pragma unroll
                for (int j = 0; j < 4; ++j) { const float g0 = acc[ai][0][m][0][j] * si, g1 = acc[ai][0][m][1][j] * si;
                    v0[j] = g0 * sigmoidf_(g0) * (acc[ai][1][m][0][j] * si) * so; v1[j] = g1 * sigmoidf_(g1) * (acc[ai][1][m][1][j] * si) * so; }
                u32x2 w; w.x = pack_fp8x4(v0[0], v0[1], v0[2], v0[3]); w.y = pack_fp8x4(v1[0], v1[1], v1[2], v1[3]);
                *(u32x2*)rowp = w; }
    }
};
struct EpiResF32 {
    static constexpr bool PERM = false;
    const float* base; float* out; float s;
    __device__ __forceinline__ void operator()(const Acc& acc, const Unit& u, int wr, int wc, int fr, int fq) const {
        const int row0 = u.orow + wr * 64 + fr, col0 = u.ocol * 256 + wc * 32 + 4 * fq;
#pragma unroll
        for (int ai = 0; ai < 2; ++ai)
#pragma unroll
            for (int mp = 0; mp < 2; ++mp) {
                f32x4 bs[2][2][2];
#pragma unroll
                for (int mm = 0; mm < 2; ++mm) { const size_t off = (size_t)(row0 + ai * HALF + (mp * 2 + mm) * 16) * DM + col0;
#pragma unroll
                    for (int bj = 0; bj < 2; ++bj)
#pragma unroll
                        for (int n = 0; n < 2; ++n) bs[mm][bj][n] = *(const f32x4*)(base + off + bj * HALF + n * 16); }
#pragma unroll
                for (int mm = 0; mm < 2; ++mm) { const int m = mp * 2 + mm; const size_t off = (size_t)(row0 + ai * HALF + m * 16) * DM + col0;
#pragma unroll
                    for (int bj = 0; bj < 2; ++bj)
#pragma unroll
                        for (int n = 0; n < 2; ++n) *(f32x4*)(out + off + bj * HALF + n * 16) = bs[mm][bj][n] + acc[ai][bj][m][n] * s; }
                asm volatile("" ::: "memory"); }
    }
};
struct EpiMoeDown {
    static constexpr bool PERM = false;
    float* out; const int* tok; const float* wt; const unsigned* cnt; float s;
    __device__ __forceinline__ void operator()(const Acc& acc, const Unit& u, int wr, int wc, int fr, int fq) const {
        const int e = u.x0, nrow = (int)cnt[e * 64]; const int lrow0 = u.x1 + wr * 64 + fr, col0 = u.ocol * 256 + wc * 32 + 4 * fq;
#pragma unroll
        for (int ai = 0; ai < 2; ++ai)
#pragma unroll
            for (int m = 0; m < 4; ++m) { const int lr = lrow0 + ai * HALF + m * 16;
                if (lr < nrow) { const int slot = e * ECAP + lr; const int t = tok[slot]; const float w = wt[slot] * s; float* op = out + (size_t)t * DM + col0;
#pragma unroll
                    for (int bj = 0; bj < 2; ++bj)
#pragma unroll
                        for (int n = 0; n < 2; ++n)
#pragma unroll
                            for (int j = 0; j < 4; ++j) unsafeAtomicAdd(op + bj * HALF + n * 16 + j, w * acc[ai][bj][m][n][j]); } }
    }
};
struct EpiMoeDownY {
    static constexpr bool PERM = true;
    bf16_t* y; const float* wt; const unsigned* cnt; float s;
    __device__ __forceinline__ void operator()(const Acc& acc, const Unit& u, int wr, int wc, int fr, int fq) const {
        const int e = u.x0, nrow = (int)cnt[e * 64]; const int lrow0 = u.x1 + wr * 64 + fr, col0 = u.ocol * 256 + wc * 32 + 8 * fq;
#pragma unroll
        for (int ai = 0; ai < 2; ++ai)
#pragma unroll
            for (int m = 0; m < 4; ++m) { const int lr = lrow0 + ai * HALF + m * 16;
                if (lr < nrow) { const int slot = e * ECAP + lr; const float w = wt[slot] * s; bf16_t* rowp = y + ((size_t)u.ks * NEXP * ECAP + slot) * DM + col0;
#pragma unroll
                    for (int bj = 0; bj < 2; ++bj) { const f32x4 v0 = acc[ai][bj][m][0] * w, v1 = acc[ai][bj][m][1] * w;
                        u32x4 q; q.x = cvt_pk_bf16(v0[0], v0[1]); q.y = cvt_pk_bf16(v0[2], v0[3]); q.z = cvt_pk_bf16(v1[0], v1[1]); q.w = cvt_pk_bf16(v1[2], v1[3]);
                        *(u32x4*)(rowp + bj * HALF) = q; } } }
    }
};
}
#define XB_TMO      128
#define XB_XCNT(j)  (256  + 64 * (j))
#define XB_XSUB(j)  (1280 + 64 * (j))
#define XB_XGEN(j)  (2304 + 64 * (j))
#define XB_TOP      3328
#define XB_TOPGEN   3392
#define XCD_BAR_WORDS 3456
#define XB_SPIN_CAP (1u << 18)

__device__ __forceinline__ unsigned xb_ld(unsigned* p)              { return __hip_atomic_load(p, __ATOMIC_RELAXED, __HIP_MEMORY_SCOPE_AGENT); }
__device__ __forceinline__ unsigned xb_add(unsigned* p, unsigned v) { return __hip_atomic_fetch_add(p, v, __ATOMIC_RELAXED, __HIP_MEMORY_SCOPE_AGENT); }
__device__ __forceinline__ unsigned xb_xcc_id() { return (unsigned)__builtin_amdgcn_s_getreg((3 << 11) | 20) & 0xFu; }
#define XB_SPIN(cond, bar) do { unsigned _sp = 0; while (cond) { __builtin_amdgcn_s_sleep(1); \
    if ((++_sp & 255u) == 0u) { if (xb_ld(&(bar)[XB_TMO])) break; if (_sp > XB_SPIN_CAP) { atomicAdd(&(bar)[XB_TMO], 1u); break; } } } } while (0)

__device__ __forceinline__ unsigned xb_tid() { unsigned t = threadIdx.x; asm volatile("" : "+v"(t)); return t; }
struct XcdBarrier {
    unsigned* bar; unsigned x;
    volatile LAS unsigned* st;
};

__device__ __forceinline__ XcdBarrier xcd_barrier_post(unsigned* bar, volatile LAS unsigned* st) {
    XcdBarrier b; b.bar = bar; b.x = xb_xcc_id(); b.st = st;
    if (xb_tid() == 0u) (void)xb_add(&bar[XB_XCNT(b.x)], 1u);
    return b;
}
__device__ __forceinline__ void xcd_barrier_complete(unsigned* bar, unsigned x, unsigned& nloc, unsigned& nx) {
    const unsigned G = gridDim.x * gridDim.y * gridDim.z;
    unsigned sum, cnt, mine, sp = 0u;
    for (;;) {
        sum = 0u; cnt = 0u; mine = 0u;
#pragma unroll
        for (unsigned j = 0; j < 16; ++j) { const unsigned c = xb_ld(&bar[XB_XCNT(j)]); sum += c; cnt += (c > 0u) ? 1u : 0u; mine = (j == x) ? c : mine; }
        if (sum == G) break;
        __builtin_amdgcn_s_sleep(1);
        if ((++sp & 255u) == 0u) { if (xb_ld(&bar[XB_TMO])) break; if (sp > XB_SPIN_CAP) { atomicAdd(&bar[XB_TMO], 1u); break; } }
    }
    nloc = mine > 0u ? mine : 1u; nx = cnt > 0u ? cnt : 1u;
}

__device__ __forceinline__ void xcd_barrier(const XcdBarrier& b) {
    asm volatile("s_waitcnt vmcnt(0)" ::: "memory");
    __syncthreads();
    if (xb_tid() == 0u) {
        unsigned* bar = b.bar;
        __builtin_amdgcn_s_waitcnt(0);
        unsigned nloc = b.st[0], nx = b.st[1];
        if (nloc == 0u) { xcd_barrier_complete(bar, b.x, nloc, nx); b.st[0] = nloc; b.st[1] = nx; }
        const unsigned old = xb_add(&bar[XB_XSUB(b.x)], 1u);
        const unsigned gen = old / nloc;
        if (old + 1u == (gen + 1u) * nloc) {
            __builtin_amdgcn_fence(__ATOMIC_RELEASE, "agent");
            asm volatile("s_waitcnt vmcnt(0)" ::: "memory");
            const unsigned og = xb_add(&bar[XB_TOP], 1u);
            const unsigned tg = og / nx;
            if (og + 1u == (tg + 1u) * nx) xb_add(&bar[XB_TOPGEN], 1u);
            else XB_SPIN(xb_ld(&bar[XB_TOPGEN]) == tg, bar);
            __builtin_amdgcn_fence(__ATOMIC_ACQUIRE, "agent");
            xb_add(&bar[XB_XGEN(b.x)], 1u);
            asm volatile("s_waitcnt vmcnt(0)" ::: "memory");
        } else {
            XB_SPIN(xb_ld(&bar[XB_XGEN(b.x)]) == gen, bar);
            __builtin_amdgcn_fence(__ATOMIC_ACQUIRE, "agent");
            asm volatile("s_waitcnt vmcnt(0)" ::: "memory");
        }
    }
    __syncthreads();
}

struct Params { const float* in[30]; float* out; unsigned char* ws; int ph_lo, ph_hi; };
enum { I_X = 0, I_MEM, I_NORM_MIX, I_W_IN, I_NA_QN, I_NA_KN, I_NA_RPB, I_CQ_N, I_W_UQ, I_CKV_N, I_W_UKV, I_MLA_QN, I_MLA_KN, I_SWA_QN, I_SWA_KN, I_SWA_SINK,
       I_MEM_N, I_MEM_WKV, I_MEM_QN, I_MEM_KN, I_W_BRANCH, I_W_GATE, I_B_GATE, I_W_O, I_NORM_FFN, I_FFN_UP, I_FFN_DN, I_ROUTER, I_MOE_UP, I_MOE_DN };

__device__ __forceinline__ float wave_sum(float v) {
#pragma unroll
    for (int o = 32; o >= 1; o >>= 1) v += __shfl_xor(v, o);
    return v;
}
__device__ __forceinline__ float bf2f(bf16_t b) { return __uint_as_float(((unsigned)b) << 16); }
__device__ __forceinline__ bf16_t f2bf(float f) { return (bf16_t)(pg8::cvt_pk_bf16(f, 0.f) & 0xffffu); }
using pg8::cvt_pk_bf16; using pg8::bflo; using pg8::bfhi;

struct CvtJob { const float* src; bf16_t* dst; int src_ld, K, ntn, tile0, mode, dff; };
constexpr int NJOBS = 40;
__device__ __forceinline__ void make_job(int j, const Params& p, CvtJob& jb) {
    unsigned char* ws = p.ws; jb.mode = 0; jb.dff = 1; jb.tile0 = 0;
    if (j < 22) { const int l = j / 11, k = j % 11; unsigned char* lw = ws + WS_LW + (size_t)l * LW_BYTES;
        if (k == 0) { jb.src = p.in[I_W_IN] + (size_t)l * DM * INC; jb.dst = (bf16_t*)(lw + LW_IN); jb.src_ld = INC; jb.K = DM; jb.ntn = INC / 64; jb.mode = INGATE_FP8 ? 3 : 0; }
        else if (k == 1) { jb.src = p.in[I_W_IN]; jb.dst = (bf16_t*)(lw + LW_IN + (size_t)INC * DM * (INGATE_FP8 ? 1 : 2)); jb.src_ld = INC; jb.K = DM; jb.ntn = (ZC - INC) / 64; jb.mode = INGATE_FP8 ? 5 : 2; }
        else if (k == 2) { jb.src = p.in[I_W_GATE] + (size_t)l * DM * 8192; jb.dst = (bf16_t*)(lw + LW_IN + (size_t)ZC * DM * (INGATE_FP8 ? 1 : 2)); jb.src_ld = 8192; jb.K = DM; jb.ntn = 8192 / 64; jb.mode = INGATE_FP8 ? 3 : 0; }
        else if (k == 3) { jb.src = p.in[I_W_UQ] + (size_t)l * 768 * 768; jb.dst = (bf16_t*)(lw + LW_UQ); jb.src_ld = 768; jb.K = 768; jb.ntn = 768 / 64; }
        else if (k == 4) { jb.src = p.in[I_W_UKV] + (size_t)l * 256 * 1024; jb.dst = (bf16_t*)(lw + LW_UKV); jb.src_ld = 1024; jb.K = 256; jb.ntn = 1024 / 64; }
        else if (k == 5) { jb.src = p.in[I_MEM_WKV] + (size_t)l * DM * 1024; jb.dst = (bf16_t*)(lw + LW_MEMKV); jb.src_ld = 1024; jb.K = DM; jb.ntn = 1024 / 64; }
        else if (k < 10) { const int n = k - 6; jb.src = p.in[I_W_BRANCH] + ((size_t)l * 4 + n) * 512 * DM; jb.dst = (bf16_t*)(lw + LW_BR) + (size_t)n * DM * 512; jb.src_ld = DM; jb.K = 512; jb.ntn = DM / 64; }
        else { jb.src = p.in[I_W_O] + (size_t)l * DM * DM; jb.dst = (bf16_t*)(lw + LW_O); jb.src_ld = DM; jb.K = DM; jb.ntn = DM / 64; }
    } else if (j == 22) { jb.src = p.in[I_FFN_UP]; jb.dst = (bf16_t*)(ws + WS_FFNUP); jb.src_ld = 2 * DFF; jb.K = DM; jb.ntn = 2 * DFF / 64; jb.mode = 1; jb.dff = DFF; }
    else if (j == 23) { jb.src = p.in[I_FFN_DN]; jb.dst = (bf16_t*)(ws + WS_FFNDN); jb.src_ld = DM; jb.K = DFF; jb.ntn = DM / 64; }
    else if (j < 32) { const int e = j - 24; jb.src = p.in[I_MOE_UP] + (size_t)e * DM * 2 * DFFE; jb.dst = (bf16_t*)(ws + WS_MOEUP + (size_t)e * 2 * DFFE * DM * MOE_ES); jb.src_ld = 2 * DFFE; jb.K = DM; jb.ntn = 2 * DFFE / 64; jb.mode = MOE_FP8 ? 4 : 1; jb.dff = DFFE; }
    else { const int e = j - 32; jb.src = p.in[I_MOE_DN] + (size_t)e * DFFE * DM; jb.dst = (bf16_t*)(ws + WS_MOEDN + (size_t)e * DM * DFFE * MOE_ES); jb.src_ld = DM; jb.K = DFFE; jb.ntn = DM / 64; jb.mode = MOE_FP8 ? 3 : 0; }
}

__device__ __forceinline__ void norm_rows(const float* src, const float* g, bf16_t* dst, unsigned char* dst8, int nrows, int wid, int lane) {
    const int nw = gridDim.x * 8;
    for (int row = blockIdx.x * 8 + wid; row < nrows; row += 2 * nw) {
        const int rowb = row + nw; const bool hb = rowb < nrows;
        const f32x4* sa = (const f32x4*)(src + (size_t)row * DM); const f32x4* sb = (const f32x4*)(src + (size_t)(hb ? rowb : row) * DM);
        f32x4 va[8], vb[8]; float ssa = 0.f, ssb = 0.f;
#pragma unroll
        for (int j = 0; j < 8; ++j) { va[j] = sa[lane + 64 * j]; vb[j] = sb[lane + 64 * j]; }
#pragma unroll
        for (int j = 0; j < 8; ++j) { ssa += va[j][0] * va[j][0] + va[j][1] * va[j][1] + va[j][2] * va[j][2] + va[j][3] * va[j][3]; ssb += vb[j][0] * vb[j][0] + vb[j][1] * vb[j][1] + vb[j][2] * vb[j][2] + vb[j][3] * vb[j][3]; }
#pragma unroll
        for (int o = 32; o >= 1; o >>= 1) { ssa += __shfl_xor(ssa, o); ssb += __shfl_xor(ssb, o); }
        const float ra = 1.0f / sqrtf(ssa * (1.0f / DM) + EPS), rb = 1.0f / sqrtf(ssb * (1.0f / DM) + EPS);
#pragma unroll
        for (int j = 0; j < 8; ++j) { const f32x4 gv = ((const f32x4*)g)[lane + 64 * j];
            { const f32x4 y = va[j] * ra * gv; u32x2 w; w.x = cvt_pk_bf16(y[0], y[1]); w.y = cvt_pk_bf16(y[2], y[3]); *(u32x2*)(dst + (size_t)row * DM + 4 * (lane + 64 * j)) = w;
              if (dst8) *(unsigned*)(dst8 + (size_t)row * DM + 4 * (lane + 64 * j)) = pg8::pack_fp8x4(y[0] * SC_ACT8, y[1] * SC_ACT8, y[2] * SC_ACT8, y[3] * SC_ACT8); }
            if (hb) { const f32x4 y = vb[j] * rb * gv; u32x2 w; w.x = cvt_pk_bf16(y[0], y[1]); w.y = cvt_pk_bf16(y[2], y[3]); *(u32x2*)(dst + (size_t)rowb * DM + 4 * (lane + 64 * j)) = w;
              if (dst8) *(unsigned*)(dst8 + (size_t)rowb * DM + 4 * (lane + 64 * j)) = pg8::pack_fp8x4(y[0] * SC_ACT8, y[1] * SC_ACT8, y[2] * SC_ACT8, y[3] * SC_ACT8); } }
    }
}

__device__ __forceinline__ void p0_prologue(const Params& p, LAS unsigned char* lds, int tid, int wid, int lane) {
    LAS CvtJob* jt = (LAS CvtJob*)(lds + 65536);
    LAS int* jtot = (LAS int*)(lds + 65536 + 4096);
    if (tid < NJOBS) { CvtJob jb; make_job(tid, p, jb); jt[tid].src = jb.src; jt[tid].dst = jb.dst; jt[tid].src_ld = jb.src_ld; jt[tid].K = jb.K; jt[tid].ntn = jb.ntn; jt[tid].tile0 = 0; jt[tid].mode = jb.mode; jt[tid].dff = jb.dff; }
    __syncthreads();
    if (tid == 0) { int acc = 0; for (int j = 0; j < NJOBS; ++j) { jt[j].tile0 = acc; acc += (jt[j].K / 128) * jt[j].ntn; } jtot[0] = acc; }
    __syncthreads();
    const int total = jtot[0];
    struct Tile { int mode, K, tn, tk, dff; bf16_t* dst; f32x4 r0, r1, r2, r3; };
    const int tq = tid >> 4, nq = tid & 15;
    int j = 0;
#define P0_FETCH(TL, G_) do { (TL).mode = -1; if ((G_) < total) { while (j + 1 < NJOBS && jt[j + 1].tile0 <= (G_)) ++j; \
        const float* src = (const float*)(__attribute__((address_space(1))) const float*)jt[j].src; const int src_ld = jt[j].src_ld, ntn = jt[j].ntn, local = (G_) - jt[j].tile0; \
        (TL).mode = jt[j].mode; (TL).K = jt[j].K; (TL).dff = jt[j].dff; (TL).dst = (bf16_t*)(__attribute__((address_space(1))) bf16_t*)jt[j].dst; (TL).tn = local % ntn; (TL).tk = local / ntn; \
        if ((TL).mode != 2 && (TL).mode != 5) { const bool f8 = (TL).mode >= 3; const int ra = f8 ? 4 * tq : 2 * tq, rb = ra + 1, rc = f8 ? ra + 2 : ra + 64, rd = rc + 1; \
            const float* sp = src + (size_t)((TL).tk * 128) * src_ld + (TL).tn * 64 + 4 * nq; \
            (TL).r0 = __builtin_nontemporal_load((const f32x4*)(sp + (size_t)ra * src_ld)); (TL).r1 = __builtin_nontemporal_load((const f32x4*)(sp + (size_t)rb * src_ld)); \
            (TL).r2 = __builtin_nontemporal_load((const f32x4*)(sp + (size_t)rc * src_ld)); (TL).r3 = __builtin_nontemporal_load((const f32x4*)(sp + (size_t)rd * src_ld)); } } } while (0)
#define P0_TOLDS(TL, T) do { if ((TL).mode >= 3 && (TL).mode != 5) { _Pragma("unroll") for (int q = 0; q < 4; ++q) (T)[(4 * nq + q) * 33 + tq] = pg8::pack_fp8x4((TL).r0[q] * SC_W8, (TL).r1[q] * SC_W8, (TL).r2[q] * SC_W8, (TL).r3[q] * SC_W8); } \
        else if ((TL).mode == 0 || (TL).mode == 1) { _Pragma("unroll") for (int q = 0; q < 4; ++q) { (T)[(4 * nq + q) * 65 + tq] = cvt_pk_bf16((TL).r0[q], (TL).r1[q]); (T)[(4 * nq + q) * 65 + tq + 32] = cvt_pk_bf16((TL).r2[q], (TL).r3[q]); } } } while (0)
#define P0_OUT(TL, T) do { const int mode = (TL).mode, K = (TL).K, tn = (TL).tn, tk = (TL).tk, dff = (TL).dff; bf16_t* dst = (TL).dst; \
        if (mode == 2) { _Pragma("unroll") for (int it = 0; it < 2; ++it) { const int piece = tid + it * 512, n = piece >> 4, seg = piece & 15; \
                *(u32x4*)(dst + (size_t)(tn * 64 + n) * K + tk * 128 + seg * 8) = (u32x4){0u, 0u, 0u, 0u}; } } \
        else if (mode == 5) { const int n = tid >> 3, seg = tid & 7; *(u32x4*)((unsigned char*)dst + (size_t)(tn * 64 + n) * K + tk * 128 + seg * 16) = (u32x4){0u, 0u, 0u, 0u}; } \
        else if (mode >= 3) { const int n = tid >> 3, seg = tid & 7; \
            u32x4 w; w.x = (T)[n * 33 + seg * 4 + 0]; w.y = (T)[n * 33 + seg * 4 + 1]; w.z = (T)[n * 33 + seg * 4 + 2]; w.w = (T)[n * 33 + seg * 4 + 3]; \
            int drow = tn * 64 + n; if (mode == 4) { const int bj = drow / dff, cc = drow - bj * dff; drow = 256 * (cc >> 7) + 128 * bj + (cc & 127); } \
            __builtin_nontemporal_store(w, (u32x4*)((unsigned char*)dst + (size_t)drow * K + tk * 128 + seg * 16)); } \
        else if (mode >= 0) { _Pragma("unroll") for (int it = 0; it < 2; ++it) { const int piece = tid + it * 512, n = piece >> 4, seg = piece & 15; \
                u32x4 w; w.x = (T)[n * 65 + seg * 4 + 0]; w.y = (T)[n * 65 + seg * 4 + 1]; w.z = (T)[n * 65 + seg * 4 + 2]; w.w = (T)[n * 65 + seg * 4 + 3]; \
                int drow = tn * 64 + n; if (mode == 1) { const int bj = drow / dff, cc = drow - bj * dff; drow = 256 * (cc >> 7) + 128 * bj + (cc & 127); } \
                __builtin_nontemporal_store(w, (u32x4*)(dst + (size_t)drow * K + tk * 128 + seg * 8)); } } } while (0)
    LAS unsigned* T0 = (LAS unsigned*)lds; LAS unsigned* T1 = (LAS unsigned*)(lds + 20480);
    Tile na, nb;
    int g = 2 * blockIdx.x;
    P0_FETCH(na, g); P0_FETCH(nb, g + 1);
    while (g < total) {
        const Tile ca = na, cb = nb;
        g += 2 * gridDim.x;
        P0_FETCH(na, g); P0_FETCH(nb, g + 1);
        P0_TOLDS(ca, T0); P0_TOLDS(cb, T1);
        __syncthreads();
        P0_OUT(ca, T0); P0_OUT(cb, T1);
        __syncthreads();
    }
#undef P0_FETCH
#undef P0_TOLDS
#undef P0_OUT
#ifdef PROBE_POISON
    { u32x4* q = (u32x4*)(p.ws + WS_XG); const size_t n1 = (size_t)NEXP * ECAP * DM / 16; for (size_t i = (size_t)blockIdx.x * NTHREADS + tid; i < n1; i += (size_t)gridDim.x * NTHREADS) q[i] = (u32x4){0u, 0u, 0u, 0u};
      q = (u32x4*)(p.ws + WS_ACTM); const size_t n2 = (size_t)NEXP * ECAP * DFFE / 16; for (size_t i = (size_t)blockIdx.x * NTHREADS + tid; i < n2; i += (size_t)gridDim.x * NTHREADS) q[i] = (u32x4){0u, 0u, 0u, 0u}; }
#endif
    { f32x2* rt = (f32x2*)(p.ws + WS_ROPE);
      for (int e = blockIdx.x * NTHREADS + tid; e < SEQ * 32; e += gridDim.x * NTHREADS) { const int pos = e >> 5, i = e & 31;
          const float freq = __builtin_amdgcn_exp2f(-(float)i * (13.287712379549449f / 32.0f));
          const float ang = (float)pos * freq;
          const double rev = (double)ang * 0.15915494309189535; const float fr_ = (float)(rev - __builtin_rint(rev));
          rt[e] = (f32x2){__builtin_amdgcn_cosf(fr_), __builtin_amdgcn_sinf(fr_)}; } }
    norm_rows(p.in[I_MEM], p.in[I_MEM_N], (bf16_t*)(p.ws + WS_MEMN), nullptr, NMEM, wid, lane);
    norm_rows(p.in[I_MEM], p.in[I_MEM_N] + DM, (bf16_t*)(p.ws + WS_MEMN) + (size_t)NMEM * DM, nullptr, NMEM, wid, lane);
    norm_rows(p.in[I_X], p.in[I_NORM_MIX], (bf16_t*)(p.ws + WS_U), p.ws + WS_U8, NTOK, wid, lane);
}

__device__ __forceinline__ void unpack8(const u32x4 w, float (&x)[8]) { x[0] = bflo(w.x); x[1] = bfhi(w.x); x[2] = bflo(w.y); x[3] = bfhi(w.y); x[4] = bflo(w.z); x[5] = bfhi(w.z); x[6] = bflo(w.w); x[7] = bfhi(w.w); }
__device__ __forceinline__ u32x4 pack8(const float (&y)[8]) { u32x4 w; w.x = cvt_pk_bf16(y[0], y[1]); w.y = cvt_pk_bf16(y[2], y[3]); w.z = cvt_pk_bf16(y[4], y[5]); w.w = cvt_pk_bf16(y[6], y[7]); return w; }
__device__ __forceinline__ float sumsq8(const float (&x)[8]) { return (x[0] * x[0] + x[1] * x[1]) + (x[2] * x[2] + x[3] * x[3]) + (x[4] * x[4] + x[5] * x[5]) + (x[6] * x[6] + x[7] * x[7]); }
template <int NL> __device__ __forceinline__ float group_sum(float v) {
#pragma unroll
    for (int o = NL / 2; o >= 1; o >>= 1) v += __shfl_xor(v, o);
    return v;
}
struct Gain8 { f32x4 a, b; };
__device__ __forceinline__ Gain8 ldg8(const float* g) { Gain8 r; r.a = *(const f32x4*)g; r.b = *(const f32x4*)(g + 4); return r; }
__device__ __forceinline__ void scale8(float (&x)[8], float rs, const Gain8& g) { x[0] *= rs * g.a[0]; x[1] *= rs * g.a[1]; x[2] *= rs * g.a[2]; x[3] *= rs * g.a[3]; x[4] *= rs * g.b[0]; x[5] *= rs * g.b[1]; x[6] *= rs * g.b[2]; x[7] *= rs * g.b[3]; }
__device__ __forceinline__ void rope8(float (&y)[8], const f32x4 (&cs)[4], bool upper) {
#pragma unroll
    for (int e = 0; e < 8; ++e) { const float pr = __shfl_xor(y[e], 4); const float c = cs[e >> 1][(e & 1) * 2], s = cs[e >> 1][(e & 1) * 2 + 1]; y[e] = upper ? (y[e] * c + pr * s) : (y[e] * c - pr * s); }
}

__device__ __forceinline__ void prep1(const Params& p, int l, LAS unsigned char* lds, int tid, int wid, int lane) {
    const bf16_t* z = (const bf16_t*)(p.ws + WS_Z);
    bf16_t* naq = (bf16_t*)(p.ws + WS_NAQ); bf16_t* nak = (bf16_t*)(p.ws + WS_NAK); bf16_t* navT = (bf16_t*)(p.ws + WS_NAVT);
    bf16_t* cqn = (bf16_t*)(p.ws + WS_CQN); bf16_t* ckvn = (bf16_t*)(p.ws + WS_CKVN);
    bf16_t* swq = (bf16_t*)(p.ws + WS_SWQ); bf16_t* swk = (bf16_t*)(p.ws + WS_SWK); bf16_t* swvT = (bf16_t*)(p.ws + WS_SWVT); bf16_t* meq = (bf16_t*)(p.ws + WS_MEQ);
    const f32x4* rt4 = (const f32x4*)(p.ws + WS_ROPE);
    const float qs128 = 0.08838834764831845f * LOG2E, qs64 = 0.125f * LOG2E;
    const int l16 = lane & 15, l8 = lane & 7;
    const Gain8 g_naq = ldg8(p.in[I_NA_QN] + l * 128 + 8 * l16), g_nak = ldg8(p.in[I_NA_KN] + l * 128 + 8 * l16), g_meq = ldg8(p.in[I_MEM_QN] + l * 128 + 8 * l16);
    const Gain8 g_cq0 = ldg8(p.in[I_CQ_N] + l * 768 + 8 * lane), g_cq1 = ldg8(p.in[I_CQ_N] + l * 768 + 512 + 8 * (lane & 31)), g_ckv = ldg8(p.in[I_CKV_N] + l * 256 + 8 * (lane & 31));
    const Gain8 g_swq = ldg8(p.in[I_SWA_QN] + l * 64 + 8 * l8), g_swk = ldg8(p.in[I_SWA_KN] + l * 64 + 8 * l8);
    constexpr int VW = 640;
    LAS bf16_t* vt = (LAS bf16_t*)lds;
    const u32x4 zero4 = (u32x4){0u, 0u, 0u, 0u};
    for (int grp = blockIdx.x; grp < NTOK / 32; grp += gridDim.x) {
        const int b = grp >> 6, chunk = grp & 63;
#pragma unroll 2
        for (int ti = 0; ti < 4; ++ti) {
            const int tl = wid * 4 + ti, s = chunk * 32 + tl, token = grp * 32 + tl;
            const bf16_t* zr = z + (size_t)token * ZC;
            const u32x4 w_naq = *(const u32x4*)(zr + Z_NAQ + 8 * lane), w_nak = *(const u32x4*)(zr + Z_NAK + 8 * lane), w_nav = *(const u32x4*)(zr + Z_NAV + 8 * lane), w_meq = *(const u32x4*)(zr + Z_MEQ + 8 * lane);
            const u32x4 w_cq0 = *(const u32x4*)(zr + Z_CQ + 8 * lane); const u32x4 w_cq1 = lane < 32 ? *(const u32x4*)(zr + Z_CQ + 512 + 8 * lane) : zero4;
            const u32x4 w_ckv = lane < 32 ? *(const u32x4*)(zr + Z_CKV + 8 * lane) : zero4;
            const u32x4 w_swq = *(const u32x4*)(zr + Z_SWQ + 8 * lane);
            const u32x4 w_swkv = lane < 32 ? *(const u32x4*)(zr + (lane < 16 ? Z_SWK + 8 * lane : Z_SWV + 8 * (lane - 16))) : zero4;
            f32x4 cs[4];
#pragma unroll
            for (int q = 0; q < 4; ++q) cs[q] = rt4[(s * 32 + (lane & 3) * 8) / 2 + q];
            *(LAS u32x4*)(vt + tl * VW + 8 * lane) = w_nav;
            if (lane >= 16 && lane < 32) *(LAS u32x4*)(vt + tl * VW + 512 + 8 * (lane - 16)) = w_swkv;
            float x[8];
            { unpack8(w_naq, x); const float ss = group_sum<16>(sumsq8(x)); scale8(x, 1.0f / sqrtf(ss * (1.0f / 128) + EPS) * qs128, g_naq);
              *(u32x4*)(naq + ((size_t)(b * 4 + (lane >> 4)) * SEQ + s) * 128 + 8 * l16) = pack8(x); }
            { unpack8(w_nak, x); const float ss = group_sum<16>(sumsq8(x)); scale8(x, 1.0f / sqrtf(ss * (1.0f / 128) + EPS), g_nak);
              *(u32x4*)(nak + ((size_t)(b * 4 + (lane >> 4)) * SEQ + s) * 128 + 8 * l16) = pack8(x); }
            { unpack8(w_meq, x); const float ss = group_sum<16>(sumsq8(x)); scale8(x, 1.0f / sqrtf(ss * (1.0f / 128) + EPS) * qs128, g_meq);
              *(u32x4*)(meq + ((size_t)(b * 4 + (lane >> 4)) * SEQ + s) * 128 + 8 * l16) = pack8(x); }
            { float y[8]; unpack8(w_cq0, x); unpack8(w_cq1, y); const float ss = group_sum<64>(sumsq8(x) + sumsq8(y)); const float rs = 1.0f / sqrtf(ss * (1.0f / 768) + EPS);
              scale8(x, rs, g_cq0); scale8(y, rs, g_cq1);
              *(u32x4*)(cqn + (size_t)token * 768 + 8 * lane) = pack8(x); if (lane < 32) *(u32x4*)(cqn + (size_t)token * 768 + 512 + 8 * lane) = pack8(y); }
            { unpack8(w_ckv, x); const float ss = group_sum<64>(sumsq8(x)); scale8(x, 1.0f / sqrtf(ss * (1.0f / 256) + EPS), g_ckv);
              if (lane < 32) *(u32x4*)(ckvn + (size_t)token * 256 + 8 * lane) = pack8(x); }
            { unpack8(w_swq, x); const float ss = group_sum<8>(sumsq8(x)); scale8(x, 1.0f / sqrtf(ss * (1.0f / 64) + EPS), g_swq); rope8(x, cs, (lane & 4) != 0);
#pragma unroll
              for (int e = 0; e < 8; ++e) x[e] *= qs64;
              *(u32x4*)(swq + ((size_t)(b * 8 + (lane >> 3)) * SEQ + s) * 64 + 8 * l8) = pack8(x); }
            { unpack8(w_swkv, x); const float ss = group_sum<8>(sumsq8(x)); scale8(x, 1.0f / sqrtf(ss * (1.0f / 64) + EPS), g_swk); rope8(x, cs, (lane & 4) != 0);
              if (lane < 16) *(u32x4*)(swk + ((size_t)(b * 2 + (lane >> 3)) * SEQ + s) * 64 + 8 * l8) = pack8(x); }
        }
        __syncthreads();
#pragma unroll 1
        for (int it = 0; it < 5; ++it) { const int item = tid + it * 512, part = item / VW, c = item - part * VW;
            unsigned short e[8];
#pragma unroll
            for (int q = 0; q < 8; ++q) e[q] = vt[(part * 8 + q) * VW + c];
            u32x4 w; w.x = e[0] | ((unsigned)e[1] << 16); w.y = e[2] | ((unsigned)e[3] << 16); w.z = e[4] | ((unsigned)e[5] << 16); w.w = e[6] | ((unsigned)e[7] << 16);
            bf16_t* dp = (c < 512) ? navT + ((((size_t)(b * 4 + (c >> 7)) * 64 + chunk) * 128 + (c & 127)) * 32 + part * 8)
                                   : swvT + ((((size_t)(b * 2 + ((c - 512) >> 6)) * 64 + chunk) * 64 + ((c - 512) & 63)) * 32 + part * 8);
            *(u32x4*)dp = w; }
        __syncthreads();
    }
}

__device__ __forceinline__ void prep2(const Params& p, int l, LAS unsigned char* lds, int tid, int wid, int lane) {
    const bf16_t* z = (const bf16_t*)(p.ws + WS_Z); const bf16_t* qraw = (const bf16_t*)(p.ws + WS_QRAW); const bf16_t* kvraw = (const bf16_t*)(p.ws + WS_KVRAW);
    const bf16_t* memkv = (const bf16_t*)(p.ws + WS_MEMKV) + (size_t)l * NMEM * 1024;
    bf16_t* mlq = (bf16_t*)(p.ws + WS_MLQ); bf16_t* mlk = (bf16_t*)(p.ws + WS_MLK); bf16_t* mlvT = (bf16_t*)(p.ws + WS_MLVT);
    bf16_t* mek = (bf16_t*)(p.ws + WS_MEK); bf16_t* mevT = (bf16_t*)(p.ws + WS_MEVT);
    const f32x4* rt4 = (const f32x4*)(p.ws + WS_ROPE);
    const float qs192 = 0.07216878364870322f * LOG2E;
    const int l16 = lane & 15, l24 = lane < 24 ? lane : 0;
    const Gain8 g_q = ldg8(p.in[I_MLA_QN] + l * 192 + 8 * l24), g_k = ldg8(p.in[I_MLA_KN] + l * 192 + 8 * l24), g_mk = ldg8(p.in[I_MEM_KN] + l * 128 + 8 * l16);
    constexpr int VW = 512;
    LAS bf16_t* vt = (LAS bf16_t*)lds;
    const u32x4 zero4 = (u32x4){0u, 0u, 0u, 0u};
    for (int grp = blockIdx.x; grp < NTOK / 32 + NMEM / 32; grp += gridDim.x) {
        const bool ismem = grp >= NTOK / 32;
        if (!ismem) {
            const int b = grp >> 6, chunk = grp & 63;
#pragma unroll 2
            for (int ti = 0; ti < 4; ++ti) {
                const int tl = wid * 4 + ti, s = chunk * 32 + tl, token = grp * 32 + tl;
                u32x4 wq[4], wk[4];
#pragma unroll
                for (int h = 0; h < 4; ++h) { wq[h] = lane < 24 ? *(const u32x4*)(qraw + (size_t)token * 768 + h * 192 + 8 * lane) : zero4;
                    wk[h] = lane < 16 ? *(const u32x4*)(kvraw + (size_t)token * 1024 + h * 256 + 8 * lane) : (lane < 24 ? *(const u32x4*)(z + (size_t)token * ZC + Z_KPE + 8 * (lane - 16)) : zero4); }
                const u32x4 wv = *(const u32x4*)(kvraw + (size_t)token * 1024 + (lane >> 4) * 256 + 128 + 8 * l16);
                f32x4 cs[4];
#pragma unroll
                for (int q = 0; q < 4; ++q) cs[q] = rt4[(s * 32 + (lane & 3) * 8) / 2 + q];
                *(LAS u32x4*)(vt + tl * VW + (lane >> 4) * 128 + 8 * l16) = wv;
                const bool ropel = lane >= 16 && lane < 24;
#pragma unroll
                for (int h = 0; h < 4; ++h) {
                    float x[8];
                    { unpack8(wq[h], x); const float ss = group_sum<64>(sumsq8(x)); scale8(x, 1.0f / sqrtf(ss * (1.0f / 192) + EPS), g_q);
                      float y[8];
#pragma unroll
                      for (int e = 0; e < 8; ++e) y[e] = x[e];
                      rope8(y, cs, (lane & 4) != 0);
#pragma unroll
                      for (int e = 0; e < 8; ++e) x[e] = (ropel ? y[e] : x[e]) * qs192;
                      if (lane < 24) *(u32x4*)(mlq + ((size_t)(b * 4 + h) * SEQ + s) * 192 + 8 * lane) = pack8(x); }
                    { unpack8(wk[h], x); const float ss = group_sum<64>(sumsq8(x)); scale8(x, 1.0f / sqrtf(ss * (1.0f / 192) + EPS), g_k);
                      float y[8];
#pragma unroll
                      for (int e = 0; e < 8; ++e) y[e] = x[e];
                      rope8(y, cs, (lane & 4) != 0);
#pragma unroll
                      for (int e = 0; e < 8; ++e) x[e] = ropel ? y[e] : x[e];
                      if (lane < 24) *(u32x4*)(mlk + ((size_t)(b * 4 + h) * SEQ + s) * 192 + 8 * lane) = pack8(x); }
                }
            }
            __syncthreads();
#pragma unroll 1
            for (int it = 0; it < 4; ++it) { const int item = tid + it * 512, part = item >> 9, c = item & 511;
                unsigned short e[8];
#pragma unroll
                for (int q = 0; q < 8; ++q) e[q] = vt[(part * 8 + q) * VW + c];
                u32x4 w; w.x = e[0] | ((unsigned)e[1] << 16); w.y = e[2] | ((unsigned)e[3] << 16); w.z = e[4] | ((unsigned)e[5] << 16); w.w = e[6] | ((unsigned)e[7] << 16);
                *(u32x4*)(mlvT + ((((size_t)(b * 4 + (c >> 7)) * 64 + chunk) * 128 + (c & 127)) * 32 + part * 8)) = w; }
            __syncthreads();
        } else {
            const int mg = grp - NTOK / 32, b = mg >> 3, chunk = mg & 7;
#pragma unroll 2
            for (int ti = 0; ti < 4; ++ti) {
                const int tl = wid * 4 + ti, m = chunk * 32 + tl, mt = mg * 32 + tl;
                const bf16_t* mr = memkv + (size_t)mt * 1024;
                const u32x4 wkk = *(const u32x4*)(mr + 8 * lane), wv = *(const u32x4*)(mr + 512 + 8 * lane);
                *(LAS u32x4*)(vt + tl * VW + 8 * lane) = wv;
                float x[8]; unpack8(wkk, x); const float ss = group_sum<16>(sumsq8(x)); scale8(x, 1.0f / sqrtf(ss * (1.0f / 128) + EPS), g_mk);
                *(u32x4*)(mek + ((size_t)(b * 4 + (lane >> 4)) * MEML + m) * 128 + 8 * l16) = pack8(x);
            }
            __syncthreads();
#pragma unroll 1
            for (int it = 0; it < 4; ++it) { const int item = tid + it * 512, part = item >> 9, c = item & 511;
                unsigned short e[8];
#pragma unroll
                for (int q = 0; q < 8; ++q) e[q] = vt[(part * 8 + q) * VW + c];
                u32x4 w; w.x = e[0] | ((unsigned)e[1] << 16); w.y = e[2] | ((unsigned)e[3] << 16); w.z = e[4] | ((unsigned)e[5] << 16); w.w = e[6] | ((unsigned)e[7] << 16);
                *(u32x4*)(mevT + ((((size_t)(b * 4 + (c >> 7)) * 8 + chunk) * 128 + (c & 127)) * 32 + part * 8)) = w; }
            __syncthreads();
        }
    }
}
constexpr int ATT_RPB_OFF = 98304;
template <int DQ, int DV, int MODE, int NQT>
__device__ __forceinline__ void attn_unit(LAS unsigned char* lds, const bf16_t* qp, const bf16_t* kp, const bf16_t* vp, bf16_t* op,
                                          int nsub, int c_lo, int c_hi, int mq0, int mk0, int mr, float kbound, float sadd, float sink2, int tid, int lane) {
    constexpr int KROW = DQ * 2 + 16, KBUF = 64 * KROW, VROW = 144, VBUF = DV * VROW, NDC = DQ / 32, NDV = DV / 16, DQ8 = DQ / 8;
    constexpr int KP = 64 * DQ8 / 512, VP = 2 * DV * 4 / 512;
    static_assert(KP * 512 == 64 * DQ8 && VP * 512 == 2 * DV * 4 && 2 * KBUF + 2 * VBUF <= ATT_RPB_OFF, "attention staging geometry");
    const int fr = lane & 15, fq = lane >> 4;
    bf16x8 qf[NQT][NDC];
#pragma unroll
    for (int qt = 0; qt < NQT; ++qt)
#pragma unroll
        for (int dc = 0; dc < NDC; ++dc) qf[qt][dc] = *(const bf16x8*)(qp + (size_t)(qt * 16 + fr) * DQ + dc * 32 + fq * 8);
    f32x4 o[NQT][NDV];
#pragma unroll
    for (int qt = 0; qt < NQT; ++qt)
#pragma unroll
        for (int d = 0; d < NDV; ++d) o[qt][d] = (f32x4){0.f, 0.f, 0.f, 0.f};
    float mref[NQT], lrun[NQT];
#pragma unroll
    for (int qt = 0; qt < NQT; ++qt) { float qq = 0.f;
#pragma unroll
        for (int dc = 0; dc < NDC; ++dc) { const u32x4 w = __builtin_bit_cast(u32x4, qf[qt][dc]);
            qq += bflo(w.x) * bflo(w.x) + bfhi(w.x) * bfhi(w.x) + bflo(w.y) * bflo(w.y) + bfhi(w.y) * bfhi(w.y) + bflo(w.z) * bflo(w.z) + bfhi(w.z) * bfhi(w.z) + bflo(w.w) * bflo(w.w) + bfhi(w.w) * bfhi(w.w); }
        qq += __shfl_xor(qq, 16); qq += __shfl_xor(qq, 32);
        mref[qt] = sqrtf(qq) * kbound + sadd; lrun[qt] = 0.f; }
    int kd[KP], vd[VP];
#pragma unroll
    for (int i = 0; i < KP; ++i) { const int pk = tid + i * 512, key = pk / DQ8, dp = pk - key * DQ8, k32 = key & 31;
        kd[i] = (32 * (key >> 5) + 16 * ((k32 >> 2) & 1) + 4 * (k32 >> 3) + (k32 & 3)) * KROW + dp * 16; }
#pragma unroll
    for (int i = 0; i < VP; ++i) { const int pv = tid + i * 512, sub = pv / (DV * 4), r = pv - sub * (DV * 4); vd[i] = (r >> 2) * VROW + sub * 64 + (r & 3) * 16; }
    u32x4 rk[KP], rv[VP];
#pragma unroll
    for (int i = 0; i < KP; ++i) rk[i] = *(const u32x4*)(kp + (size_t)(tid + i * 512) * 8);
#pragma unroll
    for (int i = 0; i < VP; ++i) rv[i] = *(const u32x4*)(vp + (size_t)(tid + i * 512) * 8);
#pragma unroll
    for (int i = 0; i < KP; ++i) *(LAS u32x4*)(lds + kd[i]) = rk[i];
#pragma unroll
    for (int i = 0; i < VP; ++i) *(LAS u32x4*)(lds + 2 * KBUF + vd[i]) = rv[i];
    __syncthreads();
    __builtin_amdgcn_s_waitcnt(0x0F70);
    const int n64 = nsub >> 1;
#pragma unroll 1
    for (int c = 0; c < n64; ++c) {
        const int cur = c & 1; const bool more = (c + 1 < n64);
        if (more) { const bf16_t* kn = kp + (size_t)(c + 1) * 64 * DQ; const bf16_t* vn = vp + (size_t)(c + 1) * 2 * DV * 32;
#pragma unroll
            for (int i = 0; i < KP; ++i) { const bf16_t* ga = kn + (size_t)(tid + i * 512) * 8; asm volatile("global_load_dwordx4 %0, %1, off" : "=v"(rk[i]) : "v"(ga) : "memory"); }
#pragma unroll
            for (int i = 0; i < VP; ++i) { const bf16_t* ga = vn + (size_t)(tid + i * 512) * 8; asm volatile("global_load_dwordx4 %0, %1, off" : "=v"(rv[i]) : "v"(ga) : "memory"); } }
#pragma unroll (NQT == 1 ? 2 : 1)
        for (int sub = 0; sub < 2; ++sub) {
            const int sc = 2 * c + sub;
            if (sc >= c_lo && sc < c_hi) {
                const LAS unsigned char* kb = lds + cur * KBUF + sub * 32 * KROW; const LAS unsigned char* vb = lds + 2 * KBUF + cur * VBUF + sub * 64;
                f32x4 s[NQT][2];
#pragma unroll
                for (int qt = 0; qt < NQT; ++qt) { s[qt][0] = (f32x4){0.f, 0.f, 0.f, 0.f}; s[qt][1] = (f32x4){0.f, 0.f, 0.f, 0.f}; }
                { bf16x8 kf[NDC][2];
#pragma unroll
                  for (int dc = 0; dc < NDC; ++dc) { kf[dc][0] = *(const LAS bf16x8*)(kb + fr * KROW + (dc * 32 + fq * 8) * 2); kf[dc][1] = *(const LAS bf16x8*)(kb + (16 + fr) * KROW + (dc * 32 + fq * 8) * 2); }
#pragma unroll
                  for (int dc = 0; dc < NDC; ++dc)
#pragma unroll
                    for (int qt = 0; qt < NQT; ++qt) { s[qt][0] = __builtin_amdgcn_mfma_f32_16x16x32_bf16(kf[dc][0], qf[qt][dc], s[qt][0], 0, 0, 0);
                                                       s[qt][1] = __builtin_amdgcn_mfma_f32_16x16x32_bf16(kf[dc][1], qf[qt][dc], s[qt][1], 0, 0, 0); } }
                bf16x8 pf[NQT];
#pragma unroll
                for (int qt = 0; qt < NQT; ++qt) {
                    if (MODE == 1) {
                        const int qpos = mq0 + qt * 16 + fr, kbase = mk0 + sc * 32 + 8 * fq;
#pragma unroll
                        for (int b = 0; b < 2; ++b)
#pragma unroll
                            for (int i = 0; i < 4; ++i) { const int dd = qpos - (kbase + 4 * b + i); if (dd > 128 || dd < -128) s[qt][b][i] = -1e30f; }
                    } else if (MODE == 2) {
                        const LAS float* rpb = (const LAS float*)(lds + ATT_RPB_OFF);
                        const int qc = mq0 + qt * 16 + fr, kr = mk0 + (sc >> 1), kcb = (sc & 1) * 32 + 8 * fq;
                        int cs = qc - 8; cs = cs < 0 ? 0 : (cs > 48 ? 48 : cs);
                        const int rowoff = (kr - mr + 7) * 31;
#pragma unroll
                        for (int b = 0; b < 2; ++b)
#pragma unroll
                            for (int i = 0; i < 4; ++i) { const int kc = kcb + 4 * b + i; const bool ok = (kc >= cs) && (kc <= cs + 15);
                                int bi = kc - qc + 15; bi = bi < 0 ? 0 : (bi > 30 ? 30 : bi);
                                const float bias = rpb[rowoff + bi];
                                s[qt][b][i] = ok ? s[qt][b][i] + bias : -1e30f; }
                    }
                    float ps = 0.f;
#pragma unroll
                    for (int b = 0; b < 2; ++b)
#pragma unroll
                        for (int i = 0; i < 4; ++i) { const float e = __builtin_amdgcn_exp2f(s[qt][b][i] - mref[qt]); s[qt][b][i] = e; ps += e; }
                    lrun[qt] += ps;
                    u32x4 w; w.x = cvt_pk_bf16(s[qt][0][0], s[qt][0][1]); w.y = cvt_pk_bf16(s[qt][0][2], s[qt][0][3]); w.z = cvt_pk_bf16(s[qt][1][0], s[qt][1][1]); w.w = cvt_pk_bf16(s[qt][1][2], s[qt][1][3]);
                    pf[qt] = __builtin_bit_cast(bf16x8, w);
                }
                { bf16x8 vf[NDV];
#pragma unroll
                  for (int d = 0; d < NDV; ++d) vf[d] = *(const LAS bf16x8*)(vb + (d * 16 + fr) * VROW + fq * 16);
#pragma unroll
                  for (int d = 0; d < NDV; ++d)
#pragma unroll
                    for (int qt = 0; qt < NQT; ++qt) o[qt][d] = __builtin_amdgcn_mfma_f32_16x16x32_bf16(vf[d], pf[qt], o[qt][d], 0, 0, 0); }
            }
        }
        if (more) { const int nb = cur ^ 1;
            if constexpr (KP == 3) asm volatile("s_waitcnt vmcnt(0)" : "+v"(rk[0]), "+v"(rk[1]), "+v"(rk[2]), "+v"(rv[0]), "+v"(rv[1]) :: "memory");
            else if constexpr (KP == 2) asm volatile("s_waitcnt vmcnt(0)" : "+v"(rk[0]), "+v"(rk[1]), "+v"(rv[0]), "+v"(rv[1]) :: "memory");
            else asm volatile("s_waitcnt vmcnt(0)" : "+v"(rk[0]), "+v"(rv[0]) :: "memory");
#pragma unroll
            for (int i = 0; i < KP; ++i) *(LAS u32x4*)(lds + nb * KBUF + kd[i]) = rk[i];
#pragma unroll
            for (int i = 0; i < VP; ++i) *(LAS u32x4*)(lds + 2 * KBUF + nb * VBUF + vd[i]) = rv[i]; }
        __syncthreads();
    }
#pragma unroll
    for (int qt = 0; qt < NQT; ++qt) {
        float l = lrun[qt]; l += __shfl_xor(l, 16); l += __shfl_xor(l, 32);
        if (MODE == 1) l += __builtin_amdgcn_exp2f(sink2 - mref[qt]);
        const float inv = 1.0f / l;
        bf16_t* orow = op + (size_t)(qt * 16 + fr) * DM + 4 * fq;
#pragma unroll
        for (int d = 0; d < NDV; ++d) { u32x2 w; w.x = cvt_pk_bf16(o[qt][d][0] * inv, o[qt][d][1] * inv); w.y = cvt_pk_bf16(o[qt][d][2] * inv, o[qt][d][3] * inv); *(u32x2*)(orow + d * 16) = w; }
    }
}

__device__ __forceinline__ float gain_absmax(const float* g, int n, int lane) {
    float m = 0.f;
#pragma unroll
    for (int j = 0; j < 3; ++j) { const int i = lane + 64 * j; if (i < n) m = fmaxf(m, fabsf(g[i])); }
#pragma unroll
    for (int o = 32; o >= 1; o >>= 1) m = fmaxf(m, __shfl_xor(m, o));
    return m;
}
__device__ __forceinline__ void attn_phase(const Params& p, int lq, LAS unsigned char* lds, int tid, int wid, int lane, int G, int cblk) {
    const int l = lq & 1;
    unsigned* head = (unsigned*)(p.ws + WS_CTL) + CW_ATTQ + lq * 64;
    volatile LAS int* qw = (volatile LAS int*)(lds + LDS_MISC + 64);
    bf16_t* br = (bf16_t*)(p.ws + ((lq & 2) ? WS_ACT : WS_BR));
    const float kb_mla = 13.856406460551018f * gain_absmax(p.in[I_MLA_KN] + l * 192, 192, lane), kb_na = 11.313708498984761f * gain_absmax(p.in[I_NA_KN] + l * 128, 128, lane);
    const float kb_swa = 8.0f * gain_absmax(p.in[I_SWA_KN] + l * 64, 64, lane), kb_mem = 11.313708498984761f * gain_absmax(p.in[I_MEM_KN] + l * 128, 128, lane);
    const int pmode = lq >> 2;
    if (pmode != 2) {
        const int x = cblk & 7, j = cblk >> 3;
        if (G == 256 ? (j < 16) : true)
        for (int id = (G == 256 ? x * 16 + j : cblk); id < 128; id += (G == 256 ? 128 : G)) {
            const int bhi = id >> 3, qt8 = id & 7, b = bhi >> 2, h = bhi & 3; const size_t bh = (size_t)bhi;
            const bf16_t* q = (const bf16_t*)(p.ws + WS_MLQ) + (bh * SEQ + qt8 * 256 + wid * 32) * 192;
            const bf16_t* k = (const bf16_t*)(p.ws + WS_MLK) + bh * SEQ * 192; const bf16_t* v = (const bf16_t*)(p.ws + WS_MLVT) + bh * SEQ * 128;
            bf16_t* o = br + (size_t)(b * SEQ + qt8 * 256 + wid * 32) * DM + 512 + h * 128;
            attn_unit<192, 128, 0, 2>(lds, q, k, v, o, 64, 0, 64, 0, 0, 0, kb_mla, 0.f, 0.f, tid, lane);
        }
    }
    if (pmode != 1)
    for (;;) {
        if (tid == 0) qw[0] = 256 + (int)__hip_atomic_fetch_add(head, 1u, __ATOMIC_RELAXED, __HIP_MEMORY_SCOPE_AGENT);
        __syncthreads();
        const int id = __builtin_amdgcn_readfirstlane(qw[0]);
        __syncthreads();
        if (id >= 896) break;
        if (id < 256) {
        } else if (id < 512) {
            const int u = id - 256, b = u >> 6, h = (u >> 4) & 3, r2 = u & 15; const size_t bh = (size_t)(b * 4 + h);
            const int r = r2 * 2 + (wid >> 2), half = (wid >> 1) & 1, qs = wid & 1;
            int kr_lo = r2 * 2 - 4; kr_lo = kr_lo < 0 ? 0 : (kr_lo > 24 ? 24 : kr_lo);
            int kr_hi = r2 * 2 + 1 - 4; kr_hi = (kr_hi < 0 ? 0 : (kr_hi > 24 ? 24 : kr_hi)) + 7;
            int rs = r - 4; rs = rs < 0 ? 0 : (rs > 24 ? 24 : rs);
            float bmax;
            { const float* rp = p.in[I_NA_RPB] + ((size_t)l * 4 + h) * 15 * 31; LAS float* rl = (LAS float*)(lds + ATT_RPB_OFF); float bv = 0.f;
              if (tid < 465) { bv = rp[tid] * LOG2E; rl[tid] = bv; }
              bv = fabsf(bv);
#pragma unroll
              for (int o2 = 32; o2 >= 1; o2 >>= 1) bv = fmaxf(bv, __shfl_xor(bv, o2));
              if (lane == 0) rl[480 + wid] = bv;
              __syncthreads();
              bmax = fmaxf(fmaxf(fmaxf(rl[480], rl[481]), fmaxf(rl[482], rl[483])), fmaxf(fmaxf(rl[484], rl[485]), fmaxf(rl[486], rl[487]))); }
            const int qtok = r * 64 + half * 32 + qs * 16;
            const bf16_t* q = (const bf16_t*)(p.ws + WS_NAQ) + (bh * SEQ + qtok) * 128;
            const bf16_t* k = (const bf16_t*)(p.ws + WS_NAK) + (bh * SEQ + kr_lo * 64) * 128; const bf16_t* v = (const bf16_t*)(p.ws + WS_NAVT) + (bh * 64 + kr_lo * 2) * 128 * 32;
            bf16_t* o = br + (size_t)(b * SEQ + qtok) * DM + 0 + h * 128;
            attn_unit<128, 128, 2, 1>(lds, q, k, v, o, 2 * (kr_hi - kr_lo + 1), 2 * (rs - kr_lo), 2 * (rs - kr_lo) + 16, half * 32 + qs * 16, kr_lo, r, kb_na, bmax, 0.f, tid, lane);
        } else if (id < 768) {
            const int u = id - 512, b = u >> 6, kvh = (u >> 5) & 1, qb = u & 31, q0 = qb * 64; const int hq = kvh * 4 + (wid >> 1), qpos0 = q0 + (wid & 1) * 32;
            const int kstart = q0 - 128 < 0 ? 0 : q0 - 128, kend = q0 + 192 > SEQ ? SEQ : q0 + 192, nch = (kend - kstart) >> 5;
            int c_lo = (qpos0 - 128 - kstart) >> 5; c_lo = c_lo < 0 ? 0 : c_lo; int c_hi = ((qpos0 + 159 - kstart) >> 5) + 1; c_hi = c_hi > nch ? nch : c_hi;
            const bf16_t* q = (const bf16_t*)(p.ws + WS_SWQ) + ((size_t)(b * 8 + hq) * SEQ + qpos0) * 64;
            const bf16_t* k = (const bf16_t*)(p.ws + WS_SWK) + ((size_t)(b * 2 + kvh) * SEQ + kstart) * 64; const bf16_t* v = (const bf16_t*)(p.ws + WS_SWVT) + ((size_t)(b * 2 + kvh) * 64 + (kstart >> 5)) * 64 * 32;
            bf16_t* o = br + (size_t)(b * SEQ + qpos0) * DM + 1024 + hq * 64;
            attn_unit<64, 64, 1, 2>(lds, q, k, v, o, nch, c_lo, c_hi, qpos0, kstart, 0, kb_swa, 0.f, p.in[I_SWA_SINK][l * 8 + hq] * LOG2E, tid, lane);
        } else {
            const int u = id - 768, b = u >> 5, h = (u >> 3) & 3, qt8 = u & 7; const size_t bh = (size_t)(b * 4 + h);
            const bf16_t* q = (const bf16_t*)(p.ws + WS_MEQ) + (bh * SEQ + qt8 * 256 + wid * 32) * 128;
            const bf16_t* k = (const bf16_t*)(p.ws + WS_MEK) + bh * MEML * 128; const bf16_t* v = (const bf16_t*)(p.ws + WS_MEVT) + bh * MEML * 128;
            bf16_t* o = br + (size_t)(b * SEQ + qt8 * 256 + wid * 32) * DM + 1536 + h * 128;
            attn_unit<128, 128, 0, 2>(lds, q, k, v, o, 8, 0, 8, 0, 0, 0, kb_mem, 0.f, 0.f, tid, lane);
        }
    }
}

__device__ __forceinline__ void router_phase(const Params& p, LAS unsigned char* lds, int tid, int wid, int lane) {
    const float* hres = p.out; const float* g = p.in[I_NORM_FFN] + DM; const float* wr = p.in[I_ROUTER];
    unsigned* cnt = (unsigned*)(p.ws + WS_CTL) + CW_MOECNT;
    unsigned char* xg = p.ws + WS_XG; int* tokv = (int*)(p.ws + WS_TOK); float* wtv = (float*)(p.ws + WS_WT);
    LAS float* wl = (LAS float*)lds;
    LAS float* sel = (LAS float*)(lds + 65536);
    for (int i = tid; i < DM * NEXP; i += NTHREADS) { const int d = i >> 3, e = i & 7; wl[e * DM + d] = wr[i]; }
    __syncthreads();
    for (int grp = blockIdx.x; grp < NTOK / 32; grp += gridDim.x) {
#pragma unroll 1
        for (int ti = 0; ti < 4; ++ti) {
            const int tl = wid * 4 + ti, token = grp * 32 + tl;
            const f32x4* sp = (const f32x4*)(hres + (size_t)token * DM); f32x4 v[8]; float ss = 0.f;
#pragma unroll
            for (int j = 0; j < 8; ++j) { v[j] = sp[lane + 64 * j]; ss += v[j][0] * v[j][0] + v[j][1] * v[j][1] + v[j][2] * v[j][2] + v[j][3] * v[j][3]; }
            ss = wave_sum(ss); const float rstd = 1.0f / sqrtf(ss * (1.0f / DM) + EPS);
            float lg[8];
#pragma unroll
            for (int e = 0; e < 8; ++e) lg[e] = 0.f;
#pragma unroll
            for (int j = 0; j < 8; ++j) { const f32x4 gv = ((const f32x4*)g)[lane + 64 * j]; const f32x4 hn = v[j] * rstd * gv;
#pragma unroll
                for (int e = 0; e < 8; ++e) { const f32x4 w4 = *(const LAS f32x4*)(wl + e * DM + 4 * (lane + 64 * j)); lg[e] += hn[0] * w4[0] + hn[1] * w4[1] + hn[2] * w4[2] + hn[3] * w4[3]; } }
#pragma unroll
            for (int e = 0; e < 8; ++e) lg[e] = wave_sum(lg[e]);
            int i0 = 0; float v0 = lg[0];
#pragma unroll
            for (int e = 1; e < 8; ++e) if (lg[e] > v0) { v0 = lg[e]; i0 = e; }
            int i1 = -1; float v1 = -3.0e38f;
#pragma unroll
            for (int e = 0; e < 8; ++e) if (e != i0 && lg[e] > v1) { v1 = lg[e]; i1 = e; }
            const float e1 = __expf(v1 - v0), w0 = 1.0f / (1.0f + e1), w1 = e1 * w0;
            if (lane == 0) { sel[tl * 8 + 0] = __int_as_float(i0); sel[tl * 8 + 1] = __int_as_float(i1); sel[tl * 8 + 2] = w0; sel[tl * 8 + 3] = w1; sel[tl * 8 + 4] = rstd; }
        }
        __syncthreads();
        if (tid < NEXP) { int n = 0;
            for (int t = 0; t < 32; ++t) { n += (__float_as_int(sel[t * 8 + 0]) == tid) ? 1 : 0; n += (__float_as_int(sel[t * 8 + 1]) == tid) ? 1 : 0; }
            int base = n ? (int)__hip_atomic_fetch_add(cnt + tid * 64, (unsigned)n, __ATOMIC_RELAXED, __HIP_MEMORY_SCOPE_AGENT) : 0;
            for (int t = 0; t < 32; ++t) { if (__float_as_int(sel[t * 8 + 0]) == tid) sel[t * 8 + 5] = __int_as_float(base++); if (__float_as_int(sel[t * 8 + 1]) == tid) sel[t * 8 + 6] = __int_as_float(base++); } }
        __syncthreads();
#pragma unroll 1
        for (int ti = 0; ti < 4; ++ti) {
            const int tl = wid * 4 + ti, token = grp * 32 + tl;
            const int e0 = __float_as_int(sel[tl * 8 + 0]), e1 = __float_as_int(sel[tl * 8 + 1]); const float w0 = sel[tl * 8 + 2], w1 = sel[tl * 8 + 3], rstd = sel[tl * 8 + 4];
            const int s0 = e0 * ECAP + __float_as_int(sel[tl * 8 + 5]), s1 = e1 * ECAP + __float_as_int(sel[tl * 8 + 6]);
            const f32x4* sp = (const f32x4*)(hres + (size_t)token * DM);
#pragma unroll
            for (int j = 0; j < 8; ++j) { const f32x4 x = sp[lane + 64 * j]; const f32x4 gv = ((const f32x4*)g)[lane + 64 * j];
#if MOE_FP8
                const float rg = rstd * SC_ACT8; const unsigned w = pg8::pack_fp8x4(x[0] * rg * gv[0], x[1] * rg * gv[1], x[2] * rg * gv[2], x[3] * rg * gv[3]);
                *(unsigned*)(xg + (size_t)s0 * DM + 4 * (lane + 64 * j)) = w; *(unsigned*)(xg + (size_t)s1 * DM + 4 * (lane + 64 * j)) = w; }
#else
                u32x2 w; w.x = cvt_pk_bf16(x[0] * rstd * gv[0], x[1] * rstd * gv[1]); w.y = cvt_pk_bf16(x[2] * rstd * gv[2], x[3] * rstd * gv[3]);
                *(u32x2*)(xg + ((size_t)s0 * DM + 4 * (lane + 64 * j)) * 2) = w; *(u32x2*)(xg + ((size_t)s1 * DM + 4 * (lane + 64 * j)) * 2) = w; }
#endif
            if (lane == 0) { tokv[s0] = token; wtv[s0] = w0; tokv[s1] = token; wtv[s1] = w1; int* ts = (int*)(p.ws + WS_TSLOT); ts[token * 2] = s0; ts[token * 2 + 1] = s1; }
        }
        __syncthreads();
    }
}

constexpr int MOE_TAB_OFF = LDS_MISC + 128;
__device__ __forceinline__ void moe_table(LAS unsigned char* lds, const unsigned* cnt, int nN, int tid) {
    LAS int* tab = (LAS int*)(lds + MOE_TAB_OFF);
    __syncthreads();
    if (tid == 0) { int acc = 0; for (int e = 0; e < 8; ++e) { const int n = ((int)cnt[e * 64] + 255) >> 8; tab[e] = n; tab[8 + e] = acc; acc += n * nN; } tab[16] = acc; }
    __syncthreads();
}
struct SchedMoe {
    const char* A; const char* B; size_t a_estride, b_estride, a_tstride, b_tstride; const LAS int* tab; int G, c; int ksplit; size_t kbytes;
    __device__ __forceinline__ bool next(int i, pg8::Unit& u) const {
        const int L0 = i * G + c; if (L0 >= tab[16] * ksplit) return false;
        const int ks = L0 % ksplit, L = L0 / ksplit;
        int e = 0;
#pragma unroll
        for (int k = 1; k < 8; ++k) e = (L >= tab[8 + k]) ? k : e;
        const int ne = tab[e], loc = L - tab[8 + e], pn = (loc & 7) + 8 * (loc / (8 * ne)), pm = (loc >> 3) % ne;
        u.A = A + (size_t)e * a_estride + (size_t)pm * a_tstride + (size_t)ks * kbytes; u.B = B + (size_t)e * b_estride + (size_t)pn * b_tstride + (size_t)ks * kbytes;
        u.orow = e * ECAP + pm * 256; u.ocol = pn; u.x0 = e; u.x1 = pm * 256; u.ks = ks; u.pad_ = 0; return true;
    }
};
struct SchedMerge {
    const char* br; const char* wb; int G, c;
    __device__ __forceinline__ bool next(int i, pg8::Unit& u) const {
        int pm, pn; if (!pg8::static_tile(i >> 2, G, c, NTOK / 256, DM / 256, pm, pn)) return false;
        const int n = i & 3;
        u.A = br + ((size_t)pm * 256 * DM + n * 512) * 2; u.B = wb + ((size_t)n * DM * 512 + (size_t)pn * 256 * 512) * 2; u.orow = pm * 256; u.ocol = pn; u.x0 = n; u.x1 = 0; u.ks = 0; u.pad_ = 0; return true;
    }
};

__device__ __forceinline__ void moe_combine(const Params& p, int wid, int lane) {
    const int* ts = (const int*)(p.ws + WS_TSLOT); const bf16_t* y = (const bf16_t*)(p.ws + WS_Y); float* out = p.out;
    for (int row = blockIdx.x * 8 + wid; row < NTOK; row += gridDim.x * 8) {
        const int s0 = ts[row * 2], s1 = ts[row * 2 + 1];
        f32x4* o = (f32x4*)(out + (size_t)row * DM);
        u32x4 a[MOE_KS][4], b[MOE_KS][4]; f32x4 hv[8];
#pragma unroll
        for (int ks = 0; ks < MOE_KS; ++ks) { const u32x4* y0 = (const u32x4*)(y + ((size_t)ks * NEXP * ECAP + s0) * DM); const u32x4* y1 = (const u32x4*)(y + ((size_t)ks * NEXP * ECAP + s1) * DM);
#pragma unroll
            for (int j = 0; j < 4; ++j) { a[ks][j] = y0[lane + 64 * j]; b[ks][j] = y1[lane + 64 * j]; } }
#pragma unroll
        for (int j = 0; j < 4; ++j) { hv[2 * j] = o[2 * (lane + 64 * j)]; hv[2 * j + 1] = o[2 * (lane + 64 * j) + 1]; }
#pragma unroll
        for (int j = 0; j < 4; ++j) {
            f32x4 r0 = hv[2 * j], r1 = hv[2 * j + 1];
#pragma unroll
            for (int ks = 0; ks < MOE_KS; ++ks) { const u32x4 av = a[ks][j], bv = b[ks][j];
                r0[0] += bflo(av.x) + bflo(bv.x); r0[1] += bfhi(av.x) + bfhi(bv.x); r0[2] += bflo(av.y) + bflo(bv.y); r0[3] += bfhi(av.y) + bfhi(bv.y);
                r1[0] += bflo(av.z) + bflo(bv.z); r1[1] += bfhi(av.z) + bfhi(bv.z); r1[2] += bflo(av.w) + bflo(bv.w); r1[3] += bfhi(av.w) + bfhi(bv.w); }
            o[2 * (lane + 64 * j)] = r0; o[2 * (lane + 64 * j) + 1] = r1; }
    }
}

#ifdef PROBE_NAIVE
#ifndef NAIVE_TOL2
#define NAIVE_TOL2 0.0036f
#endif
__device__ __forceinline__ void nv_rope(float& x2, int lane, int pos) {
    const int i = lane & 31; const float freq = exp2f(-(float)i * (13.287712379549449f / 32.0f)); const float ang = (float)pos * freq;
    const double rev = (double)ang * 0.15915494309189535; const float fr_ = (float)(rev - __builtin_rint(rev));
    const float c = __builtin_amdgcn_cosf(fr_), s = __builtin_amdgcn_sinf(fr_); const float pr = __shfl_xor(x2, 32);
    x2 = lane < 32 ? x2 * c - pr * s : x2 * c + pr * s;
}
__device__ __forceinline__ void naive_check(const Params& p, unsigned* flag, int wid, int lane) {
    const int l = 1;
    const bf16_t* z = (const bf16_t*)(p.ws + WS_Z); const bf16_t* qraw = (const bf16_t*)(p.ws + WS_QRAW); const bf16_t* kvraw = (const bf16_t*)(p.ws + WS_KVRAW);
    const bf16_t* memkv = (const bf16_t*)(p.ws + WS_MEMKV) + (size_t)l * NMEM * 1024; const bf16_t* br = (const bf16_t*)(p.ws + WS_BR);
    const int poslist[16] = {0, 1, 31, 63, 64, 65, 127, 128, 129, 500, 1023, 1024, 1500, 1919, 1984, 2047};
    for (int unit = blockIdx.x * 8 + wid; unit < 64 * 20; unit += gridDim.x * 8) {
        const int smp = unit / 20, hh = unit % 20;
        int pos = 0;
#pragma unroll
        for (int q = 0; q < 16; ++q) pos = ((smp >> 2) == q) ? poslist[q] : pos;
        const int b = smp & 3, t = b * SEQ + pos;
        float o[3] = {0.f, 0.f, 0.f}, m = -3.0e38f, lsum = 0.f; float q[3] = {0.f, 0.f, 0.f};
        float ref[3] = {0.f, 0.f, 0.f}; int nd = 2;
        if (hh < 4) {
            const int h = hh; const float* gq = p.in[I_NA_QN] + l * 128; const float* gk = p.in[I_NA_KN] + l * 128;
            float ss = 0.f; for (int j = 0; j < 2; ++j) { q[j] = bf2f(z[(size_t)t * ZC + Z_NAQ + h * 128 + lane + 64 * j]); ss += q[j] * q[j]; }
            ss = wave_sum(ss); for (int j = 0; j < 2; ++j) q[j] *= (1.0f / sqrtf(ss / 128 + EPS)) * gq[lane + 64 * j];
            const int r = pos >> 6, c = pos & 63; int rs = r - 4; rs = rs < 0 ? 0 : (rs > 24 ? 24 : rs); int cs = c - 8; cs = cs < 0 ? 0 : (cs > 48 ? 48 : cs);
            for (int i = 0; i < 8; ++i) for (int jj = 0; jj < 16; ++jj) { const int n = b * SEQ + (rs + i) * 64 + cs + jj;
                float k[2], ks = 0.f; for (int j = 0; j < 2; ++j) { k[j] = bf2f(z[(size_t)n * ZC + Z_NAK + h * 128 + lane + 64 * j]); ks += k[j] * k[j]; }
                ks = wave_sum(ks); float dot = 0.f; for (int j = 0; j < 2; ++j) dot += q[j] * k[j] * (1.0f / sqrtf(ks / 128 + EPS)) * gk[lane + 64 * j];
                const float s = wave_sum(dot) * 0.08838834764831845f + p.in[I_NA_RPB][(((size_t)l * 4 + h) * 15 + (rs + i - r + 7)) * 31 + (cs + jj - c + 15)];
                const float mn = fmaxf(m, s), al = __expf(m - mn), pe = __expf(s - mn); m = mn; lsum = lsum * al + pe;
                for (int j = 0; j < 2; ++j) o[j] = o[j] * al + pe * bf2f(z[(size_t)n * ZC + Z_NAV + h * 128 + lane + 64 * j]); }
            for (int j = 0; j < 2; ++j) ref[j] = bf2f(br[(size_t)t * DM + 0 + h * 128 + lane + 64 * j]);
        } else if (hh < 8) {
            const int h = hh - 4; nd = 3; const float* gq = p.in[I_MLA_QN] + l * 192; const float* gk = p.in[I_MLA_KN] + l * 192;
            float ss = 0.f; for (int j = 0; j < 3; ++j) { q[j] = bf2f(qraw[(size_t)t * 768 + h * 192 + lane + 64 * j]); ss += q[j] * q[j]; }
            ss = wave_sum(ss); for (int j = 0; j < 3; ++j) q[j] *= (1.0f / sqrtf(ss / 192 + EPS)) * gq[lane + 64 * j];
            nv_rope(q[2], lane, pos);
            for (int kp = 0; kp < SEQ; ++kp) { const int n = b * SEQ + kp;
                float k[3], ks = 0.f; k[0] = bf2f(kvraw[(size_t)n * 1024 + h * 256 + lane]); k[1] = bf2f(kvraw[(size_t)n * 1024 + h * 256 + 64 + lane]); k[2] = bf2f(z[(size_t)n * ZC + Z_KPE + lane]);
                for (int j = 0; j < 3; ++j) ks += k[j] * k[j];
                ks = wave_sum(ks); const float rk = 1.0f / sqrtf(ks / 192 + EPS); for (int j = 0; j < 3; ++j) k[j] *= rk * gk[lane + 64 * j];
                nv_rope(k[2], lane, kp);
                float dot = 0.f; for (int j = 0; j < 3; ++j) dot += q[j] * k[j];
                const float s = wave_sum(dot) * 0.07216878364870322f;
                const float mn = fmaxf(m, s), al = __expf(m - mn), pe = __expf(s - mn); m = mn; lsum = lsum * al + pe;
                for (int j = 0; j < 2; ++j) o[j] = o[j] * al + pe * bf2f(kvraw[(size_t)n * 1024 + h * 256 + 128 + lane + 64 * j]); }
            nd = 2;
            for (int j = 0; j < 2; ++j) ref[j] = bf2f(br[(size_t)t * DM + 512 + h * 128 + lane + 64 * j]);
        } else if (hh < 16) {
            const int hq = hh - 8, kvh = hq >> 2; nd = 1; const float* gq = p.in[I_SWA_QN] + l * 64; const float* gk = p.in[I_SWA_KN] + l * 64;
            q[0] = bf2f(z[(size_t)t * ZC + Z_SWQ + hq * 64 + lane]); float ss = wave_sum(q[0] * q[0]); q[0] *= (1.0f / sqrtf(ss / 64 + EPS)) * gq[lane]; nv_rope(q[0], lane, pos);
            for (int kp = pos - 128; kp <= pos + 128; ++kp) { if (kp < 0 || kp >= SEQ) continue; const int n = b * SEQ + kp;
                float k = bf2f(z[(size_t)n * ZC + Z_SWK + kvh * 64 + lane]); const float ks = wave_sum(k * k); k *= (1.0f / sqrtf(ks / 64 + EPS)) * gk[lane]; nv_rope(k, lane, kp);
                const float s = wave_sum(q[0] * k) * 0.125f;
                const float mn = fmaxf(m, s), al = __expf(m - mn), pe = __expf(s - mn); m = mn; lsum = lsum * al + pe;
                o[0] = o[0] * al + pe * bf2f(z[(size_t)n * ZC + Z_SWV + kvh * 64 + lane]); }
            { const float s = p.in[I_SWA_SINK][l * 8 + hq]; const float mn = fmaxf(m, s), al = __expf(m - mn), pe = __expf(s - mn); m = mn; lsum = lsum * al + pe; o[0] *= al; }
            ref[0] = bf2f(br[(size_t)t * DM + 1024 + hq * 64 + lane]);
        } else {
            const int h = hh - 16; const float* gq = p.in[I_MEM_QN] + l * 128; const float* gk = p.in[I_MEM_KN] + l * 128;
            float ss = 0.f; for (int j = 0; j < 2; ++j) { q[j] = bf2f(z[(size_t)t * ZC + Z_MEQ + h * 128 + lane + 64 * j]); ss += q[j] * q[j]; }
            ss = wave_sum(ss); for (int j = 0; j < 2; ++j) q[j] *= (1.0f / sqrtf(ss / 128 + EPS)) * gq[lane + 64 * j];
            for (int mm = 0; mm < MEML; ++mm) { const size_t n = (size_t)(b * MEML + mm) * 1024;
                float k[2], ks = 0.f; for (int j = 0; j < 2; ++j) { k[j] = bf2f(memkv[n + h * 128 + lane + 64 * j]); ks += k[j] * k[j]; }
                ks = wave_sum(ks); float dot = 0.f; for (int j = 0; j < 2; ++j) dot += q[j] * k[j] * (1.0f / sqrtf(ks / 128 + EPS)) * gk[lane + 64 * j];
                const float s = wave_sum(dot) * 0.08838834764831845f;
                const float mn = fmaxf(m, s), al = __expf(m - mn), pe = __expf(s - mn); m = mn; lsum = lsum * al + pe;
                for (int j = 0; j < 2; ++j) o[j] = o[j] * al + pe * bf2f(memkv[n + 512 + h * 128 + lane + 64 * j]); }
            for (int j = 0; j < 2; ++j) ref[j] = bf2f(br[(size_t)t * DM + 1536 + h * 128 + lane + 64 * j]);
        }
        float e2 = 0.f, n2 = 0.f;
        for (int j = 0; j < 3; ++j) if (j < nd) { const float a = o[j] / lsum; e2 += (a - ref[j]) * (a - ref[j]); n2 += a * a; }
        e2 = wave_sum(e2); n2 = wave_sum(n2);
        if (!(e2 <= NAIVE_TOL2 * n2 + 1e-12f) && lane == 0) atomicOr(flag, 1u << (hh < 4 ? 1 : hh < 8 ? 2 : hh < 16 ? 3 : 4));
    }
}
#endif
#ifndef HEAVY_ALIGN
#define HEAVY_ALIGN true
#endif
constexpr int NPHASE = 23;
constexpr int LDS_PARAMS = LDS_MISC + 256;
template <class T> __device__ __forceinline__ T* uni(T* q) { const unsigned long long v = (unsigned long long)q; const unsigned lo = __builtin_amdgcn_readfirstlane((unsigned)v), hi = __builtin_amdgcn_readfirstlane((unsigned)(v >> 32)); return (T*)(__attribute__((address_space(1))) T*)(((unsigned long long)hi << 32) | lo); }
__device__ __forceinline__ Params load_params(LAS unsigned char* lds) {
    unsigned poff = LDS_PARAMS; asm volatile("" : "+v"(poff)); poff = __builtin_amdgcn_readfirstlane(poff);
    const LAS Params* P = (const LAS Params*)(lds + poff); Params p;
#pragma unroll
    for (int i = 0; i < 30; ++i) p.in[i] = uni(P->in[i]);
    p.out = uni(P->out); p.ws = uni(P->ws); p.ph_lo = __builtin_amdgcn_readfirstlane(P->ph_lo); p.ph_hi = __builtin_amdgcn_readfirstlane(P->ph_hi); return p;
}
#define PH_HEAD int tid = threadIdx.x; asm volatile("" : "+v"(tid)); const Params p = load_params(lds); const int lane = tid & 63, wid = __builtin_amdgcn_readfirstlane(tid >> 6); const int G = p.ph_lo, cblk = p.ph_hi;     \
    unsigned char* ws = p.ws; unsigned* ctl = (unsigned*)(ws + WS_CTL); unsigned char* lw = ws + WS_LW + (size_t)l * LW_BYTES; bf16_t* U = (bf16_t*)(ws + WS_U); (void)lane; (void)wid; (void)G; (void)cblk; (void)ctl; (void)lw; (void)U
#define PHASE_FN static __device__ __forceinline__ void

PHASE_FN ph_prologue(LAS unsigned char* lds, int l) { PH_HEAD; p0_prologue(p, lds, tid, wid, lane); }
PHASE_FN ph_ingate(LAS unsigned char* lds, int l) { PH_HEAD;
#if INGATE_FP8
    pg8::SchedGrid S{(const char*)(ws + WS_U8), (const char*)(lw + LW_IN), DM / 2, DM / 2, NTOK / 256, 12288 / 256, G, cblk};
    pg8::EpiInGate E{(bf16_t*)(ws + WS_Z), (bf16_t*)(ws + WS_GATES), p.in[I_B_GATE] + (size_t)l * 8192, 1.0f / (SC_ACT8 * SC_W8)};
    pg8::gemm_phase<pg8::EpiInGate, pg8::SchedGrid, true, HEAVY_ALIGN>(lds, DM / 2, DM / 2, DM / 2, S, E, tid);
#else
    pg8::SchedGrid S{(const char*)U, (const char*)(lw + LW_IN), DM, DM, NTOK / 256, 12288 / 256, G, cblk};
    pg8::EpiInGate E{(bf16_t*)(ws + WS_Z), (bf16_t*)(ws + WS_GATES), p.in[I_B_GATE] + (size_t)l * 8192, 1.0f};
    pg8::gemm_phase(lds, DM, DM, DM, S, E, tid);
#endif
}
PHASE_FN ph_inproj(LAS unsigned char* lds, int l) { PH_HEAD;
    const bool sh = l >= 2; l &= 1; lw = ws + WS_LW + (size_t)l * LW_BYTES;
    pg8::SchedGrid S{(const char*)U, (const char*)(lw + LW_IN), DM, DM, NTOK / 256, ZC / 256, G, cblk};
    pg8::EpiBf16 E{(bf16_t*)(ws + (sh ? WS_ACT : WS_Z)), ZC};
    pg8::gemm_phase(lds, DM, DM, DM, S, E, tid); }
PHASE_FN ph_gates(LAS unsigned char* lds, int l) { PH_HEAD;
#if GATES_FP8
    pg8::SchedGrid S{(const char*)(ws + WS_U8), (const char*)(lw + LW_GATE8), DM / 2, DM / 2, NTOK / 256, 8192 / 256, G, cblk};
    pg8::EpiGates E{(bf16_t*)(ws + WS_GATES), p.in[I_B_GATE] + (size_t)l * 8192, 1.0f / (SC_ACT8 * SC_W8)};
    pg8::gemm_phase<pg8::EpiGates, pg8::SchedGrid, true>(lds, DM / 2, DM / 2, DM / 2, S, E, tid);
#else
    pg8::SchedGrid S{(const char*)U, (const char*)(lw + LW_GATE8), DM, DM, NTOK / 256, 8192 / 256, G, cblk};
    pg8::EpiGates E{(bf16_t*)(ws + WS_GATES), p.in[I_B_GATE] + (size_t)l * 8192, 1.0f};
    pg8::gemm_phase<pg8::EpiGates, pg8::SchedGrid, false>(lds, DM, DM, DM, S, E, tid);
#endif
}
PHASE_FN ph_prep1(LAS unsigned char* lds, int l) { PH_HEAD; prep1(p, l, lds, tid, wid, lane); }
PHASE_FN ph_mlaup_q(LAS unsigned char* lds, int l) { PH_HEAD;
    pg8::SchedGrid S{(const char*)(ws + WS_CQN), (const char*)(lw + LW_UQ), 768, 768, NTOK / 256, 3, G, cblk};
    pg8::EpiBf16 E{(bf16_t*)(ws + WS_QRAW), 768}; pg8::gemm_phase(lds, 768, 768, 768, S, E, tid); }
PHASE_FN ph_mlaup_kv(LAS unsigned char* lds, int l) { PH_HEAD;
    pg8::SchedGrid S{(const char*)(ws + WS_CKVN), (const char*)(lw + LW_UKV), 256, 256, NTOK / 256, 4, G, (cblk + G - 96 % G) % G};
    pg8::EpiBf16 E{(bf16_t*)(ws + WS_KVRAW), 1024}; pg8::gemm_phase(lds, 256, 256, 256, S, E, tid); }
PHASE_FN ph_memkv(LAS unsigned char* lds, int l) { PH_HEAD;
    pg8::SchedGrid S{(const char*)(ws + WS_MEMN + (size_t)l * NMEM * DM * 2), (const char*)(lw + LW_MEMKV), DM, DM, NMEM / 256, 4, G, (cblk + G - (224 + 16 * l) % G) % G};
    pg8::EpiBf16 E{(bf16_t*)(ws + WS_MEMKV) + (size_t)l * NMEM * 1024, 1024}; pg8::gemm_phase(lds, DM, DM, DM, S, E, tid); }
PHASE_FN ph_prep2(LAS unsigned char* lds, int l) { PH_HEAD; prep2(p, l, lds, tid, wid, lane); }
PHASE_FN ph_attn(LAS unsigned char* lds, int l) { PH_HEAD; attn_phase(p, l, lds, tid, wid, lane, G, cblk); }
PHASE_FN ph_merge(LAS unsigned char* lds, int l) { PH_HEAD;
    SchedMerge S{(const char*)(ws + WS_BR), (const char*)(lw + LW_BR), G, cblk};
    pg8::EpiMerge E{(const bf16_t*)(ws + WS_GATES), (bf16_t*)(ws + WS_MERGED)};
#ifndef MERGE_ALIGN
#define MERGE_ALIGN false
#endif
    pg8::gemm_phase<pg8::EpiMerge, SchedMerge, false, MERGE_ALIGN>(lds, DM, 512, 512, S, E, tid); }
PHASE_FN ph_wo(LAS unsigned char* lds, int l) { PH_HEAD;
    pg8::SchedGrid S{(const char*)(ws + WS_MERGED), (const char*)(lw + LW_O), DM, DM, NTOK / 256, DM / 256, G, cblk};
    pg8::EpiResF32 E{l == 0 ? p.in[I_X] : (const float*)p.out, p.out, 1.0f};
    pg8::gemm_phase(lds, DM, DM, DM, S, E, tid); }
PHASE_FN ph_norm(LAS unsigned char* lds, int l) { PH_HEAD;
    norm_rows(p.out, l == 0 ? p.in[I_NORM_FFN] : p.in[I_NORM_MIX] + DM, U, l == 0 ? nullptr : ws + WS_U8, NTOK, wid, lane); }
PHASE_FN ph_ffnup(LAS unsigned char* lds, int l) { PH_HEAD;
    pg8::SchedGrid S{(const char*)U, (const char*)(ws + WS_FFNUP), DM, DM, NTOK / 256, 2 * DFF / 256, G, cblk};
    pg8::EpiSwiGLU E{(bf16_t*)(ws + WS_ACT), DFF};
    pg8::gemm_phase<pg8::EpiSwiGLU, pg8::SchedGrid, false, HEAVY_ALIGN>(lds, DM, DM, DM, S, E, tid); }
PHASE_FN ph_ffndown(LAS unsigned char* lds, int l) { PH_HEAD;
    pg8::SchedGrid S{(const char*)(ws + WS_ACT), (const char*)(ws + WS_FFNDN), DFF, DFF, NTOK / 256, DM / 256, G, cblk};
    pg8::EpiResF32 E{(const float*)p.out, p.out, 1.0f};
    pg8::gemm_phase(lds, DFF, DFF, DFF, S, E, tid); }
PHASE_FN ph_router(LAS unsigned char* lds, int l) { PH_HEAD; router_phase(p, lds, tid, wid, lane); }
PHASE_FN ph_moeup(LAS unsigned char* lds, int l) { PH_HEAD;
    moe_table(lds, ctl + CW_MOECNT, 2 * DFFE / 256, tid);
    const SchedMoe S{(const char*)(ws + WS_XG), (const char*)(ws + WS_MOEUP), (size_t)ECAP * DM * MOE_ES, (size_t)2 * DFFE * DM * MOE_ES, (size_t)256 * DM * MOE_ES, (size_t)256 * DM * MOE_ES, (const LAS int*)(lds + MOE_TAB_OFF), G, cblk, 1, 0};
#if MOE_FP8
    pg8::EpiSwiGLU8 E{ws + WS_ACTM, DFFE, 1.0f / (SC_ACT8 * SC_W8), SC_H8};
    pg8::gemm_phase<pg8::EpiSwiGLU8, SchedMoe, true, HEAVY_ALIGN>(lds, DM / 2, DM / 2, DM / 2, S, E, tid);
#else
    pg8::EpiSwiGLU E{(bf16_t*)(ws + WS_ACTM), DFFE};
    pg8::gemm_phase(lds, DM, DM, DM, S, E, tid);
#endif
}
#ifndef MOE_KSPLIT
#define MOE_KSPLIT MOE_KS
#endif
PHASE_FN ph_moedown(LAS unsigned char* lds, int l) { PH_HEAD;
    moe_table(lds, ctl + CW_MOECNT, DM / 256, tid);
    const SchedMoe S{(const char*)(ws + WS_ACTM), (const char*)(ws + WS_MOEDN), (size_t)ECAP * DFFE * MOE_ES, (size_t)DM * DFFE * MOE_ES, (size_t)256 * DFFE * MOE_ES, (size_t)256 * DFFE * MOE_ES, (const LAS int*)(lds + MOE_TAB_OFF), G, cblk, MOE_KSPLIT, (size_t)DFFE * MOE_ES / MOE_KSPLIT};
#if MOE_FP8
    pg8::EpiMoeDownY E{(bf16_t*)(ws + WS_Y), (const float*)(ws + WS_WT), ctl + CW_MOECNT, 1.0f / (SC_H8 * SC_W8)};
    pg8::gemm_phase<pg8::EpiMoeDownY, SchedMoe, true>(lds, DFFE / 2, DFFE / 2, DFFE / 2 / MOE_KSPLIT, S, E, tid);
#else
    pg8::EpiMoeDown E{p.out, (const int*)(ws + WS_TOK), (const float*)(ws + WS_WT), ctl + CW_MOECNT, 1.0f};
    pg8::gemm_phase(lds, DFFE, DFFE, DFFE / MOE_KSPLIT, S, E, tid);
#endif
}


#ifndef PROBE_CHK
#define PROBE_CHK 0
#endif
constexpr int CW_CHKFLAG = 4096 + 2048;
PHASE_FN ph_compare(LAS unsigned char* lds, int l, size_t offa, size_t offb, size_t nbytes) { PH_HEAD;
    const u32x4* a = (const u32x4*)(ws + offa); const u32x4* b = (const u32x4*)(ws + offb); unsigned bad = 0;
    for (size_t i = (size_t)cblk * NTHREADS + tid; i < nbytes / 16; i += (size_t)G * NTHREADS) { const u32x4 x = a[i], y = b[i]; bad |= (x.x ^ y.x) | (x.y ^ y.y) | (x.z ^ y.z) | (x.w ^ y.w); }
    if (bad) atomicOr(ctl + CW_CHKFLAG, 1u); }
#ifdef PROBE_NAIVE
PHASE_FN ph_naive(LAS unsigned char* lds, int l) { PH_HEAD; naive_check(p, ctl + CW_CHKFLAG, wid, lane); }
#endif
PHASE_FN ph_poison(LAS unsigned char* lds, int l) { PH_HEAD;
    if (__hip_atomic_load(ctl + CW_CHKFLAG, __ATOMIC_RELAXED, __HIP_MEMORY_SCOPE_AGENT) != 0u && tid == 0) p.out[cblk] = __builtin_nanf(""); }
PHASE_FN ph_combine(LAS unsigned char* lds, int l) { PH_HEAD; moe_combine(p, wid, lane); }
__global__ void __launch_bounds__(NTHREADS, 2) mk_fwd(Params pk) {
    extern __shared__ __attribute__((aligned(16))) unsigned char lds_raw[];
    LAS unsigned char* lds = (LAS unsigned char*)lds_raw;
    const int tid = threadIdx.x;
    if (tid < 64) ((LAS unsigned*)(lds + LDS_MISC))[tid] = 0u;
    if (tid == 64) { LAS Params* P = (LAS Params*)(lds + LDS_PARAMS);
#pragma unroll
        for (int i = 0; i < 30; ++i) P->in[i] = pk.in[i];
        P->out = pk.out; P->ws = pk.ws; P->ph_lo = (int)gridDim.x; P->ph_hi = (int)blockIdx.x; }
    __syncthreads();
    unsigned* ctl = (unsigned*)(pk.ws + WS_CTL);
#if !MK_MULTI
    (void)xcd_barrier_post(ctl + CW_BAR, (volatile LAS unsigned*)(lds + LDS_MISC));
#endif
#ifdef ONLY_FN
    ONLY_FN(lds, pk.ph_lo); return;
#endif
    const int lo = pk.ph_lo, hi = pk.ph_hi;
#define IN(k) (lo <= (k) && (k) < hi)
#if MK_MULTI
#define SEAM(k) do { } while (0)
#else
#ifndef PROBE_BAR
#define PROBE_BAR 0
#endif
#define SEAM(k) do { for (int rep_ = 0; rep_ < 1 + PROBE_BAR; ++rep_) if (IN((k) + 1)) { const Params q_ = load_params(lds); XcdBarrier b2_; b2_.bar = (unsigned*)(q_.ws + WS_CTL) + CW_BAR; b2_.x = xb_xcc_id(); b2_.st = (volatile LAS unsigned*)(lds + LDS_MISC); xcd_barrier(b2_); } } while (0)
#endif
#ifndef PROBE_P0
#define PROBE_P0 0
#endif
#ifndef PROBE_DUP
#define PROBE_DUP 0
#endif
#define DUP(bit) ((PROBE_DUP >> (bit)) & 1)
#ifndef PROBE_ATTN
#define PROBE_ATTN 0
#endif
#ifndef PROBE_THIN
#define PROBE_THIN 0
#endif
    if (IN(0)) { ph_prologue(lds, 0); if (PROBE_P0) { __syncthreads(); ph_prologue(lds, 0); } SEAM(0); }
#pragma unroll 1
    for (int l = 0; l < DEPTH; ++l) {
        const int pb = 1 + 11 * l;
#ifndef SPLIT_INGATE
#define SPLIT_INGATE 0
#endif
        if (IN(pb + 0)) { if (SPLIT_INGATE == 1) { ph_inproj(lds, l); __syncthreads(); ph_gates(lds, l); } else if (SPLIT_INGATE == 2) { ph_ingate(lds, l); SEAM(pb + 0); ph_inproj(lds, l); } else if (SPLIT_INGATE == 3) { ph_ingate(lds, l); SEAM(pb + 0); ph_gates(lds, l); } else { ph_ingate(lds, l); if (DUP(0)) ph_ingate(lds, l); } if (PROBE_CHK == 2) ph_inproj(lds, l + 2); SEAM(pb + 0);
            if (PROBE_CHK == 2) { ph_compare(lds, l, WS_Z, WS_ACT, (size_t)NTOK * ZC * 2); SEAM(pb + 0); } }
        if (IN(pb + 1)) { ph_prep1(lds, l); if (PROBE_THIN) { __syncthreads(); ph_prep1(lds, l); } SEAM(pb + 1); }
        if (IN(pb + 2)) { for (int rep = 0; rep < 1 + DUP(1); ++rep) { ph_mlaup_q(lds, l); ph_mlaup_kv(lds, l); if (l == 0) { ph_memkv(lds, 0); ph_memkv(lds, 1); } } SEAM(pb + 2); }
        if (IN(pb + 3)) { ph_prep2(lds, l); if (PROBE_THIN) { __syncthreads(); ph_prep2(lds, l); } SEAM(pb + 3); }
        if (IN(pb + 4)) { ph_attn(lds, l); if (PROBE_ATTN || PROBE_CHK == 1) { __syncthreads(); ph_attn(lds, l + 2 + 4 * (PROBE_ATTN > 1 ? PROBE_ATTN - 1 : 0)); } SEAM(pb + 4);
            if (PROBE_CHK == 1) { ph_compare(lds, l, WS_BR, WS_ACT, (size_t)NTOK * DM * 2); SEAM(pb + 4); } }
        if (IN(pb + 5)) { ph_merge(lds, l); if (DUP(2)) ph_merge(lds, l); SEAM(pb + 5); }
        if (IN(pb + 6)) { ph_wo(lds, l); if (DUP(3) && l == 0) ph_wo(lds, l); SEAM(pb + 6); }
        if (l == 0) {
            if (IN(pb + 7)) { ph_norm(lds, 0); if (PROBE_THIN) { __syncthreads(); ph_norm(lds, 0); } SEAM(pb + 7); }
            if (IN(pb + 8)) { ph_ffnup(lds, 0); if (DUP(4)) ph_ffnup(lds, 0); SEAM(pb + 8); }
            if (IN(pb + 9)) { ph_ffndown(lds, 0); SEAM(pb + 9); }
            if (IN(pb + 10)) { ph_norm(lds, 1); if (PROBE_THIN) { __syncthreads(); ph_norm(lds, 1); } SEAM(pb + 10); }
        } else {
            if (IN(pb + 7)) { ph_router(lds, 1); SEAM(pb + 7); }
            if (IN(pb + 8)) { ph_moeup(lds, 1); if (DUP(5)) ph_moeup(lds, 1); SEAM(pb + 8); }
            if (IN(pb + 9)) { ph_moedown(lds, 1); if (DUP(6)) ph_moedown(lds, 1); SEAM(pb + 8); ph_combine(lds, 1);
#ifdef PROBE_NAIVE
                ph_naive(lds, 1); SEAM(pb + 8); ph_poison(lds, 1);
#endif
                if (PROBE_CHK) { SEAM(pb + 8); ph_poison(lds, 1); } }
        }
    }
#undef IN
#undef SEAM
}

extern "C" void kernel_launch(void* const* d_in, const int* in_sizes, int n_in, void* d_out, int out_size, void* d_ws, size_t ws_size, hipStream_t stream) {
    static int grid = 0;
    if (grid == 0) {
        if (n_in != 30 || out_size != NTOK * DM || ws_size < WS_END) { fprintf(stderr, "kernel_launch: unexpected problem (n_in %d, out %d, ws %zu < %zu)\n", n_in, out_size, ws_size, (size_t)WS_END); grid = -1; return; }
        int dev = 0, cus = 0, per_cu = 0;
        if (hipGetDevice(&dev) != hipSuccess || hipDeviceGetAttribute(&cus, hipDeviceAttributeMultiprocessorCount, dev) != hipSuccess) { grid = -1; return; }
        if (hipFuncSetAttribute((const void*)mk_fwd, hipFuncAttributeMaxDynamicSharedMemorySize, LDS_BYTES) != hipSuccess) { fprintf(stderr, "kernel_launch: hipFuncSetAttribute failed\n"); grid = -1; return; }
        if (hipOccupancyMaxActiveBlocksPerMultiprocessor(&per_cu, (const void*)mk_fwd, NTHREADS, LDS_BYTES) != hipSuccess || per_cu < 1) fprintf(stderr, "kernel_launch: occupancy query reports %d\n", per_cu);
        (void)hipGetLastError();
        grid = cus;
    }
    if (grid < 0) return;
    if (hipMemsetAsync((char*)d_ws + WS_CTL, 0, CTL_BYTES, stream) != hipSuccess) return;
    Params a{};
    for (int i = 0; i < 30; ++i) a.in[i] = (const float*)d_in[i];
    a.out = (float*)d_out; a.ws = (unsigned char*)d_ws;
#if MK_MULTI
    for (int ph = 0; ph < NPHASE - 1; ++ph) { a.ph_lo = ph; a.ph_hi = ph + 1; hipLaunchKernelGGL(mk_fwd, dim3(grid), dim3(NTHREADS), LDS_BYTES, stream, a); }
#else
    a.ph_lo = 0; a.ph_hi = NPHASE;
    hipLaunchKernelGGL(mk_fwd, dim3(grid), dim3(NTHREADS), LDS_BYTES, stream, a);
#endif
    const hipError_t le = hipPeekAtLastError();
    if (le != hipSuccess) fprintf(stderr, "kernel_launch: launch failed: %s\n", hipGetErrorName(le));
}
```

```cpp
#include <hip/hip_runtime.h>
#include <cstdio>
#include <cstdint>

#define LAS __attribute__((address_space(3)))
typedef unsigned short bf16_t;
typedef short bf16x8 __attribute__((ext_vector_type(8)));
typedef float f32x4 __attribute__((ext_vector_type(4)));
typedef float f32x2 __attribute__((ext_vector_type(2)));
typedef unsigned u32x4 __attribute__((ext_vector_type(4)));
typedef unsigned u32x2 __attribute__((ext_vector_type(2)));

#ifndef MK_MULTI
#define MK_MULTI 0
#endif

constexpr int DM = 2048, NBATCH = 4, SEQ = 2048, NTOK = NBATCH * SEQ, MEML = 256, NMEM = NBATCH * MEML, DEPTH = 2;
constexpr int ZC = 4096;
constexpr int INC = 3904;
constexpr int Z_NAQ = 0, Z_NAK = 512, Z_NAV = 1024, Z_CQ = 1536, Z_CKV = 2304, Z_KPE = 2560, Z_SWQ = 2624, Z_SWK = 3136, Z_SWV = 3264, Z_MEQ = 3392;
constexpr int DFF = 5632, NEXP = 8, DFFE = 7168, ECAP = 8192;
constexpr float LOG2E = 1.4426950408889634f;
constexpr float EPS = 1e-6f;
constexpr int NTHREADS = 512;
constexpr float SC_ACT8 = 16.0f, SC_W8 = 64.0f, SC_H8 = 8.0f, SC_BR8 = 64.0f, SC_MG8 = 64.0f;

constexpr size_t al256(size_t x) { return (x + 255) & ~(size_t)255; }
constexpr size_t WS_CTL = 0, CTL_BYTES = 65536;
constexpr size_t WS_ROPE = WS_CTL + CTL_BYTES;
constexpr size_t WS_LW = WS_ROPE + (size_t)SEQ * 32 * 8;
constexpr size_t LW_IN = 0;
constexpr size_t LW_GATE8 = LW_IN + (size_t)4096 * 2048 * 2;
#ifndef INGATE_FP8
#define INGATE_FP8 1
#endif
#define GATES_FP8 0
#ifndef MOE_FP8
#define MOE_FP8 1
#endif
#ifndef MIX_FP8
#define MIX_FP8 1
#endif
constexpr size_t MOE_ES = MOE_FP8 ? 1 : 2;
constexpr size_t LW_UQ = LW_GATE8 + (size_t)8192 * 2048 * 2;
constexpr size_t LW_UKV = LW_UQ + (size_t)768 * 768 * 2;
constexpr size_t LW_MEMKV = LW_UKV + (size_t)1024 * 256 * 2;
constexpr size_t LW_BR = LW_MEMKV + (size_t)1024 * 2048 * 2;
constexpr size_t LW_O = LW_BR + (size_t)4 * 2048 * 512 * 2;
constexpr size_t LW_BYTES = LW_O + (size_t)2048 * 2048 * 2;
constexpr size_t WS_FFNUP = WS_LW + 2 * LW_BYTES;
constexpr size_t WS_FFNDN = WS_FFNUP + (size_t)2 * DFF * 2048 * 2;
constexpr size_t WS_MOEUP = WS_FFNDN + (size_t)2048 * DFF * 2;
constexpr size_t WS_MOEDN = WS_MOEUP + (size_t)NEXP * 2 * DFFE * 2048 * MOE_ES;
constexpr size_t WS_U = WS_MOEDN + (size_t)NEXP * 2048 * DFFE * MOE_ES;
constexpr size_t WS_U8 = WS_U + (size_t)NTOK * DM * 2;
constexpr size_t WS_MEMN = WS_U8 + (size_t)NTOK * DM;
constexpr size_t WS_Z = WS_MEMN + (size_t)2 * NMEM * DM * 2;
constexpr size_t WS_GATES = WS_Z + (size_t)NTOK * ZC * 2;
constexpr size_t WS_NAQ = WS_GATES + (size_t)NTOK * 8192 * 2;
constexpr size_t WS_NAK = WS_NAQ + (size_t)NTOK * 512 * 2;
constexpr size_t WS_NAVT = WS_NAK + (size_t)NTOK * 512 * 2;
constexpr size_t WS_CQN = WS_NAVT + (size_t)NTOK * 512 * 2;
constexpr size_t WS_CKVN = WS_CQN + (size_t)NTOK * 768 * 2;
constexpr size_t WS_SWQ = WS_CKVN + (size_t)NTOK * 256 * 2;
constexpr size_t WS_SWK = WS_SWQ + (size_t)NTOK * 512 * 2;
constexpr size_t WS_SWVT = WS_SWK + (size_t)NTOK * 128 * 2;
constexpr size_t WS_MEQ = WS_SWVT + (size_t)NTOK * 128 * 2;
constexpr size_t WS_QRAW = WS_MEQ + (size_t)NTOK * 512 * 2;
constexpr size_t WS_KVRAW = WS_QRAW + (size_t)NTOK * 768 * 2;
constexpr size_t WS_MEMKV = WS_KVRAW + (size_t)NTOK * 1024 * 2;
constexpr size_t WS_MLQ = WS_MEMKV + (size_t)2 * NMEM * 1024 * 2;
constexpr size_t WS_MLK = WS_MLQ + (size_t)NTOK * 768 * 2;
constexpr size_t WS_MLVT = WS_MLK + (size_t)NTOK * 768 * 2;
constexpr size_t WS_MEK = WS_MLVT + (size_t)NTOK * 512 * 2;
constexpr size_t WS_MEVT = WS_MEK + (size_t)NMEM * 512 * 2;
constexpr size_t WS_BR = WS_MEVT + (size_t)NMEM * 512 * 2;
constexpr size_t WS_MERGED = WS_BR + (size_t)NTOK * DM * 2;
constexpr size_t WS_ACT = WS_MERGED + (size_t)NTOK * DM * 2;
constexpr size_t WS_XG = WS_ACT + (size_t)NTOK * DFF * 2;
constexpr size_t WS_TOK = WS_XG + (size_t)NEXP * ECAP * DM * MOE_ES;
constexpr size_t WS_WT = WS_TOK + (size_t)NEXP * ECAP * 4;
constexpr size_t WS_ACTM = WS_WT + (size_t)NEXP * ECAP * 4;
constexpr size_t WS_Y = WS_ACTM + (size_t)NEXP * ECAP * DFFE * MOE_ES;
constexpr int MOE_KS = 2;
constexpr size_t WS_TSLOT = WS_Y + (size_t)MOE_KS * NEXP * ECAP * DM * 2;
constexpr size_t WS_BR8 = WS_TSLOT + (size_t)NTOK * 2 * 4;
constexpr size_t WS_MERGED8 = WS_BR8 + (size_t)NTOK * DM;
constexpr size_t WS_END = WS_MERGED8 + (size_t)NTOK * DM;

constexpr int CW_BAR = 0;
constexpr int CW_MOECNT = 4096;
constexpr int CW_ATTQ = 4096 + 1024;

constexpr int LDS_BYTES = 147456;
constexpr int LDS_MISC = 147456 - 1024;
namespace pg8 {
constexpr int BM = 256, BK = 64, HALF = 128, HTB = HALF * BK * 2, STAGE_BYTES = 8 * HTB, NXCD = 8, WGM = 8;
__host__ __device__ __forceinline__ int lds_byte(int r, int c) { const int st = (r >> 4) * 2 + (c >> 5), rr = r & 15, cc = c & 31, ob = rr * 64 + cc * 2; return st * 1024 + (ob ^ (((ob >> 9) & 1) << 5)); }
__host__ __device__ __forceinline__ void stage_rc(int b, int& R, int& C) { const int st = b / 1024, sb = b % 1024, swz = sb ^ (((sb >> 9) & 1) << 5); R = (st >> 1) * 16 + swz / 64; C = (st & 1) * 32 + (swz % 64) / 2; }
__host__ __device__ __forceinline__ int perm32(int rho) { const int n = rho >> 4, i = rho & 15; return 8 * (i >> 2) + 4 * n + (i & 3); }

struct Unit { const char* A; const char* B; int orow, ocol, x0, x1, ks, pad_; };

__device__ __forceinline__ bool static_tile(int i, int G, int c, int nM, int nN, int& pm, int& pn) {
    const int nwg = nM * nN; const long L = (long)i * G + c; if (L >= nwg) return false;
    int wgid = (int)L; { const int q = nwg / NXCD, r = nwg % NXCD, xcd = wgid % NXCD, off = wgid / NXCD; wgid = (xcd < r ? xcd * (q + 1) : r * (q + 1) + (xcd - r) * q) + off; }
    const int nig = WGM * nN, gid = wgid / nig, fm = gid * WGM, gsz = (nM - fm) < WGM ? (nM - fm) : WGM;
    pm = fm + ((wgid % nig) % gsz); pn = (wgid % nig) / gsz; return true;
}
struct SchedGrid {
    const char* A; const char* B; int lda, ldb, nM, nN, G, c;
    __device__ __forceinline__ bool next(int i, Unit& u) const {
        int pm, pn; if (!static_tile(i, G, c, nM, nN, pm, pn)) return false;
        u.A = A + (size_t)pm * 256 * lda * 2; u.B = B + (size_t)pn * 256 * ldb * 2; u.orow = pm * 256; u.ocol = pn; u.x0 = 0; u.x1 = 0; u.ks = 0; u.pad_ = 0; return true;
    }
};

__device__ __forceinline__ unsigned cvt_pk_bf16(float lo, float hi) { unsigned r; asm volatile("v_cvt_pk_bf16_f32 %0, %1, %2" : "=v"(r) : "v"(lo), "v"(hi)); return r; }
__device__ __forceinline__ unsigned pack_fp8x4(float a, float b, float c, float d) { int w = 0; w = __builtin_amdgcn_cvt_pk_fp8_f32(a, b, w, false); w = __builtin_amdgcn_cvt_pk_fp8_f32(c, d, w, true); return (unsigned)w; }
__device__ __forceinline__ float sigmoidf_(float x) { return __builtin_amdgcn_rcpf(1.0f + __builtin_amdgcn_exp2f(-x * LOG2E)); }
__device__ __forceinline__ void sigmoid2(float& x, float& y) {
    const float cx = fminf(fmaxf(x, -40.f), 40.f), cy = fminf(fmaxf(y, -40.f), 40.f);
    const float a = 1.0f + __builtin_amdgcn_exp2f(-cx * LOG2E), b = 1.0f + __builtin_amdgcn_exp2f(-cy * LOG2E), r = __builtin_amdgcn_rcpf(a * b);
    x = b * r; y = a * r; }

typedef f32x4 Acc[2][2][4][2];

#ifndef FP8_MMA_PRIO
#define FP8_MMA_PRIO 0
#endif
typedef int i32x8 __attribute__((ext_vector_type(8)));
typedef int i32x4 __attribute__((ext_vector_type(4)));
template <class Epi, class Sched, bool FP8 = false, bool ALIGN_EPI = true>
__device__ __forceinline__ void gemm_phase(LAS unsigned char* lds, const int lda, const int ldb, const int K, const Sched S, Epi& E, const int tid) {
    const int wid = __builtin_amdgcn_readfirstlane(tid >> 6), lane = tid & 63, wr = wid >> 2, wc = wid & 3, fr = lane & 15, fq = lane >> 4;
    const int nt = K / BK;
    unsigned voffA[2], voffB[2];
#pragma unroll
    for (int i = 0; i < 2; ++i) { int R, C; stage_rc(tid * 16 + i * 8192, R, C); const int Rb = Epi::PERM ? ((R & ~31) + perm32(R & 31)) : R;
        voffA[i] = (unsigned)(R * lda + C) * 2u; voffB[i] = (unsigned)(Rb * ldb + C) * 2u; }
    const size_t kstep = (size_t)(BK * 2);
    const size_t hstepA = (size_t)HALF * lda * 2, hstepB = (size_t)HALF * ldb * 2;
    const unsigned ldsw = (unsigned)wid * 1024u;
    const int aoff = lds_byte(wr * 64 + fr, fq * 8), boff = lds_byte(wc * 32 + fr, fq * 8);
#define PG8_SA(b, h) (((b) * 2 + (h)) * HTB)
#define PG8_SB(b, h) ((4 + (b) * 2 + (h)) * HTB)
#define PG8_STAGE(bufoff, gbase, voff) do { _Pragma("unroll") for (int _i = 0; _i < 2; ++_i) \
        __builtin_amdgcn_global_load_lds((const unsigned*)((const char*)(gbase) + (voff)[_i]), (LAS unsigned*)(lds + (bufoff) + ldsw + _i * 8192), 16, 0, 0); } while (0)
#define PG8_LDA(dst, b, h) do { _Pragma("unroll") for (int m = 0; m < 4; ++m) _Pragma("unroll") for (int k = 0; k < 2; ++k) dst[m][k] = *(const LAS bf16x8*)(lds + PG8_SA(b, h) + aoff + m * 2048 + k * 1024); } while (0)
#define PG8_LDB(dst, b, h) do { _Pragma("unroll") for (int n = 0; n < 2; ++n) _Pragma("unroll") for (int k = 0; k < 2; ++k) dst[n][k] = *(const LAS bf16x8*)(lds + PG8_SB(b, h) + boff + n * 2048 + k * 1024); } while (0)
#define PG8_MMA(ai, bj, At, Bt) do { __builtin_amdgcn_s_setprio(1); _Pragma("unroll") for (int m = 0; m < 4; ++m) _Pragma("unroll") for (int n = 0; n < 2; ++n) _Pragma("unroll") for (int k = 0; k < 2; ++k) \
        acc[ai][bj][m][n] = __builtin_amdgcn_mfma_f32_16x16x32_bf16(Bt[n][k], At[m][k], acc[ai][bj][m][n], 0, 0, 0); __builtin_amdgcn_s_setprio(0); } while (0)
#define PG8_CAT(x, y) __builtin_shufflevector(__builtin_bit_cast(i32x4, x), __builtin_bit_cast(i32x4, y), 0, 1, 2, 3, 4, 5, 6, 7)
#define PG8_MMA8(ai, bj, At, Bt) do { __builtin_amdgcn_s_setprio(1); _Pragma("unroll") for (int m = 0; m < 4; ++m) _Pragma("unroll") for (int n = 0; n < 2; ++n) \
        asm volatile("v_mfma_f32_16x16x128_f8f6f4 %0, %1, %2, %0" : "+v"(acc[ai][bj][m][n]) : "v"(PG8_CAT(Bt[n][0], Bt[n][1])), "v"(PG8_CAT(At[m][0], At[m][1]))); __builtin_amdgcn_s_setprio(0); } while (0)
#define PG8_WAIT_V(n) asm volatile("s_waitcnt vmcnt(" #n ")" ::: "memory")
#define PG8_WAIT_L(n) asm volatile("s_waitcnt lgkmcnt(" #n ")" ::: "memory")
#define PG8_BAR __builtin_amdgcn_s_barrier()
#define PG8_SCHED __builtin_amdgcn_sched_barrier(0)
    Unit cur, nxt; int ui = 0;
    if (!S.next(0, cur)) return;
    Acc acc;
#pragma unroll
    for (int a = 0; a < 2; ++a)
#pragma unroll
        for (int b = 0; b < 2; ++b)
#pragma unroll
            for (int m = 0; m < 4; ++m)
#pragma unroll
                for (int n = 0; n < 2; ++n) acc[a][b][m][n] = (f32x4){0.f, 0.f, 0.f, 0.f};
    bf16x8 At[4][2], B0[2][2], B1[2][2];
    const char* cA = cur.A; const char* cB = cur.B;
    PG8_STAGE(PG8_SB(0, 0), cB, voffB); PG8_STAGE(PG8_SB(0, 1), cB + hstepB, voffB); PG8_STAGE(PG8_SA(0, 0), cA, voffA); PG8_STAGE(PG8_SA(0, 1), cA + hstepA, voffA);
    if (wr == 1) PG8_BAR;
    PG8_WAIT_V(2); PG8_BAR;
    PG8_STAGE(PG8_SB(1, 0), cB + kstep, voffB); PG8_STAGE(PG8_SA(1, 0), cA + kstep, voffA); PG8_STAGE(PG8_SB(1, 1), cB + hstepB + kstep, voffB);
    PG8_WAIT_V(6); PG8_BAR;
    for (;;) {
        const bool has_next = S.next(ui + 1, nxt);
        const char* nA = has_next ? nxt.A : cA; const char* nB = has_next ? nxt.B : cB;
        for (int t = 0; t < nt; t += 2) {
            const bool last = (t == nt - 2);
            const char* a1 = cA + (size_t)(t + 1) * kstep;
            const char* a2 = last ? nA : cA + (size_t)(t + 2) * kstep; const char* b2 = last ? nB : cB + (size_t)(t + 2) * kstep;
            const char* a3 = a2 + kstep; const char* b3 = b2 + kstep;
            if constexpr (FP8) {
            PG8_LDB(B0, 0, 0); PG8_LDB(B1, 0, 1); PG8_SCHED; PG8_LDA(At, 0, 0); PG8_STAGE(PG8_SA(1, 1), a1 + hstepA, voffA);
            PG8_WAIT_V(8); PG8_WAIT_L(0); PG8_BAR; PG8_MMA8(0, 0, At, B0); PG8_MMA8(0, 1, At, B1); PG8_BAR; PG8_SCHED;
            PG8_LDA(At, 0, 1); PG8_STAGE(PG8_SB(0, 0), b2, voffB); PG8_STAGE(PG8_SB(0, 1), b2 + hstepB, voffB); PG8_STAGE(PG8_SA(0, 0), a2, voffA);
            PG8_WAIT_V(8); PG8_WAIT_L(0); PG8_BAR; PG8_MMA8(1, 0, At, B0); PG8_MMA8(1, 1, At, B1); PG8_BAR; PG8_SCHED;
            PG8_LDB(B0, 1, 0); PG8_LDB(B1, 1, 1); PG8_SCHED; PG8_LDA(At, 1, 0); PG8_STAGE(PG8_SA(0, 1), a2 + hstepA, voffA);
            PG8_WAIT_V(8); PG8_WAIT_L(0); PG8_BAR; PG8_MMA8(0, 0, At, B0); PG8_MMA8(0, 1, At, B1); PG8_BAR; PG8_SCHED;
            PG8_LDA(At, 1, 1); PG8_STAGE(PG8_SB(1, 0), b3, voffB); PG8_STAGE(PG8_SB(1, 1), b3 + hstepB, voffB); PG8_STAGE(PG8_SA(1, 0), a3, voffA);
            PG8_WAIT_V(8); PG8_WAIT_L(0); PG8_BAR; PG8_MMA8(1, 0, At, B0); PG8_MMA8(1, 1, At, B1); PG8_BAR; PG8_SCHED;
            } else {
            PG8_LDB(B0, 0, 0); PG8_LDB(B1, 0, 1); PG8_SCHED; PG8_LDA(At, 0, 0); PG8_STAGE(PG8_SA(1, 1), a1 + hstepA, voffA);
            PG8_WAIT_V(8); PG8_WAIT_L(0); PG8_BAR; PG8_MMA(0, 0, At, B0); PG8_MMA(0, 1, At, B1); PG8_BAR; PG8_SCHED;
            PG8_LDA(At, 0, 1); PG8_STAGE(PG8_SB(0, 0), b2, voffB); PG8_STAGE(PG8_SB(0, 1), b2 + hstepB, voffB); PG8_STAGE(PG8_SA(0, 0), a2, voffA);
            PG8_WAIT_V(8); PG8_WAIT_L(0); PG8_BAR; PG8_MMA(1, 0, At, B0); PG8_MMA(1, 1, At, B1); PG8_BAR; PG8_SCHED;
            PG8_LDB(B0, 1, 0); PG8_LDB(B1, 1, 1); PG8_SCHED; PG8_LDA(At, 1, 0); PG8_STAGE(PG8_SA(0, 1), a2 + hstepA, voffA);
            PG8_WAIT_V(8); PG8_WAIT_L(0); PG8_BAR; PG8_MMA(0, 0, At, B0); PG8_MMA(0, 1, At, B1); PG8_BAR; PG8_SCHED;
            PG8_LDA(At, 1, 1); PG8_STAGE(PG8_SB(1, 0), b3, voffB); PG8_STAGE(PG8_SB(1, 1), b3 + hstepB, voffB); PG8_STAGE(PG8_SA(1, 0), a3, voffA);
            PG8_WAIT_V(8); PG8_WAIT_L(0); PG8_BAR; PG8_MMA(1, 0, At, B0); PG8_MMA(1, 1, At, B1); PG8_BAR; PG8_SCHED;
            }
        }
        if constexpr (ALIGN_EPI) { if (wr == 0) PG8_BAR; }
        if constexpr (FP8) {
#pragma unroll
            for (int a = 0; a < 2; ++a)
#pragma unroll
                for (int b = 0; b < 2; ++b)
                    asm volatile("s_nop 15\n\ts_nop 15" : "+v"(acc[a][b][0][0]), "+v"(acc[a][b][0][1]), "+v"(acc[a][b][1][0]), "+v"(acc[a][b][1][1]), "+v"(acc[a][b][2][0]), "+v"(acc[a][b][2][1]), "+v"(acc[a][b][3][0]), "+v"(acc[a][b][3][1]));
        }
        E(acc, cur, wr, wc, fr, fq);
        if (!has_next) break;
#pragma unroll
        for (int a = 0; a < 2; ++a)
#pragma unroll
            for (int b = 0; b < 2; ++b)
#pragma unroll
                for (int m = 0; m < 4; ++m)
#pragma unroll
                    for (int n = 0; n < 2; ++n) acc[a][b][m][n] = (f32x4){0.f, 0.f, 0.f, 0.f};
        cur = nxt; cA = nA; cB = nB; ++ui;
        if constexpr (ALIGN_EPI) { if (wr == 1) PG8_BAR; }
    }
    PG8_WAIT_V(0);
    if constexpr (!ALIGN_EPI) { if (wr == 0) PG8_BAR; }
    PG8_BAR;
#undef PG8_SA
#undef PG8_SB
#undef PG8_STAGE
#undef PG8_LDA
#undef PG8_MMA8
#undef PG8_CAT
#undef PG8_LDB
#undef PG8_MMA
#undef PG8_WAIT_V
#undef PG8_WAIT_L
#undef PG8_BAR
#undef PG8_SCHED
}

struct EpiInGate {
    static constexpr bool PERM = true;
    bf16_t* z; bf16_t* gates; const float* bgate; float s;
    __device__ __forceinline__ void operator()(const Acc& acc, const Unit& u, int wr, int wc, int fr, int fq) const {
        const int row0 = u.orow + wr * 64 + fr; const bool isg = u.ocol >= 16;
        const int colt = (isg ? u.ocol - 16 : u.ocol) * 256 + wc * 32 + 8 * fq; const int ldc = isg ? 8192 : ZC; bf16_t* base = isg ? gates : z;
        f32x4 bv[2][2];
#pragma unroll
        for (int bj = 0; bj < 2; ++bj)
#pragma unroll
            for (int n = 0; n < 2; ++n) bv[bj][n] = isg ? *(const f32x4*)(bgate + colt + bj * HALF + 4 * n) : (f32x4){0.f, 0.f, 0.f, 0.f};
#pragma unroll
        for (int ai = 0; ai < 2; ++ai)
#pragma unroll
            for (int m = 0; m < 4; ++m) { bf16_t* rowp = base + (size_t)(row0 + ai * HALF + m * 16) * ldc + colt;
#pragma unroll
                for (int bj = 0; bj < 2; ++bj) { f32x4 v0 = acc[ai][bj][m][0] * s + bv[bj][0], v1 = acc[ai][bj][m][1] * s + bv[bj][1];
                    if (isg) {
#pragma unroll
                        for (int j = 0; j < 4; ++j) { v0[j] = sigmoidf_(v0[j]); v1[j] = sigmoidf_(v1[j]); } }
                    u32x4 w; w.x = cvt_pk_bf16(v0[0], v0[1]); w.y = cvt_pk_bf16(v0[2], v0[3]); w.z = cvt_pk_bf16(v1[0], v1[1]); w.w = cvt_pk_bf16(v1[2], v1[3]);
                    *(u32x4*)(rowp + bj * HALF) = w; } }
    }
};
struct EpiBf16 {
    static constexpr bool PERM = true;
    bf16_t* O; int ldc;
    __device__ __forceinline__ void operator()(const Acc& acc, const Unit& u, int wr, int wc, int fr, int fq) const {
        const int row0 = u.orow + wr * 64 + fr, col0 = u.ocol * 256 + wc * 32 + 8 * fq;
#pragma unroll
        for (int ai = 0; ai < 2; ++ai)
#pragma unroll
            for (int m = 0; m < 4; ++m) { bf16_t* rowp = O + (size_t)(row0 + ai * HALF + m * 16) * ldc + col0;
#pragma unroll
                for (int bj = 0; bj < 2; ++bj) { const f32x4 v0 = acc[ai][bj][m][0], v1 = acc[ai][bj][m][1];
                    u32x4 w; w.x = cvt_pk_bf16(v0[0], v0[1]); w.y = cvt_pk_bf16(v0[2], v0[3]); w.z = cvt_pk_bf16(v1[0], v1[1]); w.w = cvt_pk_bf16(v1[2], v1[3]);
                    *(u32x4*)(rowp + bj * HALF) = w; } }
    }
};
struct EpiSwiGLU {
    static constexpr bool PERM = true;
    bf16_t* O; int ldc;
    __device__ __forceinline__ void operator()(const Acc& acc, const Unit& u, int wr, int wc, int fr, int fq) const {
        const int row0 = u.orow + wr * 64 + fr, col0 = u.ocol * 128 + wc * 32 + 8 * fq;
#pragma unroll
        for (int ai = 0; ai < 2; ++ai)
#pragma unroll
            for (int m = 0; m < 4; ++m) { bf16_t* rowp = O + (size_t)(row0 + ai * HALF + m * 16) * ldc + col0;
                f32x4 v0, v1;
#pragma unroll
                for (int j = 0; j < 4; ++j) { const float g0 = acc[ai][0][m][0][j], g1 = acc[ai][0][m][1][j];
                    v0[j] = g0 * sigmoidf_(g0) * acc[ai][1][m][0][j]; v1[j] = g1 * sigmoidf_(g1) * acc[ai][1][m][1][j]; }
                u32x4 w; w.x = cvt_pk_bf16(v0[0], v0[1]); w.y = cvt_pk_bf16(v0[2], v0[3]); w.z = cvt_pk_bf16(v1[0], v1[1]); w.w = cvt_pk_bf16(v1[2], v1[3]);
                *(u32x4*)rowp = w; }
    }
};
__device__ __forceinline__ float bflo(unsigned w) { return __uint_as_float(w << 16); }
__device__ __forceinline__ float bfhi(unsigned w) { return __uint_as_float(w & 0xffff0000u); }
struct EpiMerge {
    static constexpr bool PERM = true;
    const bf16_t* gates; bf16_t* merged; unsigned char* merged8; float s, s8;
    __device__ __forceinline__ void operator()(const Acc& acc, const Unit& u, int wr, int wc, int fr, int fq) const {
        const int row0 = u.orow + wr * 64 + fr, col0 = u.ocol * 256 + wc * 32 + 8 * fq, n = u.x0;
#pragma unroll
        for (int ai = 0; ai < 2; ++ai) {
            u32x4 gv[4][2], ov[4][2];
#pragma unroll
            for (int m = 0; m < 4; ++m)
#pragma unroll
                for (int bj = 0; bj < 2; ++bj) { const size_t r = (size_t)(row0 + ai * HALF + m * 16);
                    gv[m][bj] = *(const u32x4*)(gates + r * 8192 + n * 2048 + col0 + bj * HALF);
                    ov[m][bj] = (u32x4){0u, 0u, 0u, 0u}; if (n > 0) ov[m][bj] = *(const u32x4*)(merged + r * DM + col0 + bj * HALF); }
#pragma unroll
            for (int m = 0; m < 4; ++m)
#pragma unroll
                for (int bj = 0; bj < 2; ++bj) { const size_t r = (size_t)(row0 + ai * HALF + m * 16);
                    const u32x4 g = gv[m][bj], o = ov[m][bj]; const f32x4 v0 = acc[ai][bj][m][0] * s, v1 = acc[ai][bj][m][1] * s;
                    const float t0 = bflo(o.x) + bflo(g.x) * v0[0], t1 = bfhi(o.x) + bfhi(g.x) * v0[1], t2 = bflo(o.y) + bflo(g.y) * v0[2], t3 = bfhi(o.y) + bfhi(g.y) * v0[3];
                    const float t4 = bflo(o.z) + bflo(g.z) * v1[0], t5 = bfhi(o.z) + bfhi(g.z) * v1[1], t6 = bflo(o.w) + bflo(g.w) * v1[2], t7 = bfhi(o.w) + bfhi(g.w) * v1[3];
                    u32x4 w; w.x = cvt_pk_bf16(t0, t1); w.y = cvt_pk_bf16(t2, t3); w.z = cvt_pk_bf16(t4, t5); w.w = cvt_pk_bf16(t6, t7);
                    *(u32x4*)(merged + r * DM + col0 + bj * HALF) = w;
                    if (merged8 && n == 3) { u32x2 q; q.x = pack_fp8x4(t0 * s8, t1 * s8, t2 * s8, t3 * s8); q.y = pack_fp8x4(t4 * s8, t5 * s8, t6 * s8, t7 * s8); *(u32x2*)(merged8 + r * DM + col0 + bj * HALF) = q; } }
        }
    }
};
struct EpiGates {
    static constexpr bool PERM = true;
    bf16_t* gates; const float* bgate; float s;
    __device__ __forceinline__ void operator()(const Acc& acc, const Unit& u, int wr, int wc, int fr, int fq) const {
        const int row0 = u.orow + wr * 64 + fr, colt = u.ocol * 256 + wc * 32 + 8 * fq;
        f32x4 bv[2][2];
#pragma unroll
        for (int bj = 0; bj < 2; ++bj)
#pragma unroll
            for (int n = 0; n < 2; ++n) bv[bj][n] = *(const f32x4*)(bgate + colt + bj * HALF + 4 * n);
#pragma unroll
        for (int ai = 0; ai < 2; ++ai)
#pragma unroll
            for (int m = 0; m < 4; ++m) { bf16_t* rowp = gates + (size_t)(row0 + ai * HALF + m * 16) * 8192 + colt;
#pragma unroll
                for (int bj = 0; bj < 2; ++bj) { f32x4 v0 = acc[ai][bj][m][0] * s + bv[bj][0], v1 = acc[ai][bj][m][1] * s + bv[bj][1];
#pragma unroll
                    for (int j = 0; j < 4; ++j) { v0[j] = sigmoidf_(v0[j]); v1[j] = sigmoidf_(v1[j]); }
                    u32x4 w; w.x = cvt_pk_bf16(v0[0], v0[1]); w.y = cvt_pk_bf16(v0[2], v0[3]); w.z = cvt_pk_bf16(v1[0], v1[1]); w.w = cvt_pk_bf16(v1[2], v1[3]);
                    *(u32x4*)(rowp + bj * HALF) = w; } }
    }
};
struct EpiSwiGLU8 {
    static constexpr bool PERM = true;
    unsigned char* O; int ldc; float si, so;
    __device__ __forceinline__ void operator()(const Acc& acc, const Unit& u, int wr, int wc, int fr, int fq) const {
        const int row0 = u.orow + wr * 64 + fr, col0 = u.ocol * 128 + wc * 32 + 8 * fq;
#pragma unroll
        for (int ai = 0; ai < 2; ++ai)
#pragma unroll
            for (int m = 0; m < 4; ++m) { unsigned char* rowp = O + (size_t)(row0 + ai * HALF + m * 16) * ldc + col0;
                f32x4 v0, v1;
#pragma unroll
                for (int j = 0; j < 4; ++j) { const float g0 = acc[ai][0][m][0][j] * si, g1 = acc[ai][0][m][1][j] * si;
                    v0[j] = g0 * sigmoidf_(g0) * (acc[ai][1][m][0][j] * si) * so; v1[j] = g1 * sigmoidf_(g1) * (acc[ai][1][m][1][j] * si) * so; }
                u32x2 w; w.x = pack_fp8x4(v0[0], v0[1], v0[2], v0[3]); w.y = pack_fp8x4(v1[0], v1[1], v1[2], v1[3]);
                *(u32x2*)rowp = w; }
    }
};
struct EpiResF32 {
    static constexpr bool PERM = false;
    const float* base; float* out; float s;
    __device__ __forceinline__ void operator()(const Acc& acc, const Unit& u, int wr, int wc, int fr, int fq) const {
        const int row0 = u.orow + wr * 64 + fr, col0 = u.ocol * 256 + wc * 32 + 4 * fq;
#pragma unroll
        for (int ai = 0; ai < 2; ++ai)
#pragma unroll
            for (int mp = 0; mp < 2; ++mp) {
                f32x4 bs[2][2][2];
#pragma unroll
                for (int mm = 0; mm < 2; ++mm) { const size_t off = (size_t)(row0 + ai * HALF + (mp * 2 + mm) * 16) * DM + col0;
#pragma unroll
                    for (int bj = 0; bj < 2; ++bj)
#pragma unroll
                        for (int n = 0; n < 2; ++n) bs[mm][bj][n] = *(const f32x4*)(base + off + bj * HALF + n * 16); }
#pragma unroll
                for (int mm = 0; mm < 2; ++mm) { const int m = mp * 2 + mm; const size_t off = (size_t)(row0 + ai * HALF + m * 16) * DM + col0;
#pragma unroll
                    for (int bj = 0; bj < 2; ++bj)
#pragma unroll
                        for (int n = 0; n < 2; ++n) *(f32x4*)(out + off + bj * HALF + n * 16) = bs[mm][bj][n] + acc[ai][bj][m][n] * s; }
                asm volatile("" ::: "memory"); }
    }
};
struct EpiMoeDown {
    static constexpr bool PERM = false;
    float* out; const int* tok; const float* wt; const unsigned* cnt; float s;
    __device__ __forceinline__ void operator()(const Acc& acc, const Unit& u, int wr, int wc, int fr, int fq) const {
        const int e = u.x0, nrow = (int)cnt[e * 64]; const int lrow0 = u.x1 + wr * 64 + fr, col0 = u.ocol * 256 + wc * 32 + 4 * fq;
#pragma unroll
        for (int ai = 0; ai < 2; ++ai)
#pragma unroll
            for (int m = 0; m < 4; ++m) { const int lr = lrow0 + ai * HALF + m * 16;
                if (lr < nrow) { const int slot = e * ECAP + lr; const int t = tok[slot]; const float w = wt[slot] * s; float* op = out + (size_t)t * DM + col0;
#pragma unroll
                    for (int bj = 0; bj < 2; ++bj)
#pragma unroll
                        for (int n = 0; n < 2; ++n)
#pragma unroll
                            for (int j = 0; j < 4; ++j) unsafeAtomicAdd(op + bj * HALF + n * 16 + j, w * acc[ai][bj][m][n][j]); } }
    }
};
struct EpiMoeDownY {
    static constexpr bool PERM = true;
    bf16_t* y; const float* wt; const unsigned* cnt; float s;
    __device__ __forceinline__ void operator()(const Acc& acc, const Unit& u, int wr, int wc, int fr, int fq) const {
        const int e = u.x0, nrow = (int)cnt[e * 64]; const int lrow0 = u.x1 + wr * 64 + fr, col0 = u.ocol * 256 + wc * 32 + 8 * fq;
#pragma unroll
        for (int ai = 0; ai < 2; ++ai)
#pragma unroll
            for (int m = 0; m < 4; ++m) { const int lr = lrow0 + ai * HALF + m * 16;
                if (lr < nrow) { const int slot = e * ECAP + lr; const float w = wt[slot] * s; bf16_t* rowp = y + ((size_t)u.ks * NEXP * ECAP + slot) * DM + col0;
#pragma unroll
                    for (int bj = 0; bj < 2; ++bj) { const f32x4 v0 = acc[ai][bj][m][0] * w, v1 = acc[ai][bj][m][1] * w;
                        u32x4 q; q.x = cvt_pk_bf16(v0[0], v0[1]); q.y = cvt_pk_bf16(v0[2], v0[3]); q.z = cvt_pk_bf16(v1[0], v1[1]); q.w = cvt_pk_bf16(v1[2], v1[3]);
                        *(u32x4*)(rowp + bj * HALF) = q; } } }
    }
};
}
#define XB_TMO      128
#define XB_XCNT(j)  (256  + 64 * (j))
#define XB_XSUB(j)  (1280 + 64 * (j))
#define XB_XGEN(j)  (2304 + 64 * (j))
#define XB_TOP      3328
#define XB_TOPGEN   3392
#define XCD_BAR_WORDS 3456
#define XB_SPIN_CAP (1u << 18)

__device__ __forceinline__ unsigned xb_ld(unsigned* p)              { return __hip_atomic_load(p, __ATOMIC_RELAXED, __HIP_MEMORY_SCOPE_AGENT); }
__device__ __forceinline__ unsigned xb_add(unsigned* p, unsigned v) { return __hip_atomic_fetch_add(p, v, __ATOMIC_RELAXED, __HIP_MEMORY_SCOPE_AGENT); }
__device__ __forceinline__ unsigned xb_xcc_id() { return (unsigned)__builtin_amdgcn_s_getreg((3 << 11) | 20) & 0xFu; }
#define XB_SPIN(cond, bar) do { unsigned _sp = 0; while (cond) { __builtin_amdgcn_s_sleep(1); \
    if ((++_sp & 255u) == 0u) { if (xb_ld(&(bar)[XB_TMO])) break; if (_sp > XB_SPIN_CAP) { atomicAdd(&(bar)[XB_TMO], 1u); break; } } } } while (0)

__device__ __forceinline__ unsigned xb_tid() { unsigned t = threadIdx.x; asm volatile("" : "+v"(t)); return t; }
struct XcdBarrier {
    unsigned* bar; unsigned x;
    volatile LAS unsigned* st;
};

__device__ __forceinline__ XcdBarrier xcd_barrier_post(unsigned* bar, volatile LAS unsigned* st) {
    XcdBarrier b; b.bar = bar; b.x = xb_xcc_id(); b.st = st;
    if (xb_tid() == 0u) (void)xb_add(&bar[XB_XCNT(b.x)], 1u);
    return b;
}
__device__ __forceinline__ void xcd_barrier_complete(unsigned* bar, unsigned x, unsigned& nloc, unsigned& nx) {
    const unsigned G = gridDim.x * gridDim.y * gridDim.z;
    unsigned sum, cnt, mine, sp = 0u;
    for (;;) {
        sum = 0u; cnt = 0u; mine = 0u;
#pragma unroll
        for (unsigned j = 0; j < 16; ++j) { const unsigned c = xb_ld(&bar[XB_XCNT(j)]); sum += c; cnt += (c > 0u) ? 1u : 0u; mine = (j == x) ? c : mine; }
        if (sum == G) break;
        __builtin_amdgcn_s_sleep(1);
        if ((++sp & 255u) == 0u) { if (xb_ld(&bar[XB_TMO])) break; if (sp > XB_SPIN_CAP) { atomicAdd(&bar[XB_TMO], 1u); break; } }
    }
    nloc = mine > 0u ? mine : 1u; nx = cnt > 0u ? cnt : 1u;
}

__device__ __forceinline__ void xcd_barrier(const XcdBarrier& b) {
    asm volatile("s_waitcnt vmcnt(0)" ::: "memory");
    __syncthreads();
    if (xb_tid() == 0u) {
        unsigned* bar = b.bar;
        __builtin_amdgcn_s_waitcnt(0);
        unsigned nloc = b.st[0], nx = b.st[1];
        if (nloc == 0u) { xcd_barrier_complete(bar, b.x, nloc, nx); b.st[0] = nloc; b.st[1] = nx; }
        const unsigned old = xb_add(&bar[XB_XSUB(b.x)], 1u);
        const unsigned gen = old / nloc;
        if (old + 1u == (gen + 1u) * nloc) {
            __builtin_amdgcn_fence(__ATOMIC_RELEASE, "agent");
            asm volatile("s_waitcnt vmcnt(0)" ::: "memory");
            const unsigned og = xb_add(&bar[XB_TOP], 1u);
            const unsigned tg = og / nx;
            if (og + 1u == (tg + 1u) * nx) xb_add(&bar[XB_TOPGEN], 1u);
            else XB_SPIN(xb_ld(&bar[XB_TOPGEN]) == tg, bar);
            __builtin_amdgcn_fence(__ATOMIC_ACQUIRE, "agent");
            xb_add(&bar[XB_XGEN(b.x)], 1u);
            asm volatile("s_waitcnt vmcnt(0)" ::: "memory");
        } else {
            XB_SPIN(xb_ld(&bar[XB_XGEN(b.x)]) == gen, bar);
            __builtin_amdgcn_fence(__ATOMIC_ACQUIRE, "agent");
            asm volatile("s_waitcnt vmcnt(0)" ::: "memory");
        }
    }
    __syncthreads();
}

struct Params { const float* in[30]; float* out; unsigned char* ws; int ph_lo, ph_hi; };
enum { I_X = 0, I_MEM, I_NORM_MIX, I_W_IN, I_NA_QN, I_NA_KN, I_NA_RPB, I_CQ_N, I_W_UQ, I_CKV_N, I_W_UKV, I_MLA_QN, I_MLA_KN, I_SWA_QN, I_SWA_KN, I_SWA_SINK,
       I_MEM_N, I_MEM_WKV, I_MEM_QN, I_MEM_KN, I_W_BRANCH, I_W_GATE, I_B_GATE, I_W_O, I_NORM_FFN, I_FFN_UP, I_FFN_DN, I_ROUTER, I_MOE_UP, I_MOE_DN };

__device__ __forceinline__ float wave_sum(float v) {
#pragma unroll
    for (int o = 32; o >= 1; o >>= 1) v += __shfl_xor(v, o);
    return v;
}
__device__ __forceinline__ float bf2f(bf16_t b) { return __uint_as_float(((unsigned)b) << 16); }
__device__ __forceinline__ bf16_t f2bf(float f) { return (bf16_t)(pg8::cvt_pk_bf16(f, 0.f) & 0xffffu); }
using pg8::cvt_pk_bf16; using pg8::bflo; using pg8::bfhi;

struct CvtJob { const float* src; bf16_t* dst; int src_ld, K, ntn, tile0, mode, dff; };
constexpr int NJOBS = 40;
__device__ __forceinline__ void make_job(int j, const Params& p, CvtJob& jb) {
    unsigned char* ws = p.ws; jb.mode = 0; jb.dff = 1; jb.tile0 = 0;
    if (j < 22) { const int l = j / 11, k = j % 11; unsigned char* lw = ws + WS_LW + (size_t)l * LW_BYTES;
        if (k == 0) { jb.src = p.in[I_W_IN] + (size_t)l * DM * INC; jb.dst = (bf16_t*)(lw + LW_IN); jb.src_ld = INC; jb.K = DM; jb.ntn = INC / 64; jb.mode = INGATE_FP8 ? 3 : 0; }
        else if (k == 1) { jb.src = p.in[I_W_IN]; jb.dst = (bf16_t*)(lw + LW_IN + (size_t)INC * DM * (INGATE_FP8 ? 1 : 2)); jb.src_ld = INC; jb.K = DM; jb.ntn = (ZC - INC) / 64; jb.mode = INGATE_FP8 ? 5 : 2; }
        else if (k == 2) { jb.src = p.in[I_W_GATE] + (size_t)l * DM * 8192; jb.dst = (bf16_t*)(lw + LW_IN + (size_t)ZC * DM * (INGATE_FP8 ? 1 : 2)); jb.src_ld = 8192; jb.K = DM; jb.ntn = 8192 / 64; jb.mode = INGATE_FP8 ? 3 : 0; }
        else if (k == 3) { jb.src = p.in[I_W_UQ] + (size_t)l * 768 * 768; jb.dst = (bf16_t*)(lw + LW_UQ); jb.src_ld = 768; jb.K = 768; jb.ntn = 768 / 64; }
        else if (k == 4) { jb.src = p.in[I_W_UKV] + (size_t)l * 256 * 1024; jb.dst = (bf16_t*)(lw + LW_UKV); jb.src_ld = 1024; jb.K = 256; jb.ntn = 1024 / 64; }
        else if (k == 5) { jb.src = p.in[I_MEM_WKV] + (size_t)l * DM * 1024; jb.dst = (bf16_t*)(lw + LW_MEMKV); jb.src_ld = 1024; jb.K = DM; jb.ntn = 1024 / 64; }
        else if (k < 10) { const int n = k - 6; jb.src = p.in[I_W_BRANCH] + ((size_t)l * 4 + n) * 512 * DM; jb.dst = (bf16_t*)(lw + LW_BR + (size_t)n * DM * 512 * (MIX_FP8 ? 1 : 2)); jb.src_ld = DM; jb.K = 512; jb.ntn = DM / 64; jb.mode = MIX_FP8 ? 3 : 0; }
        else { jb.src = p.in[I_W_O] + (size_t)l * DM * DM; jb.dst = (bf16_t*)(lw + LW_O); jb.src_ld = DM; jb.K = DM; jb.ntn = DM / 64; jb.mode = MIX_FP8 ? 3 : 0; }
    } else if (j == 22) { jb.src = p.in[I_FFN_UP]; jb.dst = (bf16_t*)(ws + WS_FFNUP); jb.src_ld = 2 * DFF; jb.K = DM; jb.ntn = 2 * DFF / 64; jb.mode = 1; jb.dff = DFF; }
    else if (j == 23) { jb.src = p.in[I_FFN_DN]; jb.dst = (bf16_t*)(ws + WS_FFNDN); jb.src_ld = DM; jb.K = DFF; jb.ntn = DM / 64; }
    else if (j < 32) { const int e = j - 24; jb.src = p.in[I_MOE_UP] + (size_t)e * DM * 2 * DFFE; jb.dst = (bf16_t*)(ws + WS_MOEUP + (size_t)e * 2 * DFFE * DM * MOE_ES); jb.src_ld = 2 * DFFE; jb.K = DM; jb.ntn = 2 * DFFE / 64; jb.mode = MOE_FP8 ? 4 : 1; jb.dff = DFFE; }
    else { const int e = j - 32; jb.src = p.in[I_MOE_DN] + (size_t)e * DFFE * DM; jb.dst = (bf16_t*)(ws + WS_MOEDN + (size_t)e * DM * DFFE * MOE_ES); jb.src_ld = DM; jb.K = DFFE; jb.ntn = DM / 64; jb.mode = MOE_FP8 ? 3 : 0; }
}

__device__ __forceinline__ void norm_rows(const float* src, const float* g, bf16_t* dst, unsigned char* dst8, int nrows, int wid, int lane) {
    const int nw = gridDim.x * 8;
    for (int row = blockIdx.x * 8 + wid; row < nrows; row += 2 * nw) {
        const int rowb = row + nw; const bool hb = rowb < nrows;
        const f32x4* sa = (const f32x4*)(src + (size_t)row * DM); const f32x4* sb = (const f32x4*)(src + (size_t)(hb ? rowb : row) * DM);
        f32x4 va[8], vb[8]; float ssa = 0.f, ssb = 0.f;
#pragma unroll
        for (int j = 0; j < 8; ++j) { va[j] = sa[lane + 64 * j]; vb[j] = sb[lane + 64 * j]; }
#pragma unroll
        for (int j = 0; j < 8; ++j) { ssa += va[j][0] * va[j][0] + va[j][1] * va[j][1] + va[j][2] * va[j][2] + va[j][3] * va[j][3]; ssb += vb[j][0] * vb[j][0] + vb[j][1] * vb[j][1] + vb[j][2] * vb[j][2] + vb[j][3] * vb[j][3]; }
#pragma unroll
        for (int o = 32; o >= 1; o >>= 1) { ssa += __shfl_xor(ssa, o); ssb += __shfl_xor(ssb, o); }
        const float ra = 1.0f / sqrtf(ssa * (1.0f / DM) + EPS), rb = 1.0f / sqrtf(ssb * (1.0f / DM) + EPS);
#pragma unroll
        for (int j = 0; j < 8; ++j) { const f32x4 gv = ((const f32x4*)g)[lane + 64 * j];
            { const f32x4 y = va[j] * ra * gv; u32x2 w; w.x = cvt_pk_bf16(y[0], y[1]); w.y = cvt_pk_bf16(y[2], y[3]); *(u32x2*)(dst + (size_t)row * DM + 4 * (lane + 64 * j)) = w;
              if (dst8) *(unsigned*)(dst8 + (size_t)row * DM + 4 * (lane + 64 * j)) = pg8::pack_fp8x4(y[0] * SC_ACT8, y[1] * SC_ACT8, y[2] * SC_ACT8, y[3] * SC_ACT8); }
            if (hb) { const f32x4 y = vb[j] * rb * gv; u32x2 w; w.x = cvt_pk_bf16(y[0], y[1]); w.y = cvt_pk_bf16(y[2], y[3]); *(u32x2*)(dst + (size_t)rowb * DM + 4 * (lane + 64 * j)) = w;
              if (dst8) *(unsigned*)(dst8 + (size_t)rowb * DM + 4 * (lane + 64 * j)) = pg8::pack_fp8x4(y[0] * SC_ACT8, y[1] * SC_ACT8, y[2] * SC_ACT8, y[3] * SC_ACT8); } }
    }
}

__device__ __forceinline__ void p0_prologue(const Params& p, LAS unsigned char* lds, int tid, int wid, int lane) {
    LAS CvtJob* jt = (LAS CvtJob*)(lds + 65536);
    LAS int* jtot = (LAS int*)(lds + 65536 + 4096);
    if (tid < NJOBS) { CvtJob jb; make_job(tid, p, jb); jt[tid].src = jb.src; jt[tid].dst = jb.dst; jt[tid].src_ld = jb.src_ld; jt[tid].K = jb.K; jt[tid].ntn = jb.ntn; jt[tid].tile0 = 0; jt[tid].mode = jb.mode; jt[tid].dff = jb.dff; }
    __syncthreads();
    if (tid == 0) { int acc = 0; for (int j = 0; j < NJOBS; ++j) { jt[j].tile0 = acc; acc += (jt[j].K / 128) * jt[j].ntn; } jtot[0] = acc; }
    __syncthreads();
    const int total = jtot[0];
    struct Tile { int mode, K, tn, tk, dff; bf16_t* dst; f32x4 r0, r1, r2, r3; };
    const int tq = tid >> 4, nq = tid & 15;
    int j = 0;
#define P0_FETCH(TL, G_) do { (TL).mode = -1; if ((G_) < total) { while (j + 1 < NJOBS && jt[j + 1].tile0 <= (G_)) ++j; \
        const float* src = (const float*)(__attribute__((address_space(1))) const float*)jt[j].src; const int src_ld = jt[j].src_ld, ntn = jt[j].ntn, local = (G_) - jt[j].tile0; \
        (TL).mode = jt[j].mode; (TL).K = jt[j].K; (TL).dff = jt[j].dff; (TL).dst = (bf16_t*)(__attribute__((address_space(1))) bf16_t*)jt[j].dst; (TL).tn = local % ntn; (TL).tk = local / ntn; \
        if ((TL).mode != 2 && (TL).mode != 5) { const bool f8 = (TL).mode >= 3; const int ra = f8 ? 4 * tq : 2 * tq, rb = ra + 1, rc = f8 ? ra + 2 : ra + 64, rd = rc + 1; \
            const float* sp = src + (size_t)((TL).tk * 128) * src_ld + (TL).tn * 64 + 4 * nq; \
            (TL).r0 = __builtin_nontemporal_load((const f32x4*)(sp + (size_t)ra * src_ld)); (TL).r1 = __builtin_nontemporal_load((const f32x4*)(sp + (size_t)rb * src_ld)); \
            (TL).r2 = __builtin_nontemporal_load((const f32x4*)(sp + (size_t)rc * src_ld)); (TL).r3 = __builtin_nontemporal_load((const f32x4*)(sp + (size_t)rd * src_ld)); } } } while (0)
#define P0_TOLDS(TL, T) do { if ((TL).mode >= 3 && (TL).mode != 5) { _Pragma("unroll") for (int q = 0; q < 4; ++q) (T)[(4 * nq + q) * 33 + tq] = pg8::pack_fp8x4((TL).r0[q] * SC_W8, (TL).r1[q] * SC_W8, (TL).r2[q] * SC_W8, (TL).r3[q] * SC_W8); } \
        else if ((TL).mode == 0 || (TL).mode == 1) { _Pragma("unroll") for (int q = 0; q < 4; ++q) { (T)[(4 * nq + q) * 65 + tq] = cvt_pk_bf16((TL).r0[q], (TL).r1[q]); (T)[(4 * nq + q) * 65 + tq + 32] = cvt_pk_bf16((TL).r2[q], (TL).r3[q]); } } } while (0)
#define P0_OUT(TL, T) do { const int mode = (TL).mode, K = (TL).K, tn = (TL).tn, tk = (TL).tk, dff = (TL).dff; bf16_t* dst = (TL).dst; \
        if (mode == 2) { _Pragma("unroll") for (int it = 0; it < 2; ++it) { const int piece = tid + it * 512, n = piece >> 4, seg = piece & 15; \
                *(u32x4*)(dst + (size_t)(tn * 64 + n) * K + tk * 128 + seg * 8) = (u32x4){0u, 0u, 0u, 0u}; } } \
        else if (mode == 5) { const int n = tid >> 3, seg = tid & 7; *(u32x4*)((unsigned char*)dst + (size_t)(tn * 64 + n) * K + tk * 128 + seg * 16) = (u32x4){0u, 0u, 0u, 0u}; } \
        else if (mode >= 3) { const int n = tid >> 3, seg = tid & 7; \
            u32x4 w; w.x = (T)[n * 33 + seg * 4 + 0]; w.y = (T)[n * 33 + seg * 4 + 1]; w.z = (T)[n * 33 + seg * 4 + 2]; w.w = (T)[n * 33 + seg * 4 + 3]; \
            int drow = tn * 64 + n; if (mode == 4) { const int bj = drow / dff, cc = drow - bj * dff; drow = 256 * (cc >> 7) + 128 * bj + (cc & 127); } \
            __builtin_nontemporal_store(w, (u32x4*)((unsigned char*)dst + (size_t)drow * K + tk * 128 + seg * 16)); } \
        else if (mode >= 0) { _Pragma("unroll") for (int it = 0; it < 2; ++it) { const int piece = tid + it * 512, n = piece >> 4, seg = piece & 15; \
                u32x4 w; w.x = (T)[n * 65 + seg * 4 + 0]; w.y = (T)[n * 65 + seg * 4 + 1]; w.z = (T)[n * 65 + seg * 4 + 2]; w.w = (T)[n * 65 + seg * 4 + 3]; \
                int drow = tn * 64 + n; if (mode == 1) { const int bj = drow / dff, cc = drow - bj * dff; drow = 256 * (cc >> 7) + 128 * bj + (cc & 127); } \
                __builtin_nontemporal_store(w, (u32x4*)(dst + (size_t)drow * K + tk * 128 + seg * 8)); } } } while (0)
    LAS unsigned* T0 = (LAS unsigned*)lds; LAS unsigned* T1 = (LAS unsigned*)(lds + 20480);
    Tile na, nb;
    int g = 2 * blockIdx.x;
    P0_FETCH(na, g); P0_FETCH(nb, g + 1);
    while (g < total) {
        const Tile ca = na, cb = nb;
        g += 2 * gridDim.x;
        P0_FETCH(na, g); P0_FETCH(nb, g + 1);
        P0_TOLDS(ca, T0); P0_TOLDS(cb, T1);
        __syncthreads();
        P0_OUT(ca, T0); P0_OUT(cb, T1);
        __syncthreads();
    }
#undef P0_FETCH
#undef P0_TOLDS
#undef P0_OUT
#ifdef PROBE_POISON
    { u32x4* q = (u32x4*)(p.ws + WS_XG); const size_t n1 = (size_t)NEXP * ECAP * DM / 16; for (size_t i = (size_t)blockIdx.x * NTHREADS + tid; i < n1; i += (size_t)gridDim.x * NTHREADS) q[i] = (u32x4){0u, 0u, 0u, 0u};
      q = (u32x4*)(p.ws + WS_ACTM); const size_t n2 = (size_t)NEXP * ECAP * DFFE / 16; for (size_t i = (size_t)blockIdx.x * NTHREADS + tid; i < n2; i += (size_t)gridDim.x * NTHREADS) q[i] = (u32x4){0u, 0u, 0u, 0u}; }
#endif
    { f32x2* rt = (f32x2*)(p.ws + WS_ROPE);
      for (int e = blockIdx.x * NTHREADS + tid; e < SEQ * 32; e += gridDim.x * NTHREADS) { const int pos = e >> 5, i = e & 31;
          const float freq = __builtin_amdgcn_exp2f(-(float)i * (13.287712379549449f / 32.0f));
          const float ang = (float)pos * freq;
          const double rev = (double)ang * 0.15915494309189535; const float fr_ = (float)(rev - __builtin_rint(rev));
          rt[e] = (f32x2){__builtin_amdgcn_cosf(fr_), __builtin_amdgcn_sinf(fr_)}; } }
    norm_rows(p.in[I_MEM], p.in[I_MEM_N], (bf16_t*)(p.ws + WS_MEMN), nullptr, NMEM, wid, lane);
    norm_rows(p.in[I_MEM], p.in[I_MEM_N] + DM, (bf16_t*)(p.ws + WS_MEMN) + (size_t)NMEM * DM, nullptr, NMEM, wid, lane);
    norm_rows(p.in[I_X], p.in[I_NORM_MIX], (bf16_t*)(p.ws + WS_U), p.ws + WS_U8, NTOK, wid, lane);
}

__device__ __forceinline__ void unpack8(const u32x4 w, float (&x)[8]) { x[0] = bflo(w.x); x[1] = bfhi(w.x); x[2] = bflo(w.y); x[3] = bfhi(w.y); x[4] = bflo(w.z); x[5] = bfhi(w.z); x[6] = bflo(w.w); x[7] = bfhi(w.w); }
__device__ __forceinline__ u32x4 pack8(const float (&y)[8]) { u32x4 w; w.x = cvt_pk_bf16(y[0], y[1]); w.y = cvt_pk_bf16(y[2], y[3]); w.z = cvt_pk_bf16(y[4], y[5]); w.w = cvt_pk_bf16(y[6], y[7]); return w; }
__device__ __forceinline__ float sumsq8(const float (&x)[8]) { return (x[0] * x[0] + x[1] * x[1]) + (x[2] * x[2] + x[3] * x[3]) + (x[4] * x[4] + x[5] * x[5]) + (x[6] * x[6] + x[7] * x[7]); }
template <int NL> __device__ __forceinline__ float group_sum(float v) {
#pragma unroll
    for (int o = NL / 2; o >= 1; o >>= 1) v += __shfl_xor(v, o);
    return v;
}
struct Gain8 { f32x4 a, b; };
__device__ __forceinline__ Gain8 ldg8(const float* g) { Gain8 r; r.a = *(const f32x4*)g; r.b = *(const f32x4*)(g + 4); return r; }
__device__ __forceinline__ void scale8(float (&x)[8], float rs, const Gain8& g) { x[0] *= rs * g.a[0]; x[1] *= rs * g.a[1]; x[2] *= rs * g.a[2]; x[3] *= rs * g.a[3]; x[4] *= rs * g.b[0]; x[5] *= rs * g.b[1]; x[6] *= rs * g.b[2]; x[7] *= rs * g.b[3]; }
__device__ __forceinline__ void rope8(float (&y)[8], const f32x4 (&cs)[4], bool upper) {
#pragma unroll
    for (int e = 0; e < 8; ++e) { const float pr = __shfl_xor(y[e], 4); const float c = cs[e >> 1][(e & 1) * 2], s = cs[e >> 1][(e & 1) * 2 + 1]; y[e] = upper ? (y[e] * c + pr * s) : (y[e] * c - pr * s); }
}

__device__ __forceinline__ void prep1(const Params& p, int l, LAS unsigned char* lds, int tid, int wid, int lane) {
    const bf16_t* z = (const bf16_t*)(p.ws + WS_Z);
    bf16_t* naq = (bf16_t*)(p.ws + WS_NAQ); bf16_t* nak = (bf16_t*)(p.ws + WS_NAK); bf16_t* navT = (bf16_t*)(p.ws + WS_NAVT);
    bf16_t* cqn = (bf16_t*)(p.ws + WS_CQN); bf16_t* ckvn = (bf16_t*)(p.ws + WS_CKVN);
    bf16_t* swq = (bf16_t*)(p.ws + WS_SWQ); bf16_t* swk = (bf16_t*)(p.ws + WS_SWK); bf16_t* swvT = (bf16_t*)(p.ws + WS_SWVT); bf16_t* meq = (bf16_t*)(p.ws + WS_MEQ);
    const f32x4* rt4 = (const f32x4*)(p.ws + WS_ROPE);
    const float qs128 = 0.08838834764831845f * LOG2E, qs64 = 0.125f * LOG2E;
    const int l16 = lane & 15, l8 = lane & 7;
    const Gain8 g_naq = ldg8(p.in[I_NA_QN] + l * 128 + 8 * l16), g_nak = ldg8(p.in[I_NA_KN] + l * 128 + 8 * l16), g_meq = ldg8(p.in[I_MEM_QN] + l * 128 + 8 * l16);
    const Gain8 g_cq0 = ldg8(p.in[I_CQ_N] + l * 768 + 8 * lane), g_cq1 = ldg8(p.in[I_CQ_N] + l * 768 + 512 + 8 * (lane & 31)), g_ckv = ldg8(p.in[I_CKV_N] + l * 256 + 8 * (lane & 31));
    const Gain8 g_swq = ldg8(p.in[I_SWA_QN] + l * 64 + 8 * l8), g_swk = ldg8(p.in[I_SWA_KN] + l * 64 + 8 * l8);
    constexpr int VW = 640;
    LAS bf16_t* vt = (LAS bf16_t*)lds;
    const u32x4 zero4 = (u32x4){0u, 0u, 0u, 0u};
    for (int grp = blockIdx.x; grp < NTOK / 32; grp += gridDim.x) {
        const int b = grp >> 6, chunk = grp & 63;
#pragma unroll 2
        for (int ti = 0; ti < 4; ++ti) {
            const int tl = wid * 4 + ti, s = chunk * 32 + tl, token = grp * 32 + tl;
            const bf16_t* zr = z + (size_t)token * ZC;
            const u32x4 w_naq = *(const u32x4*)(zr + Z_NAQ + 8 * lane), w_nak = *(const u32x4*)(zr + Z_NAK + 8 * lane), w_nav = *(const u32x4*)(zr + Z_NAV + 8 * lane), w_meq = *(const u32x4*)(zr + Z_MEQ + 8 * lane);
            const u32x4 w_cq0 = *(const u32x4*)(zr + Z_CQ + 8 * lane); const u32x4 w_cq1 = lane < 32 ? *(const u32x4*)(zr + Z_CQ + 512 + 8 * lane) : zero4;
            const u32x4 w_ckv = lane < 32 ? *(const u32x4*)(zr + Z_CKV + 8 * lane) : zero4;
            const u32x4 w_swq = *(const u32x4*)(zr + Z_SWQ + 8 * lane);
            const u32x4 w_swkv = lane < 32 ? *(const u32x4*)(zr + (lane < 16 ? Z_SWK + 8 * lane : Z_SWV + 8 * (lane - 16))) : zero4;
            f32x4 cs[4];
#pragma unroll
            for (int q = 0; q < 4; ++q) cs[q] = rt4[(s * 32 + (lane & 3) * 8) / 2 + q];
            *(LAS u32x4*)(vt + tl * VW + 8 * lane) = w_nav;
            if (lane >= 16 && lane < 32) *(LAS u32x4*)(vt + tl * VW + 512 + 8 * (lane - 16)) = w_swkv;
            float x[8];
            { unpack8(w_naq, x); const float ss = group_sum<16>(sumsq8(x)); scale8(x, 1.0f / sqrtf(ss * (1.0f / 128) + EPS) * qs128, g_naq);
              *(u32x4*)(naq + ((size_t)(b * 4 + (lane >> 4)) * SEQ + s) * 128 + 8 * l16) = pack8(x); }
            { unpack8(w_nak, x); const float ss = group_sum<16>(sumsq8(x)); scale8(x, 1.0f / sqrtf(ss * (1.0f / 128) + EPS), g_nak);
              *(u32x4*)(nak + ((size_t)(b * 4 + (lane >> 4)) * SEQ + s) * 128 + 8 * l16) = pack8(x); }
            { unpack8(w_meq, x); const float ss = group_sum<16>(sumsq8(x)); scale8(x, 1.0f / sqrtf(ss * (1.0f / 128) + EPS) * qs128, g_meq);
              *(u32x4*)(meq + ((size_t)(b * 4 + (lane >> 4)) * SEQ + s) * 128 + 8 * l16) = pack8(x); }
            { float y[8]; unpack8(w_cq0, x); unpack8(w_cq1, y); const float ss = group_sum<64>(sumsq8(x) + sumsq8(y)); const float rs = 1.0f / sqrtf(ss * (1.0f / 768) + EPS);
              scale8(x, rs, g_cq0); scale8(y, rs, g_cq1);
              *(u32x4*)(cqn + (size_t)token * 768 + 8 * lane) = pack8(x); if (lane < 32) *(u32x4*)(cqn + (size_t)token * 768 + 512 + 8 * lane) = pack8(y); }
            { unpack8(w_ckv, x); const float ss = group_sum<64>(sumsq8(x)); scale8(x, 1.0f / sqrtf(ss * (1.0f / 256) + EPS), g_ckv);
              if (lane < 32) *(u32x4*)(ckvn + (size_t)token * 256 + 8 * lane) = pack8(x); }
            { unpack8(w_swq, x); const float ss = group_sum<8>(sumsq8(x)); scale8(x, 1.0f / sqrtf(ss * (1.0f / 64) + EPS), g_swq); rope8(x, cs, (lane & 4) != 0);
#pragma unroll
              for (int e = 0; e < 8; ++e) x[e] *= qs64;
              *(u32x4*)(swq + ((size_t)(b * 8 + (lane >> 3)) * SEQ + s) * 64 + 8 * l8) = pack8(x); }
            { unpack8(w_swkv, x); const float ss = group_sum<8>(sumsq8(x)); scale8(x, 1.0f / sqrtf(ss * (1.0f / 64) + EPS), g_swk); rope8(x, cs, (lane & 4) != 0);
              if (lane < 16) *(u32x4*)(swk + ((size_t)(b * 2 + (lane >> 3)) * SEQ + s) * 64 + 8 * l8) = pack8(x); }
        }
        __syncthreads();
#pragma unroll 1
        for (int it = 0; it < 5; ++it) { const int item = tid + it * 512, part = item / VW, c = item - part * VW;
            unsigned short e[8];
#pragma unroll
            for (int q = 0; q < 8; ++q) e[q] = vt[(part * 8 + q) * VW + c];
            u32x4 w; w.x = e[0] | ((unsigned)e[1] << 16); w.y = e[2] | ((unsigned)e[3] << 16); w.z = e[4] | ((unsigned)e[5] << 16); w.w = e[6] | ((unsigned)e[7] << 16);
            bf16_t* dp = (c < 512) ? navT + ((((size_t)(b * 4 + (c >> 7)) * 64 + chunk) * 128 + (c & 127)) * 32 + part * 8)
                                   : swvT + ((((size_t)(b * 2 + ((c - 512) >> 6)) * 64 + chunk) * 64 + ((c - 512) & 63)) * 32 + part * 8);
            *(u32x4*)dp = w; }
        __syncthreads();
    }
}

__device__ __forceinline__ void prep2(const Params& p, int l, LAS unsigned char* lds, int tid, int wid, int lane) {
    const bf16_t* z = (const bf16_t*)(p.ws + WS_Z); const bf16_t* qraw = (const bf16_t*)(p.ws + WS_QRAW); const bf16_t* kvraw = (const bf16_t*)(p.ws + WS_KVRAW);
    const bf16_t* memkv = (const bf16_t*)(p.ws + WS_MEMKV) + (size_t)l * NMEM * 1024;
    bf16_t* mlq = (bf16_t*)(p.ws + WS_MLQ); bf16_t* mlk = (bf16_t*)(p.ws + WS_MLK); bf16_t* mlvT = (bf16_t*)(p.ws + WS_MLVT);
    bf16_t* mek = (bf16_t*)(p.ws + WS_MEK); bf16_t* mevT = (bf16_t*)(p.ws + WS_MEVT);
    const f32x4* rt4 = (const f32x4*)(p.ws + WS_ROPE);
    const float qs192 = 0.07216878364870322f * LOG2E;
    const int l16 = lane & 15, l24 = lane < 24 ? lane : 0;
    const Gain8 g_q = ldg8(p.in[I_MLA_QN] + l * 192 + 8 * l24), g_k = ldg8(p.in[I_MLA_KN] + l * 192 + 8 * l24), g_mk = ldg8(p.in[I_MEM_KN] + l * 128 + 8 * l16);
    constexpr int VW = 512;
    LAS bf16_t* vt = (LAS bf16_t*)lds;
    const u32x4 zero4 = (u32x4){0u, 0u, 0u, 0u};
    for (int grp = blockIdx.x; grp < NTOK / 32 + NMEM / 32; grp += gridDim.x) {
        const bool ismem = grp >= NTOK / 32;
        if (!ismem) {
            const int b = grp >> 6, chunk = grp & 63;
#pragma unroll 2
            for (int ti = 0; ti < 4; ++ti) {
                const int tl = wid * 4 + ti, s = chunk * 32 + tl, token = grp * 32 + tl;
                u32x4 wq[4], wk[4];
#pragma unroll
                for (int h = 0; h < 4; ++h) { wq[h] = lane < 24 ? *(const u32x4*)(qraw + (size_t)token * 768 + h * 192 + 8 * lane) : zero4;
                    wk[h] = lane < 16 ? *(const u32x4*)(kvraw + (size_t)token * 1024 + h * 256 + 8 * lane) : (lane < 24 ? *(const u32x4*)(z + (size_t)token * ZC + Z_KPE + 8 * (lane - 16)) : zero4); }
                const u32x4 wv = *(const u32x4*)(kvraw + (size_t)token * 1024 + (lane >> 4) * 256 + 128 + 8 * l16);
                f32x4 cs[4];
#pragma unroll
                for (int q = 0; q < 4; ++q) cs[q] = rt4[(s * 32 + (lane & 3) * 8) / 2 + q];
                *(LAS u32x4*)(vt + tl * VW + (lane >> 4) * 128 + 8 * l16) = wv;
                const bool ropel = lane >= 16 && lane < 24;
#pragma unroll
                for (int h = 0; h < 4; ++h) {
                    float x[8];
                    { unpack8(wq[h], x); const float ss = group_sum<64>(sumsq8(x)); scale8(x, 1.0f / sqrtf(ss * (1.0f / 192) + EPS), g_q);
                      float y[8];
#pragma unroll
                      for (int e = 0; e < 8; ++e) y[e] = x[e];
                      rope8(y, cs, (lane & 4) != 0);
#pragma unroll
                      for (int e = 0; e < 8; ++e) x[e] = (ropel ? y[e] : x[e]) * qs192;
                      if (lane < 24) *(u32x4*)(mlq + ((size_t)(b * 4 + h) * SEQ + s) * 192 + 8 * lane) = pack8(x); }
                    { unpack8(wk[h], x); const float ss = group_sum<64>(sumsq8(x)); scale8(x, 1.0f / sqrtf(ss * (1.0f / 192) + EPS), g_k);
                      float y[8];
#pragma unroll
                      for (int e = 0; e < 8; ++e) y[e] = x[e];
                      rope8(y, cs, (lane & 4) != 0);
#pragma unroll
                      for (int e = 0; e < 8; ++e) x[e] = ropel ? y[e] : x[e];
                      if (lane < 24) *(u32x4*)(mlk + ((size_t)(b * 4 + h) * SEQ + s) * 192 + 8 * lane) = pack8(x); }
                }
            }
            __syncthreads();
#pragma unroll 1
            for (int it = 0; it < 4; ++it) { const int item = tid + it * 512, part = item >> 9, c = item & 511;
                unsigned short e[8];
#pragma unroll
                for (int q = 0; q < 8; ++q) e[q] = vt[(part * 8 + q) * VW + c];
                u32x4 w; w.x = e[0] | ((unsigned)e[1] << 16); w.y = e[2] | ((unsigned)e[3] << 16); w.z = e[4] | ((unsigned)e[5] << 16); w.w = e[6] | ((unsigned)e[7] << 16);
                *(u32x4*)(mlvT + ((((size_t)(b * 4 + (c >> 7)) * 64 + chunk) * 128 + (c & 127)) * 32 + part * 8)) = w; }
            __syncthreads();
        } else {
            const int mg = grp - NTOK / 32, b = mg >> 3, chunk = mg & 7;
#pragma unroll 2
            for (int ti = 0; ti < 4; ++ti) {
                const int tl = wid * 4 + ti, m = chunk * 32 + tl, mt = mg * 32 + tl;
                const bf16_t* mr = memkv + (size_t)mt * 1024;
                const u32x4 wkk = *(const u32x4*)(mr + 8 * lane), wv = *(const u32x4*)(mr + 512 + 8 * lane);
                *(LAS u32x4*)(vt + tl * VW + 8 * lane) = wv;
                float x[8]; unpack8(wkk, x); const float ss = group_sum<16>(sumsq8(x)); scale8(x, 1.0f / sqrtf(ss * (1.0f / 128) + EPS), g_mk);
                *(u32x4*)(mek + ((size_t)(b * 4 + (lane >> 4)) * MEML + m) * 128 + 8 * l16) = pack8(x);
            }
            __syncthreads();
#pragma unroll 1
            for (int it = 0; it < 4; ++it) { const int item = tid + it * 512, part = item >> 9, c = item & 511;
                unsigned short e[8];
#pragma unroll
                for (int q = 0; q < 8; ++q) e[q] = vt[(part * 8 + q) * VW + c];
                u32x4 w; w.x = e[0] | ((unsigned)e[1] << 16); w.y = e[2] | ((unsigned)e[3] << 16); w.z = e[4] | ((unsigned)e[5] << 16); w.w = e[6] | ((unsigned)e[7] << 16);
                *(u32x4*)(mevT + ((((size_t)(b * 4 + (c >> 7)) * 8 + chunk) * 128 + (c & 127)) * 32 + part * 8)) = w; }
            __syncthreads();
        }
    }
}
constexpr int ATT_RPB_OFF = 98304;
template <int DQ, int DV, int MODE, int NQT>
__device__ __forceinline__ void attn_unit(LAS unsigned char* lds, const bf16_t* qp, const bf16_t* kp, const bf16_t* vp, bf16_t* op,
                                          int nsub, int c_lo, int c_hi, int mq0, int mk0, int mr, float kbound, float sadd, float sink2, int tid, int lane, unsigned char* op8) {
    constexpr int KROW = DQ * 2 + 16, KBUF = 64 * KROW, VROW = 144, VBUF = DV * VROW, NDC = DQ / 32, NDV = DV / 16, DQ8 = DQ / 8;
    constexpr int KP = 64 * DQ8 / 512, VP = 2 * DV * 4 / 512;
    static_assert(KP * 512 == 64 * DQ8 && VP * 512 == 2 * DV * 4 && 2 * KBUF + 2 * VBUF <= ATT_RPB_OFF, "attention staging geometry");
    const int fr = lane & 15, fq = lane >> 4;
    bf16x8 qf[NQT][NDC];
#pragma unroll
    for (int qt = 0; qt < NQT; ++qt)
#pragma unroll
        for (int dc = 0; dc < NDC; ++dc) qf[qt][dc] = *(const bf16x8*)(qp + (size_t)(qt * 16 + fr) * DQ + dc * 32 + fq * 8);
    f32x4 o[NQT][NDV];
#pragma unroll
    for (int qt = 0; qt < NQT; ++qt)
#pragma unroll
        for (int d = 0; d < NDV; ++d) o[qt][d] = (f32x4){0.f, 0.f, 0.f, 0.f};
    float mref[NQT], lrun[NQT];
#pragma unroll
    for (int qt = 0; qt < NQT; ++qt) { float qq = 0.f;
#pragma unroll
        for (int dc = 0; dc < NDC; ++dc) { const u32x4 w = __builtin_bit_cast(u32x4, qf[qt][dc]);
            qq += bflo(w.x) * bflo(w.x) + bfhi(w.x) * bfhi(w.x) + bflo(w.y) * bflo(w.y) + bfhi(w.y) * bfhi(w.y) + bflo(w.z) * bflo(w.z) + bfhi(w.z) * bfhi(w.z) + bflo(w.w) * bflo(w.w) + bfhi(w.w) * bfhi(w.w); }
        qq += __shfl_xor(qq, 16); qq += __shfl_xor(qq, 32);
        mref[qt] = sqrtf(qq) * kbound + sadd; lrun[qt] = 0.f; }
    int kd[KP], vd[VP];
#pragma unroll
    for (int i = 0; i < KP; ++i) { const int pk = tid + i * 512, key = pk / DQ8, dp = pk - key * DQ8, k32 = key & 31;
        kd[i] = (32 * (key >> 5) + 16 * ((k32 >> 2) & 1) + 4 * (k32 >> 3) + (k32 & 3)) * KROW + dp * 16; }
#pragma unroll
    for (int i = 0; i < VP; ++i) { const int pv = tid + i * 512, sub = pv / (DV * 4), r = pv - sub * (DV * 4); vd[i] = (r >> 2) * VROW + sub * 64 + (r & 3) * 16; }
    u32x4 rk[KP], rv[VP];
#pragma unroll
    for (int i = 0; i < KP; ++i) rk[i] = *(const u32x4*)(kp + (size_t)(tid + i * 512) * 8);
#pragma unroll
    for (int i = 0; i < VP; ++i) rv[i] = *(const u32x4*)(vp + (size_t)(tid + i * 512) * 8);
#pragma unroll
    for (int i = 0; i < KP; ++i) *(LAS u32x4*)(lds + kd[i]) = rk[i];
#pragma unroll
    for (int i = 0; i < VP; ++i) *(LAS u32x4*)(lds + 2 * KBUF + vd[i]) = rv[i];
    __syncthreads();
    __builtin_amdgcn_s_waitcnt(0x0F70);
    const int n64 = nsub >> 1;
#pragma unroll 1
    for (int c = 0; c < n64; ++c) {
        const int cur = c & 1; const bool more = (c + 1 < n64);
        if (more) { const bf16_t* kn = kp + (size_t)(c + 1) * 64 * DQ; const bf16_t* vn = vp + (size_t)(c + 1) * 2 * DV * 32;
#pragma unroll
            for (int i = 0; i < KP; ++i) { const bf16_t* ga = kn + (size_t)(tid + i * 512) * 8; asm volatile("global_load_dwordx4 %0, %1, off" : "=v"(rk[i]) : "v"(ga) : "memory"); }
#pragma unroll
            for (int i = 0; i < VP; ++i) { const bf16_t* ga = vn + (size_t)(tid + i * 512) * 8; asm volatile("global_load_dwordx4 %0, %1, off" : "=v"(rv[i]) : "v"(ga) : "memory"); } }
#pragma unroll (NQT == 1 ? 2 : 1)
        for (int sub = 0; sub < 2; ++sub) {
            const int sc = 2 * c + sub;
            if (sc >= c_lo && sc < c_hi) {
                const LAS unsigned char* kb = lds + cur * KBUF + sub * 32 * KROW; const LAS unsigned char* vb = lds + 2 * KBUF + cur * VBUF + sub * 64;
                f32x4 s[NQT][2];
#pragma unroll
                for (int qt = 0; qt < NQT; ++qt) { s[qt][0] = (f32x4){0.f, 0.f, 0.f, 0.f}; s[qt][1] = (f32x4){0.f, 0.f, 0.f, 0.f}; }
                { bf16x8 kf[NDC][2];
#pragma unroll
                  for (int dc = 0; dc < NDC; ++dc) { kf[dc][0] = *(const LAS bf16x8*)(kb + fr * KROW + (dc * 32 + fq * 8) * 2); kf[dc][1] = *(const LAS bf16x8*)(kb + (16 + fr) * KROW + (dc * 32 + fq * 8) * 2); }
#pragma unroll
                  for (int dc = 0; dc < NDC; ++dc)
#pragma unroll
                    for (int qt = 0; qt < NQT; ++qt) { s[qt][0] = __builtin_amdgcn_mfma_f32_16x16x32_bf16(kf[dc][0], qf[qt][dc], s[qt][0], 0, 0, 0);
                                                       s[qt][1] = __builtin_amdgcn_mfma_f32_16x16x32_bf16(kf[dc][1], qf[qt][dc], s[qt][1], 0, 0, 0); } }
                bf16x8 pf[NQT];
#pragma unroll
                for (int qt = 0; qt < NQT; ++qt) {
                    if (MODE == 1) {
                        const int qpos = mq0 + qt * 16 + fr, kbase = mk0 + sc * 32 + 8 * fq;
#pragma unroll
                        for (int b = 0; b < 2; ++b)
#pragma unroll
                            for (int i = 0; i < 4; ++i) { const int dd = qpos - (kbase + 4 * b + i); if (dd > 128 || dd < -128) s[qt][b][i] = -1e30f; }
                    } else if (MODE == 2) {
                        const LAS float* rpb = (const LAS float*)(lds + ATT_RPB_OFF);
                        const int qc = mq0 + qt * 16 + fr, kr = mk0 + (sc >> 1), kcb = (sc & 1) * 32 + 8 * fq;
                        int cs = qc - 8; cs = cs < 0 ? 0 : (cs > 48 ? 48 : cs);
                        const int rowoff = (kr - mr + 7) * 31;
#pragma unroll
                        for (int b = 0; b < 2; ++b)
#pragma unroll
                            for (int i = 0; i < 4; ++i) { const int kc = kcb + 4 * b + i; const bool ok = (kc >= cs) && (kc <= cs + 15);
                                int bi = kc - qc + 15; bi = bi < 0 ? 0 : (bi > 30 ? 30 : bi);
                                const float bias = rpb[rowoff + bi];
                                s[qt][b][i] = ok ? s[qt][b][i] + bias : -1e30f; }
                    }
                    float ps = 0.f;
#pragma unroll
                    for (int b = 0; b < 2; ++b)
#pragma unroll
                        for (int i = 0; i < 4; ++i) { const float e = __builtin_amdgcn_exp2f(s[qt][b][i] - mref[qt]); s[qt][b][i] = e; ps += e; }
                    lrun[qt] += ps;
                    u32x4 w; w.x = cvt_pk_bf16(s[qt][0][0], s[qt][0][1]); w.y = cvt_pk_bf16(s[qt][0][2], s[qt][0][3]); w.z = cvt_pk_bf16(s[qt][1][0], s[qt][1][1]); w.w = cvt_pk_bf16(s[qt][1][2], s[qt][1][3]);
                    pf[qt] = __builtin_bit_cast(bf16x8, w);
                }
                { bf16x8 vf[NDV];
#pragma unroll
                  for (int d = 0; d < NDV; ++d) vf[d] = *(const LAS bf16x8*)(vb + (d * 16 + fr) * VROW + fq * 16);
#pragma unroll
                  for (int d = 0; d < NDV; ++d)
#pragma unroll
                    for (int qt = 0; qt < NQT; ++qt) o[qt][d] = __builtin_amdgcn_mfma_f32_16x16x32_bf16(vf[d], pf[qt], o[qt][d], 0, 0, 0); }
            }
        }
        if (more) { const int nb = cur ^ 1;
            if constexpr (KP == 3) asm volatile("s_waitcnt vmcnt(0)" : "+v"(rk[0]), "+v"(rk[1]), "+v"(rk[2]), "+v"(rv[0]), "+v"(rv[1]) :: "memory");
            else if constexpr (KP == 2) asm volatile("s_waitcnt vmcnt(0)" : "+v"(rk[0]), "+v"(rk[1]), "+v"(rv[0]), "+v"(rv[1]) :: "memory");
            else asm volatile("s_waitcnt vmcnt(0)" : "+v"(rk[0]), "+v"(rv[0]) :: "memory");
#pragma unroll
            for (int i = 0; i < KP; ++i) *(LAS u32x4*)(lds + nb * KBUF + kd[i]) = rk[i];
#pragma unroll
            for (int i = 0; i < VP; ++i) *(LAS u32x4*)(lds + 2 * KBUF + nb * VBUF + vd[i]) = rv[i]; }
        __syncthreads();
    }
#pragma unroll
    for (int qt = 0; qt < NQT; ++qt) {
        float l = lrun[qt]; l += __shfl_xor(l, 16); l += __shfl_xor(l, 32);
        if (MODE == 1) l += __builtin_amdgcn_exp2f(sink2 - mref[qt]);
        const float inv = 1.0f / l;
        bf16_t* orow = op + (size_t)(qt * 16 + fr) * DM + 4 * fq;
#pragma unroll
        for (int d = 0; d < NDV; ++d) { u32x2 w; w.x = cvt_pk_bf16(o[qt][d][0] * inv, o[qt][d][1] * inv); w.y = cvt_pk_bf16(o[qt][d][2] * inv, o[qt][d][3] * inv); *(u32x2*)(orow + d * 16) = w;
            if (op8) { const float i8 = inv * SC_BR8; *(unsigned*)(op8 + (size_t)(qt * 16 + fr) * DM + 4 * fq + d * 16) = pg8::pack_fp8x4(o[qt][d][0] * i8, o[qt][d][1] * i8, o[qt][d][2] * i8, o[qt][d][3] * i8); } }
    }
}

__device__ __forceinline__ float gain_absmax(const float* g, int n, int lane) {
    float m = 0.f;
#pragma unroll
    for (int j = 0; j < 3; ++j) { const int i = lane + 64 * j; if (i < n) m = fmaxf(m, fabsf(g[i])); }
#pragma unroll
    for (int o = 32; o >= 1; o >>= 1) m = fmaxf(m, __shfl_xor(m, o));
    return m;
}
__device__ __forceinline__ void attn_phase(const Params& p, int lq, LAS unsigned char* lds, int tid, int wid, int lane, int G, int cblk) {
    const int l = lq & 1;
    unsigned* head = (unsigned*)(p.ws + WS_CTL) + CW_ATTQ + lq * 64;
    volatile LAS int* qw = (volatile LAS int*)(lds + LDS_MISC + 64);
    bf16_t* br = (bf16_t*)(p.ws + ((lq & 2) ? WS_ACT : WS_BR)); unsigned char* br8 = (MIX_FP8 && !(lq & 2)) ? p.ws + WS_BR8 : nullptr;
#define O8(o_) (br8 ? br8 + ((o_) - br) : nullptr)
    const float kb_mla = 13.856406460551018f * gain_absmax(p.in[I_MLA_KN] + l * 192, 192, lane), kb_na = 11.313708498984761f * gain_absmax(p.in[I_NA_KN] + l * 128, 128, lane);
    const float kb_swa = 8.0f * gain_absmax(p.in[I_SWA_KN] + l * 64, 64, lane), kb_mem = 11.313708498984761f * gain_absmax(p.in[I_MEM_KN] + l * 128, 128, lane);
    const int pmode = lq >> 2;
    if (pmode != 2) {
        const int x = cblk & 7, j = cblk >> 3;
        if (G == 256 ? (j < 16) : true)
        for (int id = (G == 256 ? x * 16 + j : cblk); id < 128; id += (G == 256 ? 128 : G)) {
            const int bhi = id >> 3, qt8 = id & 7, b = bhi >> 2, h = bhi & 3; const size_t bh = (size_t)bhi;
            const bf16_t* q = (const bf16_t*)(p.ws + WS_MLQ) + (bh * SEQ + qt8 * 256 + wid * 32) * 192;
            const bf16_t* k = (const bf16_t*)(p.ws + WS_MLK) + bh * SEQ * 192; const bf16_t* v = (const bf16_t*)(p.ws + WS_MLVT) + bh * SEQ * 128;
            bf16_t* o = br + (size_t)(b * SEQ + qt8 * 256 + wid * 32) * DM + 512 + h * 128;
            attn_unit<192, 128, 0, 2>(lds, q, k, v, o, 64, 0, 64, 0, 0, 0, kb_mla, 0.f, 0.f, tid, lane, O8(o));
        }
    }
    if (pmode != 1)
    for (;;) {
        if (tid == 0) qw[0] = 256 + (int)__hip_atomic_fetch_add(head, 1u, __ATOMIC_RELAXED, __HIP_MEMORY_SCOPE_AGENT);
        __syncthreads();
        const int id = __builtin_amdgcn_readfirstlane(qw[0]);
        __syncthreads();
        if (id >= 896) break;
        if (id < 256) {
        } else if (id < 512) {
            const int u = id - 256, b = u >> 6, h = (u >> 4) & 3, r2 = u & 15; const size_t bh = (size_t)(b * 4 + h);
            const int r = r2 * 2 + (wid >> 2), half = (wid >> 1) & 1, qs = wid & 1;
            int kr_lo = r2 * 2 - 4; kr_lo = kr_lo < 0 ? 0 : (kr_lo > 24 ? 24 : kr_lo);
            int kr_hi = r2 * 2 + 1 - 4; kr_hi = (kr_hi < 0 ? 0 : (kr_hi > 24 ? 24 : kr_hi)) + 7;
            int rs = r - 4; rs = rs < 0 ? 0 : (rs > 24 ? 24 : rs);
            float bmax;
            { const float* rp = p.in[I_NA_RPB] + ((size_t)l * 4 + h) * 15 * 31; LAS float* rl = (LAS float*)(lds + ATT_RPB_OFF); float bv = 0.f;
              if (tid < 465) { bv = rp[tid] * LOG2E; rl[tid] = bv; }
              bv = fabsf(bv);
#pragma unroll
              for (int o2 = 32; o2 >= 1; o2 >>= 1) bv = fmaxf(bv, __shfl_xor(bv, o2));
              if (lane == 0) rl[480 + wid] = bv;
              __syncthreads();
              bmax = fmaxf(fmaxf(fmaxf(rl[480], rl[481]), fmaxf(rl[482], rl[483])), fmaxf(fmaxf(rl[484], rl[485]), fmaxf(rl[486], rl[487]))); }
            const int qtok = r * 64 + half * 32 + qs * 16;
            const bf16_t* q = (const bf16_t*)(p.ws + WS_NAQ) + (bh * SEQ + qtok) * 128;
            const bf16_t* k = (const bf16_t*)(p.ws + WS_NAK) + (bh * SEQ + kr_lo * 64) * 128; const bf16_t* v = (const bf16_t*)(p.ws + WS_NAVT) + (bh * 64 + kr_lo * 2) * 128 * 32;
            bf16_t* o = br + (size_t)(b * SEQ + qtok) * DM + 0 + h * 128;
            attn_unit<128, 128, 2, 1>(lds, q, k, v, o, 2 * (kr_hi - kr_lo + 1), 2 * (rs - kr_lo), 2 * (rs - kr_lo) + 16, half * 32 + qs * 16, kr_lo, r, kb_na, bmax, 0.f, tid, lane, O8(o));
        } else if (id < 768) {
            const int u = id - 512, b = u >> 6, kvh = (u >> 5) & 1, qb = u & 31, q0 = qb * 64; const int hq = kvh * 4 + (wid >> 1), qpos0 = q0 + (wid & 1) * 32;
            const int kstart = q0 - 128 < 0 ? 0 : q0 - 128, kend = q0 + 192 > SEQ ? SEQ : q0 + 192, nch = (kend - kstart) >> 5;
            int c_lo = (qpos0 - 128 - kstart) >> 5; c_lo = c_lo < 0 ? 0 : c_lo; int c_hi = ((qpos0 + 159 - kstart) >> 5) + 1; c_hi = c_hi > nch ? nch : c_hi;
            const bf16_t* q = (const bf16_t*)(p.ws + WS_SWQ) + ((size_t)(b * 8 + hq) * SEQ + qpos0) * 64;
            const bf16_t* k = (const bf16_t*)(p.ws + WS_SWK) + ((size_t)(b * 2 + kvh) * SEQ + kstart) * 64; const bf16_t* v = (const bf16_t*)(p.ws + WS_SWVT) + ((size_t)(b * 2 + kvh) * 64 + (kstart >> 5)) * 64 * 32;
            bf16_t* o = br + (size_t)(b * SEQ + qpos0) * DM + 1024 + hq * 64;
            attn_unit<64, 64, 1, 2>(lds, q, k, v, o, nch, c_lo, c_hi, qpos0, kstart, 0, kb_swa, 0.f, p.in[I_SWA_SINK][l * 8 + hq] * LOG2E, tid, lane, O8(o));
        } else {
            const int u = id - 768, b = u >> 5, h = (u >> 3) & 3, qt8 = u & 7; const size_t bh = (size_t)(b * 4 + h);
            const bf16_t* q = (const bf16_t*)(p.ws + WS_MEQ) + (bh * SEQ + qt8 * 256 + wid * 32) * 128;
            const bf16_t* k = (const bf16_t*)(p.ws + WS_MEK) + bh * MEML * 128; const bf16_t* v = (const bf16_t*)(p.ws + WS_MEVT) + bh * MEML * 128;
            bf16_t* o = br + (size_t)(b * SEQ + qt8 * 256 + wid * 32) * DM + 1536 + h * 128;
            attn_unit<128, 128, 0, 2>(lds, q, k, v, o, 8, 0, 8, 0, 0, 0, kb_mem, 0.f, 0.f, tid, lane, O8(o));
        }
    }
}

__device__ __forceinline__ void router_phase(const Params& p, LAS unsigned char* lds, int tid, int wid, int lane) {
    const float* hres = p.out; const float* g = p.in[I_NORM_FFN] + DM; const float* wr = p.in[I_ROUTER];
    unsigned* cnt = (unsigned*)(p.ws + WS_CTL) + CW_MOECNT;
    unsigned char* xg = p.ws + WS_XG; int* tokv = (int*)(p.ws + WS_TOK); float* wtv = (float*)(p.ws + WS_WT);
    LAS float* wl = (LAS float*)lds;
    LAS float* sel = (LAS float*)(lds + 65536);
    for (int i = tid; i < DM * NEXP; i += NTHREADS) { const int d = i >> 3, e = i & 7; wl[e * DM + d] = wr[i]; }
    __syncthreads();
    for (int grp = blockIdx.x; grp < NTOK / 32; grp += gridDim.x) {
#pragma unroll 1
        for (int ti = 0; ti < 4; ++ti) {
            const int tl = wid * 4 + ti, token = grp * 32 + tl;
            const f32x4* sp = (const f32x4*)(hres + (size_t)token * DM); f32x4 v[8]; float ss = 0.f;
#pragma unroll
            for (int j = 0; j < 8; ++j) { v[j] = sp[lane + 64 * j]; ss += v[j][0] * v[j][0] + v[j][1] * v[j][1] + v[j][2] * v[j][2] + v[j][3] * v[j][3]; }
            ss = wave_sum(ss); const float rstd = 1.0f / sqrtf(ss * (1.0f / DM) + EPS);
            float lg[8];
#pragma unroll
            for (int e = 0; e < 8; ++e) lg[e] = 0.f;
#pragma unroll
            for (int j = 0; j < 8; ++j) { const f32x4 gv = ((const f32x4*)g)[lane + 64 * j]; const f32x4 hn = v[j] * rstd * gv;
#pragma unroll
                for (int e = 0; e < 8; ++e) { const f32x4 w4 = *(const LAS f32x4*)(wl + e * DM + 4 * (lane + 64 * j)); lg[e] += hn[0] * w4[0] + hn[1] * w4[1] + hn[2] * w4[2] + hn[3] * w4[3]; } }
#pragma unroll
            for (int e = 0; e < 8; ++e) lg[e] = wave_sum(lg[e]);
            int i0 = 0; float v0 = lg[0];
#pragma unroll
            for (int e = 1; e < 8; ++e) if (lg[e] > v0) { v0 = lg[e]; i0 = e; }
            int i1 = -1; float v1 = -3.0e38f;
#pragma unroll
            for (int e = 0; e < 8; ++e) if (e != i0 && lg[e] > v1) { v1 = lg[e]; i1 = e; }
            const float e1 = __expf(v1 - v0), w0 = 1.0f / (1.0f + e1), w1 = e1 * w0;
            if (lane == 0) { sel[tl * 8 + 0] = __int_as_float(i0); sel[tl * 8 + 1] = __int_as_float(i1); sel[tl * 8 + 2] = w0; sel[tl * 8 + 3] = w1; sel[tl * 8 + 4] = rstd; }
        }
        __syncthreads();
        if (tid < NEXP) { int n = 0;
            for (int t = 0; t < 32; ++t) { n += (__float_as_int(sel[t * 8 + 0]) == tid) ? 1 : 0; n += (__float_as_int(sel[t * 8 + 1]) == tid) ? 1 : 0; }
            int base = n ? (int)__hip_atomic_fetch_add(cnt + tid * 64, (unsigned)n, __ATOMIC_RELAXED, __HIP_MEMORY_SCOPE_AGENT) : 0;
            for (int t = 0; t < 32; ++t) { if (__float_as_int(sel[t * 8 + 0]) == tid) sel[t * 8 + 5] = __int_as_float(base++); if (__float_as_int(sel[t * 8 + 1]) == tid) sel[t * 8 + 6] = __int_as_float(base++); } }
        __syncthreads();
#pragma unroll 1
        for (int ti = 0; ti < 4; ++ti) {
            const int tl = wid * 4 + ti, token = grp * 32 + tl;
            const int e0 = __float_as_int(sel[tl * 8 + 0]), e1 = __float_as_int(sel[tl * 8 + 1]); const float w0 = sel[tl * 8 + 2], w1 = sel[tl * 8 + 3], rstd = sel[tl * 8 + 4];
            const int s0 = e0 * ECAP + __float_as_int(sel[tl * 8 + 5]), s1 = e1 * ECAP + __float_as_int(sel[tl * 8 + 6]);
            const f32x4* sp = (const f32x4*)(hres + (size_t)token * DM);
#pragma unroll
            for (int j = 0; j < 8; ++j) { const f32x4 x = sp[lane + 64 * j]; const f32x4 gv = ((const f32x4*)g)[lane + 64 * j];
#if MOE_FP8
                const float rg = rstd * SC_ACT8; const unsigned w = pg8::pack_fp8x4(x[0] * rg * gv[0], x[1] * rg * gv[1], x[2] * rg * gv[2], x[3] * rg * gv[3]);
                *(unsigned*)(xg + (size_t)s0 * DM + 4 * (lane + 64 * j)) = w; *(unsigned*)(xg + (size_t)s1 * DM + 4 * (lane + 64 * j)) = w; }
#else
                u32x2 w; w.x = cvt_pk_bf16(x[0] * rstd * gv[0], x[1] * rstd * gv[1]); w.y = cvt_pk_bf16(x[2] * rstd * gv[2], x[3] * rstd * gv[3]);
                *(u32x2*)(xg + ((size_t)s0 * DM + 4 * (lane + 64 * j)) * 2) = w; *(u32x2*)(xg + ((size_t)s1 * DM + 4 * (lane + 64 * j)) * 2) = w; }
#endif
            if (lane == 0) { tokv[s0] = token; wtv[s0] = w0; tokv[s1] = token; wtv[s1] = w1; int* ts = (int*)(p.ws + WS_TSLOT); ts[token * 2] = s0; ts[token * 2 + 1] = s1; }
        }
        __syncthreads();
    }
}

constexpr int MOE_TAB_OFF = LDS_MISC + 128;
__device__ __forceinline__ void moe_table(LAS unsigned char* lds, const unsigned* cnt, int nN, int tid) {
    LAS int* tab = (LAS int*)(lds + MOE_TAB_OFF);
    __syncthreads();
    if (tid == 0) { int acc = 0; for (int e = 0; e < 8; ++e) { const int n = ((int)cnt[e * 64] + 255) >> 8; tab[e] = n; tab[8 + e] = acc; acc += n * nN; } tab[16] = acc; }
    __syncthreads();
}
struct SchedMoe {
    const char* A; const char* B; size_t a_estride, b_estride, a_tstride, b_tstride; const LAS int* tab; int G, c; int ksplit; size_t kbytes;
    __device__ __forceinline__ bool next(int i, pg8::Unit& u) const {
        const int L0 = i * G + c; if (L0 >= tab[16] * ksplit) return false;
        const int ks = L0 % ksplit, L = L0 / ksplit;
        int e = 0;
#pragma unroll
        for (int k = 1; k < 8; ++k) e = (L >= tab[8 + k]) ? k : e;
        const int ne = tab[e], loc = L - tab[8 + e], pn = (loc & 7) + 8 * (loc / (8 * ne)), pm = (loc >> 3) % ne;
        u.A = A + (size_t)e * a_estride + (size_t)pm * a_tstride + (size_t)ks * kbytes; u.B = B + (size_t)e * b_estride + (size_t)pn * b_tstride + (size_t)ks * kbytes;
        u.orow = e * ECAP + pm * 256; u.ocol = pn; u.x0 = e; u.x1 = pm * 256; u.ks = ks; u.pad_ = 0; return true;
    }
};
struct SchedMerge {
    const char* br; const char* wb; int G, c; int es;
    __device__ __forceinline__ bool next(int i, pg8::Unit& u) const {
        int pm, pn; if (!pg8::static_tile(i >> 2, G, c, NTOK / 256, DM / 256, pm, pn)) return false;
        const int n = i & 3;
        u.A = br + ((size_t)pm * 256 * DM + n * 512) * es; u.B = wb + ((size_t)n * DM * 512 + (size_t)pn * 256 * 512) * es; u.orow = pm * 256; u.ocol = pn; u.x0 = n; u.x1 = 0; u.ks = 0; u.pad_ = 0; return true;
    }
};

__device__ __forceinline__ void moe_combine(const Params& p, int wid, int lane) {
    const int* ts = (const int*)(p.ws + WS_TSLOT); const bf16_t* y = (const bf16_t*)(p.ws + WS_Y); float* out = p.out;
    for (int row = blockIdx.x * 8 + wid; row < NTOK; row += gridDim.x * 8) {
        const int s0 = ts[row * 2], s1 = ts[row * 2 + 1];
        f32x4* o = (f32x4*)(out + (size_t)row * DM);
        u32x4 a[MOE_KS][4], b[MOE_KS][4]; f32x4 hv[8];
#pragma unroll
        for (int ks = 0; ks < MOE_KS; ++ks) { const u32x4* y0 = (const u32x4*)(y + ((size_t)ks * NEXP * ECAP + s0) * DM); const u32x4* y1 = (const u32x4*)(y + ((size_t)ks * NEXP * ECAP + s1) * DM);
#pragma unroll
            for (int j = 0; j < 4; ++j) { a[ks][j] = y0[lane + 64 * j]; b[ks][j] = y1[lane + 64 * j]; } }
#pragma unroll
        for (int j = 0; j < 4; ++j) { hv[2 * j] = o[2 * (lane + 64 * j)]; hv[2 * j + 1] = o[2 * (lane + 64 * j) + 1]; }
#pragma unroll
        for (int j = 0; j < 4; ++j) {
            f32x4 r0 = hv[2 * j], r1 = hv[2 * j + 1];
#pragma unroll
            for (int ks = 0; ks < MOE_KS; ++ks) { const u32x4 av = a[ks][j], bv = b[ks][j];
                r0[0] += bflo(av.x) + bflo(bv.x); r0[1] += bfhi(av.x) + bfhi(bv.x); r0[2] += bflo(av.y) + bflo(bv.y); r0[3] += bfhi(av.y) + bfhi(bv.y);
                r1[0] += bflo(av.z) + bflo(bv.z); r1[1] += bfhi(av.z) + bfhi(bv.z); r1[2] += bflo(av.w) + bflo(bv.w); r1[3] += bfhi(av.w) + bfhi(bv.w); }
            o[2 * (lane + 64 * j)] = r0; o[2 * (lane + 64 * j) + 1] = r1; }
    }
}

#ifdef PROBE_NAIVE
#ifndef NAIVE_TOL2
#define NAIVE_TOL2 0.0036f
#endif
__device__ __forceinline__ void nv_rope(float& x2, int lane, int pos) {
    const int i = lane & 31; const float freq = exp2f(-(float)i * (13.287712379549449f / 32.0f)); const float ang = (float)pos * freq;
    const double rev = (double)ang * 0.15915494309189535; const float fr_ = (float)(rev - __builtin_rint(rev));
    const float c = __builtin_amdgcn_cosf(fr_), s = __builtin_amdgcn_sinf(fr_); const float pr = __shfl_xor(x2, 32);
    x2 = lane < 32 ? x2 * c - pr * s : x2 * c + pr * s;
}
__device__ __forceinline__ void naive_check(const Params& p, unsigned* flag, int wid, int lane) {
    const int l = 1;
    const bf16_t* z = (const bf16_t*)(p.ws + WS_Z); const bf16_t* qraw = (const bf16_t*)(p.ws + WS_QRAW); const bf16_t* kvraw = (const bf16_t*)(p.ws + WS_KVRAW);
    const bf16_t* memkv = (const bf16_t*)(p.ws + WS_MEMKV) + (size_t)l * NMEM * 1024; const bf16_t* br = (const bf16_t*)(p.ws + WS_BR);
    const int poslist[16] = {0, 1, 31, 63, 64, 65, 127, 128, 129, 500, 1023, 1024, 1500, 1919, 1984, 2047};
    for (int unit = blockIdx.x * 8 + wid; unit < 64 * 20; unit += gridDim.x * 8) {
        const int smp = unit / 20, hh = unit % 20;
        int pos = 0;
#pragma unroll
        for (int q = 0; q < 16; ++q) pos = ((smp >> 2) == q) ? poslist[q] : pos;
        const int b = smp & 3, t = b * SEQ + pos;
        float o[3] = {0.f, 0.f, 0.f}, m = -3.0e38f, lsum = 0.f; float q[3] = {0.f, 0.f, 0.f};
        float ref[3] = {0.f, 0.f, 0.f}; int nd = 2;
        if (hh < 4) {
            const int h = hh; const float* gq = p.in[I_NA_QN] + l * 128; const float* gk = p.in[I_NA_KN] + l * 128;
            float ss = 0.f; for (int j = 0; j < 2; ++j) { q[j] = bf2f(z[(size_t)t * ZC + Z_NAQ + h * 128 + lane + 64 * j]); ss += q[j] * q[j]; }
            ss = wave_sum(ss); for (int j = 0; j < 2; ++j) q[j] *= (1.0f / sqrtf(ss / 128 + EPS)) * gq[lane + 64 * j];
            const int r = pos >> 6, c = pos & 63; int rs = r - 4; rs = rs < 0 ? 0 : (rs > 24 ? 24 : rs); int cs = c - 8; cs = cs < 0 ? 0 : (cs > 48 ? 48 : cs);
            for (int i = 0; i < 8; ++i) for (int jj = 0; jj < 16; ++jj) { const int n = b * SEQ + (rs + i) * 64 + cs + jj;
                float k[2], ks = 0.f; for (int j = 0; j < 2; ++j) { k[j] = bf2f(z[(size_t)n * ZC + Z_NAK + h * 128 + lane + 64 * j]); ks += k[j] * k[j]; }
                ks = wave_sum(ks); float dot = 0.f; for (int j = 0; j < 2; ++j) dot += q[j] * k[j] * (1.0f / sqrtf(ks / 128 + EPS)) * gk[lane + 64 * j];
                const float s = wave_sum(dot) * 0.08838834764831845f + p.in[I_NA_RPB][(((size_t)l * 4 + h) * 15 + (rs + i - r + 7)) * 31 + (cs + jj - c + 15)];
                const float mn = fmaxf(m, s), al = __expf(m - mn), pe = __expf(s - mn); m = mn; lsum = lsum * al + pe;
                for (int j = 0; j < 2; ++j) o[j] = o[j] * al + pe * bf2f(z[(size_t)n * ZC + Z_NAV + h * 128 + lane + 64 * j]); }
            for (int j = 0; j < 2; ++j) ref[j] = bf2f(br[(size_t)t * DM + 0 + h * 128 + lane + 64 * j]);
        } else if (hh < 8) {
            const int h = hh - 4; nd = 3; const float* gq = p.in[I_MLA_QN] + l * 192; const float* gk = p.in[I_MLA_KN] + l * 192;
            float ss = 0.f; for (int j = 0; j < 3; ++j) { q[j] = bf2f(qraw[(size_t)t * 768 + h * 192 + lane + 64 * j]); ss += q[j] * q[j]; }
            ss = wave_sum(ss); for (int j = 0; j < 3; ++j) q[j] *= (1.0f / sqrtf(ss / 192 + EPS)) * gq[lane + 64 * j];
            nv_rope(q[2], lane, pos);
            for (int kp = 0; kp < SEQ; ++kp) { const int n = b * SEQ + kp;
                float k[3], ks = 0.f; k[0] = bf2f(kvraw[(size_t)n * 1024 + h * 256 + lane]); k[1] = bf2f(kvraw[(size_t)n * 1024 + h * 256 + 64 + lane]); k[2] = bf2f(z[(size_t)n * ZC + Z_KPE + lane]);
                for (int j = 0; j < 3; ++j) ks += k[j] * k[j];
                ks = wave_sum(ks); const float rk = 1.0f / sqrtf(ks / 192 + EPS); for (int j = 0; j < 3; ++j) k[j] *= rk * gk[lane + 64 * j];
                nv_rope(k[2], lane, kp);
                float dot = 0.f; for (int j = 0; j < 3; ++j) dot += q[j] * k[j];
                const float s = wave_sum(dot) * 0.07216878364870322f;
                const float mn = fmaxf(m, s), al = __expf(m - mn), pe = __expf(s - mn); m = mn; lsum = lsum * al + pe;
                for (int j = 0; j < 2; ++j) o[j] = o[j] * al + pe * bf2f(kvraw[(size_t)n * 1024 + h * 256 + 128 + lane + 64 * j]); }
            nd = 2;
            for (int j = 0; j < 2; ++j) ref[j] = bf2f(br[(size_t)t * DM + 512 + h * 128 + lane + 64 * j]);
        } else if (hh < 16) {
            const int hq = hh - 8, kvh = hq >> 2; nd = 1; const float* gq = p.in[I_SWA_QN] + l * 64; const float* gk = p.in[I_SWA_KN] + l * 64;
            q[0] = bf2f(z[(size_t)t * ZC + Z_SWQ + hq * 64 + lane]); float ss = wave_sum(q[0] * q[0]); q[0] *= (1.0f / sqrtf(ss / 64 + EPS)) * gq[lane]; nv_rope(q[0], lane, pos);
            for (int kp = pos - 128; kp <= pos + 128; ++kp) { if (kp < 0 || kp >= SEQ) continue; const int n = b * SEQ + kp;
                float k = bf2f(z[(size_t)n * ZC + Z_SWK + kvh * 64 + lane]); const float ks = wave_sum(k * k); k *= (1.0f / sqrtf(ks / 64 + EPS)) * gk[lane]; nv_rope(k, lane, kp);
                const float s = wave_sum(q[0] * k) * 0.125f;
                const float mn = fmaxf(m, s), al = __expf(m - mn), pe = __expf(s - mn); m = mn; lsum = lsum * al + pe;
                o[0] = o[0] * al + pe * bf2f(z[(size_t)n * ZC + Z_SWV + kvh * 64 + lane]); }
            { const float s = p.in[I_SWA_SINK][l * 8 + hq]; const float mn = fmaxf(m, s), al = __expf(m - mn), pe = __expf(s - mn); m = mn; lsum = lsum * al + pe; o[0] *= al; }
            ref[0] = bf2f(br[(size_t)t * DM + 1024 + hq * 64 + lane]);
        } else {
            const int h = hh - 16; const float* gq = p.in[I_MEM_QN] + l * 128; const float* gk = p.in[I_MEM_KN] + l * 128;
            float ss = 0.f; for (int j = 0; j < 2; ++j) { q[j] = bf2f(z[(size_t)t * ZC + Z_MEQ + h * 128 + lane + 64 * j]); ss += q[j] * q[j]; }
            ss = wave_sum(ss); for (int j = 0; j < 2; ++j) q[j] *= (1.0f / sqrtf(ss / 128 + EPS)) * gq[lane + 64 * j];
            for (int mm = 0; mm < MEML; ++mm) { const size_t n = (size_t)(b * MEML + mm) * 1024;
                float k[2], ks = 0.f; for (int j = 0; j < 2; ++j) { k[j] = bf2f(memkv[n + h * 128 + lane + 64 * j]); ks += k[j] * k[j]; }
                ks = wave_sum(ks); float dot = 0.f; for (int j = 0; j < 2; ++j) dot += q[j] * k[j] * (1.0f / sqrtf(ks / 128 + EPS)) * gk[lane + 64 * j];
                const float s = wave_sum(dot) * 0.08838834764831845f;
                const float mn = fmaxf(m, s), al = __expf(m - mn), pe = __expf(s - mn); m = mn; lsum = lsum * al + pe;
                for (int j = 0; j < 2; ++j) o[j] = o[j] * al + pe * bf2f(memkv[n + 512 + h * 128 + lane + 64 * j]); }
            for (int j = 0; j < 2; ++j) ref[j] = bf2f(br[(size_t)t * DM + 1536 + h * 128 + lane + 64 * j]);
        }
        float e2 = 0.f, n2 = 0.f;
        for (int j = 0; j < 3; ++j) if (j < nd) { const float a = o[j] / lsum; e2 += (a - ref[j]) * (a - ref[j]); n2 += a * a; }
        e2 = wave_sum(e2); n2 = wave_sum(n2);
        if (!(e2 <= NAIVE_TOL2 * n2 + 1e-12f) && lane == 0) atomicOr(flag, 1u << (hh < 4 ? 1 : hh < 8 ? 2 : hh < 16 ? 3 : 4));
    }
}
#endif
#ifndef HEAVY_ALIGN
#define HEAVY_ALIGN true
#endif
constexpr int NPHASE = 23;
constexpr int LDS_PARAMS = LDS_MISC + 256;
template <class T> __device__ __forceinline__ T* uni(T* q) { const unsigned long long v = (unsigned long long)q; const unsigned lo = __builtin_amdgcn_readfirstlane((unsigned)v), hi = __builtin_amdgcn_readfirstlane((unsigned)(v >> 32)); return (T*)(__attribute__((address_space(1))) T*)(((unsigned long long)hi << 32) | lo); }
__device__ __forceinline__ Params load_params(LAS unsigned char* lds) {
    unsigned poff = LDS_PARAMS; asm volatile("" : "+v"(poff)); poff = __builtin_amdgcn_readfirstlane(poff);
    const LAS Params* P = (const LAS Params*)(lds + poff); Params p;
#pragma unroll
    for (int i = 0; i < 30; ++i) p.in[i] = uni(P->in[i]);
    p.out = uni(P->out); p.ws = uni(P->ws); p.ph_lo = __builtin_amdgcn_readfirstlane(P->ph_lo); p.ph_hi = __builtin_amdgcn_readfirstlane(P->ph_hi); return p;
}
#define PH_HEAD int tid = threadIdx.x; asm volatile("" : "+v"(tid)); const Params p = load_params(lds); const int lane = tid & 63, wid = __builtin_amdgcn_readfirstlane(tid >> 6); const int G = p.ph_lo, cblk = p.ph_hi;     \
    unsigned char* ws = p.ws; unsigned* ctl = (unsigned*)(ws + WS_CTL); unsigned char* lw = ws + WS_LW + (size_t)l * LW_BYTES; bf16_t* U = (bf16_t*)(ws + WS_U); (void)lane; (void)wid; (void)G; (void)cblk; (void)ctl; (void)lw; (void)U
#define PHASE_FN static __device__ __forceinline__ void

PHASE_FN ph_prologue(LAS unsigned char* lds, int l) { PH_HEAD; p0_prologue(p, lds, tid, wid, lane); }
PHASE_FN ph_ingate(LAS unsigned char* lds, int l) { PH_HEAD;
#if INGATE_FP8
    pg8::SchedGrid S{(const char*)(ws + WS_U8), (const char*)(lw + LW_IN), DM / 2, DM / 2, NTOK / 256, 12288 / 256, G, cblk};
    pg8::EpiInGate E{(bf16_t*)(ws + WS_Z), (bf16_t*)(ws + WS_GATES), p.in[I_B_GATE] + (size_t)l * 8192, 1.0f / (SC_ACT8 * SC_W8)};
    pg8::gemm_phase<pg8::EpiInGate, pg8::SchedGrid, true, HEAVY_ALIGN>(lds, DM / 2, DM / 2, DM / 2, S, E, tid);
#else
    pg8::SchedGrid S{(const char*)U, (const char*)(lw + LW_IN), DM, DM, NTOK / 256, 12288 / 256, G, cblk};
    pg8::EpiInGate E{(bf16_t*)(ws + WS_Z), (bf16_t*)(ws + WS_GATES), p.in[I_B_GATE] + (size_t)l * 8192, 1.0f};
    pg8::gemm_phase(lds, DM, DM, DM, S, E, tid);
#endif
}
PHASE_FN ph_inproj(LAS unsigned char* lds, int l) { PH_HEAD;
    const bool sh = l >= 2; l &= 1; lw = ws + WS_LW + (size_t)l * LW_BYTES;
    pg8::SchedGrid S{(const char*)U, (const char*)(lw + LW_IN), DM, DM, NTOK / 256, ZC / 256, G, cblk};
    pg8::EpiBf16 E{(bf16_t*)(ws + (sh ? WS_ACT : WS_Z)), ZC};
    pg8::gemm_phase(lds, DM, DM, DM, S, E, tid); }
PHASE_FN ph_gates(LAS unsigned char* lds, int l) { PH_HEAD;
#if GATES_FP8
    pg8::SchedGrid S{(const char*)(ws + WS_U8), (const char*)(lw + LW_GATE8), DM / 2, DM / 2, NTOK / 256, 8192 / 256, G, cblk};
    pg8::EpiGates E{(bf16_t*)(ws + WS_GATES), p.in[I_B_GATE] + (size_t)l * 8192, 1.0f / (SC_ACT8 * SC_W8)};
    pg8::gemm_phase<pg8::EpiGates, pg8::SchedGrid, true>(lds, DM / 2, DM / 2, DM / 2, S, E, tid);
#else
    pg8::SchedGrid S{(const char*)U, (const char*)(lw + LW_GATE8), DM, DM, NTOK / 256, 8192 / 256, G, cblk};
    pg8::EpiGates E{(bf16_t*)(ws + WS_GATES), p.in[I_B_GATE] + (size_t)l * 8192, 1.0f};
    pg8::gemm_phase<pg8::EpiGates, pg8::SchedGrid, false>(lds, DM, DM, DM, S, E, tid);
#endif
}
PHASE_FN ph_prep1(LAS unsigned char* lds, int l) { PH_HEAD; prep1(p, l, lds, tid, wid, lane); }
PHASE_FN ph_mlaup_q(LAS unsigned char* lds, int l) { PH_HEAD;
    pg8::SchedGrid S{(const char*)(ws + WS_CQN), (const char*)(lw + LW_UQ), 768, 768, NTOK / 256, 3, G, cblk};
    pg8::EpiBf16 E{(bf16_t*)(ws + WS_QRAW), 768}; pg8::gemm_phase(lds, 768, 768, 768, S, E, tid); }
PHASE_FN ph_mlaup_kv(LAS unsigned char* lds, int l) { PH_HEAD;
    pg8::SchedGrid S{(const char*)(ws + WS_CKVN), (const char*)(lw + LW_UKV), 256, 256, NTOK / 256, 4, G, (cblk + G - 96 % G) % G};
    pg8::EpiBf16 E{(bf16_t*)(ws + WS_KVRAW), 1024}; pg8::gemm_phase(lds, 256, 256, 256, S, E, tid); }
PHASE_FN ph_memkv(LAS unsigned char* lds, int l) { PH_HEAD;
    pg8::SchedGrid S{(const char*)(ws + WS_MEMN + (size_t)l * NMEM * DM * 2), (const char*)(lw + LW_MEMKV), DM, DM, NMEM / 256, 4, G, (cblk + G - (224 + 16 * l) % G) % G};
    pg8::EpiBf16 E{(bf16_t*)(ws + WS_MEMKV) + (size_t)l * NMEM * 1024, 1024}; pg8::gemm_phase(lds, DM, DM, DM, S, E, tid); }
PHASE_FN ph_prep2(LAS unsigned char* lds, int l) { PH_HEAD; prep2(p, l, lds, tid, wid, lane); }
PHASE_FN ph_attn(LAS unsigned char* lds, int l) { PH_HEAD; attn_phase(p, l, lds, tid, wid, lane, G, cblk); }
PHASE_FN ph_merge(LAS unsigned char* lds, int l) { PH_HEAD;
#ifndef MERGE_ALIGN
#define MERGE_ALIGN false
#endif
#if MIX_FP8
    SchedMerge S{(const char*)(ws + WS_BR8), (const char*)(lw + LW_BR), G, cblk, 1};
    pg8::EpiMerge E{(const bf16_t*)(ws + WS_GATES), (bf16_t*)(ws + WS_MERGED), ws + WS_MERGED8, 1.0f / (SC_BR8 * SC_W8), SC_MG8};
    pg8::gemm_phase<pg8::EpiMerge, SchedMerge, true, MERGE_ALIGN>(lds, DM / 2, 256, 256, S, E, tid);
#else
    SchedMerge S{(const char*)(ws + WS_BR), (const char*)(lw + LW_BR), G, cblk, 2};
    pg8::EpiMerge E{(const bf16_t*)(ws + WS_GATES), (bf16_t*)(ws + WS_MERGED), nullptr, 1.0f, 1.0f};
    pg8::gemm_phase<pg8::EpiMerge, SchedMerge, false, MERGE_ALIGN>(lds, DM, 512, 512, S, E, tid);
#endif
}
PHASE_FN ph_wo(LAS unsigned char* lds, int l) { PH_HEAD;
#if MIX_FP8
    pg8::SchedGrid S{(const char*)(ws + WS_MERGED8), (const char*)(lw + LW_O), DM / 2, DM / 2, NTOK / 256, DM / 256, G, cblk};
    pg8::EpiResF32 E{l == 0 ? p.in[I_X] : (const float*)p.out, p.out, 1.0f / (SC_MG8 * SC_W8)};
    pg8::gemm_phase<pg8::EpiResF32, pg8::SchedGrid, true>(lds, DM / 2, DM / 2, DM / 2, S, E, tid);
#else
    pg8::SchedGrid S{(const char*)(ws + WS_MERGED), (const char*)(lw + LW_O), DM, DM, NTOK / 256, DM / 256, G, cblk};
    pg8::EpiResF32 E{l == 0 ? p.in[I_X] : (const float*)p.out, p.out, 1.0f};
    pg8::gemm_phase(lds, DM, DM, DM, S, E, tid);
#endif
}
PHASE_FN ph_norm(LAS unsigned char* lds, int l) { PH_HEAD;
    norm_rows(p.out, l == 0 ? p.in[I_NORM_FFN] : p.in[I_NORM_MIX] + DM, U, l == 0 ? nullptr : ws + WS_U8, NTOK, wid, lane); }
PHASE_FN ph_ffnup(LAS unsigned char* lds, int l) { PH_HEAD;
    pg8::SchedGrid S{(const char*)U, (const char*)(ws + WS_FFNUP), DM, DM, NTOK / 256, 2 * DFF / 256, G, cblk};
    pg8::EpiSwiGLU E{(bf16_t*)(ws + WS_ACT), DFF};
    pg8::gemm_phase<pg8::EpiSwiGLU, pg8::SchedGrid, false, HEAVY_ALIGN>(lds, DM, DM, DM, S, E, tid); }
PHASE_FN ph_ffndown(LAS unsigned char* lds, int l) { PH_HEAD;
    pg8::SchedGrid S{(const char*)(ws + WS_ACT), (const char*)(ws + WS_FFNDN), DFF, DFF, NTOK / 256, DM / 256, G, cblk};
    pg8::EpiResF32 E{(const float*)p.out, p.out, 1.0f};
    pg8::gemm_phase(lds, DFF, DFF, DFF, S, E, tid); }
PHASE_FN ph_router(LAS unsigned char* lds, int l) { PH_HEAD; router_phase(p, lds, tid, wid, lane); }
PHASE_FN ph_moeup(LAS unsigned char* lds, int l) { PH_HEAD;
    moe_table(lds, ctl + CW_MOECNT, 2 * DFFE / 256, tid);
    const SchedMoe S{(const char*)(ws + WS_XG), (const char*)(ws + WS_MOEUP), (size_t)ECAP * DM * MOE_ES, (size_t)2 * DFFE * DM * MOE_ES, (size_t)256 * DM * MOE_ES, (size_t)256 * DM * MOE_ES, (const LAS int*)(lds + MOE_TAB_OFF), G, cblk, 1, 0};
#if MOE_FP8
    pg8::EpiSwiGLU8 E{ws + WS_ACTM, DFFE, 1.0f / (SC_ACT8 * SC_W8), SC_H8};
    pg8::gemm_phase<pg8::EpiSwiGLU8, SchedMoe, true, HEAVY_ALIGN>(lds, DM / 2, DM / 2, DM / 2, S, E, tid);
#else
    pg8::EpiSwiGLU E{(bf16_t*)(ws + WS_ACTM), DFFE};
    pg8::gemm_phase(lds, DM, DM, DM, S, E, tid);
#endif
}
#ifndef MOE_KSPLIT
#define MOE_KSPLIT MOE_KS
#endif
PHASE_FN ph_moedown(LAS unsigned char* lds, int l) { PH_HEAD;
    moe_table(lds, ctl + CW_MOECNT, DM / 256, tid);
    const SchedMoe S{(const char*)(ws + WS_ACTM), (const char*)(ws + WS_MOEDN), (size_t)ECAP * DFFE * MOE_ES, (size_t)DM * DFFE * MOE_ES, (size_t)256 * DFFE * MOE_ES, (size_t)256 * DFFE * MOE_ES, (const LAS int*)(lds + MOE_TAB_OFF), G, cblk, MOE_KSPLIT, (size_t)DFFE * MOE_ES / MOE_KSPLIT};
#if MOE_FP8
    pg8::EpiMoeDownY E{(bf16_t*)(ws + WS_Y), (const float*)(ws + WS_WT), ctl + CW_MOECNT, 1.0f / (SC_H8 * SC_W8)};
    pg8::gemm_phase<pg8::EpiMoeDownY, SchedMoe, true>(lds, DFFE / 2, DFFE / 2, DFFE / 2 / MOE_KSPLIT, S, E, tid);
#else
    pg8::EpiMoeDown E{p.out, (const int*)(ws + WS_TOK), (const float*)(ws + WS_WT), ctl + CW_MOECNT, 1.0f};
    pg8::gemm_phase(lds, DFFE, DFFE, DFFE / MOE_KSPLIT, S, E, tid);
#endif
}


#ifndef PROBE_CHK
#define PROBE_CHK 0
#endif
constexpr int CW_CHKFLAG = 4096 + 2048;
PHASE_FN ph_compare(LAS unsigned char* lds, int l, size_t offa, size_t offb, size_t nbytes) { PH_HEAD;
    const u32x4* a = (const u32x4*)(ws + offa); const u32x4* b = (const u32x4*)(ws + offb); unsigned bad = 0;
    for (size_t i = (size_t)cblk * NTHREADS + tid; i < nbytes / 16; i += (size_t)G * NTHREADS) { const u32x4 x = a[i], y = b[i]; bad |= (x.x ^ y.x) | (x.y ^ y.y) | (x.z ^ y.z) | (x.w ^ y.w); }
    if (bad) atomicOr(ctl + CW_CHKFLAG, 1u); }
#ifdef PROBE_NAIVE
PHASE_FN ph_naive(LAS unsigned char* lds, int l) { PH_HEAD; naive_check(p, ctl + CW_CHKFLAG, wid, lane); }
#endif
PHASE_FN ph_poison(LAS unsigned char* lds, int l) { PH_HEAD;
    if (__hip_atomic_load(ctl + CW_CHKFLAG, __ATOMIC_RELAXED, __HIP_MEMORY_SCOPE_AGENT) != 0u && tid == 0) p.out[cblk] = __builtin_nanf(""); }
PHASE_FN ph_combine(LAS unsigned char* lds, int l) { PH_HEAD; moe_combine(p, wid, lane); }
__global__ void __launch_bounds__(NTHREADS, 2) mk_fwd(Params pk) {
    extern __shared__ __attribute__((aligned(16))) unsigned char lds_raw[];
    LAS unsigned char* lds = (LAS unsigned char*)lds_raw;
    const int tid = threadIdx.x;
    if (tid < 64) ((LAS unsigned*)(lds + LDS_MISC))[tid] = 0u;
    if (tid == 64) { LAS Params* P = (LAS Params*)(lds + LDS_PARAMS);
#pragma unroll
        for (int i = 0; i < 30; ++i) P->in[i] = pk.in[i];
        P->out = pk.out; P->ws = pk.ws; P->ph_lo = (int)gridDim.x; P->ph_hi = (int)blockIdx.x; }
    __syncthreads();
    unsigned* ctl = (unsigned*)(pk.ws + WS_CTL);
#if !MK_MULTI
    (void)xcd_barrier_post(ctl + CW_BAR, (volatile LAS unsigned*)(lds + LDS_MISC));
#endif
#ifdef ONLY_FN
    ONLY_FN(lds, pk.ph_lo); return;
#endif
    const int lo = pk.ph_lo, hi = pk.ph_hi;
#define IN(k) (lo <= (k) && (k) < hi)
#if MK_MULTI
#define SEAM(k) do { } while (0)
#else
#ifndef PROBE_BAR
#define PROBE_BAR 0
#endif
#define SEAM(k) do { for (int rep_ = 0; rep_ < 1 + PROBE_BAR; ++rep_) if (IN((k) + 1)) { const Params q_ = load_params(lds); XcdBarrier b2_; b2_.bar = (unsigned*)(q_.ws + WS_CTL) + CW_BAR; b2_.x = xb_xcc_id(); b2_.st = (volatile LAS unsigned*)(lds + LDS_MISC); xcd_barrier(b2_); } } while (0)
#endif
#ifndef PROBE_P0
#define PROBE_P0 0
#endif
#ifndef PROBE_DUP
#define PROBE_DUP 0
#endif
#define DUP(bit) ((PROBE_DUP >> (bit)) & 1)
#ifndef PROBE_ATTN
#define PROBE_ATTN 0
#endif
#ifndef PROBE_THIN
#define PROBE_THIN 0
#endif
    if (IN(0)) { ph_prologue(lds, 0); if (PROBE_P0) { __syncthreads(); ph_prologue(lds, 0); } SEAM(0); }
#pragma unroll 1
    for (int l = 0; l < DEPTH; ++l) {
        const int pb = 1 + 11 * l;
#ifndef SPLIT_INGATE
#define SPLIT_INGATE 0
#endif
        if (IN(pb + 0)) { if (SPLIT_INGATE == 1) { ph_inproj(lds, l); __syncthreads(); ph_gates(lds, l); } else if (SPLIT_INGATE == 2) { ph_ingate(lds, l); SEAM(pb + 0); ph_inproj(lds, l); } else if (SPLIT_INGATE == 3) { ph_ingate(lds, l); SEAM(pb + 0); ph_gates(lds, l); } else { ph_ingate(lds, l); if (DUP(0)) ph_ingate(lds, l); } if (PROBE_CHK == 2) ph_inproj(lds, l + 2); SEAM(pb + 0);
            if (PROBE_CHK == 2) { ph_compare(lds, l, WS_Z, WS_ACT, (size_t)NTOK * ZC * 2); SEAM(pb + 0); } }
        if (IN(pb + 1)) { ph_prep1(lds, l); if (PROBE_THIN) { __syncthreads(); ph_prep1(lds, l); } SEAM(pb + 1); }
        if (IN(pb + 2)) { for (int rep = 0; rep < 1 + DUP(1); ++rep) { ph_mlaup_q(lds, l); ph_mlaup_kv(lds, l); if (l == 0) { ph_memkv(lds, 0); ph_memkv(lds, 1); } } SEAM(pb + 2); }
        if (IN(pb + 3)) { ph_prep2(lds, l); if (PROBE_THIN) { __syncthreads(); ph_prep2(lds, l); } SEAM(pb + 3); }
        if (IN(pb + 4)) { ph_attn(lds, l); if (PROBE_ATTN || PROBE_CHK == 1) { __syncthreads(); ph_attn(lds, l + 2 + 4 * (PROBE_ATTN > 1 ? PROBE_ATTN - 1 : 0)); } SEAM(pb + 4);
            if (PROBE_CHK == 1) { ph_compare(lds, l, WS_BR, WS_ACT, (size_t)NTOK * DM * 2); SEAM(pb + 4); } }
        if (IN(pb + 5)) { ph_merge(lds, l); if (DUP(2)) ph_merge(lds, l); SEAM(pb + 5); }
        if (IN(pb + 6)) { ph_wo(lds, l); if (DUP(3) && l == 0) ph_wo(lds, l); SEAM(pb + 6); }
        if (l == 0) {
            if (IN(pb + 7)) { ph_norm(lds, 0); if (PROBE_THIN) { __syncthreads(); ph_norm(lds, 0); } SEAM(pb + 7); }
            if (IN(pb + 8)) { ph_ffnup(lds, 0); if (DUP(4)) ph_ffnup(lds, 0); SEAM(pb + 8); }
            if (IN(pb + 9)) { ph_ffndown(lds, 0); SEAM(pb + 9); }
            if (IN(pb + 10)) { ph_norm(lds, 1); if (PROBE_THIN) { __syncthreads(); ph_norm(lds, 1); } SEAM(pb + 10); }
        } else {
            if (IN(pb + 7)) { ph_router(lds, 1); SEAM(pb + 7); }
            if (IN(pb + 8)) { ph_moeup(lds, 1); if (DUP(5)) ph_moeup(lds, 1); SEAM(pb + 8); }
            if (IN(pb + 9)) { ph_moedown(lds, 1); if (DUP(6)) ph_moedown(lds, 1); SEAM(pb + 8); ph_combine(lds, 1);
#ifdef PROBE_NAIVE
                ph_naive(lds, 1); SEAM(pb + 8); ph_poison(lds, 1);
#endif
                if (PROBE_CHK) { SEAM(pb + 8); ph_poison(lds, 1); } }
        }
    }
#undef IN
#undef SEAM
}

extern "C" void kernel_launch(void* const* d_in, const int* in_sizes, int n_in, void* d_out, int out_size, void* d_ws, size_t ws_size, hipStream_t stream) {
    static int grid = 0;
    if (grid == 0) {
        if (n_in != 30 || out_size != NTOK * DM || ws_size < WS_END) { fprintf(stderr, "kernel_launch: unexpected problem (n_in %d, out %d, ws %zu < %zu)\n", n_in, out_size, ws_size, (size_t)WS_END); grid = -1; return; }
        int dev = 0, cus = 0, per_cu = 0;
        if (hipGetDevice(&dev) != hipSuccess || hipDeviceGetAttribute(&cus, hipDeviceAttributeMultiprocessorCount, dev) != hipSuccess) { grid = -1; return; }
        if (hipFuncSetAttribute((const void*)mk_fwd, hipFuncAttributeMaxDynamicSharedMemorySize, LDS_BYTES) != hipSuccess) { fprintf(stderr, "kernel_launch: hipFuncSetAttribute failed\n"); grid = -1; return; }
        if (hipOccupancyMaxActiveBlocksPerMultiprocessor(&per_cu, (const void*)mk_fwd, NTHREADS, LDS_BYTES) != hipSuccess || per_cu < 1) fprintf(stderr, "kernel_launch: occupancy query reports %d\n", per_cu);
        (void)hipGetLastError();
        grid = cus;
    }
    if (grid < 0) return;
    if (hipMemsetAsync((char*)d_ws + WS_CTL, 0, CTL_BYTES, stream) != hipSuccess) return;
    Params a{};
    for (int i = 0; i < 30; ++i) a.in[i] = (const float*)d_in[i];
    a.out = (float*)d_out; a.ws = (unsigned char*)d_ws;
#if MK_MULTI
    for (int ph = 0; ph < NPHASE - 1; ++ph) { a.ph_lo = ph; a.ph_hi = ph + 1; hipLaunchKernelGGL(mk_fwd, dim3(grid), dim3(NTHREADS), LDS_BYTES, stream, a); }
#else
    a.ph_lo = 0; a.ph_hi = NPHASE;
    hipLaunchKernelGGL(mk_fwd, dim3(grid), dim3(NTHREADS), LDS_BYTES, stream, a);
#endif
    const hipError_t le = hipPeekAtLastError();
    if (le != hipSuccess) fprintf(stderr, "kernel_launch: launch failed: %s\n", hipGetErrorName(le));
}
```
